# Optimizing an MI355X kernel written in HIP

```python
import math
import jax, jax.numpy as jnp
from jax import lax
import numpy as np

D_MODEL = 1024
BATCH = 16
SEQ = 2048
DEPTH = 1

MLA_HEADS = 8
MLA_Q_RANK = 256
MLA_KV_RANK = 128
MLA_NOPE_DIM = 64
MLA_ROPE_DIM = 32
MLA_V_DIM = 64
MLA_QK_DIM = MLA_NOPE_DIM + MLA_ROPE_DIM
DIFF_HEADS = 4
DIFF_HEAD_DIM = 64
DIFF_V_DIM = 2 * DIFF_HEAD_DIM
DIFF_QK_COLS = DIFF_HEADS * 2 * DIFF_HEAD_DIM
DIFF_V_COLS = DIFF_HEADS * DIFF_V_DIM
MIX_WIDTH = MLA_HEADS * MLA_V_DIM + DIFF_HEADS * DIFF_V_DIM
IN_SIZES = (MLA_Q_RANK, MLA_KV_RANK, MLA_ROPE_DIM, DIFF_QK_COLS, DIFF_QK_COLS, DIFF_V_COLS)
IN_COLS = sum(IN_SIZES)
IN_SPLITS = tuple(int(s) for s in np.cumsum(IN_SIZES)[:-1])
N_EXPERTS = 32
TOP_K = 4
D_EXPERT = D_MODEL
SWIGLU_LIMIT = 7.0
SWIGLU_ALPHA = 1.702
MOE_BLOCK = 256
ROPE_THETA = 10000.0
NORM_EPS = 1e-6
SUBLN_EPS = 1e-5
Q_BLOCK = 128
N_MOD = 6
MASK_VALUE = -1e30

kernel_name = "hymba_mla_diffattn_moe_adaln_layer"


def rmsnorm(x, g, eps=NORM_EPS):
    xf = x.astype(jnp.float32)
    y = xf * lax.rsqrt(jnp.mean(xf * xf, axis=-1, keepdims=True) + eps)
    return y.astype(x.dtype) * g


def rope_tables(positions, dim):
    inv_freq = ROPE_THETA ** (-jnp.arange(0, dim, 2, dtype=jnp.float32) / dim)
    ang = positions.astype(jnp.float32)[..., None] * inv_freq
    return jnp.cos(ang), jnp.sin(ang)


def apply_rope(x, cos, sin):
    shape = cos.shape[:2] + (1,) * (x.ndim - 3) + cos.shape[2:]
    cs = cos.reshape(shape).astype(x.dtype)
    sn = sin.reshape(shape).astype(x.dtype)
    x1, x2 = jnp.split(x, 2, axis=-1)
    return jnp.concatenate([x1 * cs - x2 * sn, x2 * cs + x1 * sn], axis=-1)


def to_query_blocks(q):
    b, s = q.shape[:2]
    return jnp.swapaxes(q.reshape((b, s // Q_BLOCK, Q_BLOCK) + q.shape[2:]), 0, 1)


def from_query_blocks(o):
    o = jnp.swapaxes(o, 0, 1)
    return o.reshape((o.shape[0], -1) + o.shape[3:])


def causal_mask(i, seq):
    q_pos = i * Q_BLOCK + jnp.arange(Q_BLOCK)
    return jnp.arange(seq)[None, :] <= q_pos[:, None]


def masked_softmax(s, mask):
    return jax.nn.softmax(jnp.where(mask, s.astype(jnp.float32), MASK_VALUE), axis=-1)


def mla_attention(c_q, c_kv, k_rope, g_q_a, w_q_b, g_kv_a, w_kv_b, cos, sin):
    b, s, _ = c_q.shape
    q = (rmsnorm(c_q, g_q_a) @ w_q_b).reshape(b, s, MLA_HEADS, MLA_QK_DIM)
    q = jnp.concatenate([q[..., :MLA_NOPE_DIM], apply_rope(q[..., MLA_NOPE_DIM:], cos, sin)], axis=-1)
    kv = (rmsnorm(c_kv, g_kv_a) @ w_kv_b).reshape(b, s, MLA_HEADS, MLA_NOPE_DIM + MLA_V_DIM)
    k_r = apply_rope(k_rope, cos, sin)
    k = jnp.concatenate(
        [kv[..., :MLA_NOPE_DIM], jnp.broadcast_to(k_r[:, :, None, :], (b, s, MLA_HEADS, MLA_ROPE_DIM))], axis=-1)
    v = kv[..., MLA_NOPE_DIM:]
    scale = MLA_QK_DIM ** -0.5

    def block(args):
        q_blk, i = args
        sc = jnp.einsum('bqhd,bkhd->bhqk', q_blk, k) * scale
        p = masked_softmax(sc, causal_mask(i, s))
        return jnp.einsum('bhqk,bkhd->bqhd', p.astype(v.dtype), v)

    o = lax.map(block, (to_query_blocks(q), jnp.arange(s // Q_BLOCK)))
    return from_query_blocks(o).reshape(b, s, MLA_HEADS * MLA_V_DIM)


def diff_attention(q_d, k_d, v_d, lambda_q1, lambda_k1, lambda_q2, lambda_k2, g_subln, lambda_init, cos, sin):
    b, s, _ = q_d.shape
    q = apply_rope(q_d.reshape(b, s, DIFF_HEADS, 2, DIFF_HEAD_DIM), cos, sin)
    k = apply_rope(k_d.reshape(b, s, DIFF_HEADS, 2, DIFF_HEAD_DIM), cos, sin)
    v = v_d.reshape(b, s, DIFF_HEADS, DIFF_V_DIM)
    lam = (jnp.exp(jnp.sum(lambda_q1.astype(jnp.float32) * lambda_k1.astype(jnp.float32)))
           - jnp.exp(jnp.sum(lambda_q2.astype(jnp.float32) * lambda_k2.astype(jnp.float32)))
           + lambda_init)
    scale = DIFF_HEAD_DIM ** -0.5

    def block(args):
        q_blk, i = args
        sc = jnp.einsum('bqhjd,bkhjd->bhjqk', q_blk, k) * scale
        p = masked_softmax(sc, causal_mask(i, s))
        a = p[:, :, 0] - lam * p[:, :, 1]
        return jnp.einsum('bhqk,bkhe->bqhe', a.astype(v.dtype), v)

    o = from_query_blocks(lax.map(block, (to_query_blocks(q), jnp.arange(s // Q_BLOCK))))
    o = rmsnorm(o, g_subln, SUBLN_EPS) * (1.0 - lambda_init)
    return o.reshape(b, s, DIFF_HEADS * DIFF_V_DIM)


def moe_ffn(h, w_router, b_router, w_gate_up, b_gate_up, w_down, b_down):
    b, s, d = h.shape
    n_tok = b * s
    xt = h.reshape(n_tok, d)
    logits = (xt @ w_router + b_router).astype(jnp.float32)
    top_val, top_idx = lax.top_k(logits, TOP_K)
    gates = jax.nn.softmax(top_val, axis=-1).astype(h.dtype)

    n_assign = n_tok * TOP_K
    n_blocks = -(-n_assign // MOE_BLOCK) + N_EXPERTS
    n_rows = n_blocks * MOE_BLOCK
    flat_e = top_idx.reshape(-1)
    flat_tok = jnp.arange(n_assign, dtype=jnp.int32) // TOP_K
    order = jnp.argsort(flat_e)
    sorted_e = flat_e[order]
    counts = jnp.bincount(flat_e, length=N_EXPERTS)
    padded = ((counts + MOE_BLOCK - 1) // MOE_BLOCK) * MOE_BLOCK
    start_sorted = jnp.cumsum(counts) - counts
    end_padded = jnp.cumsum(padded)
    start_padded = end_padded - padded
    dest = start_padded[sorted_e] + jnp.arange(n_assign) - start_sorted[sorted_e]
    row_tok = jnp.full((n_rows,), n_tok, dtype=jnp.int32).at[dest].set(flat_tok[order])
    row_w = jnp.zeros((n_rows,), h.dtype).at[dest].set(gates.reshape(-1)[order])
    blk_start = jnp.arange(n_blocks) * MOE_BLOCK
    blk_e = jnp.minimum(jnp.sum(blk_start[:, None] >= end_padded[None, :], axis=-1), N_EXPERTS - 1)
    x_rows = jnp.concatenate([xt, jnp.zeros((1, d), xt.dtype)], axis=0)[row_tok]
    x_rows = x_rows.reshape(n_blocks, MOE_BLOCK, d)

    def expert_block(args):
        xb, e = args
        gu = xb @ w_gate_up[e] + b_gate_up[e]
        g, u = jnp.split(gu, 2, axis=-1)
        g = jnp.minimum(g, SWIGLU_LIMIT)
        u = jnp.clip(u, -SWIGLU_LIMIT, SWIGLU_LIMIT)
        act = g * jax.nn.sigmoid(SWIGLU_ALPHA * g) * (u + 1.0)
        return act @ w_down[e] + b_down[e]

    y_rows = lax.map(expert_block, (x_rows, blk_e)).reshape(n_rows, d) * row_w[:, None]
    y = jax.ops.segment_sum(y_rows, row_tok, num_segments=n_tok + 1)[:n_tok]
    return y.reshape(b, s, d)


def setup_inputs(seed: int = 0) -> dict:
    key = jax.random.key(seed)
    ks = jax.random.split(key, 28)

    def nrm(k, shape, scale):
        return jax.random.normal(k, shape, jnp.float32) * scale

    def gain(k, shape):
        return 1.0 + 0.02 * jax.random.normal(k, shape, jnp.float32)

    L = DEPTH
    x = nrm(ks[0], (BATCH, SEQ, D_MODEL), 1.0)
    c = nrm(ks[1], (BATCH, D_MODEL), 1.0)
    offset = jax.random.randint(ks[2], (BATCH, 1), 0, 4096, dtype=jnp.int32)
    positions = offset + jnp.arange(SEQ, dtype=jnp.int32)[None, :]
    return {
        "x": x,
        "c": c,
        "positions": positions,
        "w_ada": nrm(ks[3], (L, D_MODEL, N_MOD * D_MODEL), 0.5 * D_MODEL ** -0.5),
        "b_ada": nrm(ks[4], (L, N_MOD * D_MODEL), 0.02),
        "g_mix_pre": gain(ks[5], (L, D_MODEL)),
        "g_mix_post": gain(ks[6], (L, D_MODEL)),
        "w_in": nrm(ks[7], (L, D_MODEL, IN_COLS), D_MODEL ** -0.5),
        "g_q_a": gain(ks[8], (L, MLA_Q_RANK)),
        "w_q_b": nrm(ks[9], (L, MLA_Q_RANK, MLA_HEADS * MLA_QK_DIM), MLA_Q_RANK ** -0.5),
        "g_kv_a": gain(ks[10], (L, MLA_KV_RANK)),
        "w_kv_b": nrm(ks[11], (L, MLA_KV_RANK, MLA_HEADS * (MLA_NOPE_DIM + MLA_V_DIM)), MLA_KV_RANK ** -0.5),
        "lambda_q1": nrm(ks[12], (L, DIFF_HEAD_DIM), 0.1),
        "lambda_k1": nrm(ks[13], (L, DIFF_HEAD_DIM), 0.1),
        "lambda_q2": nrm(ks[14], (L, DIFF_HEAD_DIM), 0.1),
        "lambda_k2": nrm(ks[15], (L, DIFF_HEAD_DIM), 0.1),
        "g_subln": gain(ks[16], (L, DIFF_V_DIM)),
        "w_o": nrm(ks[17], (L, MIX_WIDTH, D_MODEL), MIX_WIDTH ** -0.5),
        "g_ffn_pre": gain(ks[18], (L, D_MODEL)),
        "g_ffn_post": gain(ks[19], (L, D_MODEL)),
        "w_router": nrm(ks[20], (L, D_MODEL, N_EXPERTS), D_MODEL ** -0.5),
        "b_router": nrm(ks[21], (L, N_EXPERTS), 0.01),
        "w_gate_up": nrm(ks[22], (L, N_EXPERTS, D_MODEL, 2 * D_EXPERT), D_MODEL ** -0.5),
        "b_gate_up": nrm(ks[23], (L, N_EXPERTS, 2 * D_EXPERT), 0.02),
        "w_down": nrm(ks[24], (L, N_EXPERTS, D_EXPERT, D_MODEL), D_EXPERT ** -0.5),
        "b_down": nrm(ks[25], (L, N_EXPERTS, D_MODEL), 0.02),
    }


def reference(x, c, positions, w_ada, b_ada, g_mix_pre, g_mix_post, w_in, g_q_a, w_q_b, g_kv_a, w_kv_b,
              lambda_q1, lambda_k1, lambda_q2, lambda_k2, g_subln, w_o, g_ffn_pre, g_ffn_post,
              w_router, b_router, w_gate_up, b_gate_up, w_down, b_down):
    b, s, _ = x.shape
    cos_mla, sin_mla = rope_tables(positions, MLA_ROPE_DIM)
    cos_diff, sin_diff = rope_tables(positions, DIFF_HEAD_DIM)
    c_act = jax.nn.silu(c)
    for l in range(DEPTH):
        lambda_init = 0.8 - 0.6 * math.exp(-0.3 * l)
        mod = c_act @ w_ada[l] + b_ada[l]
        shift_m, scale_m, gate_m, shift_f, scale_f, gate_f = jnp.split(mod[:, None, :], N_MOD, axis=-1)

        h = rmsnorm(x, g_mix_pre[l]) * (1.0 + scale_m) + shift_m
        proj = h @ w_in[l]
        c_q, c_kv, k_rope, q_d, k_d, v_d = jnp.split(proj, IN_SPLITS, axis=-1)
        o_mla = mla_attention(c_q, c_kv, k_rope, g_q_a[l], w_q_b[l], g_kv_a[l], w_kv_b[l], cos_mla, sin_mla)
        o_diff = diff_attention(q_d, k_d, v_d, lambda_q1[l], lambda_k1[l], lambda_q2[l], lambda_k2[l],
                                g_subln[l], lambda_init, cos_diff, sin_diff)
        y = jnp.concatenate([o_mla, o_diff], axis=-1) @ w_o[l]
        x = x + gate_m * rmsnorm(y, g_mix_post[l])

        h = rmsnorm(x, g_ffn_pre[l]) * (1.0 + scale_f) + shift_f
        y = moe_ffn(h, w_router[l], b_router[l], w_gate_up[l], b_gate_up[l], w_down[l], b_down[l])
        x = x + gate_f * rmsnorm(y, g_ffn_post[l])
    return x
```

```cpp
#include <hip/hip_runtime.h>
#include <cstdio>
#include <cstdint>

namespace nv {
constexpr int D = 1024, B = 16, S = 2048, T = B * S;
constexpr int INC = 1952;
constexpr int C_CQ = 0, C_CKV = 256, C_KR = 384, C_QD = 416, C_KD = 928, C_VD = 1440;
constexpr int NE = 32, TOPK = 4, NA = T * TOPK;
constexpr int NROWS = (NA / 256 + NE) * 256;
constexpr float LAMBDA_INIT = 0.2f;
constexpr size_t MiB = 1u << 20;
constexpr size_t W_CTL = 0, W_MOD = 1 * MiB, W_TABM = 2 * MiB, W_TABD = 6 * MiB, W_TOPI = 14 * MiB, W_TOPG = 15 * MiB,
                 W_POSE = 16 * MiB, W_ROWTOK = 17 * MiB, W_ROWW = 18 * MiB, W_TILEE = 19 * MiB,
                 W_ATT = 20 * MiB, W_H = 148 * MiB, W_PROJ = 276 * MiB,
                 W_QM = 532 * MiB, W_KM = 628 * MiB, W_VM = 724 * MiB, W_KVRAW = 788 * MiB, W_QRAW = 916 * MiB,
                 W_QD = 532 * MiB, W_KD = 596 * MiB, W_VD = 660 * MiB, W_TD = 724 * MiB,
                 W_Y = 148 * MiB, W_H2 = 276 * MiB, W_Y2 = 20 * MiB, W_ACT = 404 * MiB, W_END = 948 * MiB;

__device__ __forceinline__ float wave_sum(float v) {
#pragma unroll
    for (int o = 1; o < 64; o <<= 1) v += __shfl_xor(v, o);
    return v;
}

__global__ void k_mod(const float* c, const float* w_ada, const float* b_ada, float* mod) {
    const int n = blockIdx.x * 256 + threadIdx.x, b = blockIdx.y;
    float acc = 0.f;
    for (int k = 0; k < D; ++k) { const float cv = c[b * D + k]; acc += (cv / (1.f + expf(-cv))) * w_ada[(size_t)k * 6 * D + n]; }
    mod[b * 6 * D + n] = acc + b_ada[n];
}
__global__ void k_tab(const int* pos, float2* tabm, float2* tabd) {
    const int gid = blockIdx.x * 256 + threadIdx.x;
    if (gid >= T * 48) return;
    const int t = gid / 48, i = gid % 48;
    const double p = (double)pos[t];
    if (i < 16) { const float inv = powf(10000.f, -(float)(2 * i) / 32.f); const float a = (float)p * inv; tabm[t * 16 + i] = make_float2((float)cos((double)a), (float)sin((double)a)); }
    else { const int j = i - 16; const float inv = powf(10000.f, -(float)(2 * j) / 64.f); const float a = (float)p * inv; tabd[t * 32 + j] = make_float2((float)cos((double)a), (float)sin((double)a)); }
}
__global__ void k_norm1(const float* x, const float* g, const float* mod, float* h) {
    const int row = blockIdx.x * 4 + (threadIdx.x >> 6), lane = threadIdx.x & 63, b = row / S;
    const float* xr = x + (size_t)row * D; float v[16]; float ss = 0.f;
#pragma unroll
    for (int j = 0; j < 16; ++j) { v[j] = xr[lane + 64 * j]; ss += v[j] * v[j]; }
    const float r = rsqrtf(wave_sum(ss) * (1.f / D) + 1e-6f);
    const float* sh = mod + b * 6 * D, *sc = sh + D;
#pragma unroll
    for (int j = 0; j < 16; ++j) { const int cidx = lane + 64 * j; h[(size_t)row * D + cidx] = v[j] * r * g[cidx] * (1.f + sc[cidx]) + sh[cidx]; }
}

template <class Epi, bool GATHER, bool DUAL, bool GROUPED>
__global__ void __launch_bounds__(256) k_gemm(const float* A, const int* rowidx, const float* Bm, const int* tile_e, size_t bstride,
                                               int lda, int ldb, int N, int K, int dualoff, int pad_, Epi epi) {
    __shared__ float As[16][68]; __shared__ float Bs[16][64]; __shared__ float Bs2[DUAL ? 16 : 1][64];
    const int tid = threadIdx.x, tx = tid & 15, ty = tid >> 4, m0 = blockIdx.y * 64, n0 = blockIdx.x * 64;
    int e = 0;
    if (GROUPED) { e = tile_e[blockIdx.y]; if (e < 0) return; }
    const float* Bp = Bm + (size_t)e * bstride;
    const int ar = tid >> 2, ak = (tid & 3) * 4;
    size_t arow = GATHER ? (size_t)rowidx[m0 + ar] : (size_t)(m0 + ar);
    const float* ap = A + arow * lda + ak;
    const int bk = tid >> 4, bn = (tid & 15) * 4;
    const bool bok = (n0 + bn) < N;
    float acc[4][4] = {}, acc2[4][4] = {};
    for (int k0 = 0; k0 < K; k0 += 16) {
        const float4 av = *(const float4*)(ap + k0);
        As[ak + 0][ar] = av.x; As[ak + 1][ar] = av.y; As[ak + 2][ar] = av.z; As[ak + 3][ar] = av.w;
        float4 bv = make_float4(0, 0, 0, 0), bv2 = bv;
        if (bok) { bv = *(const float4*)(Bp + (size_t)(k0 + bk) * ldb + n0 + bn); if (DUAL) bv2 = *(const float4*)(Bp + (size_t)(k0 + bk) * ldb + dualoff + n0 + bn); }
        *(float4*)&Bs[bk][bn] = bv; if (DUAL) *(float4*)&Bs2[bk][bn] = bv2;
        __syncthreads();
#pragma unroll
        for (int kk = 0; kk < 16; ++kk) {
            const float4 a4 = *(const float4*)&As[kk][ty * 4]; const float4 b4 = *(const float4*)&Bs[kk][tx * 4];
            const float a_[4] = {a4.x, a4.y, a4.z, a4.w}, b_[4] = {b4.x, b4.y, b4.z, b4.w};
#pragma unroll
            for (int i = 0; i < 4; ++i)
#pragma unroll
                for (int j = 0; j < 4; ++j) acc[i][j] += a_[i] * b_[j];
            if (DUAL) { const float4 c4 = *(const float4*)&Bs2[kk][tx * 4]; const float c_[4] = {c4.x, c4.y, c4.z, c4.w};
#pragma unroll
                for (int i = 0; i < 4; ++i)
#pragma unroll
                    for (int j = 0; j < 4; ++j) acc2[i][j] += a_[i] * c_[j]; }
        }
        __syncthreads();
    }
#pragma unroll
    for (int i = 0; i < 4; ++i)
#pragma unroll
        for (int j = 0; j < 4; ++j) { const int r = m0 + ty * 4 + i, cc = n0 + tx * 4 + j; if (cc < N) epi(r, cc, e, acc[i][j], acc2[i][j]); }
}
struct EpiStore { float* C; int ldc; int pad; __device__ void operator()(int r, int c, int, float v, float) const { C[(size_t)r * ldc + c] = v; } };
struct EpiAct { float* C; const float* bgu; __device__ void operator()(int r, int c, int e, float g, float u) const {
    g += bgu[(size_t)e * 2048 + c]; u += bgu[(size_t)e * 2048 + 1024 + c];
    g = fminf(g, 7.f); u = fminf(fmaxf(u, -7.f), 7.f);
    C[(size_t)r * 1024 + c] = g * (1.f / (1.f + expf(-1.702f * g))) * (u + 1.f); } };
struct EpiDown { float* Y2; const float* bd; const int* rowtok; const float* roww; __device__ void operator()(int r, int c, int e, float v, float) const {
    const float w = roww[r]; if (w != 0.f) atomicAdd(&Y2[(size_t)rowtok[r] * 1024 + c], (v + bd[(size_t)e * 1024 + c]) * w); } };

__global__ void k_rms_cols(float* proj, int c0, int n, const float* g) {
    const int row = blockIdx.x * 4 + (threadIdx.x >> 6), lane = threadIdx.x & 63;
    float* p = proj + (size_t)row * INC + c0; float v[4]; float ss = 0.f; const int per = n / 64;
    for (int j = 0; j < per; ++j) { v[j] = p[lane + 64 * j]; ss += v[j] * v[j]; }
    const float r = rsqrtf(wave_sum(ss) / (float)n + 1e-6f);
    for (int j = 0; j < per; ++j) p[lane + 64 * j] = v[j] * r * g[lane + 64 * j];
}
__global__ void k_pack_mla(const float* qraw, const float* kvraw, const float* proj, const float2* tabm, float* QM, float* KM, float* VM) {
    const int t = blockIdx.x, b = t / S, s = t % S, tid = threadIdx.x;
    for (int i = tid; i < 8 * 96; i += 256) { const int h = i / 96, d = i % 96; float v;
        const float* q = qraw + (size_t)t * 768 + h * 96;
        if (d < 64) v = q[d]; else { const int r = d - 64; const float2 cs = tabm[t * 16 + (r & 15)]; const float x1 = q[64 + (r & 15)], x2 = q[64 + 16 + (r & 15)]; v = r < 16 ? x1 * cs.x - x2 * cs.y : x2 * cs.x + x1 * cs.y; }
        QM[(((size_t)b * 8 + h) * S + s) * 96 + d] = v;
        float kvv;
        if (d < 64) kvv = kvraw[(size_t)t * 1024 + h * 128 + d]; else { const int r = d - 64; const float* kr = proj + (size_t)t * INC + C_KR; const float2 cs = tabm[t * 16 + (r & 15)]; const float x1 = kr[r & 15], x2 = kr[16 + (r & 15)]; kvv = r < 16 ? x1 * cs.x - x2 * cs.y : x2 * cs.x + x1 * cs.y; }
        KM[(((size_t)b * 8 + h) * S + s) * 96 + d] = kvv; }
    for (int i = tid; i < 8 * 64; i += 256) { const int h = i / 64, d = i % 64; VM[(((size_t)b * 8 + h) * S + s) * 64 + d] = kvraw[(size_t)t * 1024 + h * 128 + 64 + d]; }
}
__global__ void k_pack_diff(const float* proj, const float2* tabd, float* QD, float* KD, float* VD) {
    const int t = blockIdx.x, b = t / S, s = t % S, tid = threadIdx.x;
    for (int i = tid; i < 512; i += 256) { const int hj = i / 64, d = i % 64, r = d & 31; const float2 cs = tabd[t * 32 + r];
        const float* q = proj + (size_t)t * INC + C_QD + hj * 64; const float* k = proj + (size_t)t * INC + C_KD + hj * 64;
        const float qv = d < 32 ? q[r] * cs.x - q[32 + r] * cs.y : q[32 + r] * cs.x + q[r] * cs.y;
        const float kv = d < 32 ? k[r] * cs.x - k[32 + r] * cs.y : k[32 + r] * cs.x + k[r] * cs.y;
        QD[(((size_t)b * 8 + hj) * S + s) * 64 + d] = qv; KD[(((size_t)b * 8 + hj) * S + s) * 64 + d] = kv; }
    for (int i = tid; i < 512; i += 256) { const int h = i / 128, d = i % 128; VD[(((size_t)b * 4 + h) * S + s) * 128 + d] = proj[(size_t)t * INC + C_VD + i]; }
}
template <int DQK, int DV>
__global__ void __launch_bounds__(256) k_attn(const float* Q, const float* K, const float* V, float* O, int nh, int vdiv, float scale, int ostride, int ohstride) {
    __shared__ float Ks[32][DQK]; __shared__ float Vs[32][DV];
    const int bh = blockIdx.y, b = bh / nh, h = bh % nh, q = blockIdx.x * 256 + threadIdx.x, tid = threadIdx.x;
    const float* qp = Q + ((size_t)bh * S + q) * DQK; const float* Kb = K + (size_t)bh * S * DQK; const float* Vb = V + (size_t)(b * (nh / vdiv) + h / vdiv) * S * DV;
    float qv[DQK]; float o[DV];
#pragma unroll
    for (int d = 0; d < DQK; ++d) qv[d] = qp[d] * scale;
#pragma unroll
    for (int d = 0; d < DV; ++d) o[d] = 0.f;
    float m = -1e30f, l = 0.f;
    const int kend = blockIdx.x * 256 + 256;
    for (int k0 = 0; k0 < kend; k0 += 32) {
        __syncthreads();
        for (int i = tid; i < 32 * DQK; i += 256) Ks[i / DQK][i % DQK] = Kb[(size_t)k0 * DQK + i];
        for (int i = tid; i < 32 * DV; i += 256) Vs[i / DV][i % DV] = Vb[(size_t)k0 * DV + i];
        __syncthreads();
        for (int kk = 0; kk < 32; ++kk) {
            if (k0 + kk > q) break;
            float s = 0.f;
#pragma unroll
            for (int d = 0; d < DQK; ++d) s += qv[d] * Ks[kk][d];
            const float mn = fmaxf(m, s), al = expf(m - mn), p = expf(s - mn);
            l = l * al + p; m = mn;
#pragma unroll
            for (int d = 0; d < DV; ++d) o[d] = o[d] * al + p * Vs[kk][d];
        }
    }
    const float inv = 1.f / l; float* op = O + (size_t)(b * S + q) * ostride + h * ohstride;
#pragma unroll
    for (int d = 0; d < DV; ++d) op[d] = o[d] * inv;
}
__global__ void k_diff_comb(const float* TD, const float* lq1, const float* lk1, const float* lq2, const float* lk2, const float* g, float* att) {
    const int gw = blockIdx.x * 4 + (threadIdx.x >> 6), lane = threadIdx.x & 63, t = gw / 4, h = gw % 4;
    float s1 = lq1[lane] * lk1[lane], s2 = lq2[lane] * lk2[lane]; s1 = wave_sum(s1); s2 = wave_sum(s2);
    const float lam = expf(s1) - expf(s2) + LAMBDA_INIT;
    const float* o0 = TD + ((size_t)t * 8 + h * 2) * 128, *o1 = o0 + 128;
    const float a = o0[lane] - lam * o1[lane], b2 = o0[lane + 64] - lam * o1[lane + 64];
    const float r = rsqrtf(wave_sum(a * a + b2 * b2) * (1.f / 128.f) + 1e-5f);
    att[(size_t)t * D + 512 + h * 128 + lane] = a * r * g[lane] * (1.f - LAMBDA_INIT);
    att[(size_t)t * D + 512 + h * 128 + 64 + lane] = b2 * r * g[lane + 64] * (1.f - LAMBDA_INIT);
}
__global__ void k_norm2(const float* x, const float* y, const float* mod, const float* gpost, const float* gpre, const float* wr, const float* br,
                        float* x1, float* h2, int* topi, float* topg) {
    const int row = blockIdx.x * 4 + (threadIdx.x >> 6), lane = threadIdx.x & 63, b = row / S;
    const float* md = mod + b * 6 * D; float v[16], hv[16]; float ss = 0.f;
#pragma unroll
    for (int j = 0; j < 16; ++j) { v[j] = y[(size_t)row * D + lane + 64 * j]; ss += v[j] * v[j]; }
    float r = rsqrtf(wave_sum(ss) * (1.f / D) + 1e-6f); ss = 0.f;
#pragma unroll
    for (int j = 0; j < 16; ++j) { const int c = lane + 64 * j; v[j] = x[(size_t)row * D + c] + md[2 * D + c] * (v[j] * r * gpost[c]); x1[(size_t)row * D + c] = v[j]; ss += v[j] * v[j]; }
    r = rsqrtf(wave_sum(ss) * (1.f / D) + 1e-6f);
#pragma unroll
    for (int j = 0; j < 16; ++j) { const int c = lane + 64 * j; hv[j] = v[j] * r * gpre[c] * (1.f + md[4 * D + c]) + md[3 * D + c]; h2[(size_t)row * D + c] = hv[j]; }
    float lg = 0.f;
    for (int e = 0; e < NE; ++e) { float p = 0.f;
#pragma unroll
        for (int j = 0; j < 16; ++j) p += hv[j] * wr[(size_t)(lane + 64 * j) * NE + e];
        p = wave_sum(p) + br[e]; if (lane == e) lg = p; }
    float vals[4]; int idx[4]; unsigned long long used = 0ull;
    for (int k = 0; k < 4; ++k) { float best = -INFINITY; int bi = 0;
        for (int e = 0; e < NE; ++e) { const float le = __shfl(lg, e); if (!((used >> e) & 1ull) && le > best) { best = le; bi = e; } }
        vals[k] = best; idx[k] = bi; used |= 1ull << bi; }
    const float mx = vals[0]; float den = 0.f, ex[4];
    for (int k = 0; k < 4; ++k) { ex[k] = expf(vals[k] - mx); den += ex[k]; }
    if (lane < 4) { topi[row * 4 + lane] = idx[lane]; topg[row * 4 + lane] = ex[lane] / den; }
}
__global__ void k_count(const int* topi, int* cnt, int* pose) { const int a = blockIdx.x * 256 + threadIdx.x; pose[a] = atomicAdd(&cnt[topi[a]], 1); }
__global__ void k_offsets(const int* cnt, int* startp, int* tile_e) {
    if (threadIdx.x == 0) { int acc = 0; for (int e = 0; e < NE; ++e) { startp[e] = acc; const int pad = (cnt[e] + 255) / 256 * 256; for (int r = acc; r < acc + pad; r += 64) tile_e[r / 64] = e; acc += pad; }
        startp[NE] = acc; for (int r = acc; r < NROWS; r += 64) tile_e[r / 64] = -1; }
}
__global__ void k_fill(int* rowtok, float* roww) { const int r = blockIdx.x * 256 + threadIdx.x; if (r < NROWS) { rowtok[r] = 0; roww[r] = 0.f; } }
__global__ void k_scatter(const int* topi, const float* topg, const int* pose, const int* startp, int* rowtok, float* roww) {
    const int a = blockIdx.x * 256 + threadIdx.x; const int d = startp[topi[a]] + pose[a]; rowtok[d] = a / TOPK; roww[d] = topg[a]; }
__global__ void k_final(const float* x1, const float* y2, const float* mod, const float* gpost, float* out) {
    const int row = blockIdx.x * 4 + (threadIdx.x >> 6), lane = threadIdx.x & 63, b = row / S;
    const float* md = mod + b * 6 * D; float v[16]; float ss = 0.f;
#pragma unroll
    for (int j = 0; j < 16; ++j) { v[j] = y2[(size_t)row * D + lane + 64 * j]; ss += v[j] * v[j]; }
    const float r = rsqrtf(wave_sum(ss) * (1.f / D) + 1e-6f);
#pragma unroll
    for (int j = 0; j < 16; ++j) { const int c = lane + 64 * j; out[(size_t)row * D + c] = x1[(size_t)row * D + c] + md[5 * D + c] * (v[j] * r * gpost[c]); }
}
}

extern "C" void kernel_launch(void* const* d_in, const int* in_sizes, int n_in, void* d_out, int out_size, void* d_ws, size_t ws_size, hipStream_t stream) {
    using namespace nv;
    if (n_in != 26 || ws_size < W_END) { fprintf(stderr, "kernel_launch: unexpected n_in %d / ws %zu\n", n_in, ws_size); return; }
    const float* x = (const float*)d_in[0]; const float* c = (const float*)d_in[1]; const int* pos = (const int*)d_in[2];
    const float* w_ada = (const float*)d_in[3]; const float* b_ada = (const float*)d_in[4]; const float* g_mix_pre = (const float*)d_in[5]; const float* g_mix_post = (const float*)d_in[6];
    const float* w_in = (const float*)d_in[7]; const float* g_q_a = (const float*)d_in[8]; const float* w_q_b = (const float*)d_in[9]; const float* g_kv_a = (const float*)d_in[10]; const float* w_kv_b = (const float*)d_in[11];
    const float* lq1 = (const float*)d_in[12]; const float* lk1 = (const float*)d_in[13]; const float* lq2 = (const float*)d_in[14]; const float* lk2 = (const float*)d_in[15];
    const float* g_subln = (const float*)d_in[16]; const float* w_o = (const float*)d_in[17]; const float* g_ffn_pre = (const float*)d_in[18]; const float* g_ffn_post = (const float*)d_in[19];
    const float* w_router = (const float*)d_in[20]; const float* b_router = (const float*)d_in[21]; const float* w_gu = (const float*)d_in[22]; const float* b_gu = (const float*)d_in[23];
    const float* w_dn = (const float*)d_in[24]; const float* b_dn = (const float*)d_in[25];
    char* ws = (char*)d_ws; float* out = (float*)d_out;
    int* cnt = (int*)(ws + W_CTL); int* startp = cnt + 64; float* mod = (float*)(ws + W_MOD); float2* tabm = (float2*)(ws + W_TABM); float2* tabd = (float2*)(ws + W_TABD);
    int* topi = (int*)(ws + W_TOPI); float* topg = (float*)(ws + W_TOPG); int* pose = (int*)(ws + W_POSE); int* rowtok = (int*)(ws + W_ROWTOK); float* roww = (float*)(ws + W_ROWW); int* tile_e = (int*)(ws + W_TILEE);
    float* ATT = (float*)(ws + W_ATT); float* H = (float*)(ws + W_H); float* PROJ = (float*)(ws + W_PROJ); float* QM = (float*)(ws + W_QM); float* KM = (float*)(ws + W_KM); float* VM = (float*)(ws + W_VM);
    float* KVRAW = (float*)(ws + W_KVRAW); float* QRAW = (float*)(ws + W_QRAW); float* QD = (float*)(ws + W_QD); float* KD = (float*)(ws + W_KD); float* VD = (float*)(ws + W_VD); float* TD = (float*)(ws + W_TD);
    float* Y = (float*)(ws + W_Y); float* H2 = (float*)(ws + W_H2); float* Y2 = (float*)(ws + W_Y2); float* ACT = (float*)(ws + W_ACT);

    (void)hipMemsetAsync(ws + W_CTL, 0, 4096, stream);
    k_mod<<<dim3(6 * D / 256, B), 256, 0, stream>>>(c, w_ada, b_ada, mod);
    k_tab<<<(T * 48 + 255) / 256, 256, 0, stream>>>(pos, tabm, tabd);
    k_norm1<<<T / 4, 256, 0, stream>>>(x, g_mix_pre, mod, H);
    k_gemm<EpiStore, false, false, false><<<dim3((INC + 63) / 64, T / 64), 256, 0, stream>>>(H, nullptr, w_in, nullptr, 0, D, INC, INC, D, 0, 0, EpiStore{PROJ, INC, 0});
    k_rms_cols<<<T / 4, 256, 0, stream>>>(PROJ, C_CQ, 256, g_q_a);
    k_rms_cols<<<T / 4, 256, 0, stream>>>(PROJ, C_CKV, 128, g_kv_a);
    k_gemm<EpiStore, false, false, false><<<dim3(768 / 64, T / 64), 256, 0, stream>>>(PROJ + C_CQ, nullptr, w_q_b, nullptr, 0, INC, 768, 768, 256, 0, 0, EpiStore{QRAW, 768, 0});
    k_gemm<EpiStore, false, false, false><<<dim3(1024 / 64, T / 64), 256, 0, stream>>>(PROJ + C_CKV, nullptr, w_kv_b, nullptr, 0, INC, 1024, 1024, 128, 0, 0, EpiStore{KVRAW, 1024, 0});
    k_pack_mla<<<T, 256, 0, stream>>>(QRAW, KVRAW, PROJ, tabm, QM, KM, VM);
    k_attn<96, 64><<<dim3(S / 256, B * 8), 256, 0, stream>>>(QM, KM, VM, ATT, 8, 1, 0.10206207261596577f, D, 64);
    k_pack_diff<<<T, 256, 0, stream>>>(PROJ, tabd, QD, KD, VD);
    k_attn<64, 128><<<dim3(S / 256, B * 8), 256, 0, stream>>>(QD, KD, VD, TD, 8, 2, 0.125f, 1024, 128);
    k_diff_comb<<<T, 256, 0, stream>>>(TD, lq1, lk1, lq2, lk2, g_subln, ATT);
    k_gemm<EpiStore, false, false, false><<<dim3(D / 64, T / 64), 256, 0, stream>>>(ATT, nullptr, w_o, nullptr, 0, D, D, D, D, 0, 0, EpiStore{Y, D, 0});
    k_norm2<<<T / 4, 256, 0, stream>>>(x, Y, mod, g_mix_post, g_ffn_pre, w_router, b_router, out, H2, topi, topg);
    k_count<<<NA / 256, 256, 0, stream>>>(topi, cnt, pose);
    k_offsets<<<1, 64, 0, stream>>>(cnt, startp, tile_e);
    k_fill<<<(NROWS + 255) / 256, 256, 0, stream>>>(rowtok, roww);
    k_scatter<<<NA / 256, 256, 0, stream>>>(topi, topg, pose, startp, rowtok, roww);
    (void)hipMemsetAsync(Y2, 0, (size_t)T * D * 4, stream);
    k_gemm<EpiAct, true, true, true><<<dim3(1024 / 64, NROWS / 64), 256, 0, stream>>>(H2, rowtok, w_gu, tile_e, (size_t)1024 * 2048, D, 2048, 1024, D, 1024, 0, EpiAct{ACT, b_gu});
    k_gemm<EpiDown, false, false, true><<<dim3(1024 / 64, NROWS / 64), 256, 0, stream>>>(ACT, nullptr, w_dn, tile_e, (size_t)1024 * 1024, D, 1024, 1024, D, 0, 0, EpiDown{Y2, b_dn, rowtok, roww});
    k_final<<<T / 4, 256, 0, stream>>>(out, Y2, mod, g_ffn_post, out);
}
```

```cpp
#include <hip/hip_runtime.h>
#include <cstdio>
#include <cstdint>

#define GAS __attribute__((address_space(1)))
#define LAS __attribute__((address_space(3)))
typedef unsigned short bf16_t;
typedef short bf16x8 __attribute__((ext_vector_type(8)));
typedef float f32x4 __attribute__((ext_vector_type(4)));
typedef float f32x2 __attribute__((ext_vector_type(2)));
typedef float f32x16 __attribute__((ext_vector_type(16)));
typedef unsigned u32x4 __attribute__((ext_vector_type(4)));
typedef unsigned u32x2 __attribute__((ext_vector_type(2)));
typedef GAS unsigned gu32;
#define RLX_AGENT __ATOMIC_RELAXED, __HIP_MEMORY_SCOPE_AGENT
#define LDS_WAIT() asm volatile("s_waitcnt lgkmcnt(0)" ::: "memory")
#define VM_WAIT() asm volatile("s_waitcnt vmcnt(0)" ::: "memory")

constexpr int D = 1024, NB = 16, S = 2048, T = NB * S;
constexpr int INC = 1952;
constexpr int PJ = 2048;
constexpr int PC_CQ = 0, PC_CKV = 256, PC_KR = 384, PC_QD = 512, PC_KD = 1024, PC_VD = 1536;
constexpr int NE = 32, TOPK = 4, NA = T * TOPK, NROWS = (NA / 256 + NE) * 256, NTILE_MAX = NROWS / 256;
constexpr float LAMBDA_INIT = 0.2f, LOG2E = 1.4426950408889634f;
constexpr float C2M = 0.10206207261596577f * LOG2E;
constexpr float C2D = 0.125f * LOG2E;

__device__ __forceinline__ unsigned cvt_pk_bf16(float lo, float hi) { unsigned r; asm volatile("v_cvt_pk_bf16_f32 %0, %1, %2" : "=v"(r) : "v"(lo), "v"(hi)); return r; }
__device__ __forceinline__ float bf2f(unsigned short h) { return __uint_as_float((unsigned)h << 16); }
__device__ __forceinline__ float bflo(unsigned w) { return __uint_as_float(w << 16); }
__device__ __forceinline__ float bfhi(unsigned w) { return __uint_as_float(w & 0xffff0000u); }
__device__ __forceinline__ float wave_sum(float v) {
#pragma unroll
    for (int o = 1; o < 64; o <<= 1) v += __shfl_xor(v, o);
    return v;
}

namespace pg8 {
constexpr int BM = 256, BK = 64, HALF = 128, HTB = HALF * BK * 2, STAGE_BYTES = 8 * HTB, NXCD = 8, WGM = 8;
__host__ __device__ __forceinline__ int lds_byte(int r, int c) { const int st = (r >> 4) * 2 + (c >> 5), rr = r & 15, cc = c & 31, ob = rr * 64 + cc * 2; return st * 1024 + (ob ^ (((ob >> 9) & 1) << 5)); }
__host__ __device__ __forceinline__ void stage_rc(int b, int& R, int& C) { const int st = b / 1024, sb = b % 1024, swz = sb ^ (((sb >> 9) & 1) << 5); R = (st >> 1) * 16 + swz / 64; C = (st & 1) * 32 + (swz % 64) / 2; }
__host__ __device__ __forceinline__ int perm32(int rho) { const int n = rho >> 4, i = rho & 15; return 8 * (i >> 2) + 4 * n + (i & 3); }

struct Unit { int pm, pn, e; };
struct Gemm { const bf16_t* A; const bf16_t* Bt; const int* rowidx; size_t b_estride; int lda, ldb, K, pad; };

struct StaticOrder {
    int nM, nN, nwg, G, c;
    __host__ __device__ void init(int M, int N, int G_, int c_) { nM = M / BM; nN = N / BM; nwg = nM * nN; G = G_; c = c_; }
    __host__ __device__ bool next(int i, Unit& u) const {
        const long L = (long)i * G + c; if (L >= nwg) return false;
        int wgid = (int)L; { const int q = nwg / NXCD, r = nwg % NXCD, xcd = wgid % NXCD, off = wgid / NXCD; wgid = (xcd < r ? xcd * (q + 1) : r * (q + 1) + (xcd - r) * q) + off; }
        const int nig = WGM * nN, gid = wgid / nig, fm = gid * WGM, gsz = (nM - fm) < WGM ? (nM - fm) : WGM;
        u.pm = fm + ((wgid % nig) % gsz); u.pn = (wgid % nig) / gsz; u.e = 0; return true;
    }
};
struct GroupedOrder {
    const LAS int* tile_e; int ntiles, ncol, G, c;
    __device__ bool next(int i, Unit& u) const {
        const int L = i * G + c, xcd = L & 7, j = L >> 3, block = j >> 5, within = j & 31, rpc = 32 / ncol;
        const int r = within / ncol, pn = within % ncol, rt = (block * 8 + xcd) * rpc + r;
        if (rt >= ntiles) return false;
        u.pm = rt; u.pn = pn; u.e = tile_e[rt]; return true;
    }
};

template <class Epi, class Sched, bool GATHER = false>
__device__ __forceinline__ void gemm_phase(LAS unsigned char* lds, const Gemm g, const Sched& S, const Epi& E) {
    int tid_ = threadIdx.x; asm volatile("" : "+v"(tid_));
    const int tid = tid_, wid = __builtin_amdgcn_readfirstlane(tid >> 6), lane = tid & 63, wr = wid >> 2, wc = wid & 3, fr = lane & 15, fq = lane >> 4;
    const int K = g.K, nt = K / BK;
    int Rr[2], Cc[2];
    unsigned voffA[2][2], voffB[2];
#pragma unroll
    for (int i = 0; i < 2; ++i) { stage_rc(tid * 16 + i * 8192, Rr[i], Cc[i]); const int Rb = Epi::PERM ? ((Rr[i] & ~31) + perm32(Rr[i] & 31)) : Rr[i];
        voffA[0][i] = (unsigned)(Rr[i] * g.lda + Cc[i]) * 2u; voffA[1][i] = (unsigned)((Rr[i] + HALF) * g.lda + Cc[i]) * 2u; voffB[i] = (unsigned)(Rb * g.ldb + Cc[i]) * 2u; }
    const size_t kstep = (size_t)(BK * 2);
    const size_t hstepB = (size_t)HALF * g.ldb * 2, tstepA = (size_t)BM * g.lda * 2, tstepB = 2 * hstepB;
    const unsigned ldsw = (unsigned)wid * 1024u;
    const int aoff = lds_byte(wr * 64 + fr, fq * 8), boff = lds_byte(wc * 32 + fr, fq * 8);
#define PG8_SA(b, h) (((b) * 2 + (h)) * HTB)
#define PG8_SB(b, h) ((4 + (b) * 2 + (h)) * HTB)
#define PG8_STAGE(bufoff, gbase, voff) do { _Pragma("unroll") for (int _i = 0; _i < 2; ++_i) \
        __builtin_amdgcn_global_load_lds((const unsigned*)((const char*)(gbase) + (voff)[_i]), (LAS unsigned*)(lds + (bufoff) + ldsw + _i * 8192), 16, 0, 0); } while (0)
#define PG8_LDA(dst, b, h) do { _Pragma("unroll") for (int m = 0; m < 4; ++m) _Pragma("unroll") for (int k = 0; k < 2; ++k) dst[m][k] = *(const LAS bf16x8*)(lds + PG8_SA(b, h) + aoff + m * 2048 + k * 1024); } while (0)
#define PG8_LDB(dst, b, h) do { _Pragma("unroll") for (int n = 0; n < 2; ++n) _Pragma("unroll") for (int k = 0; k < 2; ++k) dst[n][k] = *(const LAS bf16x8*)(lds + PG8_SB(b, h) + boff + n * 2048 + k * 1024); } while (0)
#define PG8_MMA(ai, bj, At, Bt) do { __builtin_amdgcn_s_setprio(1); _Pragma("unroll") for (int m = 0; m < 4; ++m) _Pragma("unroll") for (int n = 0; n < 2; ++n) _Pragma("unroll") for (int k = 0; k < 2; ++k) \
        acc[ai][bj][m][n] = __builtin_amdgcn_mfma_f32_16x16x32_bf16(Bt[n][k], At[m][k], acc[ai][bj][m][n], 0, 0, 0); __builtin_amdgcn_s_setprio(0); } while (0)
#define PG8_WAIT_V(n) asm volatile("s_waitcnt vmcnt(" #n ")" ::: "memory")
#define PG8_WAIT_L(n) asm volatile("s_waitcnt lgkmcnt(" #n ")" ::: "memory")
#define PG8_BAR __builtin_amdgcn_s_barrier()
#define PG8_SCHED __builtin_amdgcn_sched_barrier(0)
    Unit cur, nxt; int ui = 0;
    if (!S.next(0, cur)) return;
    f32x4 acc[2][2][4][2];
#pragma unroll
    for (int a = 0; a < 2; ++a)
#pragma unroll
        for (int b = 0; b < 2; ++b)
#pragma unroll
            for (int m = 0; m < 4; ++m)
#pragma unroll
                for (int n = 0; n < 2; ++n) acc[a][b][m][n] = (f32x4){0.f, 0.f, 0.f, 0.f};
    bf16x8 At[4][2], B0[2][2], B1[2][2];
    unsigned gA[2][2], ngA[2][2];
    const char* cA; const char* cB = (const char*)g.Bt + ((size_t)cur.e * g.b_estride) * 2 + (size_t)cur.pn * tstepB;
    if constexpr (GATHER) { cA = (const char*)g.A;
#pragma unroll
        for (int h = 0; h < 2; ++h)
#pragma unroll
            for (int i = 0; i < 2; ++i) gA[h][i] = (unsigned)g.rowidx[cur.pm * BM + h * HALF + Rr[i]] * (unsigned)(g.lda * 2) + (unsigned)Cc[i] * 2u;
    } else { cA = (const char*)g.A + (size_t)cur.pm * tstepA;
#pragma unroll
        for (int h = 0; h < 2; ++h)
#pragma unroll
            for (int i = 0; i < 2; ++i) gA[h][i] = voffA[h][i]; }
    PG8_STAGE(PG8_SB(0, 0), cB, voffB); PG8_STAGE(PG8_SB(0, 1), cB + hstepB, voffB); PG8_STAGE(PG8_SA(0, 0), cA, gA[0]); PG8_STAGE(PG8_SA(0, 1), cA, gA[1]);
    if (wr == 1) PG8_BAR;
    PG8_WAIT_V(2); PG8_BAR;
    PG8_STAGE(PG8_SB(1, 0), cB + kstep, voffB); PG8_STAGE(PG8_SA(1, 0), cA + kstep, gA[0]); PG8_STAGE(PG8_SB(1, 1), cB + hstepB + kstep, voffB);
    PG8_WAIT_V(6); PG8_BAR;
    for (;;) {
        const bool has_next = S.next(ui + 1, nxt);
        const char* nA; const char* nB = has_next ? (const char*)g.Bt + ((size_t)nxt.e * g.b_estride) * 2 + (size_t)nxt.pn * tstepB : cB;
        if constexpr (GATHER) { nA = cA; const int npm = has_next ? nxt.pm : cur.pm;
#pragma unroll
            for (int h = 0; h < 2; ++h)
#pragma unroll
                for (int i = 0; i < 2; ++i) ngA[h][i] = (unsigned)g.rowidx[npm * BM + h * HALF + Rr[i]] * (unsigned)(g.lda * 2) + (unsigned)Cc[i] * 2u;
        } else { nA = has_next ? (const char*)g.A + (size_t)nxt.pm * tstepA : cA; }
        for (int t = 0; t < nt; t += 2) {
            const bool last = (t == nt - 2);
            const char* a1 = cA + (size_t)(t + 1) * kstep;
            const char* a2 = last ? nA : cA + (size_t)(t + 2) * kstep; const char* b2 = last ? nB : cB + (size_t)(t + 2) * kstep;
            const char* a3 = a2 + kstep; const char* b3 = b2 + kstep;
            unsigned o2[2][2];
#pragma unroll
            for (int h = 0; h < 2; ++h)
#pragma unroll
                for (int i = 0; i < 2; ++i) o2[h][i] = GATHER ? (last ? ngA[h][i] : gA[h][i]) : gA[h][i];
            PG8_LDB(B0, 0, 0); PG8_LDB(B1, 0, 1); PG8_SCHED; PG8_LDA(At, 0, 0); PG8_STAGE(PG8_SA(1, 1), a1, gA[1]);
            PG8_WAIT_V(8); PG8_WAIT_L(0); PG8_BAR; PG8_MMA(0, 0, At, B0); PG8_MMA(0, 1, At, B1); PG8_BAR; PG8_SCHED;
            PG8_LDA(At, 0, 1); PG8_STAGE(PG8_SB(0, 0), b2, voffB); PG8_STAGE(PG8_SB(0, 1), b2 + hstepB, voffB); PG8_STAGE(PG8_SA(0, 0), a2, o2[0]);
            PG8_WAIT_V(8); PG8_WAIT_L(0); PG8_BAR; PG8_MMA(1, 0, At, B0); PG8_MMA(1, 1, At, B1); PG8_BAR; PG8_SCHED;
            PG8_LDB(B0, 1, 0); PG8_LDB(B1, 1, 1); PG8_SCHED; PG8_LDA(At, 1, 0); PG8_STAGE(PG8_SA(0, 1), a2, o2[1]);
            PG8_WAIT_V(8); PG8_WAIT_L(0); PG8_BAR; PG8_MMA(0, 0, At, B0); PG8_MMA(0, 1, At, B1); PG8_BAR; PG8_SCHED;
            PG8_LDA(At, 1, 1); PG8_STAGE(PG8_SB(1, 0), b3, voffB); PG8_STAGE(PG8_SB(1, 1), b3 + hstepB, voffB); PG8_STAGE(PG8_SA(1, 0), a3, o2[0]);
            PG8_WAIT_V(8); PG8_WAIT_L(0); PG8_BAR; PG8_MMA(1, 0, At, B0); PG8_MMA(1, 1, At, B1); PG8_BAR; PG8_SCHED;
        }
        if (wr == 0) PG8_BAR;
        { int t2 = threadIdx.x; asm volatile("" : "+v"(t2)); E(acc, cur, wr, wc, t2 & 15, (t2 >> 4) & 3); }
        if (!has_next) break;
#pragma unroll
        for (int a = 0; a < 2; ++a)
#pragma unroll
            for (int b = 0; b < 2; ++b)
#pragma unroll
                for (int m = 0; m < 4; ++m)
#pragma unroll
                    for (int n = 0; n < 2; ++n) acc[a][b][m][n] = (f32x4){0.f, 0.f, 0.f, 0.f};
        cur = nxt; cA = nA; cB = nB; ++ui;
        if constexpr (GATHER) {
#pragma unroll
            for (int h = 0; h < 2; ++h)
#pragma unroll
                for (int i = 0; i < 2; ++i) gA[h][i] = ngA[h][i]; }
        if (wr == 1) PG8_BAR;
    }
    PG8_WAIT_V(0);
    PG8_BAR;
#undef PG8_SA
#undef PG8_SB
#undef PG8_STAGE
#undef PG8_LDA
#undef PG8_LDB
#undef PG8_MMA
#undef PG8_WAIT_V
#undef PG8_WAIT_L
#undef PG8_BAR
#undef PG8_SCHED
}
}
namespace epi {
using pg8::Unit; using pg8::HALF; using pg8::BM;
__device__ __forceinline__ u32x4 pack8(f32x4 a, f32x4 b) { u32x4 w; w.x = cvt_pk_bf16(a[0], a[1]); w.y = cvt_pk_bf16(a[2], a[3]); w.z = cvt_pk_bf16(b[0], b[1]); w.w = cvt_pk_bf16(b[2], b[3]); return w; }
__device__ __forceinline__ u32x2 pack4(f32x4 a) { u32x2 w; w.x = cvt_pk_bf16(a[0], a[1]); w.y = cvt_pk_bf16(a[2], a[3]); return w; }
__device__ __forceinline__ void rope4(f32x4& a, f32x4& b, const f32x4 t0, const f32x4 t1) {
    const f32x4 c = {t0[0], t0[2], t1[0], t1[2]}, s = {t0[1], t0[3], t1[1], t1[3]};
    const f32x4 na = a * c - b * s, nb = b * c + a * s; a = na; b = nb;
}
__device__ __forceinline__ void ssq_add(float* ssq, int row, float ss, int fq) { ss += __shfl_xor(ss, 16); ss += __shfl_xor(ss, 32); if (fq == 0) atomicAdd(ssq + row, ss); }
__device__ __forceinline__ float sq8(f32x4 a, f32x4 b) { return (a[0] * a[0] + a[1] * a[1]) + (a[2] * a[2] + a[3] * a[3]) + (b[0] * b[0] + b[1] * b[1]) + (b[2] * b[2] + b[3] * b[3]); }

struct EpiProj {
    static constexpr bool PERM = true;
    bf16_t* P; const f32x4* tabm; const f32x4* tabd; float* ssq_q; float* ssq_kv;
    __device__ __forceinline__ void operator()(const f32x4 (&acc)[2][2][4][2], const Unit& u, int wr, int wc, int fr, int fq) const {
        const int row0 = u.pm * BM + wr * 64 + fr, pn = u.pn;
#pragma unroll
        for (int ai = 0; ai < 2; ++ai)
#pragma unroll
            for (int m = 0; m < 4; ++m) { const int row = row0 + ai * HALF + m * 16; bf16_t* rp = P + (size_t)row * PJ;
                if (pn == 0) { float ss = 0.f;
#pragma unroll
                    for (int bj = 0; bj < 2; ++bj) { const f32x4 v0 = acc[ai][bj][m][0], v1 = acc[ai][bj][m][1]; ss += sq8(v0, v1); *(u32x4*)(rp + bj * HALF + wc * 32 + 8 * fq) = pack8(v0, v1); }
                    ssq_add(ssq_q, row, ss, fq);
                } else if (pn == 1) {
                    { const f32x4 v0 = acc[ai][0][m][0], v1 = acc[ai][0][m][1]; *(u32x4*)(rp + 256 + wc * 32 + 8 * fq) = pack8(v0, v1); ssq_add(ssq_kv, row, sq8(v0, v1), fq); }
                    if (wc == 0) { f32x4 a = acc[ai][1][m][0], b = acc[ai][1][m][1]; const f32x4 t0 = tabm[(size_t)row * 8 + 2 * fq], t1 = tabm[(size_t)row * 8 + 2 * fq + 1]; rope4(a, b, t0, t1);
                        *(u32x2*)(rp + PC_KR + 4 * fq) = pack4(a); *(u32x2*)(rp + PC_KR + 16 + 4 * fq) = pack4(b); }
                } else if (pn < 6) { const int g = 4 * (wc & 1) + fq; const f32x4 t0 = tabd[(size_t)row * 16 + 2 * g], t1 = tabd[(size_t)row * 16 + 2 * g + 1]; const float sc = pn < 4 ? C2D : 1.f;
#pragma unroll
                    for (int bj = 0; bj < 2; ++bj) { f32x4 a = acc[ai][bj][m][0] * sc, b = acc[ai][bj][m][1] * sc; rope4(a, b, t0, t1);
                        bf16_t* bp = rp + pn * 256 + bj * HALF + (wc >> 1) * 64 + 4 * g; *(u32x2*)bp = pack4(a); *(u32x2*)(bp + 32) = pack4(b); }
                } else {
#pragma unroll
                    for (int bj = 0; bj < 2; ++bj) *(u32x4*)(rp + pn * 256 + bj * HALF + wc * 32 + 8 * fq) = pack8(acc[ai][bj][m][0], acc[ai][bj][m][1]);
                }
            }
    }
};
struct EpiQ {
    static constexpr bool PERM = true;
    bf16_t* Q; const f32x4* tabm; const float* ssq_q;
    __device__ __forceinline__ void operator()(const f32x4 (&acc)[2][2][4][2], const Unit& u, int wr, int wc, int fr, int fq) const {
        const int row0 = u.pm * BM + wr * 64 + fr;
        if (u.pn < 2) {
#pragma unroll
            for (int ai = 0; ai < 2; ++ai)
#pragma unroll
                for (int m = 0; m < 4; ++m) { const int row = row0 + ai * HALF + m * 16; const float rs = rsqrtf(ssq_q[row] * (1.f / 256.f) + 1e-6f) * C2M; bf16_t* rp = Q + (size_t)row * 768 + u.pn * BM + wc * 32 + 8 * fq;
#pragma unroll
                    for (int bj = 0; bj < 2; ++bj) *(u32x4*)(rp + bj * HALF) = pack8(acc[ai][bj][m][0] * rs, acc[ai][bj][m][1] * rs); }
        } else {
#pragma unroll
            for (int ai = 0; ai < 2; ++ai)
#pragma unroll
                for (int m = 0; m < 4; ++m) { const int row = row0 + ai * HALF + m * 16; const float rs = rsqrtf(ssq_q[row] * (1.f / 256.f) + 1e-6f) * C2M; bf16_t* rp = Q + (size_t)row * 768 + 512 + wc * 32 + 4 * fq;
                    const f32x4 t0 = tabm[(size_t)row * 8 + 2 * fq], t1 = tabm[(size_t)row * 8 + 2 * fq + 1];
#pragma unroll
                    for (int bj = 0; bj < 2; ++bj) { f32x4 a = acc[ai][bj][m][0] * rs, b = acc[ai][bj][m][1] * rs; rope4(a, b, t0, t1); *(u32x2*)(rp + bj * 128) = pack4(a); *(u32x2*)(rp + bj * 128 + 16) = pack4(b); }
                    asm volatile("" ::: "memory"); }
        }
    }
};
struct EpiKV {
    static constexpr bool PERM = true;
    bf16_t* KV; const float* ssq_kv;
    __device__ __forceinline__ void operator()(const f32x4 (&acc)[2][2][4][2], const Unit& u, int wr, int wc, int fr, int fq) const {
        const int row0 = u.pm * BM + wr * 64 + fr;
#pragma unroll
        for (int ai = 0; ai < 2; ++ai)
#pragma unroll
            for (int m = 0; m < 4; ++m) { const int row = row0 + ai * HALF + m * 16; const float rs = rsqrtf(ssq_kv[row] * (1.f / 128.f) + 1e-6f); bf16_t* rp = KV + (size_t)row * 1024 + u.pn * BM + wc * 32 + 8 * fq;
#pragma unroll
                for (int bj = 0; bj < 2; ++bj) *(u32x4*)(rp + bj * HALF) = pack8(acc[ai][bj][m][0] * rs, acc[ai][bj][m][1] * rs); }
    }
};
struct EpiY {
    static constexpr bool PERM = true;
    bf16_t* Y; float* ssq_y;
    __device__ __forceinline__ void operator()(const f32x4 (&acc)[2][2][4][2], const Unit& u, int wr, int wc, int fr, int fq) const {
        const int row0 = u.pm * BM + wr * 64 + fr;
#pragma unroll
        for (int ai = 0; ai < 2; ++ai)
#pragma unroll
            for (int m = 0; m < 4; ++m) { const int row = row0 + ai * HALF + m * 16; bf16_t* rp = Y + (size_t)row * 1024 + u.pn * BM + wc * 32 + 8 * fq; float ss = 0.f;
#pragma unroll
                for (int bj = 0; bj < 2; ++bj) { const f32x4 v0 = acc[ai][bj][m][0], v1 = acc[ai][bj][m][1]; ss += sq8(v0, v1); *(u32x4*)(rp + bj * HALF) = pack8(v0, v1); }
                ssq_add(ssq_y, row, ss, fq); }
    }
};
struct EpiAct {
    static constexpr bool PERM = true;
    bf16_t* ACT; const float* bgu;
    __device__ __forceinline__ void operator()(const f32x4 (&acc)[2][2][4][2], const Unit& u, int wr, int wc, int fr, int fq) const {
        const int row0 = u.pm * BM + wr * 64 + fr; const float* bb = bgu + (size_t)u.e * 2048;
#pragma unroll
        for (int bj = 0; bj < 2; ++bj) { const int j0 = u.pn * 128 + bj * 64 + wc * 16 + 4 * fq; const f32x4 bg = *(const f32x4*)(bb + j0), bu = *(const f32x4*)(bb + 1024 + j0);
#pragma unroll
            for (int ai = 0; ai < 2; ++ai)
#pragma unroll
                for (int m = 0; m < 4; ++m) { const int row = row0 + ai * HALF + m * 16; f32x4 gv = acc[ai][bj][m][0] + bg, uv = acc[ai][bj][m][1] + bu, o;
#pragma unroll
                    for (int i = 0; i < 4; ++i) { const float gg = fminf(gv[i], 7.f), uu = fminf(fmaxf(uv[i], -7.f), 7.f); o[i] = gg * __builtin_amdgcn_rcpf(1.f + __builtin_amdgcn_exp2f(-1.702f * LOG2E * gg)) * (uu + 1.f); }
                    *(u32x2*)(ACT + (size_t)row * 1024 + j0) = pack4(o); } }
    }
};
struct EpiDown {
    static constexpr bool PERM = true;
    bf16_t* YR; const float* bd; const float* roww;
    __device__ __forceinline__ void operator()(const f32x4 (&acc)[2][2][4][2], const Unit& u, int wr, int wc, int fr, int fq) const {
        const int row0 = u.pm * BM + wr * 64 + fr; const float* bb = bd + (size_t)u.e * 1024 + u.pn * BM + wc * 32 + 8 * fq;
        f32x4 b0[2], b1[2];
#pragma unroll
        for (int bj = 0; bj < 2; ++bj) { b0[bj] = *(const f32x4*)(bb + bj * HALF); b1[bj] = *(const f32x4*)(bb + bj * HALF + 4); }
#pragma unroll
        for (int ai = 0; ai < 2; ++ai)
#pragma unroll
            for (int m = 0; m < 4; ++m) { const int row = row0 + ai * HALF + m * 16; const float w = roww[row]; bf16_t* rp = YR + (size_t)row * 1024 + u.pn * BM + wc * 32 + 8 * fq;
#pragma unroll
                for (int bj = 0; bj < 2; ++bj) *(u32x4*)(rp + bj * HALF) = pack8((acc[ai][bj][m][0] + b0[bj]) * w, (acc[ai][bj][m][1] + b1[bj]) * w); }
    }
};
}
constexpr size_t MiB = 1u << 20;
constexpr size_t WS_CTL = 0, CTL_ZERO_BYTES = 1 * MiB;
constexpr size_t WS_MOD = 1 * MiB;
constexpr size_t WS_SSQ = 1 * MiB + 512 * 1024;
constexpr size_t WS_TABM = 2 * MiB, WS_TABD = 6 * MiB;
constexpr size_t WS_SE = 14 * MiB, WS_SG = 14 * MiB + 512 * 1024, WS_SRANK = 18 * MiB + 512 * 1024;
constexpr size_t WS_POS = 15 * MiB;
constexpr size_t WS_ROWTOK = 16 * MiB, WS_ROWW = 17 * MiB;
constexpr size_t WS_CNT = 18 * MiB;
constexpr size_t WS_TD0 = 19 * MiB;
constexpr size_t WS_WIN = 20 * MiB, WS_WQB = 24 * MiB, WS_WKVB = 25 * MiB, WS_WO = 26 * MiB;
constexpr size_t WS_WGU = 28 * MiB, WS_WD = 156 * MiB;
constexpr size_t WS_H = 220 * MiB;
constexpr size_t WS_PROJ = 284 * MiB;
constexpr size_t WS_QM = 412 * MiB, WS_KVM = 460 * MiB, WS_ATT = 524 * MiB, WS_Y = 588 * MiB;
constexpr size_t WS_ACT = 284 * MiB;
constexpr size_t WS_YR = 588 * MiB;
constexpr size_t WS_END = 860 * MiB;
static_assert(WS_ACT + (size_t)NROWS * 1024 * 2 <= WS_YR && WS_YR + (size_t)NROWS * 1024 * 2 <= WS_END, "ws map");
constexpr int CW_BAR = 4096;

constexpr int RING_OFF = 0, RING_BYTES = 131072;
constexpr int LDSCTL_OFF = RING_BYTES, MISC_OFF = LDSCTL_OFF + 320;
constexpr int XTRA_OFF = MISC_OFF + 128;
constexpr int X_TILEE = XTRA_OFF;
constexpr int X_SE = X_TILEE + 2304, X_SG = X_SE + 2048, X_SRANK = X_SG + 2048, X_WCNT = X_SRANK + 2048, X_MISC2 = X_WCNT + 1024;
constexpr int LDS_BYTES = 147456;
static_assert(X_MISC2 + 1024 <= LDS_BYTES, "LDS map");
constexpr int NWAVES = 8;

#define XB_TMO      128
#define XB_XCNT(j)  (256  + 64 * (j))
#define XB_XSUB(j)  (1280 + 64 * (j))
#define XB_XGEN(j)  (2304 + 64 * (j))
#define XB_TOP      3328
#define XB_TOPGEN   3392
#define XCD_BAR_WORDS 3456
#define XB_SPIN_CAP (1u << 18)
__device__ __forceinline__ unsigned xb_ld(unsigned* p)              { return __hip_atomic_load(p, __ATOMIC_RELAXED, __HIP_MEMORY_SCOPE_AGENT); }
__device__ __forceinline__ unsigned xb_add(unsigned* p, unsigned v) { return __hip_atomic_fetch_add(p, v, __ATOMIC_RELAXED, __HIP_MEMORY_SCOPE_AGENT); }
__device__ __forceinline__ unsigned xb_xcc_id() { return (unsigned)__builtin_amdgcn_s_getreg((3 << 11) | 20) & 0xFu; }
#define XB_SPIN(cond, bar) do { unsigned _sp = 0; while (cond) { __builtin_amdgcn_s_sleep(1); \
    if ((++_sp & 255u) == 0u) { if (xb_ld(&(bar)[XB_TMO])) break; if (_sp > XB_SPIN_CAP) { atomicAdd(&(bar)[XB_TMO], 1u); break; } } } } while (0)
struct XcdBarrier { unsigned* bar; unsigned x; volatile LAS unsigned* st; };
__device__ __forceinline__ XcdBarrier xcd_barrier_post(unsigned* bar, volatile LAS unsigned* st) {
    XcdBarrier b; b.bar = bar; b.x = xb_xcc_id(); b.st = st;
    if (threadIdx.x == 0) (void)xb_add(&bar[XB_XCNT(b.x)], 1u);
    return b;
}
__device__ __forceinline__ void xcd_barrier_complete(unsigned* bar, unsigned x, unsigned& nloc, unsigned& nx) {
    const unsigned G = gridDim.x * gridDim.y * gridDim.z;
    unsigned sum, cnt, mine, sp = 0u;
    for (;;) {
        sum = 0u; cnt = 0u; mine = 0u;
#pragma unroll
        for (unsigned j = 0; j < 16; ++j) { const unsigned c = xb_ld(&bar[XB_XCNT(j)]); sum += c; cnt += (c > 0u) ? 1u : 0u; mine = (j == x) ? c : mine; }
        if (sum == G) break;
        __builtin_amdgcn_s_sleep(1);
        if ((++sp & 255u) == 0u) { if (xb_ld(&bar[XB_TMO])) break; if (sp > XB_SPIN_CAP) { atomicAdd(&bar[XB_TMO], 1u); break; } }
    }
    nloc = mine > 0u ? mine : 1u; nx = cnt > 0u ? cnt : 1u;
}
__device__ __forceinline__ void xcd_barrier(const XcdBarrier& b) {
    asm volatile("s_waitcnt vmcnt(0)" ::: "memory");
    __syncthreads();
    if (threadIdx.x == 0) {
        unsigned* bar = b.bar;
        __builtin_amdgcn_s_waitcnt(0);
        unsigned nloc = b.st[0], nx = b.st[1];
        if (nloc == 0u) { xcd_barrier_complete(bar, b.x, nloc, nx); b.st[0] = nloc; b.st[1] = nx; }
        const unsigned old = xb_add(&bar[XB_XSUB(b.x)], 1u);
        const unsigned gen = old / nloc;
        if (old + 1u == (gen + 1u) * nloc) {
            __builtin_amdgcn_fence(__ATOMIC_RELEASE, "agent");
            asm volatile("s_waitcnt vmcnt(0)" ::: "memory");
            const unsigned og = xb_add(&bar[XB_TOP], 1u);
            const unsigned tg = og / nx;
            if (og + 1u == (tg + 1u) * nx) xb_add(&bar[XB_TOPGEN], 1u);
            else XB_SPIN(xb_ld(&bar[XB_TOPGEN]) == tg, bar);
            __builtin_amdgcn_fence(__ATOMIC_ACQUIRE, "agent");
            xb_add(&bar[XB_XGEN(b.x)], 1u);
            asm volatile("s_waitcnt vmcnt(0)" ::: "memory");
        } else {
            XB_SPIN(xb_ld(&bar[XB_XGEN(b.x)]) == gen, bar);
            __builtin_amdgcn_fence(__ATOMIC_ACQUIRE, "agent");
            asm volatile("s_waitcnt vmcnt(0)" ::: "memory");
        }
    }
    __syncthreads();
}

struct Args { const float* in[26]; float* out; unsigned char* ws; int ph_lo, ph_hi, li, pad; };
struct Frame {
    LAS unsigned char* lds; volatile LAS unsigned* MISC; unsigned* ctl;
    int G, bid;
    const Args* a;
};
#define PHASE_IDS() int tid_ = threadIdx.x; asm volatile("" : "+v"(tid_)); const int tid = tid_, lane = tid & 63, wave = __builtin_amdgcn_readfirstlane(tid >> 6); (void)lane; (void)wave
#define IN_X 0
#define IN_C 1
#define IN_POS 2
#define IN_WADA 3
#define IN_BADA 4
#define IN_GMIXPRE 5
#define IN_GMIXPOST 6
#define IN_WIN 7
#define IN_GQA 8
#define IN_WQB 9
#define IN_GKVA 10
#define IN_WKVB 11
#define IN_LQ1 12
#define IN_LK1 13
#define IN_LQ2 14
#define IN_LK2 15
#define IN_GSUBLN 16
#define IN_WO 17
#define IN_GFFNPRE 18
#define IN_GFFNPOST 19
#define IN_WROUTER 20
#define IN_BROUTER 21
#define IN_WGU 22
#define IN_BGU 23
#define IN_WDN 24
#define IN_BDN 25

template <class Map>
__device__ __forceinline__ void transpose_item(const float* W, int K, int N, bf16_t* WT, const float* gain, Map dst, LAS float* scr, int item, int lane) {
    const int nblk = N / 32, kb = item / nblk, nb = item % nblk, k0 = 64 * kb, n0 = 32 * nb;
#pragma unroll 8
    for (int i = 0; i < 32; ++i) { const int kk = 2 * i + (lane >> 5); scr[kk * 33 + (lane & 31)] = W[(size_t)(k0 + kk) * N + n0 + (lane & 31)]; }
    LDS_WAIT(); asm volatile("" ::: "memory");
    const int c = lane & 7;
    float gk[8];
#pragma unroll
    for (int i = 0; i < 8; ++i) gk[i] = gain ? gain[k0 + 8 * c + i] : 1.f;
#pragma unroll
    for (int j = 0; j < 4; ++j) { const int n = (lane >> 3) + 8 * j; const LAS float* s = scr + (8 * c) * 33 + n;
        u32x4 o; o.x = cvt_pk_bf16(s[0 * 33] * gk[0], s[1 * 33] * gk[1]); o.y = cvt_pk_bf16(s[2 * 33] * gk[2], s[3 * 33] * gk[3]); o.z = cvt_pk_bf16(s[4 * 33] * gk[4], s[5 * 33] * gk[5]); o.w = cvt_pk_bf16(s[6 * 33] * gk[6], s[7 * 33] * gk[7]);
        *(GAS u32x4*)(WT + (size_t)dst(n0 + n) * K + k0 + 8 * c) = o; }
    LDS_WAIT(); asm volatile("" ::: "memory");
}
__device__ __forceinline__ int il4(int i, int x2) { return 8 * (i >> 2) + 4 * x2 + (i & 3); }
struct MapWin { __device__ int operator()(int n) const {
    if (n < 384) return n;
    if (n < 416) { const int r = n - 384; return PC_KR + il4(r & 15, r >> 4); }
    if (n < 1440) { const int r = n - 416, hj = r >> 6, d = r & 63; return PC_QD + hj * 64 + il4(d & 31, d >> 5); }
    return PC_VD + (n - 1440); } };
struct MapWqb { __device__ int operator()(int n) const { const int h = n / 96, d = n - h * 96; if (d < 64) return h * 64 + d; const int r = d - 64; return 512 + h * 32 + il4(r & 15, r >> 4); } };
struct MapId { __device__ int operator()(int n) const { return n; } };
struct MapWgu { __device__ int operator()(int n) const { const int which = n >> 10, j = n & 1023; return 8 * (j >> 2) + 4 * which + (j & 3); } };

__device__ __forceinline__ void p0_prologue(Frame& F) {
    PHASE_IDS();
    float* mod = (float*)(F.a->ws + WS_MOD);
    if (F.bid < 192) {
        LAS float* cact = (LAS float*)(F.lds);
        LAS float* red = (LAS float*)(F.lds + 65536);
        const float* c = F.a->in[IN_C];
        for (int i = tid; i < 16 * 1024; i += 512) { const float cv = c[i]; cact[i] = cv / (1.f + __expf(-cv)); }
        __syncthreads();
        const int n0 = 32 * F.bid, col = tid & 31, kg = tid >> 5;
        float acc[16];
#pragma unroll
        for (int b = 0; b < 16; ++b) acc[b] = 0.f;
        const float* wp = F.a->in[IN_WADA] + (size_t)(kg * 64) * 6144 + n0 + col;
        for (int kk = 0; kk < 64; ++kk) { const float w = wp[(size_t)kk * 6144];
#pragma unroll
            for (int b = 0; b < 16; ++b) acc[b] += cact[b * 1024 + kg * 64 + kk] * w; }
#pragma unroll
        for (int b = 0; b < 16; ++b) red[(kg * 16 + b) * 32 + col] = acc[b];
        __syncthreads();
        { const int b = tid >> 5; float s = 0.f;
#pragma unroll
          for (int k2 = 0; k2 < 16; ++k2) s += red[(k2 * 16 + b) * 32 + col];
          mod[b * 6144 + n0 + col] = s + F.a->in[IN_BADA][n0 + col]; }
        __syncthreads();
    }
    { float* ssq = (float*)(F.a->ws + WS_SSQ); for (int i = F.bid * 512 + tid; i < 3 * T; i += F.G * 512) ssq[i] = 0.f;
      u32x4* wz = (u32x4*)((bf16_t*)(F.a->ws + WS_WIN) + (size_t)416 * 1024); for (int i = F.bid * 512 + tid; i < 96 * 1024 / 8; i += F.G * 512) wz[i] = (u32x4){0u, 0u, 0u, 0u}; }
    { const int* pos = (const int*)F.a->in[IN_POS]; float2* tabm = (float2*)(F.a->ws + WS_TABM); float2* tabd = (float2*)(F.a->ws + WS_TABD);
      for (int gid = F.bid * 512 + tid; gid < T * 48; gid += F.G * 512) { const int t = gid / 48, i = gid - t * 48; const float p = (float)pos[t];
          if (i < 16) { const float inv = powf(10000.f, -(float)(2 * i) / 32.f); const double a = (double)(p * inv); tabm[t * 16 + i] = make_float2((float)cos(a), (float)sin(a)); }
          else { const int j = i - 16; const float inv = powf(10000.f, -(float)(2 * j) / 64.f); const double a = (double)(p * inv); tabd[t * 32 + j] = make_float2((float)cos(a), (float)sin(a)); } } }
    LAS float* scr = (LAS float*)(F.lds + RING_OFF + wave * 16384);
    const int gw = F.bid * NWAVES + wave, NGW = F.G * NWAVES;
    constexpr int I_WIN = 16 * 61, I_WQB = 4 * 24, I_WKVB = 2 * 32, I_WO = 16 * 32, I_GU1 = 16 * 64, I_DN1 = 16 * 32;
    constexpr int NITEMS = I_WIN + I_WQB + I_WKVB + I_WO + NE * I_GU1 + NE * I_DN1;
    for (int it = gw; it < NITEMS; it += NGW) {
        int r = it;
        if (r < I_WIN) { transpose_item(F.a->in[IN_WIN], 1024, INC, (bf16_t*)(F.a->ws + WS_WIN), nullptr, MapWin{}, scr, r, lane); continue; } r -= I_WIN;
        if (r < I_WQB) { transpose_item(F.a->in[IN_WQB], 256, 768, (bf16_t*)(F.a->ws + WS_WQB), F.a->in[IN_GQA], MapWqb{}, scr, r, lane); continue; } r -= I_WQB;
        if (r < I_WKVB) { transpose_item(F.a->in[IN_WKVB], 128, 1024, (bf16_t*)(F.a->ws + WS_WKVB), F.a->in[IN_GKVA], MapId{}, scr, r, lane); continue; } r -= I_WKVB;
        if (r < I_WO) { transpose_item(F.a->in[IN_WO], 1024, 1024, (bf16_t*)(F.a->ws + WS_WO), nullptr, MapId{}, scr, r, lane); continue; } r -= I_WO;
        if (r < NE * I_GU1) { const int e = r / I_GU1; transpose_item(F.a->in[IN_WGU] + (size_t)e * 1024 * 2048, 1024, 2048, (bf16_t*)(F.a->ws + WS_WGU) + (size_t)e * 2048 * 1024, nullptr, MapWgu{}, scr, r - e * I_GU1, lane); continue; } r -= NE * I_GU1;
        { const int e = r / I_DN1; transpose_item(F.a->in[IN_WDN] + (size_t)e * 1024 * 1024, 1024, 1024, (bf16_t*)(F.a->ws + WS_WD) + (size_t)e * 1024 * 1024, nullptr, MapId{}, scr, r - e * I_DN1, lane); }
    }
}
__device__ __forceinline__ void p0b_norm(Frame& F) {
    PHASE_IDS();
    const int gw = F.bid * NWAVES + wave, NGW = F.G * NWAVES; const float* mod = (const float*)(F.a->ws + WS_MOD); bf16_t* H = (bf16_t*)(F.a->ws + WS_H);
    for (int row = gw; row < T; row += NGW) {
        const int b = row / S; const GAS f32x4* xr = (const GAS f32x4*)(F.a->in[IN_X] + (size_t)row * D) + lane;
        f32x4 v[4]; float ss = 0.f;
#pragma unroll
        for (int j = 0; j < 4; ++j) { v[j] = xr[64 * j]; ss += (v[j].x * v[j].x + v[j].y * v[j].y) + (v[j].z * v[j].z + v[j].w * v[j].w); }
        const float r = rsqrtf(wave_sum(ss) * (1.f / D) + 1e-6f);
        GAS u32x2* o8 = (GAS u32x2*)(H + (size_t)row * D) + lane;
#pragma unroll
        for (int j = 0; j < 4; ++j) { const int c = 4 * lane + 256 * j; const f32x4 g = *(const f32x4*)(F.a->in[IN_GMIXPRE] + c), sh = *(const f32x4*)(mod + b * 6144 + c), sc = *(const f32x4*)(mod + b * 6144 + 1024 + c);
            const f32x4 h = v[j] * r * g * (sc + 1.f) + sh; u32x2 w; w.x = cvt_pk_bf16(h[0], h[1]); w.y = cvt_pk_bf16(h[2], h[3]); o8[64 * j] = w; }
    }
}
__device__ __forceinline__ void p5_rows(Frame& F) {
    PHASE_IDS();
    LAS float* wt = (LAS float*)(F.lds + RING_OFF);
    for (int idx = tid; idx < NE * 1024; idx += 512) { const int e = idx >> 10, k = idx & 1023; wt[idx] = F.a->in[IN_WROUTER][k * NE + e]; }
    LAS int* se = (LAS int*)(F.lds + X_SE); LAS float* sg = (LAS float*)(F.lds + X_SG);
    __syncthreads();
    const float* mod = (const float*)(F.a->ws + WS_MOD); const float* ssq_y = (const float*)(F.a->ws + WS_SSQ) + 2 * T;
    const bf16_t* Y = (const bf16_t*)(F.a->ws + WS_Y); bf16_t* H2 = (bf16_t*)(F.a->ws + WS_H);
    const int tok0 = F.bid * 128 + wave * 16, b = (F.bid * 128) / S;
    const int c0 = 16 * lane;
    for (int i = 0; i < 16; ++i) {
        const int row = tok0 + i;
        const u32x4 y0 = *(const GAS u32x4*)(Y + (size_t)row * D + c0), y1 = *(const GAS u32x4*)(Y + (size_t)row * D + c0 + 8);
        const float rsy = rsqrtf(ssq_y[row] * (1.f / D) + 1e-6f);
        float yv[16] = {bflo(y0.x), bfhi(y0.x), bflo(y0.y), bfhi(y0.y), bflo(y0.z), bfhi(y0.z), bflo(y0.w), bfhi(y0.w), bflo(y1.x), bfhi(y1.x), bflo(y1.y), bfhi(y1.y), bflo(y1.z), bfhi(y1.z), bflo(y1.w), bfhi(y1.w)};
        float x1[16]; float ss = 0.f;
#pragma unroll
        for (int q = 0; q < 4; ++q) { const f32x4 xv = *(const GAS f32x4*)(F.a->in[IN_X] + (size_t)row * D + c0 + 4 * q), gp = *(const f32x4*)(F.a->in[IN_GMIXPOST] + c0 + 4 * q), gm = *(const f32x4*)(mod + b * 6144 + 2048 + c0 + 4 * q);
            f32x4 o;
#pragma unroll
            for (int k = 0; k < 4; ++k) { o[k] = xv[k] + gm[k] * (yv[4 * q + k] * rsy * gp[k]); x1[4 * q + k] = o[k]; ss += o[k] * o[k]; }
            *(GAS f32x4*)(F.a->out + (size_t)row * D + c0 + 4 * q) = o; }
        const float r1 = rsqrtf(wave_sum(ss) * (1.f / D) + 1e-6f);
        float h2[16];
#pragma unroll
        for (int q = 0; q < 4; ++q) { const f32x4 gp = *(const f32x4*)(F.a->in[IN_GFFNPRE] + c0 + 4 * q), sh = *(const f32x4*)(mod + b * 6144 + 3072 + c0 + 4 * q), sc = *(const f32x4*)(mod + b * 6144 + 4096 + c0 + 4 * q);
#pragma unroll
            for (int k = 0; k < 4; ++k) h2[4 * q + k] = x1[4 * q + k] * r1 * gp[k] * (1.f + sc[k]) + sh[k]; }
        { u32x4 w0, w1; w0.x = cvt_pk_bf16(h2[0], h2[1]); w0.y = cvt_pk_bf16(h2[2], h2[3]); w0.z = cvt_pk_bf16(h2[4], h2[5]); w0.w = cvt_pk_bf16(h2[6], h2[7]);
          w1.x = cvt_pk_bf16(h2[8], h2[9]); w1.y = cvt_pk_bf16(h2[10], h2[11]); w1.z = cvt_pk_bf16(h2[12], h2[13]); w1.w = cvt_pk_bf16(h2[14], h2[15]);
          *(GAS u32x4*)(H2 + (size_t)row * D + c0) = w0; *(GAS u32x4*)(H2 + (size_t)row * D + c0 + 8) = w1; }
        float v[32];
#pragma unroll
        for (int e = 0; e < NE; ++e) { const LAS f32x4* wp = (const LAS f32x4*)(wt + e * 1024 + c0); float p = 0.f;
#pragma unroll
            for (int q = 0; q < 4; ++q) { const f32x4 w = wp[q]; p += h2[4 * q] * w[0] + h2[4 * q + 1] * w[1] + h2[4 * q + 2] * w[2] + h2[4 * q + 3] * w[3]; }
            v[e] = p; }
#pragma unroll
        for (int j = 0; j < 16; ++j) { const bool up = (lane & 32) != 0; const float keep = up ? v[16 + j] : v[j], send = up ? v[j] : v[16 + j]; v[j] = keep + __shfl_xor(send, 32); }
#pragma unroll
        for (int j = 0; j < 8; ++j) { const bool up = (lane & 16) != 0; const float keep = up ? v[8 + j] : v[j], send = up ? v[j] : v[8 + j]; v[j] = keep + __shfl_xor(send, 16); }
#pragma unroll
        for (int j = 0; j < 4; ++j) { const bool up = (lane & 8) != 0; const float keep = up ? v[4 + j] : v[j], send = up ? v[j] : v[4 + j]; v[j] = keep + __shfl_xor(send, 8); }
#pragma unroll
        for (int j = 0; j < 2; ++j) { const bool up = (lane & 4) != 0; const float keep = up ? v[2 + j] : v[j], send = up ? v[j] : v[2 + j]; v[j] = keep + __shfl_xor(send, 4); }
        { const bool up = (lane & 2) != 0; const float keep = up ? v[1] : v[0], send = up ? v[0] : v[1]; v[0] = keep + __shfl_xor(send, 2); }
        float lg = v[0] + __shfl_xor(v[0], 1);
        const int my_e = lane >> 1;
        lg += F.a->in[IN_BROUTER][my_e];
        float vals[4]; int idx[4];
#pragma unroll
        for (int k = 0; k < 4; ++k) { float mx = lg;
#pragma unroll
            for (int o = 1; o < 64; o <<= 1) mx = fmaxf(mx, __shfl_xor(mx, o));
            const unsigned long long bm = __ballot(lg == mx); const int wl = __builtin_ctzll(bm); vals[k] = mx; idx[k] = wl >> 1; if (my_e == idx[k]) lg = -INFINITY; }
        float ex[4], den = 0.f;
#pragma unroll
        for (int k = 0; k < 4; ++k) { ex[k] = __expf(vals[k] - vals[0]); den += ex[k]; }
        const float inv = 1.f / den;
        if (lane < 4) { const int a = (wave * 16 + i) * 4 + lane; se[a] = lane == 0 ? idx[0] : lane == 1 ? idx[1] : lane == 2 ? idx[2] : idx[3]; sg[a] = (lane == 0 ? ex[0] : lane == 1 ? ex[1] : lane == 2 ? ex[2] : ex[3]) * inv; }
    }
    __syncthreads();
    LAS int* srank = (LAS int*)(F.lds + X_SRANK); LAS int* wcnt = (LAS int*)(F.lds + X_WCNT);
    const int e_my = se[tid]; int rk = 0;
    for (int e = 0; e < NE; ++e) { const unsigned long long bm = __ballot(e_my == e); if (e_my == e) rk = __builtin_popcountll(bm & ((1ull << lane) - 1ull)); if (lane == 0) wcnt[wave * 32 + e] = __builtin_popcountll(bm); }
    __syncthreads();
    int base = 0;
    for (int w = 0; w < wave; ++w) base += wcnt[w * 32 + e_my];
    srank[tid] = base + rk;
    { const int a = F.bid * 512 + tid; ((int*)(F.a->ws + WS_SE))[a] = e_my; ((float*)(F.a->ws + WS_SG))[a] = sg[tid]; ((int*)(F.a->ws + WS_SRANK))[a] = base + rk; }
    if (tid < NE) { int tot = 0; for (int w = 0; w < 8; ++w) tot += wcnt[w * 32 + tid]; ((int*)(F.a->ws + WS_CNT))[F.bid * NE + tid] = tot; }
}
__device__ __forceinline__ void p9_final(Frame& F) {
    PHASE_IDS();
    const float* mod = (const float*)(F.a->ws + WS_MOD); const bf16_t* YR = (const bf16_t*)(F.a->ws + WS_YR); const int* pos = (const int*)(F.a->ws + WS_POS);
    const int tok0 = F.bid * 128 + wave * 16, b = (F.bid * 128) / S, c0 = 16 * lane;
    for (int i = 0; i < 16; ++i) {
        const int row = tok0 + i; float y[16];
#pragma unroll
        for (int k = 0; k < 16; ++k) y[k] = 0.f;
#pragma unroll
        for (int s = 0; s < 4; ++s) { const int pr = pos[row * 4 + s]; const u32x4 y0 = *(const GAS u32x4*)(YR + (size_t)pr * D + c0), y1 = *(const GAS u32x4*)(YR + (size_t)pr * D + c0 + 8);
            y[0] += bflo(y0.x); y[1] += bfhi(y0.x); y[2] += bflo(y0.y); y[3] += bfhi(y0.y); y[4] += bflo(y0.z); y[5] += bfhi(y0.z); y[6] += bflo(y0.w); y[7] += bfhi(y0.w);
            y[8] += bflo(y1.x); y[9] += bfhi(y1.x); y[10] += bflo(y1.y); y[11] += bfhi(y1.y); y[12] += bflo(y1.z); y[13] += bfhi(y1.z); y[14] += bflo(y1.w); y[15] += bfhi(y1.w); }
        float ss = 0.f;
#pragma unroll
        for (int k = 0; k < 16; ++k) ss += y[k] * y[k];
        const float r = rsqrtf(wave_sum(ss) * (1.f / D) + 1e-6f);
#pragma unroll
        for (int q = 0; q < 4; ++q) { const f32x4 x1 = *(const GAS f32x4*)(F.a->out + (size_t)row * D + c0 + 4 * q), gp = *(const f32x4*)(F.a->in[IN_GFFNPOST] + c0 + 4 * q), gf = *(const f32x4*)(mod + b * 6144 + 5120 + c0 + 4 * q);
            f32x4 o;
#pragma unroll
            for (int k = 0; k < 4; ++k) o[k] = x1[k] + gf[k] * (y[4 * q + k] * r * gp[k]);
            *(GAS f32x4*)(F.a->out + (size_t)row * D + c0 + 4 * q) = o; }
    }
}
namespace att {
#define SBAR() __builtin_amdgcn_sched_barrier(0)
typedef short s16x4 __attribute__((ext_vector_type(4)));
typedef short v4i16_t __attribute__((ext_vector_type(4)));
typedef __attribute__((address_space(3))) const char* lds_cptr;
__device__ __forceinline__ int crow(int r, int hi) { return (r & 3) + 8 * (r >> 2) + 4 * hi; }
__device__ __forceinline__ void glds16(const void* gsrc, unsigned lds_dst) { unsigned keep;
    asm volatile("s_mov_b32 %0, m0\n\ts_mov_b32 m0, %2\n\ts_nop 0\n\tglobal_load_lds_dwordx4 %1, off\n\ts_mov_b32 m0, %0" : "=&s"(keep) : "v"(gsrc), "s"(lds_dst) : "memory"); }
__device__ __forceinline__ s16x4 vtr(lds_cptr p) { return __builtin_bit_cast(s16x4, __builtin_amdgcn_ds_read_tr16_b64_v4i16((__attribute__((address_space(3))) v4i16_t*)p)); }
typedef float f32x2_t __attribute__((ext_vector_type(2))); typedef __bf16 bf16x2_t __attribute__((ext_vector_type(2)));
__device__ __forceinline__ unsigned cvtpk_s(float lo, float hi) { f32x2_t v = {lo, hi}; bf16x2_t b = __builtin_convertvector(v, bf16x2_t); return __builtin_bit_cast(unsigned, b); }
#define WAIT_BAR0() asm volatile("s_waitcnt vmcnt(0) lgkmcnt(0)\n\ts_barrier" ::: "memory")

struct Src {
    const bf16_t* q0; const bf16_t* q1; int qp;
    const bf16_t* k0; const bf16_t* k1; int kp0, kp1;
    const bf16_t* v; int vp;
};
template <int DQK, int DV> struct Geo {
    static constexpr int NKC = DQK / 8, NVB = DV / 32, KSLOT = NKC * 1024, VSLOT = NVB * 4096, NPIECE = NKC + 4 * NVB;
    static constexpr int LDS_K = 0, LDS_V = 2 * KSLOT, LDS_WS = LDS_V + 2 * VSLOT, LDS_OST = LDS_WS + 8 * 256, LDS_TOTAL = LDS_OST + 8 * 32 * DV * 2;
};
constexpr float THR = 8.f;

template <int DQK, int DV, int MODE>
__device__ __forceinline__ void attn_unit(LAS char* shm, const Src sc, int qb, bf16_t* obase, float* td, float lam, const float* gsub) {
    typedef Geo<DQK, DV> G;
    int tid_ = threadIdx.x; asm volatile("" : "+v"(tid_));
    const int tid = tid_, lane = tid & 63, r32 = lane & 31, hi = lane >> 5; const int wid = __builtin_amdgcn_readfirstlane(tid >> 6);
    const int q0 = qb * 256, NT = 4 * (qb + 1);
    const unsigned lds0 = (unsigned)(uintptr_t)shm;
    LAS float* wsf = (LAS float*)(shm + G::LDS_WS) + wid * 64;
    const char* src[3]; long step[3]; unsigned dst[3], sstep[3];
#pragma unroll
    for (int i = 0; i < 3; ++i) { const int p = wid + 8 * i;
        if (p < G::NKC) { const bf16_t* base = p < 8 ? sc.k0 + 8 * p : sc.k1 + 8 * (p - 8); const int pitch = p < 8 ? sc.kp0 : sc.kp1;
            src[i] = (const char*)(base + (long)lane * pitch); step[i] = 128L * pitch; dst[i] = lds0 + G::LDS_K + p * 1024; sstep[i] = G::KSLOT; }
        else { const int pv = p - G::NKC, db = pv >> 2, rg = pv & 3;
            src[i] = (const char*)(sc.v + (long)(16 * rg + (lane >> 2)) * sc.vp + 32 * db + 8 * (lane & 3)); step[i] = 128L * sc.vp; dst[i] = lds0 + G::LDS_V + pv * 1024; sstep[i] = G::VSLOT; } }
#define DMA_TILE(slot) do { _Pragma("unroll") for (int i_ = 0; i_ < 3; ++i_) if (wid + 8 * i_ < G::NPIECE) { glds16(src[i_], (unsigned)__builtin_amdgcn_readfirstlane(dst[i_] + (slot) * sstep[i_])); src[i_] += step[i_]; } } while (0)
    DMA_TILE(0);
    bf16x8 qr[DQK / 16];
    { const long qrow = (long)(q0 + wid * 32 + r32) * sc.qp;
#pragma unroll
      for (int d0 = 0; d0 < DQK / 16; ++d0) qr[d0] = d0 < 4 ? *reinterpret_cast<const bf16x8*>(sc.q0 + qrow + d0 * 16 + hi * 8) : *reinterpret_cast<const bf16x8*>(sc.q1 + qrow + (d0 - 4) * 16 + hi * 8); }
    float m_run = -1e30f, l_reg = 0.f;
    f32x16 o[G::NVB];
#pragma unroll
    for (int d = 0; d < G::NVB; ++d) o[d] = f32x16{};
    const int qrel = wid * 32 + r32;
    const lds_cptr shm3 = (lds_cptr)shm;
    const lds_cptr kp0 = shm3 + G::LDS_K + hi * 1024 + r32 * 16;
    const lds_cptr vp0 = shm3 + G::LDS_V + ((lane >> 4) & 1) * 32 + (lane & 3) * 8 + (4 * hi + ((lane & 15) >> 2)) * 64;
    for (int t = 0; t < NT; ++t) {
        WAIT_BAR0();
        if (t + 1 < NT) DMA_TILE((t + 1) & 1);
        const int jb = t - (NT - 4);
        if (jb >= 0 && 64 * jb > 32 * wid + 31) continue;
        const lds_cptr kp = kp0 + (t & 1) * G::KSLOT; const lds_cptr vpp = vp0 + (t & 1) * G::VSLOT;
        f32x16 p0 = f32x16{}, p1 = f32x16{};
#pragma unroll
        for (int d0 = 0; d0 < DQK / 16; ++d0) {
            const bf16x8 b0 = *(const __attribute__((address_space(3))) bf16x8*)(kp + d0 * 2048);
            const bf16x8 b1 = *(const __attribute__((address_space(3))) bf16x8*)(kp + d0 * 2048 + 512);
            p0 = __builtin_amdgcn_mfma_f32_32x32x16_bf16(b0, qr[d0], p0, 0, 0, 0); p1 = __builtin_amdgcn_mfma_f32_32x32x16_bf16(b1, qr[d0], p1, 0, 0, 0); }
        if (jb >= 0) { const int kb = 64 * jb + 4 * hi;
#pragma unroll
            for (int r = 0; r < 16; ++r) { const int kv = kb + (r & 3) + 8 * (r >> 2); if (kv > qrel) p0[r] = -INFINITY; if (kv + 32 > qrel) p1[r] = -INFINITY; } }
        float rm = fmaxf(p0[0], p1[0]);
#pragma unroll
        for (int r = 1; r < 16; ++r) rm = fmaxf(rm, fmaxf(p0[r], p1[r]));
        { auto rr = __builtin_amdgcn_permlane32_swap(__float_as_uint(rm), __float_as_uint(rm), false, false); rm = fmaxf(__uint_as_float(rr[0]), __uint_as_float(rr[1])); }
        if (__any(rm > m_run + THR)) {
            const float mn = fmaxf(m_run, rm), f = __builtin_amdgcn_exp2f(m_run - mn); m_run = mn; l_reg *= f;
            if (hi == 0) wsf[r32] = f;
            asm volatile("s_waitcnt lgkmcnt(0)" ::: "memory");
#pragma unroll
            for (int g = 0; g < 4; ++g) { const f32x4 fv = *(const LAS f32x4*)(wsf + 8 * g + 4 * hi);
#pragma unroll
                for (int d = 0; d < G::NVB; ++d) { o[d][4 * g] *= fv[0]; o[d][4 * g + 1] *= fv[1]; o[d][4 * g + 2] *= fv[2]; o[d][4 * g + 3] *= fv[3]; } }
        }
        float sacc = 0.f;
#pragma unroll
        for (int r = 0; r < 16; ++r) { p0[r] = __builtin_amdgcn_exp2f(p0[r] - m_run); p1[r] = __builtin_amdgcn_exp2f(p1[r] - m_run); sacc += p0[r] + p1[r]; }
        l_reg += sacc;
        u32x4 pw[4];
#pragma unroll
        for (int k = 0; k < 4; ++k) { pw[0][k] = cvtpk_s(p0[2 * k], p0[2 * k + 1]); pw[1][k] = cvtpk_s(p0[8 + 2 * k], p0[8 + 2 * k + 1]); pw[2][k] = cvtpk_s(p1[2 * k], p1[2 * k + 1]); pw[3][k] = cvtpk_s(p1[8 + 2 * k], p1[8 + 2 * k + 1]); }
#pragma unroll
        for (int d = 0; d < G::NVB; ++d) {
#pragma unroll
            for (int ks = 0; ks < 4; ++ks) { const s16x4 lo = vtr(vpp + d * 4096 + ks * 1024), hh = vtr(vpp + d * 4096 + ks * 1024 + 512);
                const bf16x8 vf = {lo[0], lo[1], lo[2], lo[3], hh[0], hh[1], hh[2], hh[3]};
                o[d] = __builtin_amdgcn_mfma_f32_32x32x16_bf16(__builtin_bit_cast(bf16x8, pw[ks]), vf, o[d], 0, 0, 0); } }
    }
    { auto rr = __builtin_amdgcn_permlane32_swap(__float_as_uint(l_reg), __float_as_uint(l_reg), false, false); l_reg = __uint_as_float(rr[0]) + __uint_as_float(rr[1]); }
    if (hi == 0) wsf[32 + r32] = l_reg;
    asm volatile("s_waitcnt lgkmcnt(0)" ::: "memory");
    float rli[16];
#pragma unroll
    for (int r = 0; r < 16; ++r) rli[r] = __builtin_amdgcn_rcpf(wsf[32 + crow(r, hi)]);
    const long orow0 = (long)(q0 + wid * 32);
    if (MODE == 1) {
#pragma unroll
        for (int r = 0; r < 16; ++r)
#pragma unroll
            for (int d = 0; d < G::NVB; ++d) td[(orow0 + crow(r, hi)) * 512 + d * 32 + r32] = o[d][r] * rli[r];
    } else {
        if (MODE == 2) {
            float ssr[16];
#pragma unroll
            for (int r = 0; r < 16; ++r) { float ss = 0.f;
#pragma unroll
                for (int d = 0; d < G::NVB; ++d) { const float v = td[(orow0 + crow(r, hi)) * 512 + d * 32 + r32] - lam * (o[d][r] * rli[r]); o[d][r] = v; ss += v * v; }
#pragma unroll
                for (int x = 1; x < 32; x <<= 1) ss += __shfl_xor(ss, x);
                ssr[r] = rsqrtf(ss * (1.f / DV) + 1e-5f) * (1.f - LAMBDA_INIT); }
#pragma unroll
            for (int d = 0; d < G::NVB; ++d) { const float gv = gsub[d * 32 + r32];
#pragma unroll
                for (int r = 0; r < 16; ++r) o[d][r] *= ssr[r] * gv; }
#pragma unroll
            for (int r = 0; r < 16; ++r) rli[r] = 1.f;
        }
        LAS bf16_t* stg = (LAS bf16_t*)(shm + G::LDS_OST) + wid * 32 * DV;
#pragma unroll
        for (int r = 0; r < 16; ++r) { const int orow = crow(r, hi);
#pragma unroll
            for (int d = 0; d < G::NVB; ++d) stg[orow * DV + d * 32 + r32] = (bf16_t)(cvtpk_s(o[d][r] * rli[r], 0.f) & 0xffffu); }
        asm volatile("s_waitcnt lgkmcnt(0)" ::: "memory");
        constexpr int CPR = DV / 8;
#pragma unroll
        for (int i = 0; i < 32 * CPR / 64; ++i) { const int idx = i * 64 + lane, row = idx / CPR, ch = idx % CPR; const u32x4 v = *(const LAS u32x4*)(stg + row * DV + ch * 8);
            *(u32x4*)(obase + (orow0 + row) * 1024 + ch * 8) = v; }
    }
    asm volatile("s_waitcnt vmcnt(0) lgkmcnt(0)\n\ts_barrier" ::: "memory");
#undef DMA_TILE
}
#undef SBAR
#undef WAIT_BAR0
}

__device__ __forceinline__ void attn_phase_all(Frame& F) {
    LAS char* shm = (LAS char*)(F.lds + RING_OFF);
    const int vcu = (F.bid & 7) * (F.G >> 3) + (F.bid >> 3);
    const bf16_t* QM = (const bf16_t*)(F.a->ws + WS_QM); const bf16_t* KVM = (const bf16_t*)(F.a->ws + WS_KVM); const bf16_t* PR = (const bf16_t*)(F.a->ws + WS_PROJ); bf16_t* ATT = (bf16_t*)(F.a->ws + WS_ATT);
    { const int p = vcu >> 1, b = p >> 3, h = p & 7, half = vcu & 1; const long r0 = (long)b * S;
      att::Src sc{QM + r0 * 768 + h * 64, QM + r0 * 768 + 512 + h * 32, 768, KVM + r0 * 1024 + h * 128, PR + r0 * PJ + PC_KR, 1024, PJ, KVM + r0 * 1024 + h * 128 + 64, 1024};
      for (int i = 0; i < 4; ++i) { const int qb = half == 0 ? (i == 0 ? 7 : i == 1 ? 5 : i == 2 ? 2 : 0) : (i == 0 ? 6 : i == 1 ? 4 : i == 2 ? 3 : 1);
          att::attn_unit<96, 64, 0>(shm, sc, qb, ATT + r0 * 1024 + h * 64, nullptr, 0.f, nullptr); } }
    { const int p = vcu >> 2, b = p >> 2, h = p & 3, s4 = vcu & 3; const long r0 = (long)b * S;
      float lam; { const float* l1 = F.a->in[IN_LQ1]; const float* k1 = F.a->in[IN_LK1]; const float* l2 = F.a->in[IN_LQ2]; const float* k2 = F.a->in[IN_LK2]; float s1 = 0.f, s2 = 0.f;
          for (int i = 0; i < 64; ++i) { s1 += l1[i] * k1[i]; s2 += l2[i] * k2[i]; } lam = __expf(s1) - __expf(s2) + LAMBDA_INIT; }
      float* td = (float*)(F.a->ws + WS_Y) + r0 * 512 + h * 128;
      for (int i = 0; i < 2; ++i) { const int qb = i == 0 ? 7 - s4 : s4;
          att::Src s0{PR + r0 * PJ + PC_QD + (2 * h) * 64, nullptr, PJ, PR + r0 * PJ + PC_KD + (2 * h) * 64, nullptr, PJ, PJ, PR + r0 * PJ + PC_VD + h * 128, PJ};
          att::Src s1{PR + r0 * PJ + PC_QD + (2 * h + 1) * 64, nullptr, PJ, PR + r0 * PJ + PC_KD + (2 * h + 1) * 64, nullptr, PJ, PJ, PR + r0 * PJ + PC_VD + h * 128, PJ};
          att::attn_unit<64, 128, 1>(shm, s0, qb, nullptr, td, 0.f, nullptr);
          att::attn_unit<64, 128, 2>(shm, s1, qb, ATT + r0 * 1024 + 512 + h * 128, td, lam, F.a->in[IN_GSUBLN]); } }
}
__device__ __forceinline__ void offsets_from_counts(Frame& F) {
    PHASE_IDS();
    int* cnt = (int*)(F.a->ws + WS_CNT);
    LAS int* part = (LAS int*)(F.lds + RING_OFF);
    LAS int* tile_e = (LAS int*)(F.lds + X_TILEE); LAS int* m2 = (LAS int*)(F.lds + X_MISC2);
    { const int e = tid & 31, p = tid >> 5; int tot = 0, pre = 0;
      for (int w = p * 16; w < p * 16 + 16; ++w) { const int c = __hip_atomic_load(cnt + w * NE + e, RLX_AGENT); tot += c; if (w < F.bid) pre += c; }
      part[(p * 32 + e) * 2] = tot; part[(p * 32 + e) * 2 + 1] = pre; }
    __syncthreads();
    if (tid < NE) { int tot = 0, pre = 0; for (int p = 0; p < 16; ++p) { tot += part[(p * 32 + tid) * 2]; pre += part[(p * 32 + tid) * 2 + 1]; } m2[96 + tid] = tot; m2[64 + tid] = pre; }
    __syncthreads();
    if (tid < NE) { int st = 0; for (int e = 0; e < tid; ++e) st += (m2[96 + e] + 255) & ~255; m2[32 + tid] = st; const int pad = (m2[96 + tid] + 255) & ~255;
        for (int r = st; r < st + pad; r += 256) tile_e[r >> 8] = tid; if (tid == NE - 1) m2[0] = (st + pad) >> 8; }
    __syncthreads();
}
__device__ __forceinline__ void p6_scatter(Frame& F) {
    offsets_from_counts(F);
    PHASE_IDS();
    LAS int* m2 = (LAS int*)(F.lds + X_MISC2);
    int* rowtok = (int*)(F.a->ws + WS_ROWTOK); float* roww = (float*)(F.a->ws + WS_ROWW); int* pos = (int*)(F.a->ws + WS_POS);
    { const int a = F.bid * 512 + tid; const int e = ((const int*)(F.a->ws + WS_SE))[a]; const float gt = ((const float*)(F.a->ws + WS_SG))[a]; const int rk = ((const int*)(F.a->ws + WS_SRANK))[a];
      const int dst = m2[32 + e] + m2[64 + e] + rk, tok = F.bid * 128 + (tid >> 2);
      rowtok[dst] = tok; roww[dst] = gt; pos[tok * 4 + (tid & 3)] = dst; }
    if (F.bid < NE && tid < 256) { const int e = F.bid, tot = m2[96 + e], st = m2[32 + e], pad = (tot + 255) & ~255; const int r = st + tot + tid; if (r < st + pad) { rowtok[r] = 0; roww[r] = 0.f; } }
}

#ifdef DEV_NAIVE_ATTN
template <int MODE>
__global__ void __launch_bounds__(256) k_attn_ref(const bf16_t* QM, const bf16_t* KVM, const bf16_t* PROJ, bf16_t* ATT, float* TD, const float* lq1, const float* lk1, const float* lq2, const float* lk2, const float* gsub) {
    constexpr int DQK = MODE == 0 ? 96 : 64, DV = MODE == 0 ? 64 : 128, NH = MODE == 0 ? 8 : 4;
    __shared__ float Ks[32][DQK]; __shared__ float Vs[32][DV];
    const int bh = blockIdx.y, b = bh / NH, h = bh % NH, q = blockIdx.x * 256 + threadIdx.x, tid = threadIdx.x, t = b * S + q;
    float lam = 0.f;
    if (MODE == 1) { float s1 = 0.f, s2 = 0.f; for (int i = 0; i < 64; ++i) { s1 += lq1[i] * lk1[i]; s2 += lq2[i] * lk2[i]; } lam = expf(s1) - expf(s2) + LAMBDA_INIT; }
    float res[DV];
    for (int j = 0; j < (MODE == 0 ? 1 : 2); ++j) {
        float qv[DQK]; float o[DV];
#pragma unroll
        for (int d = 0; d < DQK; ++d) qv[d] = MODE == 0 ? bf2f(QM[(size_t)t * 768 + (d < 64 ? h * 64 + d : 512 + h * 32 + d - 64)]) : bf2f(PROJ[(size_t)t * PJ + PC_QD + (2 * h + j) * 64 + d]);
#pragma unroll
        for (int d = 0; d < DV; ++d) o[d] = 0.f;
        float m = -1e30f, l = 0.f;
        const int kend = blockIdx.x * 256 + 256;
        for (int k0 = 0; k0 < kend; k0 += 32) {
            __syncthreads();
            for (int i = tid; i < 32 * DQK; i += 256) { const int kk = i / DQK, d = i % DQK; const size_t tk = (size_t)b * S + k0 + kk;
                Ks[kk][d] = MODE == 0 ? (d < 64 ? bf2f(KVM[tk * 1024 + h * 128 + d]) : bf2f(PROJ[tk * PJ + PC_KR + d - 64])) : bf2f(PROJ[tk * PJ + PC_KD + (2 * h + j) * 64 + d]); }
            for (int i = tid; i < 32 * DV; i += 256) { const int kk = i / DV, d = i % DV; const size_t tk = (size_t)b * S + k0 + kk;
                Vs[kk][d] = MODE == 0 ? bf2f(KVM[tk * 1024 + h * 128 + 64 + d]) : bf2f(PROJ[tk * PJ + PC_VD + h * 128 + d]); }
            __syncthreads();
            for (int kk = 0; kk < 32; ++kk) {
                if (k0 + kk > q) break;
                float s = 0.f;
#pragma unroll
                for (int d = 0; d < DQK; ++d) s += qv[d] * Ks[kk][d];
                const float mn = fmaxf(m, s), al = exp2f(m - mn), p = exp2f(s - mn);
                l = l * al + p; m = mn;
#pragma unroll
                for (int d = 0; d < DV; ++d) o[d] = o[d] * al + p * Vs[kk][d];
            }
        }
        const float inv = 1.f / l;
        if (MODE == 0) {
#pragma unroll
            for (int d = 0; d < DV; ++d) ATT[(size_t)t * D + h * 64 + d] = (bf16_t)(cvt_pk_bf16(o[d] * inv, 0.f) & 0xffffu);
        } else if (j == 0) {
#pragma unroll
            for (int d = 0; d < DV; ++d) TD[((size_t)t * 4 + h) * 128 + d] = o[d] * inv;
        } else { float ss = 0.f;
#pragma unroll
            for (int d = 0; d < DV; ++d) { res[d] = TD[((size_t)t * 4 + h) * 128 + d] - lam * (o[d] * inv); ss += res[d] * res[d]; }
            const float r = rsqrtf(ss * (1.f / 128.f) + 1e-5f) * (1.f - LAMBDA_INIT);
#pragma unroll
            for (int d = 0; d < DV; ++d) ATT[(size_t)t * D + 512 + h * 128 + d] = (bf16_t)(cvt_pk_bf16(res[d] * r * gsub[d], 0.f) & 0xffffu);
        }
    }
}
#endif

constexpr int N_PHASES = 11;
__global__ void __launch_bounds__(NWAVES * 64, 2) mk_fwd(Args args) {
    extern __shared__ __attribute__((aligned(16))) unsigned char lds[];
    Frame F;
    F.lds = (LAS unsigned char*)lds; F.MISC = (volatile LAS unsigned*)(F.lds + MISC_OFF);
    F.G = gridDim.x; F.bid = blockIdx.x;
    F.a = &args; F.ctl = (unsigned*)(args.ws + WS_CTL);
    for (int u = threadIdx.x; u < (X_TILEE - LDSCTL_OFF) / 4; u += NWAVES * 64) ((LAS unsigned*)(F.lds + LDSCTL_OFF))[u] = 0u;
    __syncthreads();
    const int lo = args.ph_lo, hi = args.ph_hi;
    XcdBarrier bar; bar.bar = F.ctl + CW_BAR; bar.x = 0; bar.st = nullptr;
    if (hi - lo > 1) bar = xcd_barrier_post(F.ctl + CW_BAR + args.li * XCD_BAR_WORDS, F.MISC + 8);
#ifndef PH_MASK
#define PH_MASK 0x7ff
#endif
#define IN(k) (((PH_MASK >> (k)) & 1) && lo <= (k) && (k) < hi)
#define SEAM(k) do { if (IN(k) && IN((k) + 1)) xcd_barrier(bar); } while (0)
    LAS unsigned char* ring = F.lds + RING_OFF;
    if (IN(0)) { p0_prologue(F); } SEAM(0);
    if (IN(1)) { p0b_norm(F); } SEAM(1);
    if (IN(2)) {
        pg8::Gemm g{(const bf16_t*)(F.a->ws + WS_H), (const bf16_t*)(F.a->ws + WS_WIN), nullptr, 0, D, D, D, 0}; pg8::StaticOrder So; So.init(T, PJ, F.G, F.bid);
        epi::EpiProj E{(bf16_t*)(F.a->ws + WS_PROJ), (const f32x4*)(F.a->ws + WS_TABM), (const f32x4*)(F.a->ws + WS_TABD), (float*)(F.a->ws + WS_SSQ), (float*)(F.a->ws + WS_SSQ) + T};
        pg8::gemm_phase<epi::EpiProj, pg8::StaticOrder, false>(ring, g, So, E);
    } SEAM(2);
    if (IN(3)) {
#ifndef NO_Q
        { pg8::Gemm g{(const bf16_t*)(F.a->ws + WS_PROJ) + PC_CQ, (const bf16_t*)(F.a->ws + WS_WQB), nullptr, 0, PJ, 256, 256, 0}; pg8::StaticOrder So; So.init(T, 768, F.G, F.bid);
          epi::EpiQ E{(bf16_t*)(F.a->ws + WS_QM), (const f32x4*)(F.a->ws + WS_TABM), (const float*)(F.a->ws + WS_SSQ)};
          pg8::gemm_phase<epi::EpiQ, pg8::StaticOrder, false>(ring, g, So, E); }
#endif
#ifndef NO_KV
        { pg8::Gemm g{(const bf16_t*)(F.a->ws + WS_PROJ) + PC_CKV, (const bf16_t*)(F.a->ws + WS_WKVB), nullptr, 0, PJ, 128, 128, 0}; pg8::StaticOrder So; So.init(T, 1024, F.G, F.bid);
          epi::EpiKV E{(bf16_t*)(F.a->ws + WS_KVM), (const float*)(F.a->ws + WS_SSQ) + T};
          pg8::gemm_phase<epi::EpiKV, pg8::StaticOrder, false>(ring, g, So, E); }
#endif
    } SEAM(3);
    if (IN(4)) {
#ifndef DEV_NAIVE_ATTN
        attn_phase_all(F);
#endif
    } SEAM(4);
    if (IN(5)) {
        pg8::Gemm g{(const bf16_t*)(F.a->ws + WS_ATT), (const bf16_t*)(F.a->ws + WS_WO), nullptr, 0, D, D, D, 0}; pg8::StaticOrder So; So.init(T, D, F.G, F.bid);
        epi::EpiY E{(bf16_t*)(F.a->ws + WS_Y), (float*)(F.a->ws + WS_SSQ) + 2 * T};
        pg8::gemm_phase<epi::EpiY, pg8::StaticOrder, false>(ring, g, So, E);
    } SEAM(5);
    if (IN(6)) { p5_rows(F); } SEAM(6);
    if (IN(7)) { p6_scatter(F); } SEAM(7);
    if (IN(8)) {
        offsets_from_counts(F);
        pg8::GroupedOrder So{(const LAS int*)(F.lds + X_TILEE), ((LAS int*)(F.lds + X_MISC2))[0], 8, F.G, F.bid};
        pg8::Gemm g{(const bf16_t*)(F.a->ws + WS_H), (const bf16_t*)(F.a->ws + WS_WGU), (const int*)(F.a->ws + WS_ROWTOK), (size_t)2048 * 1024, D, D, D, 0};
        epi::EpiAct E{(bf16_t*)(F.a->ws + WS_ACT), F.a->in[IN_BGU]};
        pg8::gemm_phase<epi::EpiAct, pg8::GroupedOrder, true>(ring, g, So, E);
    } SEAM(8);
    if (IN(9)) {
        offsets_from_counts(F);
        pg8::GroupedOrder So{(const LAS int*)(F.lds + X_TILEE), ((LAS int*)(F.lds + X_MISC2))[0], 4, F.G, F.bid};
        pg8::Gemm g{(const bf16_t*)(F.a->ws + WS_ACT), (const bf16_t*)(F.a->ws + WS_WD), nullptr, (size_t)1024 * 1024, D, D, D, 0};
        epi::EpiDown E{(bf16_t*)(F.a->ws + WS_YR), F.a->in[IN_BDN], (const float*)(F.a->ws + WS_ROWW)};
        pg8::gemm_phase<epi::EpiDown, pg8::GroupedOrder, false>(ring, g, So, E);
    } SEAM(9);
    if (IN(10)) { p9_final(F); }
#undef IN
#undef SEAM
}

extern "C" void kernel_launch(void* const* d_in, const int* in_sizes, int n_in, void* d_out, int out_size, void* d_ws, size_t ws_size, hipStream_t stream) {
    static int grid = 0;
    if (grid == 0) {
        if (n_in != 26 || in_sizes[0] != T * D || out_size != T * D || ws_size < WS_END) { fprintf(stderr, "kernel_launch: unexpected shapes (n_in %d, ws %zu); nothing launched\n", n_in, ws_size); grid = -1; return; }
        int dev = 0, cus = 0;
        if (hipGetDevice(&dev) != hipSuccess || hipDeviceGetAttribute(&cus, hipDeviceAttributeMultiprocessorCount, dev) != hipSuccess) { grid = -1; return; }
        if (hipFuncSetAttribute((const void*)mk_fwd, hipFuncAttributeMaxDynamicSharedMemorySize, LDS_BYTES) != hipSuccess) { fprintf(stderr, "kernel_launch: hipFuncSetAttribute failed\n"); grid = -1; return; }
        grid = cus;
        if (grid != 256) fprintf(stderr, "kernel_launch: %d CUs; this kernel is built for 256\n", grid);
    }
    if (grid < 0) return;
    (void)hipMemsetAsync((char*)d_ws + WS_CTL, 0, CTL_ZERO_BYTES, stream);
    Args a{};
    for (int i = 0; i < 26; ++i) a.in[i] = (const float*)d_in[i];
    a.out = (float*)d_out; a.ws = (unsigned char*)d_ws;
#ifndef MK_CUTS
#define MK_CUTS {0, N_PHASES}
#endif
    const int cuts[] = MK_CUTS; const int ncut = (int)(sizeof(cuts) / sizeof(int)) - 1;
    for (int li = 0; li < ncut; ++li) {
        a.ph_lo = cuts[li]; a.ph_hi = cuts[li + 1]; a.li = li;
        hipLaunchKernelGGL(mk_fwd, dim3(grid), dim3(NWAVES * 64), LDS_BYTES, stream, a);
#ifdef DEV_NAIVE_ATTN
        if (cuts[li + 1] == 5) {
            unsigned char* ws = (unsigned char*)d_ws;
            k_attn_ref<0><<<dim3(S / 256, NB * 8), 256, 0, stream>>>((const bf16_t*)(ws + WS_QM), (const bf16_t*)(ws + WS_KVM), (const bf16_t*)(ws + WS_PROJ), (bf16_t*)(ws + WS_ATT), nullptr, nullptr, nullptr, nullptr, nullptr, nullptr);
            k_attn_ref<1><<<dim3(S / 256, NB * 4), 256, 0, stream>>>((const bf16_t*)(ws + WS_QM), (const bf16_t*)(ws + WS_KVM), (const bf16_t*)(ws + WS_PROJ), (bf16_t*)(ws + WS_ATT), (float*)(ws + WS_Y),
                (const float*)d_in[IN_LQ1], (const float*)d_in[IN_LK1], (const float*)d_in[IN_LQ2], (const float*)d_in[IN_LK2], (const float*)d_in[IN_GSUBLN]);
        }
#endif
    }
}
```

```cpp
#include <hip/hip_runtime.h>
#include <cstdio>
#include <cstdint>

#define GAS __attribute__((address_space(1)))
#define LAS __attribute__((address_space(3)))
typedef unsigned short bf16_t;
typedef short bf16x8 __attribute__((ext_vector_type(8)));
typedef float f32x4 __attribute__((ext_vector_type(4)));
typedef float f32x2 __attribute__((ext_vector_type(2)));
typedef float f32x16 __attribute__((ext_vector_type(16)));
typedef unsigned u32x4 __attribute__((ext_vector_type(4)));
typedef unsigned u32x2 __attribute__((ext_vector_type(2)));
typedef int i32x4 __attribute__((ext_vector_type(4)));
typedef GAS unsigned gu32;
#define RLX_AGENT __ATOMIC_RELAXED, __HIP_MEMORY_SCOPE_AGENT
#define LDS_WAIT() asm volatile("s_waitcnt lgkmcnt(0)" ::: "memory")
#define VM_WAIT() asm volatile("s_waitcnt vmcnt(0)" ::: "memory")

constexpr int D = 1024, NB = 16, S = 2048, T = NB * S;
constexpr int INC = 1952;
constexpr int PJ = 2048;
constexpr int PC_CQ = 0, PC_CKV = 256, PC_KR = 384, PC_QD = 512, PC_KD = 1024, PC_VD = 1536;
constexpr int NE = 32, TOPK = 4, NA = T * TOPK, NROWS = (NA / 256 + NE) * 256, NTILE_MAX = NROWS / 256;
constexpr float LAMBDA_INIT = 0.2f, LOG2E = 1.4426950408889634f;
constexpr float C2M = 0.10206207261596577f * LOG2E;
constexpr float C2D = 0.125f * LOG2E;
constexpr float W8_SCALE = 64.f, W8_INV = 1.f / 64.f;

__device__ __forceinline__ unsigned cvt_pk_bf16(float lo, float hi) { unsigned r; asm volatile("v_cvt_pk_bf16_f32 %0, %1, %2" : "=v"(r) : "v"(lo), "v"(hi)); return r; }
__device__ __forceinline__ unsigned pack4_fp8(float a, float b, float c, float d) { int w = 0; w = __builtin_amdgcn_cvt_pk_fp8_f32(a, b, w, false); w = __builtin_amdgcn_cvt_pk_fp8_f32(c, d, w, true); return (unsigned)w; }
__device__ __forceinline__ float bf2f(unsigned short h) { return __uint_as_float((unsigned)h << 16); }
__device__ __forceinline__ float bflo(unsigned w) { return __uint_as_float(w << 16); }
__device__ __forceinline__ float bfhi(unsigned w) { return __uint_as_float(w & 0xffff0000u); }
__device__ __forceinline__ float wave_sum(float v) {
#pragma unroll
    for (int o = 1; o < 64; o <<= 1) v += __shfl_xor(v, o);
    return v;
}

namespace pg8 {
constexpr int BM = 256, BK = 64, HALF = 128, HTB = HALF * BK * 2, STAGE_BYTES = 8 * HTB, NXCD = 8, WGM = 8;
__host__ __device__ __forceinline__ int lds_byte(int r, int c) { const int st = (r >> 4) * 2 + (c >> 5), rr = r & 15, cc = c & 31, ob = rr * 64 + cc * 2; return st * 1024 + (ob ^ (((ob >> 9) & 1) << 5)); }
__host__ __device__ __forceinline__ void stage_rc(int b, int& R, int& C) { const int st = b / 1024, sb = b % 1024, swz = sb ^ (((sb >> 9) & 1) << 5); R = (st >> 1) * 16 + swz / 64; C = (st & 1) * 32 + (swz % 64) / 2; }
__host__ __device__ __forceinline__ int perm32(int rho) { const int n = rho >> 4, i = rho & 15; return 8 * (i >> 2) + 4 * n + (i & 3); }

struct Unit { int pm, pn, e; };
struct Gemm { const bf16_t* A; const bf16_t* Bt; const int* rowidx; size_t b_estride; int lda, ldb, K, pad; };

struct StaticOrder {
    int nM, nN, nwg, G, c;
    __host__ __device__ void init(int M, int N, int G_, int c_) { nM = M / BM; nN = N / BM; nwg = nM * nN; G = G_; c = c_; }
    __host__ __device__ bool next(int i, Unit& u) const {
        const long L = (long)i * G + c; if (L >= nwg) return false;
        int wgid = (int)L; { const int q = nwg / NXCD, r = nwg % NXCD, xcd = wgid % NXCD, off = wgid / NXCD; wgid = (xcd < r ? xcd * (q + 1) : r * (q + 1) + (xcd - r) * q) + off; }
        const int nig = WGM * nN, gid = wgid / nig, fm = gid * WGM, gsz = (nM - fm) < WGM ? (nM - fm) : WGM;
        u.pm = fm + ((wgid % nig) % gsz); u.pn = (wgid % nig) / gsz; u.e = 0; return true;
    }
};
struct GroupedOrder {
    const LAS int* tile_e; int ntiles, ncol, G, c;
    __device__ bool next(int i, Unit& u) const {
        const int L = i * G + c, xcd = L & 7, j = L >> 3, block = j >> 5, within = j & 31, rpc = 32 / ncol;
        const int r = within / ncol, pn = within % ncol, rt = (block * 8 + xcd) * rpc + r;
        if (rt >= ntiles) return false;
        u.pm = rt; u.pn = pn; u.e = __builtin_amdgcn_readfirstlane(tile_e[rt]); return true;
    }
};

template <class Epi, class Sched, bool GATHER = false, bool FP8 = false>
__device__ __forceinline__ void gemm_phase(LAS unsigned char* lds, const Gemm g, const Sched& S, const Epi& E, LAS unsigned char* idxl = nullptr) {
    int tid_ = threadIdx.x; asm volatile("" : "+v"(tid_));
    const int tid = tid_, wid = __builtin_amdgcn_readfirstlane(tid >> 6), lane = tid & 63, wr = wid >> 2, wc = wid & 3, fr = lane & 15, fq = lane >> 4;
    const int K = g.K, nt = K / BK;
    int Rr[2], Cc[2];
    unsigned voffA[2][2], voffB[2];
#pragma unroll
    for (int i = 0; i < 2; ++i) { stage_rc(tid * 16 + i * 8192, Rr[i], Cc[i]); const int Rb = Epi::PERM ? ((Rr[i] & ~31) + perm32(Rr[i] & 31)) : Rr[i];
        voffA[0][i] = (unsigned)(Rr[i] * g.lda + Cc[i]) * 2u; voffA[1][i] = (unsigned)((Rr[i] + HALF) * g.lda + Cc[i]) * 2u; voffB[i] = (unsigned)(Rb * g.ldb + Cc[i]) * 2u; }
    const unsigned kstep = BK * 2, hstepB = (unsigned)(HALF * g.ldb * 2), tstepA = (unsigned)(BM * g.lda * 2), tstepB = 2 * hstepB;
    const __amdgpu_buffer_rsrc_t rA = __builtin_amdgcn_make_buffer_rsrc((void*)g.A, 0, 0x7ffffff0, 0x00020000), rB = __builtin_amdgcn_make_buffer_rsrc((void*)g.Bt, 0, 0x7ffffff0, 0x00020000);
    const unsigned ldsw = (unsigned)wid * 1024u;
    const int aoff = lds_byte(wr * 64 + fr, fq * 8), boff = lds_byte(wc * 32 + fr, fq * 8);
#define PG8_SA(b, h) (((b) * 2 + (h)) * HTB)
#define PG8_SB(b, h) ((4 + (b) * 2 + (h)) * HTB)
#define PG8_STAGE(bufoff, rs, soff, voff) do { _Pragma("unroll") for (int _i = 0; _i < 2; ++_i) \
        __builtin_amdgcn_raw_ptr_buffer_load_lds(rs, (LAS void*)(lds + (bufoff) + ldsw + _i * 8192), 16, (int)(voff)[_i], (int)(soff), 0, 0); } while (0)
#define PG8_LDA(dst, b, h) do { _Pragma("unroll") for (int m = 0; m < 4; ++m) _Pragma("unroll") for (int k = 0; k < 2; ++k) dst[m][k] = *(const LAS bf16x8*)(lds + PG8_SA(b, h) + aoff + m * 2048 + k * 1024); } while (0)
#define PG8_LDB(dst, b, h) do { _Pragma("unroll") for (int n = 0; n < 2; ++n) _Pragma("unroll") for (int k = 0; k < 2; ++k) dst[n][k] = *(const LAS bf16x8*)(lds + PG8_SB(b, h) + boff + n * 2048 + k * 1024); } while (0)
#define PG8_MMA(ai, bj, At, Bt) do { __builtin_amdgcn_s_setprio(1); _Pragma("unroll") for (int m = 0; m < 4; ++m) _Pragma("unroll") for (int n = 0; n < 2; ++n) { \
        if constexpr (FP8) acc[ai][bj][m][n] = __builtin_amdgcn_mfma_scale_f32_16x16x128_f8f6f4(PG8_CAT(Bt[n][0], Bt[n][1]), PG8_CAT(At[m][0], At[m][1]), acc[ai][bj][m][n], 0, 0, 0, 0x7f7f7f7f, 0, 0x7f7f7f7f); \
        else { _Pragma("unroll") for (int k = 0; k < 2; ++k) acc[ai][bj][m][n] = __builtin_amdgcn_mfma_f32_16x16x32_bf16(Bt[n][k], At[m][k], acc[ai][bj][m][n], 0, 0, 0); } } __builtin_amdgcn_s_setprio(0); } while (0)
#define PG8_CAT(x0, x1) __builtin_shufflevector(__builtin_bit_cast(i32x4, x0), __builtin_bit_cast(i32x4, x1), 0, 1, 2, 3, 4, 5, 6, 7)
#define PG8_WAIT_V(n) asm volatile("s_waitcnt vmcnt(" #n ")" ::: "memory")
#define PG8_WAIT_L(n) asm volatile("s_waitcnt lgkmcnt(" #n ")" ::: "memory")
#define PG8_BAR __builtin_amdgcn_s_barrier()
#define PG8_SCHED __builtin_amdgcn_sched_barrier(0)
    Unit cur, nxt; int ui = 0;
    if (!S.next(0, cur)) return;
    f32x4 acc[2][2][4][2];
#pragma unroll
    for (int a = 0; a < 2; ++a)
#pragma unroll
        for (int b = 0; b < 2; ++b)
#pragma unroll
            for (int m = 0; m < 4; ++m)
#pragma unroll
                for (int n = 0; n < 2; ++n) acc[a][b][m][n] = (f32x4){0.f, 0.f, 0.f, 0.f};
    bf16x8 At[4][2], B0[2][2], B1[2][2];
    unsigned gA[2][2];
    unsigned cA, cB = (unsigned)cur.e * (unsigned)(g.b_estride * 2) + (unsigned)cur.pn * tstepB;
    if constexpr (GATHER) { cA = 0u;
#pragma unroll
        for (int h = 0; h < 2; ++h)
#pragma unroll
            for (int i = 0; i < 2; ++i) gA[h][i] = (unsigned)g.rowidx[cur.pm * BM + h * HALF + Rr[i]] * (unsigned)(g.lda * 2) + (unsigned)Cc[i] * 2u;
    } else { cA = (unsigned)cur.pm * tstepA;
#pragma unroll
        for (int h = 0; h < 2; ++h)
#pragma unroll
            for (int i = 0; i < 2; ++i) gA[h][i] = voffA[h][i]; }
    PG8_STAGE(PG8_SB(0, 0), rB, cB, voffB); PG8_STAGE(PG8_SB(0, 1), rB, cB + hstepB, voffB); PG8_STAGE(PG8_SA(0, 0), rA, cA, gA[0]); PG8_STAGE(PG8_SA(0, 1), rA, cA, gA[1]);
    if (wr == 1) PG8_BAR;
    PG8_WAIT_V(2); PG8_BAR;
    PG8_STAGE(PG8_SB(1, 0), rB, cB + kstep, voffB); PG8_STAGE(PG8_SA(1, 0), rA, cA + kstep, gA[0]); PG8_STAGE(PG8_SB(1, 1), rB, cB + hstepB + kstep, voffB);
    PG8_WAIT_V(6); PG8_BAR;
    for (;;) {
        const bool has_next = S.next(ui + 1, nxt);
        unsigned nA; const unsigned nB = has_next ? (unsigned)nxt.e * (unsigned)(g.b_estride * 2) + (unsigned)nxt.pn * tstepB : cB;
        if constexpr (GATHER) nA = cA; else nA = has_next ? (unsigned)nxt.pm * tstepA : cA;
#pragma nounroll
        for (int t = 0; t < nt; t += 2) {
            const bool last = (t == nt - 2);
            const unsigned a1 = cA + (unsigned)(t + 1) * kstep;
            const unsigned a2 = last ? nA : cA + (unsigned)(t + 2) * kstep, b2 = last ? nB : cB + (unsigned)(t + 2) * kstep;
            const unsigned a3 = a2 + kstep, b3 = b2 + kstep;
            if constexpr (GATHER) { if (t == 0 && has_next && wid < 4)
                __builtin_amdgcn_global_load_lds((const unsigned*)(g.rowidx + nxt.pm * BM + wid * 64 + lane), (LAS unsigned*)(idxl + ((ui + 1) & 1) * 1024 + wid * 256), 4, 0, 0); }
            PG8_LDB(B0, 0, 0); PG8_LDB(B1, 0, 1); PG8_SCHED; PG8_LDA(At, 0, 0); PG8_STAGE(PG8_SA(1, 1), rA, a1, gA[1]);
            if constexpr (GATHER) { if (last && has_next) { int t3 = threadIdx.x; asm volatile("" : "+v"(t3));
#pragma unroll
                for (int i = 0; i < 2; ++i) { int R3, C3; stage_rc(t3 * 16 + i * 8192, R3, C3);
#pragma unroll
                    for (int h = 0; h < 2; ++h) gA[h][i] = *(const LAS unsigned*)(idxl + ((ui + 1) & 1) * 1024 + (h * HALF + R3) * 4) * (unsigned)(g.lda * 2) + (unsigned)C3 * 2u; } } }
            PG8_WAIT_V(8); PG8_WAIT_L(0); PG8_BAR; PG8_MMA(0, 0, At, B0); PG8_MMA(0, 1, At, B1); PG8_BAR; PG8_SCHED;
            PG8_LDA(At, 0, 1); PG8_STAGE(PG8_SB(0, 0), rB, b2, voffB); PG8_STAGE(PG8_SB(0, 1), rB, b2 + hstepB, voffB); PG8_STAGE(PG8_SA(0, 0), rA, a2, gA[0]);
            PG8_WAIT_V(8); PG8_WAIT_L(0); PG8_BAR; PG8_MMA(1, 0, At, B0); PG8_MMA(1, 1, At, B1); PG8_BAR; PG8_SCHED;
            PG8_LDB(B0, 1, 0); PG8_LDB(B1, 1, 1); PG8_SCHED; PG8_LDA(At, 1, 0); PG8_STAGE(PG8_SA(0, 1), rA, a2, gA[1]);
            PG8_WAIT_V(8); PG8_WAIT_L(0); PG8_BAR; PG8_MMA(0, 0, At, B0); PG8_MMA(0, 1, At, B1); PG8_BAR; PG8_SCHED;
            PG8_LDA(At, 1, 1); PG8_STAGE(PG8_SB(1, 0), rB, b3, voffB); PG8_STAGE(PG8_SB(1, 1), rB, b3 + hstepB, voffB); PG8_STAGE(PG8_SA(1, 0), rA, a3, gA[0]);
            PG8_WAIT_V(8); PG8_WAIT_L(0); PG8_BAR; PG8_MMA(1, 0, At, B0); PG8_MMA(1, 1, At, B1); PG8_BAR; PG8_SCHED;
        }
        if (wr == 0) PG8_BAR;
        { int t2 = threadIdx.x; asm volatile("" : "+v"(t2)); E(acc, cur, wr, wc, t2 & 15, (t2 >> 4) & 3); }
        if (!has_next) break;
#pragma unroll
        for (int a = 0; a < 2; ++a)
#pragma unroll
            for (int b = 0; b < 2; ++b)
#pragma unroll
                for (int m = 0; m < 4; ++m)
#pragma unroll
                    for (int n = 0; n < 2; ++n) acc[a][b][m][n] = (f32x4){0.f, 0.f, 0.f, 0.f};
        cur = nxt; cA = nA; cB = nB; ++ui;
        if (wr == 1) PG8_BAR;
    }
    PG8_WAIT_V(0);
    PG8_BAR;
#undef PG8_SA
#undef PG8_SB
#undef PG8_STAGE
#undef PG8_LDA
#undef PG8_LDB
#undef PG8_MMA
#undef PG8_CAT
#undef PG8_WAIT_V
#undef PG8_WAIT_L
#undef PG8_BAR
#undef PG8_SCHED
}
}
namespace epi {
using pg8::Unit; using pg8::HALF; using pg8::BM;
__device__ __forceinline__ u32x4 pack8(f32x4 a, f32x4 b) { u32x4 w; w.x = cvt_pk_bf16(a[0], a[1]); w.y = cvt_pk_bf16(a[2], a[3]); w.z = cvt_pk_bf16(b[0], b[1]); w.w = cvt_pk_bf16(b[2], b[3]); return w; }
__device__ __forceinline__ u32x2 pack4(f32x4 a) { u32x2 w; w.x = cvt_pk_bf16(a[0], a[1]); w.y = cvt_pk_bf16(a[2], a[3]); return w; }
__device__ __forceinline__ void rope4(f32x4& a, f32x4& b, const f32x4 t0, const f32x4 t1) {
    const f32x4 c = {t0[0], t0[2], t1[0], t1[2]}, s = {t0[1], t0[3], t1[1], t1[3]};
    const f32x4 na = a * c - b * s, nb = b * c + a * s; a = na; b = nb;
}
__device__ __forceinline__ void ssq_add(float* ssq, int row, float ss, int fq) { ss += __shfl_xor(ss, 16); ss += __shfl_xor(ss, 32); if (fq == 0) atomicAdd(ssq + row, ss); }
__device__ __forceinline__ float sq8(f32x4 a, f32x4 b) { return (a[0] * a[0] + a[1] * a[1]) + (a[2] * a[2] + a[3] * a[3]) + (b[0] * b[0] + b[1] * b[1]) + (b[2] * b[2] + b[3] * b[3]); }

struct EpiProj {
    static constexpr bool PERM = true;
    bf16_t* P; const f32x4* tabm; const f32x4* tabd; float* ssq_q; float* ssq_kv;
    __device__ __forceinline__ void operator()(const f32x4 (&acc)[2][2][4][2], const Unit& u, int wr, int wc, int fr, int fq) const {
        const int row0 = u.pm * BM + wr * 64 + fr, pn = u.pn;
#pragma unroll
        for (int ai = 0; ai < 2; ++ai)
#pragma unroll
            for (int m = 0; m < 4; ++m) { const int row = row0 + ai * HALF + m * 16; bf16_t* rp = P + (size_t)row * PJ;
                if (pn == 0) { float ss = 0.f;
#pragma unroll
                    for (int bj = 0; bj < 2; ++bj) { const f32x4 v0 = acc[ai][bj][m][0], v1 = acc[ai][bj][m][1]; ss += sq8(v0, v1); *(u32x4*)(rp + bj * HALF + wc * 32 + 8 * fq) = pack8(v0, v1); }
                    ssq_add(ssq_q, row, ss, fq);
                } else if (pn == 1) {
                    { const f32x4 v0 = acc[ai][0][m][0], v1 = acc[ai][0][m][1]; *(u32x4*)(rp + 256 + wc * 32 + 8 * fq) = pack8(v0, v1); ssq_add(ssq_kv, row, sq8(v0, v1), fq); }
                    if (wc == 0) { f32x4 a = acc[ai][1][m][0], b = acc[ai][1][m][1]; const f32x4 t0 = tabm[(size_t)row * 8 + 2 * fq], t1 = tabm[(size_t)row * 8 + 2 * fq + 1]; rope4(a, b, t0, t1);
                        *(u32x2*)(rp + PC_KR + 4 * fq) = pack4(a); *(u32x2*)(rp + PC_KR + 16 + 4 * fq) = pack4(b); }
                } else if (pn < 6) { const int g = 4 * (wc & 1) + fq; const f32x4 t0 = tabd[(size_t)row * 16 + 2 * g], t1 = tabd[(size_t)row * 16 + 2 * g + 1]; const float sc = pn < 4 ? C2D : 1.f;
#pragma unroll
                    for (int bj = 0; bj < 2; ++bj) { f32x4 a = acc[ai][bj][m][0] * sc, b = acc[ai][bj][m][1] * sc; rope4(a, b, t0, t1);
                        bf16_t* bp = rp + pn * 256 + bj * HALF + (wc >> 1) * 64 + 4 * g; *(u32x2*)bp = pack4(a); *(u32x2*)(bp + 32) = pack4(b); }
                } else {
#pragma unroll
                    for (int bj = 0; bj < 2; ++bj) *(u32x4*)(rp + pn * 256 + bj * HALF + wc * 32 + 8 * fq) = pack8(acc[ai][bj][m][0], acc[ai][bj][m][1]);
                }
            }
    }
};
struct EpiQ {
    static constexpr bool PERM = true;
    bf16_t* Q; const f32x4* tabm; const float* ssq_q;
    __device__ __forceinline__ void operator()(const f32x4 (&acc)[2][2][4][2], const Unit& u, int wr, int wc, int fr, int fq) const {
        const int row0 = u.pm * BM + wr * 64 + fr;
        if (u.pn < 2) {
#pragma unroll
            for (int ai = 0; ai < 2; ++ai)
#pragma unroll
                for (int m = 0; m < 4; ++m) { const int row = row0 + ai * HALF + m * 16; const float rs = rsqrtf(ssq_q[row] * (1.f / 256.f) + 1e-6f) * C2M; bf16_t* rp = Q + (size_t)row * 768 + u.pn * BM + wc * 32 + 8 * fq;
#pragma unroll
                    for (int bj = 0; bj < 2; ++bj) *(u32x4*)(rp + bj * HALF) = pack8(acc[ai][bj][m][0] * rs, acc[ai][bj][m][1] * rs); }
        } else {
#pragma unroll
            for (int ai = 0; ai < 2; ++ai)
#pragma unroll
                for (int m = 0; m < 4; ++m) { const int row = row0 + ai * HALF + m * 16; const float rs = rsqrtf(ssq_q[row] * (1.f / 256.f) + 1e-6f) * C2M; bf16_t* rp = Q + (size_t)row * 768 + 512 + wc * 32 + 4 * fq;
                    const f32x4 t0 = tabm[(size_t)row * 8 + 2 * fq], t1 = tabm[(size_t)row * 8 + 2 * fq + 1];
#pragma unroll
                    for (int bj = 0; bj < 2; ++bj) { f32x4 a = acc[ai][bj][m][0] * rs, b = acc[ai][bj][m][1] * rs; rope4(a, b, t0, t1); *(u32x2*)(rp + bj * 128) = pack4(a); *(u32x2*)(rp + bj * 128 + 16) = pack4(b); }
                    asm volatile("" ::: "memory"); }
        }
    }
};
struct EpiKV {
    static constexpr bool PERM = true;
    bf16_t* KV; const float* ssq_kv;
    __device__ __forceinline__ void operator()(const f32x4 (&acc)[2][2][4][2], const Unit& u, int wr, int wc, int fr, int fq) const {
        const int row0 = u.pm * BM + wr * 64 + fr;
#pragma unroll
        for (int ai = 0; ai < 2; ++ai)
#pragma unroll
            for (int m = 0; m < 4; ++m) { const int row = row0 + ai * HALF + m * 16; const float rs = rsqrtf(ssq_kv[row] * (1.f / 128.f) + 1e-6f); bf16_t* rp = KV + (size_t)row * 1024 + u.pn * BM + wc * 32 + 8 * fq;
#pragma unroll
                for (int bj = 0; bj < 2; ++bj) *(u32x4*)(rp + bj * HALF) = pack8(acc[ai][bj][m][0] * rs, acc[ai][bj][m][1] * rs); }
    }
};
struct EpiY {
    static constexpr bool PERM = true;
    bf16_t* Y; float* ssq_y;
    __device__ __forceinline__ void operator()(const f32x4 (&acc)[2][2][4][2], const Unit& u, int wr, int wc, int fr, int fq) const {
        const int row0 = u.pm * BM + wr * 64 + fr;
#pragma unroll
        for (int ai = 0; ai < 2; ++ai)
#pragma unroll
            for (int m = 0; m < 4; ++m) { const int row = row0 + ai * HALF + m * 16; bf16_t* rp = Y + (size_t)row * 1024 + u.pn * BM + wc * 32 + 8 * fq; float ss = 0.f;
#pragma unroll
                for (int bj = 0; bj < 2; ++bj) { const f32x4 v0 = acc[ai][bj][m][0], v1 = acc[ai][bj][m][1]; ss += sq8(v0, v1); *(u32x4*)(rp + bj * HALF) = pack8(v0, v1); }
                ssq_add(ssq_y, row, ss, fq); }
    }
};
struct EpiAct {
    static constexpr bool PERM = true;
    unsigned char* ACT; const float* bgu;
    __device__ __forceinline__ void operator()(const f32x4 (&acc)[2][2][4][2], const Unit& u, int wr, int wc, int fr, int fq) const {
        const int row0 = u.pm * BM + wr * 64 + fr; const float* bb = bgu + (size_t)u.e * 2048;
#pragma unroll
        for (int bj = 0; bj < 2; ++bj) { const int j0 = u.pn * 128 + bj * 64 + wc * 16 + 4 * fq; const f32x4 bg = *(const f32x4*)(bb + j0), bu = *(const f32x4*)(bb + 1024 + j0);
#pragma unroll
            for (int ai = 0; ai < 2; ++ai)
#pragma unroll
                for (int m = 0; m < 4; ++m) { const int row = row0 + ai * HALF + m * 16; f32x4 gv = acc[ai][bj][m][0] * W8_INV + bg, uv = acc[ai][bj][m][1] * W8_INV + bu, o;
#pragma unroll
                    for (int i = 0; i < 4; ++i) { const float gg = fminf(gv[i], 7.f), uu = fminf(fmaxf(uv[i], -7.f), 7.f); o[i] = gg * __builtin_amdgcn_rcpf(1.f + __builtin_amdgcn_exp2f(-1.702f * LOG2E * gg)) * (uu + 1.f); }
                    *(unsigned*)(ACT + (size_t)row * 1024 + j0) = pack4_fp8(o[0], o[1], o[2], o[3]); } }
    }
};
struct EpiDown {
    static constexpr bool PERM = true;
    bf16_t* YR; const float* bd; const float* roww;
    __device__ __forceinline__ void operator()(const f32x4 (&acc)[2][2][4][2], const Unit& u, int wr, int wc, int fr, int fq) const {
        const int row0 = u.pm * BM + wr * 64 + fr; const float* bb = bd + (size_t)u.e * 1024 + u.pn * BM + wc * 32 + 8 * fq;
#pragma unroll
        for (int ai = 0; ai < 2; ++ai)
#pragma unroll
            for (int m = 0; m < 4; ++m) { const int row = row0 + ai * HALF + m * 16; const float w = roww[row], w8 = w * W8_INV; bf16_t* rp = YR + (size_t)row * 1024 + u.pn * BM + wc * 32 + 8 * fq;
#pragma unroll
                for (int bj = 0; bj < 2; ++bj) { const f32x4 b0 = *(const f32x4*)(bb + bj * HALF), b1 = *(const f32x4*)(bb + bj * HALF + 4);
                    *(u32x4*)(rp + bj * HALF) = pack8(acc[ai][bj][m][0] * w8 + b0 * w, acc[ai][bj][m][1] * w8 + b1 * w); }
                asm volatile("" ::: "memory"); }
    }
};
}
constexpr size_t MiB = 1u << 20;
constexpr size_t WS_CTL = 0, CTL_ZERO_BYTES = 1 * MiB;
constexpr size_t WS_MOD = 1 * MiB;
constexpr size_t WS_SSQ = 1 * MiB + 512 * 1024;
constexpr size_t WS_TABM = 2 * MiB, WS_TABD = 6 * MiB;
constexpr size_t WS_SE = 14 * MiB, WS_SG = 14 * MiB + 512 * 1024, WS_SRANK = 18 * MiB + 512 * 1024;
constexpr size_t WS_POS = 15 * MiB;
constexpr size_t WS_ROWTOK = 16 * MiB, WS_ROWW = 17 * MiB;
constexpr size_t WS_CNT = 18 * MiB;
constexpr size_t WS_TD0 = 19 * MiB;
constexpr size_t WS_WIN = 20 * MiB, WS_WQB = 24 * MiB, WS_WKVB = 25 * MiB, WS_WO = 26 * MiB;
constexpr size_t WS_WGU = 28 * MiB, WS_WD = 156 * MiB;
constexpr size_t WS_H = 220 * MiB;
constexpr size_t WS_PROJ = 284 * MiB;
constexpr size_t WS_QM = 412 * MiB, WS_KVM = 460 * MiB, WS_ATT = 524 * MiB, WS_Y = 588 * MiB;
constexpr size_t WS_ACT = 284 * MiB;
constexpr size_t WS_YR = 588 * MiB;
constexpr size_t WS_END = 860 * MiB;
static_assert(WS_ACT + (size_t)NROWS * 1024 * 2 <= WS_YR && WS_YR + (size_t)NROWS * 1024 * 2 <= WS_END, "ws map");
constexpr int CW_BAR = 4096;

constexpr int RING_OFF = 0, RING_BYTES = 131072;
constexpr int LDSCTL_OFF = RING_BYTES, MISC_OFF = LDSCTL_OFF + 320;
constexpr int XTRA_OFF = MISC_OFF + 128;
constexpr int X_TILEE = XTRA_OFF;
constexpr int X_SE = X_TILEE + 2304, X_SG = X_SE + 2048, X_SRANK = X_SG + 2048, X_WCNT = X_SRANK + 2048, X_MISC2 = X_WCNT + 1024;
constexpr int X_IDX = X_MISC2 + 1024;
constexpr int LDS_BYTES = 147456;
static_assert(X_IDX + 2048 <= LDS_BYTES, "LDS map");
constexpr int NWAVES = 8;

#define XB_TMO      128
#define XB_XCNT(j)  (256  + 64 * (j))
#define XB_XSUB(j)  (1280 + 64 * (j))
#define XB_XGEN(j)  (2304 + 64 * (j))
#define XB_TOP      3328
#define XB_TOPGEN   3392
#define XCD_BAR_WORDS 3456
#define XB_SPIN_CAP (1u << 18)
__device__ __forceinline__ unsigned xb_ld(unsigned* p)              { return __hip_atomic_load(p, __ATOMIC_RELAXED, __HIP_MEMORY_SCOPE_AGENT); }
__device__ __forceinline__ unsigned xb_add(unsigned* p, unsigned v) { return __hip_atomic_fetch_add(p, v, __ATOMIC_RELAXED, __HIP_MEMORY_SCOPE_AGENT); }
__device__ __forceinline__ unsigned xb_xcc_id() { return (unsigned)__builtin_amdgcn_s_getreg((3 << 11) | 20) & 0xFu; }
#define XB_SPIN(cond, bar) do { unsigned _sp = 0; while (cond) { __builtin_amdgcn_s_sleep(1); \
    if ((++_sp & 255u) == 0u) { if (xb_ld(&(bar)[XB_TMO])) break; if (_sp > XB_SPIN_CAP) { atomicAdd(&(bar)[XB_TMO], 1u); break; } } } } while (0)
struct XcdBarrier { unsigned* bar; unsigned x; volatile LAS unsigned* st; };
__device__ __forceinline__ XcdBarrier xcd_barrier_post(unsigned* bar, volatile LAS unsigned* st) {
    XcdBarrier b; b.bar = bar; b.x = xb_xcc_id(); b.st = st;
    if (threadIdx.x == 0) (void)xb_add(&bar[XB_XCNT(b.x)], 1u);
    return b;
}
__device__ __forceinline__ void xcd_barrier_complete(unsigned* bar, unsigned x, unsigned& nloc, unsigned& nx) {
    const unsigned G = gridDim.x * gridDim.y * gridDim.z;
    unsigned sum, cnt, mine, sp = 0u;
    for (;;) {
        sum = 0u; cnt = 0u; mine = 0u;
#pragma unroll
        for (unsigned j = 0; j < 16; ++j) { const unsigned c = xb_ld(&bar[XB_XCNT(j)]); sum += c; cnt += (c > 0u) ? 1u : 0u; mine = (j == x) ? c : mine; }
        if (sum == G) break;
        __builtin_amdgcn_s_sleep(1);
        if ((++sp & 255u) == 0u) { if (xb_ld(&bar[XB_TMO])) break; if (sp > XB_SPIN_CAP) { atomicAdd(&bar[XB_TMO], 1u); break; } }
    }
    nloc = mine > 0u ? mine : 1u; nx = cnt > 0u ? cnt : 1u;
}
__device__ __forceinline__ void xcd_barrier(const XcdBarrier& b) {
    asm volatile("s_waitcnt vmcnt(0)" ::: "memory");
    __syncthreads();
    if (threadIdx.x == 0) {
        unsigned* bar = b.bar;
        __builtin_amdgcn_s_waitcnt(0);
        unsigned nloc = b.st[0], nx = b.st[1];
        if (nloc == 0u) { xcd_barrier_complete(bar, b.x, nloc, nx); b.st[0] = nloc; b.st[1] = nx; }
        const unsigned old = xb_add(&bar[XB_XSUB(b.x)], 1u);
        const unsigned gen = old / nloc;
        if (old + 1u == (gen + 1u) * nloc) {
            __builtin_amdgcn_fence(__ATOMIC_RELEASE, "agent");
            asm volatile("s_waitcnt vmcnt(0)" ::: "memory");
            const unsigned og = xb_add(&bar[XB_TOP], 1u);
            const unsigned tg = og / nx;
            if (og + 1u == (tg + 1u) * nx) xb_add(&bar[XB_TOPGEN], 1u);
            else XB_SPIN(xb_ld(&bar[XB_TOPGEN]) == tg, bar);
            __builtin_amdgcn_fence(__ATOMIC_ACQUIRE, "agent");
            xb_add(&bar[XB_XGEN(b.x)], 1u);
            asm volatile("s_waitcnt vmcnt(0)" ::: "memory");
        } else {
            XB_SPIN(xb_ld(&bar[XB_XGEN(b.x)]) == gen, bar);
            __builtin_amdgcn_fence(__ATOMIC_ACQUIRE, "agent");
            asm volatile("s_waitcnt vmcnt(0)" ::: "memory");
        }
    }
    __syncthreads();
}

struct Args { const float* in[26]; float* out; unsigned char* ws; int ph_lo, ph_hi, li, pad; };
struct Frame {
    LAS unsigned char* lds; volatile LAS unsigned* MISC; unsigned* ctl;
    int G, bid;
    const Args* a;
};
#define PHASE_IDS() int tid_ = threadIdx.x; asm volatile("" : "+v"(tid_)); const int tid = tid_, lane = tid & 63, wave = __builtin_amdgcn_readfirstlane(tid >> 6); (void)lane; (void)wave
#define IN_X 0
#define IN_C 1
#define IN_POS 2
#define IN_WADA 3
#define IN_BADA 4
#define IN_GMIXPRE 5
#define IN_GMIXPOST 6
#define IN_WIN 7
#define IN_GQA 8
#define IN_WQB 9
#define IN_GKVA 10
#define IN_WKVB 11
#define IN_LQ1 12
#define IN_LK1 13
#define IN_LQ2 14
#define IN_LK2 15
#define IN_GSUBLN 16
#define IN_WO 17
#define IN_GFFNPRE 18
#define IN_GFFNPOST 19
#define IN_WROUTER 20
#define IN_BROUTER 21
#define IN_WGU 22
#define IN_BGU 23
#define IN_WDN 24
#define IN_BDN 25

template <class Map>
__device__ __forceinline__ void transpose_item(const float* W, int K, int N, bf16_t* WT, const float* gain, Map dst, LAS float* scr, int item, int lane) {
    const int nblk = N / 32, kb = item / nblk, nb = item % nblk, k0 = 64 * kb, n0 = 32 * nb;
#pragma unroll 8
    for (int i = 0; i < 32; ++i) { const int kk = 2 * i + (lane >> 5); scr[kk * 33 + (lane & 31)] = W[(size_t)(k0 + kk) * N + n0 + (lane & 31)]; }
    LDS_WAIT(); asm volatile("" ::: "memory");
    const int c = lane & 7;
    float gk[8];
#pragma unroll
    for (int i = 0; i < 8; ++i) gk[i] = gain ? gain[k0 + 8 * c + i] : 1.f;
#pragma unroll
    for (int j = 0; j < 4; ++j) { const int n = (lane >> 3) + 8 * j; const LAS float* s = scr + (8 * c) * 33 + n;
        u32x4 o; o.x = cvt_pk_bf16(s[0 * 33] * gk[0], s[1 * 33] * gk[1]); o.y = cvt_pk_bf16(s[2 * 33] * gk[2], s[3 * 33] * gk[3]); o.z = cvt_pk_bf16(s[4 * 33] * gk[4], s[5 * 33] * gk[5]); o.w = cvt_pk_bf16(s[6 * 33] * gk[6], s[7 * 33] * gk[7]);
        *(GAS u32x4*)(WT + (size_t)dst(n0 + n) * K + k0 + 8 * c) = o; }
    LDS_WAIT(); asm volatile("" ::: "memory");
}
template <class Map>
__device__ __forceinline__ void transpose_item8(const float* W, int K, int N, unsigned char* WT, Map dst, LAS float* scr, int item, int lane) {
    const int nblk = N / 32, kb = item / nblk, nb = item % nblk, k0 = 64 * kb, n0 = 32 * nb;
#pragma unroll 8
    for (int i = 0; i < 32; ++i) { const int kk = 2 * i + (lane >> 5); scr[kk * 33 + (lane & 31)] = W[(size_t)(k0 + kk) * N + n0 + (lane & 31)]; }
    LDS_WAIT(); asm volatile("" ::: "memory");
    const int c = lane & 7;
#pragma unroll
    for (int j = 0; j < 4; ++j) { const int n = (lane >> 3) + 8 * j; const LAS float* s = scr + (8 * c) * 33 + n;
        u32x2 o; o.x = pack4_fp8(s[0 * 33] * W8_SCALE, s[1 * 33] * W8_SCALE, s[2 * 33] * W8_SCALE, s[3 * 33] * W8_SCALE); o.y = pack4_fp8(s[4 * 33] * W8_SCALE, s[5 * 33] * W8_SCALE, s[6 * 33] * W8_SCALE, s[7 * 33] * W8_SCALE);
        *(GAS u32x2*)(WT + (size_t)dst(n0 + n) * K + k0 + 8 * c) = o; }
    LDS_WAIT(); asm volatile("" ::: "memory");
}
__device__ __forceinline__ int il4(int i, int x2) { return 8 * (i >> 2) + 4 * x2 + (i & 3); }
struct MapWin { __device__ int operator()(int n) const {
    if (n < 384) return n;
    if (n < 416) { const int r = n - 384; return PC_KR + il4(r & 15, r >> 4); }
    if (n < 1440) { const int r = n - 416, hj = r >> 6, d = r & 63; return PC_QD + hj * 64 + il4(d & 31, d >> 5); }
    return PC_VD + (n - 1440); } };
struct MapWqb { __device__ int operator()(int n) const { const int h = n / 96, d = n - h * 96; if (d < 64) return h * 64 + d; const int r = d - 64; return 512 + h * 32 + il4(r & 15, r >> 4); } };
struct MapId { __device__ int operator()(int n) const { return n; } };
struct MapWgu { __device__ int operator()(int n) const { const int which = n >> 10, j = n & 1023; return 8 * (j >> 2) + 4 * which + (j & 3); } };

__device__ __forceinline__ void p0_prologue(Frame& F) {
    PHASE_IDS();
    float* mod = (float*)(F.a->ws + WS_MOD);
    if (F.bid < 192) {
        LAS float* cact = (LAS float*)(F.lds);
        LAS float* red = (LAS float*)(F.lds + 65536);
        const float* c = F.a->in[IN_C];
        for (int i = tid; i < 16 * 1024; i += 512) { const float cv = c[i]; cact[i] = cv / (1.f + __expf(-cv)); }
        __syncthreads();
        const int n0 = 32 * F.bid, col = tid & 31, kg = tid >> 5;
        float acc[16];
#pragma unroll
        for (int b = 0; b < 16; ++b) acc[b] = 0.f;
        const float* wp = F.a->in[IN_WADA] + (size_t)(kg * 64) * 6144 + n0 + col;
        for (int kk = 0; kk < 64; ++kk) { const float w = wp[(size_t)kk * 6144];
#pragma unroll
            for (int b = 0; b < 16; ++b) acc[b] += cact[b * 1024 + kg * 64 + kk] * w; }
#pragma unroll
        for (int b = 0; b < 16; ++b) red[(kg * 16 + b) * 32 + col] = acc[b];
        __syncthreads();
        { const int b = tid >> 5; float s = 0.f;
#pragma unroll
          for (int k2 = 0; k2 < 16; ++k2) s += red[(k2 * 16 + b) * 32 + col];
          mod[b * 6144 + n0 + col] = s + F.a->in[IN_BADA][n0 + col]; }
        __syncthreads();
    }
    { float* ssq = (float*)(F.a->ws + WS_SSQ); for (int i = F.bid * 512 + tid; i < 3 * T; i += F.G * 512) ssq[i] = 0.f;
      u32x4* wz = (u32x4*)((bf16_t*)(F.a->ws + WS_WIN) + (size_t)416 * 1024); for (int i = F.bid * 512 + tid; i < 96 * 1024 / 8; i += F.G * 512) wz[i] = (u32x4){0u, 0u, 0u, 0u}; }
    { const int* pos = (const int*)F.a->in[IN_POS]; float2* tabm = (float2*)(F.a->ws + WS_TABM); float2* tabd = (float2*)(F.a->ws + WS_TABD);
      for (int gid = F.bid * 512 + tid; gid < T * 48; gid += F.G * 512) { const int t = gid / 48, i = gid - t * 48; const float p = (float)pos[t];
          if (i < 16) { const float inv = powf(10000.f, -(float)(2 * i) / 32.f); const double a = (double)(p * inv); tabm[t * 16 + i] = make_float2((float)cos(a), (float)sin(a)); }
          else { const int j = i - 16; const float inv = powf(10000.f, -(float)(2 * j) / 64.f); const double a = (double)(p * inv); tabd[t * 32 + j] = make_float2((float)cos(a), (float)sin(a)); } } }
    LAS float* scr = (LAS float*)(F.lds + RING_OFF + wave * 16384);
    const int gw = F.bid * NWAVES + wave, NGW = F.G * NWAVES;
    constexpr int I_WIN = 16 * 61, I_WQB = 4 * 24, I_WKVB = 2 * 32, I_WO = 16 * 32, I_GU1 = 16 * 64, I_DN1 = 16 * 32;
    constexpr int NITEMS = I_WIN + I_WQB + I_WKVB + I_WO + NE * I_GU1 + NE * I_DN1;
    for (int it = gw; it < NITEMS; it += NGW) {
        int r = it;
        if (r < I_WIN) { transpose_item(F.a->in[IN_WIN], 1024, INC, (bf16_t*)(F.a->ws + WS_WIN), nullptr, MapWin{}, scr, r, lane); continue; } r -= I_WIN;
        if (r < I_WQB) { transpose_item(F.a->in[IN_WQB], 256, 768, (bf16_t*)(F.a->ws + WS_WQB), F.a->in[IN_GQA], MapWqb{}, scr, r, lane); continue; } r -= I_WQB;
        if (r < I_WKVB) { transpose_item(F.a->in[IN_WKVB], 128, 1024, (bf16_t*)(F.a->ws + WS_WKVB), F.a->in[IN_GKVA], MapId{}, scr, r, lane); continue; } r -= I_WKVB;
        if (r < I_WO) { transpose_item(F.a->in[IN_WO], 1024, 1024, (bf16_t*)(F.a->ws + WS_WO), nullptr, MapId{}, scr, r, lane); continue; } r -= I_WO;
        if (r < NE * I_GU1) { const int e = r / I_GU1; transpose_item8(F.a->in[IN_WGU] + (size_t)e * 1024 * 2048, 1024, 2048, (unsigned char*)(F.a->ws + WS_WGU) + (size_t)e * 2048 * 1024, MapWgu{}, scr, r - e * I_GU1, lane); continue; } r -= NE * I_GU1;
        { const int e = r / I_DN1; transpose_item8(F.a->in[IN_WDN] + (size_t)e * 1024 * 1024, 1024, 1024, (unsigned char*)(F.a->ws + WS_WD) + (size_t)e * 1024 * 1024, MapId{}, scr, r - e * I_DN1, lane); }
    }
}
__device__ __forceinline__ void p0b_norm(Frame& F) {
    PHASE_IDS();
    const float* mod = (const float*)(F.a->ws + WS_MOD); bf16_t* H = (bf16_t*)(F.a->ws + WS_H);
    const int tok0 = F.bid * 128 + wave * 16, b = (F.bid * 128) / S;
    f32x4 g[4], sh[4];
#pragma unroll
    for (int j = 0; j < 4; ++j) { const int c = 4 * lane + 256 * j; g[j] = *(const f32x4*)(F.a->in[IN_GMIXPRE] + c) * (*(const f32x4*)(mod + b * 6144 + 1024 + c) + 1.f); sh[j] = *(const f32x4*)(mod + b * 6144 + c); }
    for (int i = 0; i < 16; i += 4) {
        f32x4 v[4][4];
#pragma unroll
        for (int r = 0; r < 4; ++r)
#pragma unroll
            for (int j = 0; j < 4; ++j) v[r][j] = *((const GAS f32x4*)(F.a->in[IN_X] + (size_t)(tok0 + i + r) * D) + lane + 64 * j);
#pragma unroll
        for (int r = 0; r < 4; ++r) { float ss = 0.f;
#pragma unroll
            for (int j = 0; j < 4; ++j) ss += (v[r][j].x * v[r][j].x + v[r][j].y * v[r][j].y) + (v[r][j].z * v[r][j].z + v[r][j].w * v[r][j].w);
            const float rs = rsqrtf(wave_sum(ss) * (1.f / D) + 1e-6f);
            GAS u32x2* o8 = (GAS u32x2*)(H + (size_t)(tok0 + i + r) * D) + lane;
#pragma unroll
            for (int j = 0; j < 4; ++j) { const f32x4 h = (v[r][j] * rs) * g[j] + sh[j]; u32x2 w; w.x = cvt_pk_bf16(h[0], h[1]); w.y = cvt_pk_bf16(h[2], h[3]); o8[64 * j] = w; } }
    }
}
__device__ __forceinline__ void p5_rows(Frame& F) {
    PHASE_IDS();
    LAS float* wt = (LAS float*)(F.lds + RING_OFF);
    for (int idx = tid; idx < NE * 1024; idx += 512) { const int e = idx >> 10, k = idx & 1023; wt[idx] = F.a->in[IN_WROUTER][k * NE + e]; }
    LAS int* se = (LAS int*)(F.lds + X_SE); LAS float* sg = (LAS float*)(F.lds + X_SG);
    const float* mod = (const float*)(F.a->ws + WS_MOD); const float* ssq_y = (const float*)(F.a->ws + WS_SSQ) + 2 * T;
    const bf16_t* Y = (const bf16_t*)(F.a->ws + WS_Y); unsigned char* H2 = (unsigned char*)(F.a->ws + WS_H);
    const int tok0 = F.bid * 128 + wave * 16, b = (F.bid * 128) / S;
    f32x4 gpost[4], gmod[4], gpre[4], shf[4], scf[4];
#pragma unroll
    for (int j = 0; j < 4; ++j) { const int c = 4 * lane + 256 * j; gpost[j] = *(const f32x4*)(F.a->in[IN_GMIXPOST] + c); gmod[j] = *(const f32x4*)(mod + b * 6144 + 2048 + c);
        gpre[j] = *(const f32x4*)(F.a->in[IN_GFFNPRE] + c); shf[j] = *(const f32x4*)(mod + b * 6144 + 3072 + c); scf[j] = *(const f32x4*)(mod + b * 6144 + 4096 + c) + 1.f; }
#pragma unroll
    for (int j = 0; j < 4; ++j) { gpost[j] = gpost[j] * gmod[j]; gpre[j] = gpre[j] * scf[j]; }
    f32x4 xn[4]; u32x2 yn[4]; float sn;
#define P5_LOAD(row) do { _Pragma("unroll") for (int j = 0; j < 4; ++j) { xn[j] = *(const GAS f32x4*)(F.a->in[IN_X] + (size_t)(row) * D + 4 * lane + 256 * j); yn[j] = *(const GAS u32x2*)(Y + (size_t)(row) * D + 4 * lane + 256 * j); } sn = ssq_y[row]; } while (0)
    P5_LOAD(tok0);
    __syncthreads();
    for (int i = 0; i < 16; ++i) {
        const int row = tok0 + i;
        f32x4 xv[4]; u32x2 yv[4];
#pragma unroll
        for (int j = 0; j < 4; ++j) { xv[j] = xn[j]; yv[j] = yn[j]; }
        const float rsy = rsqrtf(sn * (1.f / D) + 1e-6f);
        if (i + 1 < 16) P5_LOAD(row + 1);
        f32x4 x1[4]; float ss = 0.f;
#pragma unroll
        for (int j = 0; j < 4; ++j) { const f32x4 yy = {bflo(yv[j].x), bfhi(yv[j].x), bflo(yv[j].y), bfhi(yv[j].y)}; x1[j] = xv[j] + (yy * rsy) * gpost[j];
            ss += (x1[j][0] * x1[j][0] + x1[j][1] * x1[j][1]) + (x1[j][2] * x1[j][2] + x1[j][3] * x1[j][3]);
            *(GAS f32x4*)(F.a->out + (size_t)row * D + 4 * lane + 256 * j) = x1[j]; }
        const float r1 = rsqrtf(wave_sum(ss) * (1.f / D) + 1e-6f);
        f32x4 h2[4];
#pragma unroll
        for (int j = 0; j < 4; ++j) { h2[j] = (x1[j] * r1) * gpre[j] + shf[j]; *(GAS unsigned*)(H2 + (size_t)row * D + 4 * lane + 256 * j) = pack4_fp8(h2[j][0], h2[j][1], h2[j][2], h2[j][3]); }
        float v[32];
#pragma unroll
        for (int e = 0; e < NE; ++e) { const LAS f32x4* wp = (const LAS f32x4*)(wt + e * 1024 + 4 * lane); float p = 0.f;
#pragma unroll
            for (int j = 0; j < 4; ++j) { const f32x4 w = wp[64 * j]; p += (h2[j][0] * w[0] + h2[j][1] * w[1]) + (h2[j][2] * w[2] + h2[j][3] * w[3]); }
            v[e] = p; }
#pragma unroll
        for (int j = 0; j < 16; ++j) { const bool up = (lane & 32) != 0; const float keep = up ? v[16 + j] : v[j], send = up ? v[j] : v[16 + j]; v[j] = keep + __shfl_xor(send, 32); }
#pragma unroll
        for (int j = 0; j < 8; ++j) { const bool up = (lane & 16) != 0; const float keep = up ? v[8 + j] : v[j], send = up ? v[j] : v[8 + j]; v[j] = keep + __shfl_xor(send, 16); }
#pragma unroll
        for (int j = 0; j < 4; ++j) { const bool up = (lane & 8) != 0; const float keep = up ? v[4 + j] : v[j], send = up ? v[j] : v[4 + j]; v[j] = keep + __shfl_xor(send, 8); }
#pragma unroll
        for (int j = 0; j < 2; ++j) { const bool up = (lane & 4) != 0; const float keep = up ? v[2 + j] : v[j], send = up ? v[j] : v[2 + j]; v[j] = keep + __shfl_xor(send, 4); }
        { const bool up = (lane & 2) != 0; const float keep = up ? v[1] : v[0], send = up ? v[0] : v[1]; v[0] = keep + __shfl_xor(send, 2); }
        float lg = v[0] + __shfl_xor(v[0], 1);
        const int my_e = lane >> 1;
        lg += F.a->in[IN_BROUTER][my_e];
        float vals[4]; int idx[4];
#pragma unroll
        for (int k = 0; k < 4; ++k) { float mx = lg;
#pragma unroll
            for (int o = 1; o < 64; o <<= 1) mx = fmaxf(mx, __shfl_xor(mx, o));
            const unsigned long long bm = __ballot(lg == mx); const int wl = __builtin_ctzll(bm); vals[k] = mx; idx[k] = wl >> 1; if (my_e == idx[k]) lg = -INFINITY; }
        float ex[4], den = 0.f;
#pragma unroll
        for (int k = 0; k < 4; ++k) { ex[k] = __expf(vals[k] - vals[0]); den += ex[k]; }
        const float inv = 1.f / den;
        if (lane < 4) { const int a = (wave * 16 + i) * 4 + lane; se[a] = lane == 0 ? idx[0] : lane == 1 ? idx[1] : lane == 2 ? idx[2] : idx[3]; sg[a] = (lane == 0 ? ex[0] : lane == 1 ? ex[1] : lane == 2 ? ex[2] : ex[3]) * inv; }
    }
#undef P5_LOAD
    __syncthreads();
    LAS int* srank = (LAS int*)(F.lds + X_SRANK); LAS int* wcnt = (LAS int*)(F.lds + X_WCNT);
    const int e_my = se[tid]; int rk = 0;
    for (int e = 0; e < NE; ++e) { const unsigned long long bm = __ballot(e_my == e); if (e_my == e) rk = __builtin_popcountll(bm & ((1ull << lane) - 1ull)); if (lane == 0) wcnt[wave * 32 + e] = __builtin_popcountll(bm); }
    __syncthreads();
    int base = 0;
    for (int w = 0; w < wave; ++w) base += wcnt[w * 32 + e_my];
    srank[tid] = base + rk;
    { const int a = F.bid * 512 + tid; ((int*)(F.a->ws + WS_SE))[a] = e_my; ((float*)(F.a->ws + WS_SG))[a] = sg[tid]; ((int*)(F.a->ws + WS_SRANK))[a] = base + rk; }
    if (tid < NE) { int tot = 0; for (int w = 0; w < 8; ++w) tot += wcnt[w * 32 + tid]; ((int*)(F.a->ws + WS_CNT))[F.bid * NE + tid] = tot; }
}
__device__ __forceinline__ void p9_final(Frame& F) {
    PHASE_IDS();
    const float* mod = (const float*)(F.a->ws + WS_MOD); const bf16_t* YR = (const bf16_t*)(F.a->ws + WS_YR); const int* pos = (const int*)(F.a->ws + WS_POS);
    const int tok0 = F.bid * 128 + wave * 16, b = (F.bid * 128) / S;
    f32x4 gf[4];
#pragma unroll
    for (int j = 0; j < 4; ++j) { const int c = 4 * lane + 256 * j; gf[j] = *(const f32x4*)(F.a->in[IN_GFFNPOST] + c) * *(const f32x4*)(mod + b * 6144 + 5120 + c); }
    u32x2 yn[4][4]; f32x4 xn[4];
#define P9_LOAD(row) do { _Pragma("unroll") for (int s_ = 0; s_ < 4; ++s_) { const int pr = __builtin_amdgcn_readfirstlane(pos[(row) * 4 + s_]); _Pragma("unroll") for (int j = 0; j < 4; ++j) yn[s_][j] = *(const GAS u32x2*)(YR + (size_t)pr * D + 4 * lane + 256 * j); } \
        _Pragma("unroll") for (int j = 0; j < 4; ++j) xn[j] = *(const GAS f32x4*)(F.a->out + (size_t)(row) * D + 4 * lane + 256 * j); } while (0)
    P9_LOAD(tok0);
    for (int i = 0; i < 16; ++i) {
        const int row = tok0 + i;
        f32x4 y[4], x1[4]; float ss = 0.f;
#pragma unroll
        for (int j = 0; j < 4; ++j) { y[j] = (f32x4){0.f, 0.f, 0.f, 0.f};
#pragma unroll
            for (int s_ = 0; s_ < 4; ++s_) { const u32x2 w = yn[s_][j]; y[j] += (f32x4){bflo(w.x), bfhi(w.x), bflo(w.y), bfhi(w.y)}; }
            x1[j] = xn[j]; ss += (y[j][0] * y[j][0] + y[j][1] * y[j][1]) + (y[j][2] * y[j][2] + y[j][3] * y[j][3]); }
        if (i + 1 < 16) P9_LOAD(row + 1);
        const float r = rsqrtf(wave_sum(ss) * (1.f / D) + 1e-6f);
#pragma unroll
        for (int j = 0; j < 4; ++j) *(GAS f32x4*)(F.a->out + (size_t)row * D + 4 * lane + 256 * j) = x1[j] + (y[j] * r) * gf[j];
    }
#undef P9_LOAD
}
namespace att {
#define SBAR() __builtin_amdgcn_sched_barrier(0)
typedef short s16x4 __attribute__((ext_vector_type(4)));
typedef short v4i16_t __attribute__((ext_vector_type(4)));
typedef __attribute__((address_space(3))) const char* lds_cptr;
__device__ __forceinline__ int crow(int r, int hi) { return (r & 3) + 8 * (r >> 2) + 4 * hi; }
__device__ __forceinline__ void glds16(const void* gsrc, unsigned lds_dst) { unsigned keep;
    asm volatile("s_mov_b32 %0, m0\n\ts_mov_b32 m0, %2\n\ts_nop 0\n\tglobal_load_lds_dwordx4 %1, off\n\ts_mov_b32 m0, %0" : "=&s"(keep) : "v"(gsrc), "s"(lds_dst) : "memory"); }
__device__ __forceinline__ s16x4 vtr(lds_cptr p) { return __builtin_bit_cast(s16x4, __builtin_amdgcn_ds_read_tr16_b64_v4i16((__attribute__((address_space(3))) v4i16_t*)p)); }
typedef float f32x2_t __attribute__((ext_vector_type(2))); typedef __bf16 bf16x2_t __attribute__((ext_vector_type(2)));
__device__ __forceinline__ unsigned cvtpk_s(float lo, float hi) { f32x2_t v = {lo, hi}; bf16x2_t b = __builtin_convertvector(v, bf16x2_t); return __builtin_bit_cast(unsigned, b); }
#define WAIT_BAR0() asm volatile("s_waitcnt vmcnt(0) lgkmcnt(0)\n\ts_barrier" ::: "memory")

struct Src {
    const bf16_t* q0; const bf16_t* q1; int qp;
    const bf16_t* k0; const bf16_t* k1; int kp0, kp1;
    const bf16_t* v; int vp;
};
template <int DQK, int DV> struct Geo {
    static constexpr int NKC = DQK / 8, NVB = DV / 32, KSLOT = NKC * 1024, VSLOT = NVB * 4096, NPIECE = NKC + 4 * NVB;
    static constexpr int LDS_K = 0, LDS_V = 2 * KSLOT, LDS_WS = LDS_V + 2 * VSLOT, LDS_OST = LDS_WS + 8 * 256, LDS_TOTAL = LDS_OST + 8 * 32 * DV * 2;
};
constexpr float THR = 8.f;

template <int DQK, int DV, int MODE>
__device__ __forceinline__ void attn_unit(LAS char* shm, const Src sc, int qb, bf16_t* obase, float* td, float lam, const float* gsub) {
    typedef Geo<DQK, DV> G;
    int tid_ = threadIdx.x; asm volatile("" : "+v"(tid_));
    const int tid = tid_, lane = tid & 63, r32 = lane & 31, hi = lane >> 5; const int wid = __builtin_amdgcn_readfirstlane(tid >> 6);
    const int q0 = qb * 256, NT = 4 * (qb + 1);
    const unsigned lds0 = (unsigned)(uintptr_t)shm;
    LAS float* wsf = (LAS float*)(shm + G::LDS_WS) + wid * 64;
    const char* src[3]; long step[3]; unsigned dst[3], sstep[3];
#pragma unroll
    for (int i = 0; i < 3; ++i) { const int p = wid + 8 * i;
        if (p < G::NKC) { const bf16_t* base = p < 8 ? sc.k0 + 8 * p : sc.k1 + 8 * (p - 8); const int pitch = p < 8 ? sc.kp0 : sc.kp1;
            src[i] = (const char*)(base + (long)lane * pitch); step[i] = 128L * pitch; dst[i] = lds0 + G::LDS_K + p * 1024; sstep[i] = G::KSLOT; }
        else { const int pv = p - G::NKC, db = pv >> 2, rg = pv & 3;
            src[i] = (const char*)(sc.v + (long)(16 * rg + (lane >> 2)) * sc.vp + 32 * db + 8 * (lane & 3)); step[i] = 128L * sc.vp; dst[i] = lds0 + G::LDS_V + pv * 1024; sstep[i] = G::VSLOT; } }
#define DMA_TILE(slot) do { _Pragma("unroll") for (int i_ = 0; i_ < 3; ++i_) if (wid + 8 * i_ < G::NPIECE) { glds16(src[i_], (unsigned)__builtin_amdgcn_readfirstlane(dst[i_] + (slot) * sstep[i_])); src[i_] += step[i_]; } } while (0)
    DMA_TILE(0);
    bf16x8 qr[DQK / 16];
    { const long qrow = (long)(q0 + wid * 32 + r32) * sc.qp;
#pragma unroll
      for (int d0 = 0; d0 < DQK / 16; ++d0) qr[d0] = d0 < 4 ? *reinterpret_cast<const bf16x8*>(sc.q0 + qrow + d0 * 16 + hi * 8) : *reinterpret_cast<const bf16x8*>(sc.q1 + qrow + (d0 - 4) * 16 + hi * 8); }
    float m_run = -1e30f, l_reg = 0.f;
    f32x16 o[G::NVB];
#pragma unroll
    for (int d = 0; d < G::NVB; ++d) o[d] = f32x16{};
    const int qrel = wid * 32 + r32;
    const lds_cptr shm3 = (lds_cptr)shm;
    const lds_cptr kp0 = shm3 + G::LDS_K + hi * 1024 + r32 * 16;
    const lds_cptr vp0 = shm3 + G::LDS_V + ((lane >> 4) & 1) * 32 + (lane & 3) * 8 + (4 * hi + ((lane & 15) >> 2)) * 64;
    for (int t = 0; t < NT; ++t) {
        WAIT_BAR0();
        if (t + 1 < NT) DMA_TILE((t + 1) & 1);
        const int jb = t - (NT - 4);
        if (jb >= 0 && 64 * jb > 32 * wid + 31) continue;
        const lds_cptr kp = kp0 + (t & 1) * G::KSLOT; const lds_cptr vpp = vp0 + (t & 1) * G::VSLOT;
        f32x16 p0 = f32x16{}, p1 = f32x16{};
#pragma unroll
        for (int d0 = 0; d0 < DQK / 16; ++d0) {
            const bf16x8 b0 = *(const __attribute__((address_space(3))) bf16x8*)(kp + d0 * 2048);
            const bf16x8 b1 = *(const __attribute__((address_space(3))) bf16x8*)(kp + d0 * 2048 + 512);
            p0 = __builtin_amdgcn_mfma_f32_32x32x16_bf16(b0, qr[d0], p0, 0, 0, 0); p1 = __builtin_amdgcn_mfma_f32_32x32x16_bf16(b1, qr[d0], p1, 0, 0, 0); }
        if (jb >= 0) { const int kb = 64 * jb + 4 * hi;
#pragma unroll
            for (int r = 0; r < 16; ++r) { const int kv = kb + (r & 3) + 8 * (r >> 2); if (kv > qrel) p0[r] = -INFINITY; if (kv + 32 > qrel) p1[r] = -INFINITY; } }
        float rm = fmaxf(p0[0], p1[0]);
#pragma unroll
        for (int r = 1; r < 16; ++r) rm = fmaxf(rm, fmaxf(p0[r], p1[r]));
        { auto rr = __builtin_amdgcn_permlane32_swap(__float_as_uint(rm), __float_as_uint(rm), false, false); rm = fmaxf(__uint_as_float(rr[0]), __uint_as_float(rr[1])); }
        if (__any(rm > m_run + THR)) {
            const float mn = fmaxf(m_run, rm), f = __builtin_amdgcn_exp2f(m_run - mn); m_run = mn; l_reg *= f;
            if (hi == 0) wsf[r32] = f;
            asm volatile("s_waitcnt lgkmcnt(0)" ::: "memory");
#pragma unroll
            for (int g = 0; g < 4; ++g) { const f32x4 fv = *(const LAS f32x4*)(wsf + 8 * g + 4 * hi);
#pragma unroll
                for (int d = 0; d < G::NVB; ++d) { o[d][4 * g] *= fv[0]; o[d][4 * g + 1] *= fv[1]; o[d][4 * g + 2] *= fv[2]; o[d][4 * g + 3] *= fv[3]; } }
        }
        float sacc = 0.f;
#pragma unroll
        for (int r = 0; r < 16; ++r) { p0[r] = __builtin_amdgcn_exp2f(p0[r] - m_run); p1[r] = __builtin_amdgcn_exp2f(p1[r] - m_run); sacc += p0[r] + p1[r]; }
        l_reg += sacc;
        u32x4 pw[4];
#pragma unroll
        for (int k = 0; k < 4; ++k) { pw[0][k] = cvtpk_s(p0[2 * k], p0[2 * k + 1]); pw[1][k] = cvtpk_s(p0[8 + 2 * k], p0[8 + 2 * k + 1]); pw[2][k] = cvtpk_s(p1[2 * k], p1[2 * k + 1]); pw[3][k] = cvtpk_s(p1[8 + 2 * k], p1[8 + 2 * k + 1]); }
#pragma unroll
        for (int d = 0; d < G::NVB; ++d) {
#pragma unroll
            for (int ks = 0; ks < 4; ++ks) { const s16x4 lo = vtr(vpp + d * 4096 + ks * 1024), hh = vtr(vpp + d * 4096 + ks * 1024 + 512);
                const bf16x8 vf = {lo[0], lo[1], lo[2], lo[3], hh[0], hh[1], hh[2], hh[3]};
                o[d] = __builtin_amdgcn_mfma_f32_32x32x16_bf16(__builtin_bit_cast(bf16x8, pw[ks]), vf, o[d], 0, 0, 0); } }
    }
    { auto rr = __builtin_amdgcn_permlane32_swap(__float_as_uint(l_reg), __float_as_uint(l_reg), false, false); l_reg = __uint_as_float(rr[0]) + __uint_as_float(rr[1]); }
    if (hi == 0) wsf[32 + r32] = l_reg;
    asm volatile("s_waitcnt lgkmcnt(0)" ::: "memory");
    float rli[16];
#pragma unroll
    for (int r = 0; r < 16; ++r) rli[r] = __builtin_amdgcn_rcpf(wsf[32 + crow(r, hi)]);
    const long orow0 = (long)(q0 + wid * 32);
    if (MODE == 1) {
#pragma unroll
        for (int r = 0; r < 16; ++r)
#pragma unroll
            for (int d = 0; d < G::NVB; ++d) td[(orow0 + crow(r, hi)) * 512 + d * 32 + r32] = o[d][r] * rli[r];
    } else {
        if (MODE == 2) {
            float ssr[16];
#pragma unroll
            for (int r = 0; r < 16; ++r) { float ss = 0.f;
#pragma unroll
                for (int d = 0; d < G::NVB; ++d) { const float v = td[(orow0 + crow(r, hi)) * 512 + d * 32 + r32] - lam * (o[d][r] * rli[r]); o[d][r] = v; ss += v * v; }
#pragma unroll
                for (int x = 1; x < 32; x <<= 1) ss += __shfl_xor(ss, x);
                ssr[r] = rsqrtf(ss * (1.f / DV) + 1e-5f) * (1.f - LAMBDA_INIT); }
#pragma unroll
            for (int d = 0; d < G::NVB; ++d) { const float gv = gsub[d * 32 + r32];
#pragma unroll
                for (int r = 0; r < 16; ++r) o[d][r] *= ssr[r] * gv; }
#pragma unroll
            for (int r = 0; r < 16; ++r) rli[r] = 1.f;
        }
        LAS bf16_t* stg = (LAS bf16_t*)(shm + G::LDS_OST) + wid * 32 * DV;
#pragma unroll
        for (int r = 0; r < 16; ++r) { const int orow = crow(r, hi);
#pragma unroll
            for (int d = 0; d < G::NVB; ++d) stg[orow * DV + d * 32 + r32] = (bf16_t)(cvtpk_s(o[d][r] * rli[r], 0.f) & 0xffffu); }
        asm volatile("s_waitcnt lgkmcnt(0)" ::: "memory");
        constexpr int CPR = DV / 8;
#pragma unroll
        for (int i = 0; i < 32 * CPR / 64; ++i) { const int idx = i * 64 + lane, row = idx / CPR, ch = idx % CPR; const u32x4 v = *(const LAS u32x4*)(stg + row * DV + ch * 8);
            *(u32x4*)(obase + (orow0 + row) * 1024 + ch * 8) = v; }
    }
    asm volatile("s_waitcnt vmcnt(0) lgkmcnt(0)\n\ts_barrier" ::: "memory");
#undef DMA_TILE
}
#undef SBAR
#undef WAIT_BAR0
}

__device__ __forceinline__ void attn_phase_all(Frame& F) {
    LAS char* shm = (LAS char*)(F.lds + RING_OFF);
    const int vcu = (F.bid & 7) * (F.G >> 3) + (F.bid >> 3);
    const bf16_t* QM = (const bf16_t*)(F.a->ws + WS_QM); const bf16_t* KVM = (const bf16_t*)(F.a->ws + WS_KVM); const bf16_t* PR = (const bf16_t*)(F.a->ws + WS_PROJ); bf16_t* ATT = (bf16_t*)(F.a->ws + WS_ATT);
    { const int p = vcu >> 1, b = p >> 3, h = p & 7, half = vcu & 1; const long r0 = (long)b * S;
      att::Src sc{QM + r0 * 768 + h * 64, QM + r0 * 768 + 512 + h * 32, 768, KVM + r0 * 1024 + h * 128, PR + r0 * PJ + PC_KR, 1024, PJ, KVM + r0 * 1024 + h * 128 + 64, 1024};
      for (int i = 0; i < 4; ++i) { const int qb = half == 0 ? (i == 0 ? 7 : i == 1 ? 5 : i == 2 ? 2 : 0) : (i == 0 ? 6 : i == 1 ? 4 : i == 2 ? 3 : 1);
          att::attn_unit<96, 64, 0>(shm, sc, qb, ATT + r0 * 1024 + h * 64, nullptr, 0.f, nullptr); } }
    { const int p = vcu >> 2, b = p >> 2, h = p & 3, s4 = vcu & 3; const long r0 = (long)b * S;
      float lam; { const float* l1 = F.a->in[IN_LQ1]; const float* k1 = F.a->in[IN_LK1]; const float* l2 = F.a->in[IN_LQ2]; const float* k2 = F.a->in[IN_LK2]; float s1 = 0.f, s2 = 0.f;
          for (int i = 0; i < 64; ++i) { s1 += l1[i] * k1[i]; s2 += l2[i] * k2[i]; } lam = __expf(s1) - __expf(s2) + LAMBDA_INIT; }
      float* td = (float*)(F.a->ws + WS_Y) + r0 * 512 + h * 128;
      for (int i = 0; i < 2; ++i) { const int qb = i == 0 ? 7 - s4 : s4;
          att::Src s0{PR + r0 * PJ + PC_QD + (2 * h) * 64, nullptr, PJ, PR + r0 * PJ + PC_KD + (2 * h) * 64, nullptr, PJ, PJ, PR + r0 * PJ + PC_VD + h * 128, PJ};
          att::Src s1{PR + r0 * PJ + PC_QD + (2 * h + 1) * 64, nullptr, PJ, PR + r0 * PJ + PC_KD + (2 * h + 1) * 64, nullptr, PJ, PJ, PR + r0 * PJ + PC_VD + h * 128, PJ};
          att::attn_unit<64, 128, 1>(shm, s0, qb, nullptr, td, 0.f, nullptr);
          att::attn_unit<64, 128, 2>(shm, s1, qb, ATT + r0 * 1024 + 512 + h * 128, td, lam, F.a->in[IN_GSUBLN]); } }
}
__device__ __forceinline__ void offsets_from_counts(Frame& F) {
    PHASE_IDS();
    int* cnt = (int*)(F.a->ws + WS_CNT);
    LAS int* part = (LAS int*)(F.lds + RING_OFF);
    LAS int* tile_e = (LAS int*)(F.lds + X_TILEE); LAS int* m2 = (LAS int*)(F.lds + X_MISC2);
    { const int e = tid & 31, p = tid >> 5; int tot = 0, pre = 0;
      for (int w = p * 16; w < p * 16 + 16; ++w) { const int c = __hip_atomic_load(cnt + w * NE + e, RLX_AGENT); tot += c; if (w < F.bid) pre += c; }
      part[(p * 32 + e) * 2] = tot; part[(p * 32 + e) * 2 + 1] = pre; }
    __syncthreads();
    if (tid < NE) { int tot = 0, pre = 0; for (int p = 0; p < 16; ++p) { tot += part[(p * 32 + tid) * 2]; pre += part[(p * 32 + tid) * 2 + 1]; } m2[96 + tid] = tot; m2[64 + tid] = pre; }
    __syncthreads();
    if (tid < NE) { int st = 0; for (int e = 0; e < tid; ++e) st += (m2[96 + e] + 255) & ~255; m2[32 + tid] = st; const int pad = (m2[96 + tid] + 255) & ~255;
        for (int r = st; r < st + pad; r += 256) tile_e[r >> 8] = tid; if (tid == NE - 1) m2[0] = (st + pad) >> 8; }
    __syncthreads();
}
__device__ __forceinline__ void p6_scatter(Frame& F) {
    offsets_from_counts(F);
    PHASE_IDS();
    LAS int* m2 = (LAS int*)(F.lds + X_MISC2);
    int* rowtok = (int*)(F.a->ws + WS_ROWTOK); float* roww = (float*)(F.a->ws + WS_ROWW); int* pos = (int*)(F.a->ws + WS_POS);
    { const int a = F.bid * 512 + tid; const int e = ((const int*)(F.a->ws + WS_SE))[a]; const float gt = ((const float*)(F.a->ws + WS_SG))[a]; const int rk = ((const int*)(F.a->ws + WS_SRANK))[a];
      const int dst = m2[32 + e] + m2[64 + e] + rk, tok = F.bid * 128 + (tid >> 2);
      rowtok[dst] = tok; roww[dst] = gt; pos[tok * 4 + (tid & 3)] = dst; }
    if (F.bid < NE && tid < 256) { const int e = F.bid, tot = m2[96 + e], st = m2[32 + e], pad = (tot + 255) & ~255; const int r = st + tot + tid; if (r < st + pad) { rowtok[r] = 0; roww[r] = 0.f; } }
}

#ifdef DEV_NAIVE_ATTN
template <int MODE>
__global__ void __launch_bounds__(256) k_attn_ref(const bf16_t* QM, const bf16_t* KVM, const bf16_t* PROJ, bf16_t* ATT, float* TD, const float* lq1, const float* lk1, const float* lq2, const float* lk2, const float* gsub) {
    constexpr int DQK = MODE == 0 ? 96 : 64, DV = MODE == 0 ? 64 : 128, NH = MODE == 0 ? 8 : 4;
    __shared__ float Ks[32][DQK]; __shared__ float Vs[32][DV];
    const int bh = blockIdx.y, b = bh / NH, h = bh % NH, q = blockIdx.x * 256 + threadIdx.x, tid = threadIdx.x, t = b * S + q;
    float lam = 0.f;
    if (MODE == 1) { float s1 = 0.f, s2 = 0.f; for (int i = 0; i < 64; ++i) { s1 += lq1[i] * lk1[i]; s2 += lq2[i] * lk2[i]; } lam = expf(s1) - expf(s2) + LAMBDA_INIT; }
    float res[DV];
    for (int j = 0; j < (MODE == 0 ? 1 : 2); ++j) {
        float qv[DQK]; float o[DV];
#pragma unroll
        for (int d = 0; d < DQK; ++d) qv[d] = MODE == 0 ? bf2f(QM[(size_t)t * 768 + (d < 64 ? h * 64 + d : 512 + h * 32 + d - 64)]) : bf2f(PROJ[(size_t)t * PJ + PC_QD + (2 * h + j) * 64 + d]);
#pragma unroll
        for (int d = 0; d < DV; ++d) o[d] = 0.f;
        float m = -1e30f, l = 0.f;
        const int kend = blockIdx.x * 256 + 256;
        for (int k0 = 0; k0 < kend; k0 += 32) {
            __syncthreads();
            for (int i = tid; i < 32 * DQK; i += 256) { const int kk = i / DQK, d = i % DQK; const size_t tk = (size_t)b * S + k0 + kk;
                Ks[kk][d] = MODE == 0 ? (d < 64 ? bf2f(KVM[tk * 1024 + h * 128 + d]) : bf2f(PROJ[tk * PJ + PC_KR + d - 64])) : bf2f(PROJ[tk * PJ + PC_KD + (2 * h + j) * 64 + d]); }
            for (int i = tid; i < 32 * DV; i += 256) { const int kk = i / DV, d = i % DV; const size_t tk = (size_t)b * S + k0 + kk;
                Vs[kk][d] = MODE == 0 ? bf2f(KVM[tk * 1024 + h * 128 + 64 + d]) : bf2f(PROJ[tk * PJ + PC_VD + h * 128 + d]); }
            __syncthreads();
            for (int kk = 0; kk < 32; ++kk) {
                if (k0 + kk > q) break;
                float s = 0.f;
#pragma unroll
                for (int d = 0; d < DQK; ++d) s += qv[d] * Ks[kk][d];
                const float mn = fmaxf(m, s), al = exp2f(m - mn), p = exp2f(s - mn);
                l = l * al + p; m = mn;
#pragma unroll
                for (int d = 0; d < DV; ++d) o[d] = o[d] * al + p * Vs[kk][d];
            }
        }
        const float inv = 1.f / l;
        if (MODE == 0) {
#pragma unroll
            for (int d = 0; d < DV; ++d) ATT[(size_t)t * D + h * 64 + d] = (bf16_t)(cvt_pk_bf16(o[d] * inv, 0.f) & 0xffffu);
        } else if (j == 0) {
#pragma unroll
            for (int d = 0; d < DV; ++d) TD[((size_t)t * 4 + h) * 128 + d] = o[d] * inv;
        } else { float ss = 0.f;
#pragma unroll
            for (int d = 0; d < DV; ++d) { res[d] = TD[((size_t)t * 4 + h) * 128 + d] - lam * (o[d] * inv); ss += res[d] * res[d]; }
            const float r = rsqrtf(ss * (1.f / 128.f) + 1e-5f) * (1.f - LAMBDA_INIT);
#pragma unroll
            for (int d = 0; d < DV; ++d) ATT[(size_t)t * D + 512 + h * 128 + d] = (bf16_t)(cvt_pk_bf16(res[d] * r * gsub[d], 0.f) & 0xffffu);
        }
    }
}
#endif

constexpr int N_PHASES = 11;
__global__ void __launch_bounds__(NWAVES * 64, 2) mk_fwd(Args args) {
    extern __shared__ __attribute__((aligned(16))) unsigned char lds[];
    Frame F;
    F.lds = (LAS unsigned char*)lds; F.MISC = (volatile LAS unsigned*)(F.lds + MISC_OFF);
    F.G = gridDim.x; F.bid = blockIdx.x;
    F.a = &args; F.ctl = (unsigned*)(args.ws + WS_CTL);
    for (int u = threadIdx.x; u < (X_TILEE - LDSCTL_OFF) / 4; u += NWAVES * 64) ((LAS unsigned*)(F.lds + LDSCTL_OFF))[u] = 0u;
    __syncthreads();
    const int lo = args.ph_lo, hi = args.ph_hi;
#ifdef LEAK_LO
    const unsigned long long t_start = __builtin_amdgcn_s_memrealtime();
#endif
    XcdBarrier bar; bar.bar = F.ctl + CW_BAR; bar.x = 0; bar.st = nullptr;
    if (hi - lo > 1) bar = xcd_barrier_post(F.ctl + CW_BAR + args.li * XCD_BAR_WORDS, F.MISC + 8);
#ifndef PH_MASK
#define PH_MASK 0x7ff
#endif
#define IN(k) (((PH_MASK >> (k)) & 1) && lo <= (k) && (k) < hi)
#ifdef LEAK_LO
    unsigned long long t_lo = 0, t_hi = 0;
#define SEAM(k) do { if (IN(k) && IN((k) + 1)) xcd_barrier(bar); if ((k) + 1 == LEAK_LO) t_lo = __builtin_amdgcn_s_memrealtime(); if ((k) + 1 == LEAK_HI) t_hi = __builtin_amdgcn_s_memrealtime(); } while (0)
#else
#define SEAM(k) do { if (IN(k) && IN((k) + 1)) xcd_barrier(bar); } while (0)
#endif
    LAS unsigned char* ring = F.lds + RING_OFF;
    if (IN(0)) { p0_prologue(F); } SEAM(0);
    if (IN(1)) { p0b_norm(F); } SEAM(1);
    if (IN(2)) {
        pg8::Gemm g{(const bf16_t*)(F.a->ws + WS_H), (const bf16_t*)(F.a->ws + WS_WIN), nullptr, 0, D, D, D, 0}; pg8::StaticOrder So; So.init(T, PJ, F.G, F.bid);
        epi::EpiProj E{(bf16_t*)(F.a->ws + WS_PROJ), (const f32x4*)(F.a->ws + WS_TABM), (const f32x4*)(F.a->ws + WS_TABD), (float*)(F.a->ws + WS_SSQ), (float*)(F.a->ws + WS_SSQ) + T};
        pg8::gemm_phase<epi::EpiProj, pg8::StaticOrder, false>(ring, g, So, E);
    } SEAM(2);
    if (IN(3)) {
#ifndef NO_Q
        { pg8::Gemm g{(const bf16_t*)(F.a->ws + WS_PROJ) + PC_CQ, (const bf16_t*)(F.a->ws + WS_WQB), nullptr, 0, PJ, 256, 256, 0}; pg8::StaticOrder So; So.init(T, 768, F.G, F.bid);
          epi::EpiQ E{(bf16_t*)(F.a->ws + WS_QM), (const f32x4*)(F.a->ws + WS_TABM), (const float*)(F.a->ws + WS_SSQ)};
          pg8::gemm_phase<epi::EpiQ, pg8::StaticOrder, false>(ring, g, So, E); }
#endif
#ifndef NO_KV
        { pg8::Gemm g{(const bf16_t*)(F.a->ws + WS_PROJ) + PC_CKV, (const bf16_t*)(F.a->ws + WS_WKVB), nullptr, 0, PJ, 128, 128, 0}; pg8::StaticOrder So; So.init(T, 1024, F.G, F.bid);
          epi::EpiKV E{(bf16_t*)(F.a->ws + WS_KVM), (const float*)(F.a->ws + WS_SSQ) + T};
          pg8::gemm_phase<epi::EpiKV, pg8::StaticOrder, false>(ring, g, So, E); }
#endif
    } SEAM(3);
    if (IN(4)) {
#ifndef DEV_NAIVE_ATTN
        attn_phase_all(F);
#endif
    } SEAM(4);
    if (IN(5)) {
        pg8::Gemm g{(const bf16_t*)(F.a->ws + WS_ATT), (const bf16_t*)(F.a->ws + WS_WO), nullptr, 0, D, D, D, 0}; pg8::StaticOrder So; So.init(T, D, F.G, F.bid);
        epi::EpiY E{(bf16_t*)(F.a->ws + WS_Y), (float*)(F.a->ws + WS_SSQ) + 2 * T};
        pg8::gemm_phase<epi::EpiY, pg8::StaticOrder, false>(ring, g, So, E);
    } SEAM(5);
    if (IN(6)) { p5_rows(F); } SEAM(6);
    if (IN(7)) { p6_scatter(F); } SEAM(7);
    if (IN(8)) {
        offsets_from_counts(F);
        pg8::GroupedOrder So{(const LAS int*)(F.lds + X_TILEE), __builtin_amdgcn_readfirstlane(((LAS int*)(F.lds + X_MISC2))[0]), 8, F.G, F.bid};
        pg8::Gemm g{(const bf16_t*)(F.a->ws + WS_H), (const bf16_t*)(F.a->ws + WS_WGU), (const int*)(F.a->ws + WS_ROWTOK), (size_t)2048 * 512, 512, 512, 512, 0};
        epi::EpiAct E{(unsigned char*)(F.a->ws + WS_ACT), F.a->in[IN_BGU]};
        pg8::gemm_phase<epi::EpiAct, pg8::GroupedOrder, true, true>(ring, g, So, E, F.lds + X_IDX);
    } SEAM(8);
    if (IN(9)) {
        offsets_from_counts(F);
        pg8::GroupedOrder So{(const LAS int*)(F.lds + X_TILEE), __builtin_amdgcn_readfirstlane(((LAS int*)(F.lds + X_MISC2))[0]), 4, F.G, F.bid};
        pg8::Gemm g{(const bf16_t*)(F.a->ws + WS_ACT), (const bf16_t*)(F.a->ws + WS_WD), nullptr, (size_t)1024 * 512, 512, 512, 512, 0};
        epi::EpiDown E{(bf16_t*)(F.a->ws + WS_YR), F.a->in[IN_BDN], (const float*)(F.a->ws + WS_ROWW)};
        pg8::gemm_phase<epi::EpiDown, pg8::GroupedOrder, false, true>(ring, g, So, E);
    } SEAM(9);
    if (IN(10)) { p9_final(F); }
#ifdef LEAK_LO
    if (LEAK_LO == 0) t_lo = t_start; if (LEAK_HI == 11) t_hi = __builtin_amdgcn_s_memrealtime();
    if (blockIdx.x == 0 && threadIdx.x == 0) { asm volatile("s_waitcnt vmcnt(0)" ::: "memory"); args.out[0] += (float)(t_hi - t_lo) * LEAK_SCALE; }
#endif
#undef IN
#undef SEAM
}

extern "C" void kernel_launch(void* const* d_in, const int* in_sizes, int n_in, void* d_out, int out_size, void* d_ws, size_t ws_size, hipStream_t stream) {
    static int grid = 0;
    if (grid == 0) {
        if (n_in != 26 || in_sizes[0] != T * D || out_size != T * D || ws_size < WS_END) { fprintf(stderr, "kernel_launch: unexpected shapes (n_in %d, ws %zu); nothing launched\n", n_in, ws_size); grid = -1; return; }
        int dev = 0, cus = 0;
        if (hipGetDevice(&dev) != hipSuccess || hipDeviceGetAttribute(&cus, hipDeviceAttributeMultiprocessorCount, dev) != hipSuccess) { grid = -1; return; }
        if (hipFuncSetAttribute((const void*)mk_fwd, hipFuncAttributeMaxDynamicSharedMemorySize, LDS_BYTES) != hipSuccess) { fprintf(stderr, "kernel_launch: hipFuncSetAttribute failed\n"); grid = -1; return; }
        grid = cus;
        if (grid != 256) fprintf(stderr, "kernel_launch: %d CUs; this kernel is built for 256\n", grid);
    }
    if (grid < 0) return;
    (void)hipMemsetAsync((char*)d_ws + WS_CTL, 0, CTL_ZERO_BYTES, stream);
    Args a{};
    for (int i = 0; i < 26; ++i) a.in[i] = (const float*)d_in[i];
    a.out = (float*)d_out; a.ws = (unsigned char*)d_ws;
#ifndef MK_CUTS
#define MK_CUTS {0, N_PHASES}
#endif
    const int cuts[] = MK_CUTS; const int ncut = (int)(sizeof(cuts) / sizeof(int)) - 1;
    for (int li = 0; li < ncut; ++li) {
        a.ph_lo = cuts[li]; a.ph_hi = cuts[li + 1]; a.li = li;
        hipLaunchKernelGGL(mk_fwd, dim3(grid), dim3(NWAVES * 64), LDS_BYTES, stream, a);
#ifdef DEV_NAIVE_ATTN
        if (cuts[li + 1] == 5) {
            unsigned char* ws = (unsigned char*)d_ws;
            k_attn_ref<0><<<dim3(S / 256, NB * 8), 256, 0, stream>>>((const bf16_t*)(ws + WS_QM), (const bf16_t*)(ws + WS_KVM), (const bf16_t*)(ws + WS_PROJ), (bf16_t*)(ws + WS_ATT), nullptr, nullptr, nullptr, nullptr, nullptr, nullptr);
            k_attn_ref<1><<<dim3(S / 256, NB * 4), 256, 0, stream>>>((const bf16_t*)(ws + WS_QM), (const bf16_t*)(ws + WS_KVM), (const bf16_t*)(ws + WS_PROJ), (bf16_t*)(ws + WS_ATT), (float*)(ws + WS_Y),
                (const float*)d_in[IN_LQ1], (const float*)d_in[IN_LK1], (const float*)d_in[IN_LQ2], (const float*)d_in[IN_LK2], (const float*)d_in[IN_GSUBLN]);
        }
#endif
    }
}
```

```cpp
#include <hip/hip_runtime.h>
#include <cstdio>
#include <cstdint>

#define GAS __attribute__((address_space(1)))
#define LAS __attribute__((address_space(3)))
typedef unsigned short bf16_t;
typedef short bf16x8 __attribute__((ext_vector_type(8)));
typedef float f32x4 __attribute__((ext_vector_type(4)));
typedef float f32x2 __attribute__((ext_vector_type(2)));
typedef float f32x16 __attribute__((ext_vector_type(16)));
typedef unsigned u32x4 __attribute__((ext_vector_type(4)));
typedef unsigned u32x2 __attribute__((ext_vector_type(2)));
typedef int i32x4 __attribute__((ext_vector_type(4)));
typedef GAS unsigned gu32;
#define RLX_AGENT __ATOMIC_RELAXED, __HIP_MEMORY_SCOPE_AGENT
#define LDS_WAIT() asm volatile("s_waitcnt lgkmcnt(0)" ::: "memory")
#define VM_WAIT() asm volatile("s_waitcnt vmcnt(0)" ::: "memory")

constexpr int D = 1024, NB = 16, S = 2048, T = NB * S;
constexpr int INC = 1952;
constexpr int PJ = 2048;
constexpr int PC_CQ = 0, PC_CKV = 256, PC_KR = 384, PC_QD = 512, PC_KD = 1024, PC_VD = 1536;
constexpr int NE = 32, TOPK = 4, NA = T * TOPK, NROWS = (NA / 256 + NE) * 256, NTILE_MAX = NROWS / 256;
constexpr float LAMBDA_INIT = 0.2f, LOG2E = 1.4426950408889634f;
constexpr float C2M = 0.10206207261596577f * LOG2E;
constexpr float C2D = 0.125f * LOG2E;
constexpr float W8_SCALE = 64.f, W8_INV = 1.f / 64.f;

__device__ __forceinline__ unsigned cvt_pk_bf16(float lo, float hi) { unsigned r; asm volatile("v_cvt_pk_bf16_f32 %0, %1, %2" : "=v"(r) : "v"(lo), "v"(hi)); return r; }
__device__ __forceinline__ unsigned pack4_fp8(float a, float b, float c, float d) { int w = 0; w = __builtin_amdgcn_cvt_pk_fp8_f32(a, b, w, false); w = __builtin_amdgcn_cvt_pk_fp8_f32(c, d, w, true); return (unsigned)w; }
__device__ __forceinline__ float bf2f(unsigned short h) { return __uint_as_float((unsigned)h << 16); }
__device__ __forceinline__ float bflo(unsigned w) { return __uint_as_float(w << 16); }
__device__ __forceinline__ float bfhi(unsigned w) { return __uint_as_float(w & 0xffff0000u); }
#define DPPF(v, ctrl) __builtin_bit_cast(float, __builtin_amdgcn_update_dpp(0, __builtin_bit_cast(int, (float)(v)), (ctrl), 0xf, 0xf, true))
__device__ __forceinline__ void swap16(float a, float b, float& x, float& y) { auto r = __builtin_amdgcn_permlane16_swap(__builtin_bit_cast(unsigned, a), __builtin_bit_cast(unsigned, b), false, false); unsigned r0 = r[0], r1 = r[1]; asm volatile("" : "+v"(r0), "+v"(r1)); x = __builtin_bit_cast(float, r0); y = __builtin_bit_cast(float, r1); }
__device__ __forceinline__ void swap32(float a, float b, float& x, float& y) { auto r = __builtin_amdgcn_permlane32_swap(__builtin_bit_cast(unsigned, a), __builtin_bit_cast(unsigned, b), false, false); unsigned r0 = r[0], r1 = r[1]; asm volatile("" : "+v"(r0), "+v"(r1)); x = __builtin_bit_cast(float, r0); y = __builtin_bit_cast(float, r1); }
__device__ __forceinline__ float swap16_sum(float a, float b) { float x, y; swap16(a, b, x, y); return x + y; }
__device__ __forceinline__ float swap32_sum(float a, float b) { float x, y; swap32(a, b, x, y); return x + y; }
__device__ __forceinline__ float swap32_max(float a, float b) { float x, y; swap32(a, b, x, y); return fmaxf(x, y); }
__device__ __forceinline__ float wave_sum(float v) {
    v += DPPF(v, 0xB1); v += DPPF(v, 0x4E); v += DPPF(v, 0x141); v += DPPF(v, 0x140);
    v = swap16_sum(v, v); return swap32_sum(v, v);
}
__device__ __forceinline__ float wave_max(float v) {
    v = fmaxf(v, DPPF(v, 0xB1)); v = fmaxf(v, DPPF(v, 0x4E)); v = fmaxf(v, DPPF(v, 0x141)); v = fmaxf(v, DPPF(v, 0x140));
    { float x, y; swap16(v, v, x, y); v = fmaxf(x, y); }
    return swap32_max(v, v);
}
__device__ __forceinline__ float lane_xor8(float v) { return DPPF(DPPF(v, 0x141), 0x140); }
__device__ __forceinline__ float lane_xor4(float v) { return DPPF(DPPF(v, 0x1B), 0x141); }

namespace pg8 {
constexpr int BM = 256, BK = 64, HALF = 128, HTB = HALF * BK * 2, STAGE_BYTES = 8 * HTB, NXCD = 8, WGM = 8;
__host__ __device__ __forceinline__ int lds_byte(int r, int c) { const int st = (r >> 4) * 2 + (c >> 5), rr = r & 15, cc = c & 31, ob = rr * 64 + cc * 2; return st * 1024 + (ob ^ (((ob >> 9) & 1) << 5)); }
__host__ __device__ __forceinline__ void stage_rc(int b, int& R, int& C) { const int st = b / 1024, sb = b % 1024, swz = sb ^ (((sb >> 9) & 1) << 5); R = (st >> 1) * 16 + swz / 64; C = (st & 1) * 32 + (swz % 64) / 2; }
__host__ __device__ __forceinline__ int perm32(int rho) { const int n = rho >> 4, i = rho & 15; return 8 * (i >> 2) + 4 * n + (i & 3); }

struct Unit { int pm, pn, e; };
struct Gemm { const bf16_t* A; const bf16_t* Bt; const int* rowidx; size_t b_estride; int lda, ldb, K, pad; };

struct StaticOrder {
    int nM, nN, nwg, G, c;
    __host__ __device__ void init(int M, int N, int G_, int c_) { nM = M / BM; nN = N / BM; nwg = nM * nN; G = G_; c = c_; }
    __host__ __device__ bool next(int i, Unit& u) const {
        const long L = (long)i * G + c; if (L >= nwg) return false;
        int wgid = (int)L; { const int q = nwg / NXCD, r = nwg % NXCD, xcd = wgid % NXCD, off = wgid / NXCD; wgid = (xcd < r ? xcd * (q + 1) : r * (q + 1) + (xcd - r) * q) + off; }
        const int nig = WGM * nN, gid = wgid / nig, fm = gid * WGM, gsz = (nM - fm) < WGM ? (nM - fm) : WGM;
        u.pm = fm + ((wgid % nig) % gsz); u.pn = (wgid % nig) / gsz; u.e = 0; return true;
    }
};
struct GroupedOrder {
    const LAS int* tile_e; int ntiles, ncol, G, c;
    __device__ bool next(int i, Unit& u) const {
        const int L = i * G + c, xcd = L & 7, j = L >> 3, block = j >> 5, within = j & 31, rpc = 32 / ncol;
        const int r = within / ncol, pn = within % ncol, rt = (block * 8 + xcd) * rpc + r;
        if (rt >= ntiles) return false;
        u.pm = rt; u.pn = pn; u.e = __builtin_amdgcn_readfirstlane(tile_e[rt]); return true;
    }
};

template <class Epi, class Sched, bool GATHER = false, bool FP8 = false>
__device__ __forceinline__ void gemm_phase(LAS unsigned char* lds, const Gemm g, const Sched& S, const Epi& E, LAS unsigned char* idxl = nullptr) {
    int tid_ = threadIdx.x; asm volatile("" : "+v"(tid_));
    const int tid = tid_, wid = __builtin_amdgcn_readfirstlane(tid >> 6), lane = tid & 63, wr = wid >> 2, wc = wid & 3, fr = lane & 15, fq = lane >> 4;
    const int K = g.K, nt = K / BK;
    int Rr[2], Cc[2];
    unsigned voffA[2][2], voffB[2];
#pragma unroll
    for (int i = 0; i < 2; ++i) { stage_rc(tid * 16 + i * 8192, Rr[i], Cc[i]); const int Rb = Epi::PERM ? ((Rr[i] & ~31) + perm32(Rr[i] & 31)) : Rr[i];
        voffA[0][i] = (unsigned)(Rr[i] * g.lda + Cc[i]) * 2u; voffA[1][i] = (unsigned)((Rr[i] + HALF) * g.lda + Cc[i]) * 2u; voffB[i] = (unsigned)(Rb * g.ldb + Cc[i]) * 2u; }
    const unsigned kstep = BK * 2, hstepB = (unsigned)(HALF * g.ldb * 2), tstepA = (unsigned)(BM * g.lda * 2), tstepB = 2 * hstepB;
    const __amdgpu_buffer_rsrc_t rA = __builtin_amdgcn_make_buffer_rsrc((void*)g.A, 0, 0x7ffffff0, 0x00020000), rB = __builtin_amdgcn_make_buffer_rsrc((void*)g.Bt, 0, 0x7ffffff0, 0x00020000);
    const unsigned ldsw = (unsigned)wid * 1024u;
    const int aoff = lds_byte(wr * 64 + fr, fq * 8), boff = lds_byte(wc * 32 + fr, fq * 8);
#define PG8_SA(b, h) (((b) * 2 + (h)) * HTB)
#define PG8_SB(b, h) ((4 + (b) * 2 + (h)) * HTB)
#define PG8_STAGE(bufoff, rs, soff, voff) do { _Pragma("unroll") for (int _i = 0; _i < 2; ++_i) \
        __builtin_amdgcn_raw_ptr_buffer_load_lds(rs, (LAS void*)(lds + (bufoff) + ldsw + _i * 8192), 16, (int)(voff)[_i], (int)(soff), 0, 0); } while (0)
#define PG8_LDA(dst, b, h) do { _Pragma("unroll") for (int m = 0; m < 4; ++m) _Pragma("unroll") for (int k = 0; k < 2; ++k) dst[m][k] = *(const LAS bf16x8*)(lds + PG8_SA(b, h) + aoff + m * 2048 + k * 1024); } while (0)
#define PG8_LDB(dst, b, h) do { _Pragma("unroll") for (int n = 0; n < 2; ++n) _Pragma("unroll") for (int k = 0; k < 2; ++k) dst[n][k] = *(const LAS bf16x8*)(lds + PG8_SB(b, h) + boff + n * 2048 + k * 1024); } while (0)
#define PG8_MMA(ai, bj, At, Bt) do { __builtin_amdgcn_s_setprio(1); _Pragma("unroll") for (int m = 0; m < 4; ++m) _Pragma("unroll") for (int n = 0; n < 2; ++n) { \
        if constexpr (FP8) acc[ai][bj][m][n] = __builtin_amdgcn_mfma_scale_f32_16x16x128_f8f6f4(PG8_CAT(Bt[n][0], Bt[n][1]), PG8_CAT(At[m][0], At[m][1]), acc[ai][bj][m][n], 0, 0, 0, 0x7f7f7f7f, 0, 0x7f7f7f7f); \
        else { _Pragma("unroll") for (int k = 0; k < 2; ++k) acc[ai][bj][m][n] = __builtin_amdgcn_mfma_f32_16x16x32_bf16(Bt[n][k], At[m][k], acc[ai][bj][m][n], 0, 0, 0); } } __builtin_amdgcn_s_setprio(0); } while (0)
#define PG8_CAT(x0, x1) __builtin_shufflevector(__builtin_bit_cast(i32x4, x0), __builtin_bit_cast(i32x4, x1), 0, 1, 2, 3, 4, 5, 6, 7)
#define PG8_WAIT_V(n) asm volatile("s_waitcnt vmcnt(" #n ")" ::: "memory")
#define PG8_WAIT_L(n) asm volatile("s_waitcnt lgkmcnt(" #n ")" ::: "memory")
#define PG8_BAR __builtin_amdgcn_s_barrier()
#define PG8_SCHED __builtin_amdgcn_sched_barrier(0)
    Unit cur, nxt; int ui = 0;
    if (!S.next(0, cur)) return;
    f32x4 acc[2][2][4][2];
#pragma unroll
    for (int a = 0; a < 2; ++a)
#pragma unroll
        for (int b = 0; b < 2; ++b)
#pragma unroll
            for (int m = 0; m < 4; ++m)
#pragma unroll
                for (int n = 0; n < 2; ++n) acc[a][b][m][n] = (f32x4){0.f, 0.f, 0.f, 0.f};
    bf16x8 At[4][2], B0[2][2], B1[2][2];
    unsigned gA[2][2];
    unsigned cA, cB = (unsigned)cur.e * (unsigned)(g.b_estride * 2) + (unsigned)cur.pn * tstepB;
    if constexpr (GATHER) { cA = 0u;
#pragma unroll
        for (int h = 0; h < 2; ++h)
#pragma unroll
            for (int i = 0; i < 2; ++i) gA[h][i] = (unsigned)g.rowidx[cur.pm * BM + h * HALF + Rr[i]] * (unsigned)(g.lda * 2) + (unsigned)Cc[i] * 2u;
    } else { cA = (unsigned)cur.pm * tstepA;
#pragma unroll
        for (int h = 0; h < 2; ++h)
#pragma unroll
            for (int i = 0; i < 2; ++i) gA[h][i] = voffA[h][i]; }
    PG8_STAGE(PG8_SB(0, 0), rB, cB, voffB); PG8_STAGE(PG8_SB(0, 1), rB, cB + hstepB, voffB); PG8_STAGE(PG8_SA(0, 0), rA, cA, gA[0]); PG8_STAGE(PG8_SA(0, 1), rA, cA, gA[1]);
    if (wr == 1) PG8_BAR;
    PG8_WAIT_V(2); PG8_BAR;
    PG8_STAGE(PG8_SB(1, 0), rB, cB + kstep, voffB); PG8_STAGE(PG8_SA(1, 0), rA, cA + kstep, gA[0]); PG8_STAGE(PG8_SB(1, 1), rB, cB + hstepB + kstep, voffB);
    PG8_WAIT_V(6); PG8_BAR;
    for (;;) {
        const bool has_next = S.next(ui + 1, nxt);
        unsigned nA; const unsigned nB = has_next ? (unsigned)nxt.e * (unsigned)(g.b_estride * 2) + (unsigned)nxt.pn * tstepB : cB;
        if constexpr (GATHER) nA = cA; else nA = has_next ? (unsigned)nxt.pm * tstepA : cA;
#pragma nounroll
        for (int t = 0; t < nt; t += 2) {
            const bool last = (t == nt - 2);
            const unsigned a1 = cA + (unsigned)(t + 1) * kstep;
            const unsigned a2 = last ? nA : cA + (unsigned)(t + 2) * kstep, b2 = last ? nB : cB + (unsigned)(t + 2) * kstep;
            const unsigned a3 = a2 + kstep, b3 = b2 + kstep;
            if constexpr (GATHER) { if (t == 0 && has_next && wid < 4)
                __builtin_amdgcn_global_load_lds((const unsigned*)(g.rowidx + nxt.pm * BM + wid * 64 + lane), (LAS unsigned*)(idxl + ((ui + 1) & 1) * 1024 + wid * 256), 4, 0, 0); }
            PG8_LDB(B0, 0, 0); PG8_LDB(B1, 0, 1); PG8_SCHED; PG8_LDA(At, 0, 0); PG8_STAGE(PG8_SA(1, 1), rA, a1, gA[1]);
            if constexpr (GATHER) { if (last && has_next) { int t3 = threadIdx.x; asm volatile("" : "+v"(t3));
#pragma unroll
                for (int i = 0; i < 2; ++i) { int R3, C3; stage_rc(t3 * 16 + i * 8192, R3, C3);
#pragma unroll
                    for (int h = 0; h < 2; ++h) gA[h][i] = *(const LAS unsigned*)(idxl + ((ui + 1) & 1) * 1024 + (h * HALF + R3) * 4) * (unsigned)(g.lda * 2) + (unsigned)C3 * 2u; } } }
            PG8_WAIT_V(8); PG8_WAIT_L(0); PG8_BAR; PG8_MMA(0, 0, At, B0); PG8_MMA(0, 1, At, B1); PG8_BAR; PG8_SCHED;
            PG8_LDA(At, 0, 1); PG8_STAGE(PG8_SB(0, 0), rB, b2, voffB); PG8_STAGE(PG8_SB(0, 1), rB, b2 + hstepB, voffB); PG8_STAGE(PG8_SA(0, 0), rA, a2, gA[0]);
            PG8_WAIT_V(8); PG8_WAIT_L(0); PG8_BAR; PG8_MMA(1, 0, At, B0); PG8_MMA(1, 1, At, B1); PG8_BAR; PG8_SCHED;
            PG8_LDB(B0, 1, 0); PG8_LDB(B1, 1, 1); PG8_SCHED; PG8_LDA(At, 1, 0); PG8_STAGE(PG8_SA(0, 1), rA, a2, gA[1]);
            PG8_WAIT_V(8); PG8_WAIT_L(0); PG8_BAR; PG8_MMA(0, 0, At, B0); PG8_MMA(0, 1, At, B1); PG8_BAR; PG8_SCHED;
            PG8_LDA(At, 1, 1); PG8_STAGE(PG8_SB(1, 0), rB, b3, voffB); PG8_STAGE(PG8_SB(1, 1), rB, b3 + hstepB, voffB); PG8_STAGE(PG8_SA(1, 0), rA, a3, gA[0]);
            PG8_WAIT_V(8); PG8_WAIT_L(0); PG8_BAR; PG8_MMA(1, 0, At, B0); PG8_MMA(1, 1, At, B1); PG8_BAR; PG8_SCHED;
        }
        if (wr == 0) PG8_BAR;
        { int t2 = threadIdx.x; asm volatile("" : "+v"(t2)); E(acc, cur, wr, wc, t2 & 15, (t2 >> 4) & 3); }
        if (!has_next) break;
#pragma unroll
        for (int a = 0; a < 2; ++a)
#pragma unroll
            for (int b = 0; b < 2; ++b)
#pragma unroll
                for (int m = 0; m < 4; ++m)
#pragma unroll
                    for (int n = 0; n < 2; ++n) acc[a][b][m][n] = (f32x4){0.f, 0.f, 0.f, 0.f};
        cur = nxt; cA = nA; cB = nB; ++ui;
        if (wr == 1) PG8_BAR;
    }
    PG8_WAIT_V(0);
    PG8_BAR;
#undef PG8_SA
#undef PG8_SB
#undef PG8_STAGE
#undef PG8_LDA
#undef PG8_LDB
#undef PG8_MMA
#undef PG8_CAT
#undef PG8_WAIT_V
#undef PG8_WAIT_L
#undef PG8_BAR
#undef PG8_SCHED
}
}
namespace epi {
using pg8::Unit; using pg8::HALF; using pg8::BM;
__device__ __forceinline__ u32x4 pack8(f32x4 a, f32x4 b) { u32x4 w; w.x = cvt_pk_bf16(a[0], a[1]); w.y = cvt_pk_bf16(a[2], a[3]); w.z = cvt_pk_bf16(b[0], b[1]); w.w = cvt_pk_bf16(b[2], b[3]); return w; }
__device__ __forceinline__ u32x2 pack4(f32x4 a) { u32x2 w; w.x = cvt_pk_bf16(a[0], a[1]); w.y = cvt_pk_bf16(a[2], a[3]); return w; }
__device__ __forceinline__ void rope4(f32x4& a, f32x4& b, const f32x4 t0, const f32x4 t1) {
    const f32x4 c = {t0[0], t0[2], t1[0], t1[2]}, s = {t0[1], t0[3], t1[1], t1[3]};
    const f32x4 na = a * c - b * s, nb = b * c + a * s; a = na; b = nb;
}
__device__ __forceinline__ void ssq_add(float* ssq, int row, float ss, int fq) { ss += __shfl_xor(ss, 16); ss += __shfl_xor(ss, 32); if (fq == 0) atomicAdd(ssq + row, ss); }
__device__ __forceinline__ float sq8(f32x4 a, f32x4 b) { return (a[0] * a[0] + a[1] * a[1]) + (a[2] * a[2] + a[3] * a[3]) + (b[0] * b[0] + b[1] * b[1]) + (b[2] * b[2] + b[3] * b[3]); }

struct EpiProj {
    static constexpr bool PERM = true;
    bf16_t* P; const f32x4* tabm; const f32x4* tabd; float* ssq_q; float* ssq_kv;
    __device__ __forceinline__ void operator()(const f32x4 (&acc)[2][2][4][2], const Unit& u, int wr, int wc, int fr, int fq) const {
        const int row0 = u.pm * BM + wr * 64 + fr, pn = u.pn;
#pragma unroll
        for (int ai = 0; ai < 2; ++ai)
#pragma unroll
            for (int m = 0; m < 4; ++m) { const int row = row0 + ai * HALF + m * 16; bf16_t* rp = P + (size_t)row * PJ;
                if (pn == 0) { float ss = 0.f;
#pragma unroll
                    for (int bj = 0; bj < 2; ++bj) { const f32x4 v0 = acc[ai][bj][m][0], v1 = acc[ai][bj][m][1]; ss += sq8(v0, v1); *(u32x4*)(rp + bj * HALF + wc * 32 + 8 * fq) = pack8(v0, v1); }
                    ssq_add(ssq_q, row, ss, fq);
                } else if (pn == 1) {
                    { const f32x4 v0 = acc[ai][0][m][0], v1 = acc[ai][0][m][1]; *(u32x4*)(rp + 256 + wc * 32 + 8 * fq) = pack8(v0, v1); ssq_add(ssq_kv, row, sq8(v0, v1), fq); }
                    if (wc == 0) { f32x4 a = acc[ai][1][m][0], b = acc[ai][1][m][1]; const f32x4 t0 = tabm[(size_t)row * 8 + 2 * fq], t1 = tabm[(size_t)row * 8 + 2 * fq + 1]; rope4(a, b, t0, t1);
                        *(u32x2*)(rp + PC_KR + 4 * fq) = pack4(a); *(u32x2*)(rp + PC_KR + 16 + 4 * fq) = pack4(b); }
                } else if (pn < 6) { const int g = 4 * (wc & 1) + fq; const f32x4 t0 = tabd[(size_t)row * 16 + 2 * g], t1 = tabd[(size_t)row * 16 + 2 * g + 1]; const float sc = pn < 4 ? C2D : 1.f;
#pragma unroll
                    for (int bj = 0; bj < 2; ++bj) { f32x4 a = acc[ai][bj][m][0] * sc, b = acc[ai][bj][m][1] * sc; rope4(a, b, t0, t1);
                        bf16_t* bp = rp + pn * 256 + bj * HALF + (wc >> 1) * 64 + 4 * g; *(u32x2*)bp = pack4(a); *(u32x2*)(bp + 32) = pack4(b); }
                } else {
#pragma unroll
                    for (int bj = 0; bj < 2; ++bj) *(u32x4*)(rp + pn * 256 + bj * HALF + wc * 32 + 8 * fq) = pack8(acc[ai][bj][m][0], acc[ai][bj][m][1]);
                }
            }
    }
};
struct EpiQ {
    static constexpr bool PERM = true;
    bf16_t* Q; const f32x4* tabm; const float* ssq_q;
    __device__ __forceinline__ void operator()(const f32x4 (&acc)[2][2][4][2], const Unit& u, int wr, int wc, int fr, int fq) const {
        const int row0 = u.pm * BM + wr * 64 + fr;
        if (u.pn < 2) {
#pragma unroll
            for (int ai = 0; ai < 2; ++ai)
#pragma unroll
                for (int m = 0; m < 4; ++m) { const int row = row0 + ai * HALF + m * 16; const float rs = rsqrtf(ssq_q[row] * (1.f / 256.f) + 1e-6f) * C2M; bf16_t* rp = Q + (size_t)row * 768 + u.pn * BM + wc * 32 + 8 * fq;
#pragma unroll
                    for (int bj = 0; bj < 2; ++bj) *(u32x4*)(rp + bj * HALF) = pack8(acc[ai][bj][m][0] * rs, acc[ai][bj][m][1] * rs); }
        } else {
#pragma unroll
            for (int ai = 0; ai < 2; ++ai)
#pragma unroll
                for (int m = 0; m < 4; ++m) { const int row = row0 + ai * HALF + m * 16; const float rs = rsqrtf(ssq_q[row] * (1.f / 256.f) + 1e-6f) * C2M; bf16_t* rp = Q + (size_t)row * 768 + 512 + wc * 32 + 4 * fq;
                    const f32x4 t0 = tabm[(size_t)row * 8 + 2 * fq], t1 = tabm[(size_t)row * 8 + 2 * fq + 1];
#pragma unroll
                    for (int bj = 0; bj < 2; ++bj) { f32x4 a = acc[ai][bj][m][0] * rs, b = acc[ai][bj][m][1] * rs; rope4(a, b, t0, t1); *(u32x2*)(rp + bj * 128) = pack4(a); *(u32x2*)(rp + bj * 128 + 16) = pack4(b); }
                    asm volatile("" ::: "memory"); }
        }
    }
};
struct EpiKV {
    static constexpr bool PERM = true;
    bf16_t* KV; const float* ssq_kv;
    __device__ __forceinline__ void operator()(const f32x4 (&acc)[2][2][4][2], const Unit& u, int wr, int wc, int fr, int fq) const {
        const int row0 = u.pm * BM + wr * 64 + fr;
#pragma unroll
        for (int ai = 0; ai < 2; ++ai)
#pragma unroll
            for (int m = 0; m < 4; ++m) { const int row = row0 + ai * HALF + m * 16; const float rs = rsqrtf(ssq_kv[row] * (1.f / 128.f) + 1e-6f); bf16_t* rp = KV + (size_t)row * 1024 + u.pn * BM + wc * 32 + 8 * fq;
#pragma unroll
                for (int bj = 0; bj < 2; ++bj) *(u32x4*)(rp + bj * HALF) = pack8(acc[ai][bj][m][0] * rs, acc[ai][bj][m][1] * rs); }
    }
};
struct EpiY {
    static constexpr bool PERM = true;
    bf16_t* Y; float* ssq_y;
    __device__ __forceinline__ void operator()(const f32x4 (&acc)[2][2][4][2], const Unit& u, int wr, int wc, int fr, int fq) const {
        const int row0 = u.pm * BM + wr * 64 + fr;
#pragma unroll
        for (int ai = 0; ai < 2; ++ai)
#pragma unroll
            for (int m = 0; m < 4; ++m) { const int row = row0 + ai * HALF + m * 16; bf16_t* rp = Y + (size_t)row * 1024 + u.pn * BM + wc * 32 + 8 * fq; float ss = 0.f;
#pragma unroll
                for (int bj = 0; bj < 2; ++bj) { const f32x4 v0 = acc[ai][bj][m][0], v1 = acc[ai][bj][m][1]; ss += sq8(v0, v1); *(u32x4*)(rp + bj * HALF) = pack8(v0, v1); }
                ssq_add(ssq_y, row, ss, fq); }
    }
};
struct EpiAct {
    static constexpr bool PERM = true;
    unsigned char* ACT; const float* bgu;
    __device__ __forceinline__ void operator()(const f32x4 (&acc)[2][2][4][2], const Unit& u, int wr, int wc, int fr, int fq) const {
        const __amdgpu_buffer_rsrc_t rA = __builtin_amdgcn_make_buffer_rsrc((void*)ACT, 0, 0x7ffffff0, 0x00020000), rB = __builtin_amdgcn_make_buffer_rsrc((void*)bgu, 0, NE * 2048 * 4, 0x00020000);
        const int row0 = u.pm * BM + wr * 64 + fr;
#pragma unroll
        for (int bj = 0; bj < 2; ++bj) { const int j0 = u.pn * 128 + bj * 64 + wc * 16 + 4 * fq;
            const f32x4 bg = __builtin_bit_cast(f32x4, __builtin_amdgcn_raw_buffer_load_b128(rB, (u.e * 2048 + j0) * 4, 0, 0)), bu = __builtin_bit_cast(f32x4, __builtin_amdgcn_raw_buffer_load_b128(rB, (u.e * 2048 + 1024 + j0) * 4, 0, 0));
#pragma unroll
            for (int ai = 0; ai < 2; ++ai)
#pragma unroll
                for (int m = 0; m < 4; ++m) { const int row = row0 + ai * HALF + m * 16; f32x4 gv = acc[ai][bj][m][0] * W8_INV + bg, uv = acc[ai][bj][m][1] * W8_INV + bu, o;
#pragma unroll
                    for (int i = 0; i < 4; ++i) { const float gg = fminf(gv[i], 7.f), uu = fminf(fmaxf(uv[i], -7.f), 7.f); o[i] = gg * __builtin_amdgcn_rcpf(1.f + __builtin_amdgcn_exp2f(-1.702f * LOG2E * gg)) * (uu + 1.f); }
                    __builtin_amdgcn_raw_buffer_store_b32(pack4_fp8(o[0], o[1], o[2], o[3]), rA, row * 1024 + j0, 0, 0); } }
    }
};
struct EpiDown {
    static constexpr bool PERM = true;
    bf16_t* YR; const float* bd; const float* roww;
    __device__ __forceinline__ void operator()(const f32x4 (&acc)[2][2][4][2], const Unit& u, int wr, int wc, int fr, int fq) const {
        const __amdgpu_buffer_rsrc_t rY = __builtin_amdgcn_make_buffer_rsrc((void*)YR, 0, 0x7ffffff0, 0x00020000), rB = __builtin_amdgcn_make_buffer_rsrc((void*)bd, 0, NE * 1024 * 4, 0x00020000),
                                     rW = __builtin_amdgcn_make_buffer_rsrc((void*)roww, 0, NROWS * 4, 0x00020000);
        const int row0 = u.pm * BM + wr * 64 + fr, col = u.pn * BM + wc * 32 + 8 * fq, boff = (u.e * 1024 + col) * 4;
#pragma unroll
        for (int ai = 0; ai < 2; ++ai)
#pragma unroll
            for (int m = 0; m < 4; ++m) { const int row = row0 + ai * HALF + m * 16; const float w = __builtin_bit_cast(float, __builtin_amdgcn_raw_buffer_load_b32(rW, row * 4, 0, 0)), w8 = w * W8_INV;
#pragma unroll
                for (int bj = 0; bj < 2; ++bj) { const f32x4 b0 = __builtin_bit_cast(f32x4, __builtin_amdgcn_raw_buffer_load_b128(rB, boff + bj * HALF * 4, 0, 0)), b1 = __builtin_bit_cast(f32x4, __builtin_amdgcn_raw_buffer_load_b128(rB, boff + bj * HALF * 4 + 16, 0, 0));
                    __builtin_amdgcn_raw_buffer_store_b128(pack8(acc[ai][bj][m][0] * w8 + b0 * w, acc[ai][bj][m][1] * w8 + b1 * w), rY, row * 2048 + (col + bj * HALF) * 2, 0, 0); }
                asm volatile("" ::: "memory"); }
    }
};
}
constexpr size_t MiB = 1u << 20;
constexpr size_t WS_CTL = 0, CTL_ZERO_BYTES = 1 * MiB;
constexpr size_t WS_MOD = 1 * MiB;
constexpr size_t WS_SSQ = 1 * MiB + 512 * 1024;
constexpr size_t WS_TABM = 2 * MiB, WS_TABD = 6 * MiB;
constexpr size_t WS_SE = 14 * MiB, WS_SG = 14 * MiB + 512 * 1024, WS_SRANK = 18 * MiB + 512 * 1024;
constexpr size_t WS_POS = 15 * MiB;
constexpr size_t WS_ROWTOK = 16 * MiB, WS_ROWW = 17 * MiB;
constexpr size_t WS_CNT = 18 * MiB;
constexpr size_t WS_TD0 = 19 * MiB;
constexpr size_t WS_WIN = 20 * MiB, WS_WQB = 24 * MiB, WS_WKVB = 25 * MiB, WS_WO = 26 * MiB;
constexpr size_t WS_WGU = 28 * MiB, WS_WD = 156 * MiB;
constexpr size_t WS_H = 220 * MiB;
constexpr size_t WS_PROJ = 284 * MiB;
constexpr size_t WS_QM = 412 * MiB, WS_KVM = 460 * MiB, WS_ATT = 524 * MiB, WS_Y = 588 * MiB;
constexpr size_t WS_ACT = 284 * MiB;
constexpr size_t WS_YR = 588 * MiB;
constexpr size_t WS_END = 860 * MiB;
static_assert(WS_ACT + (size_t)NROWS * 1024 * 2 <= WS_YR && WS_YR + (size_t)NROWS * 1024 * 2 <= WS_END, "ws map");
constexpr int CW_BAR = 4096;

constexpr int RING_OFF = 0, RING_BYTES = 131072;
constexpr int LDSCTL_OFF = RING_BYTES, MISC_OFF = LDSCTL_OFF + 320;
constexpr int XTRA_OFF = MISC_OFF + 128;
constexpr int X_TILEE = XTRA_OFF;
constexpr int X_SE = X_TILEE + 2304, X_SG = X_SE + 2048, X_SRANK = X_SG + 2048, X_WCNT = X_SRANK + 2048, X_MISC2 = X_WCNT + 1024;
constexpr int X_IDX = X_MISC2 + 1024;
constexpr int LDS_BYTES = 147456;
static_assert(X_IDX + 2048 <= LDS_BYTES, "LDS map");
constexpr int NWAVES = 8;

#define XB_TMO      128
#define XB_XCNT(j)  (256  + 64 * (j))
#define XB_XSUB(j)  (1280 + 64 * (j))
#define XB_XGEN(j)  (2304 + 64 * (j))
#define XB_TOP      3328
#define XB_TOPGEN   3392
#define XCD_BAR_WORDS 3456
#define XB_SPIN_CAP (1u << 18)
__device__ __forceinline__ unsigned xb_ld(unsigned* p)              { return __hip_atomic_load(p, __ATOMIC_RELAXED, __HIP_MEMORY_SCOPE_AGENT); }
__device__ __forceinline__ unsigned xb_add(unsigned* p, unsigned v) { return __hip_atomic_fetch_add(p, v, __ATOMIC_RELAXED, __HIP_MEMORY_SCOPE_AGENT); }
__device__ __forceinline__ unsigned xb_xcc_id() { return (unsigned)__builtin_amdgcn_s_getreg((3 << 11) | 20) & 0xFu; }
#define XB_SPIN(cond, bar) do { unsigned _sp = 0; while (cond) { __builtin_amdgcn_s_sleep(1); \
    if ((++_sp & 255u) == 0u) { if (xb_ld(&(bar)[XB_TMO])) break; if (_sp > XB_SPIN_CAP) { atomicAdd(&(bar)[XB_TMO], 1u); break; } } } } while (0)
struct XcdBarrier { unsigned* bar; unsigned x; volatile LAS unsigned* st; };
__device__ __forceinline__ XcdBarrier xcd_barrier_post(unsigned* bar, volatile LAS unsigned* st) {
    XcdBarrier b; b.bar = bar; b.x = xb_xcc_id(); b.st = st;
    if (threadIdx.x == 0) (void)xb_add(&bar[XB_XCNT(b.x)], 1u);
    return b;
}
__device__ __forceinline__ void xcd_barrier_complete(unsigned* bar, unsigned x, unsigned& nloc, unsigned& nx) {
    const unsigned G = gridDim.x * gridDim.y * gridDim.z;
    unsigned sum, cnt, mine, sp = 0u;
    for (;;) {
        sum = 0u; cnt = 0u; mine = 0u;
#pragma unroll
        for (unsigned j = 0; j < 16; ++j) { const unsigned c = xb_ld(&bar[XB_XCNT(j)]); sum += c; cnt += (c > 0u) ? 1u : 0u; mine = (j == x) ? c : mine; }
        if (sum == G) break;
        __builtin_amdgcn_s_sleep(1);
        if ((++sp & 255u) == 0u) { if (xb_ld(&bar[XB_TMO])) break; if (sp > XB_SPIN_CAP) { atomicAdd(&bar[XB_TMO], 1u); break; } }
    }
    nloc = mine > 0u ? mine : 1u; nx = cnt > 0u ? cnt : 1u;
}
__device__ __forceinline__ void xcd_barrier(const XcdBarrier& b) {
    asm volatile("s_waitcnt vmcnt(0)" ::: "memory");
    __syncthreads();
    if (threadIdx.x == 0) {
        unsigned* bar = b.bar;
        __builtin_amdgcn_s_waitcnt(0);
        unsigned nloc = b.st[0], nx = b.st[1];
        if (nloc == 0u) { xcd_barrier_complete(bar, b.x, nloc, nx); b.st[0] = nloc; b.st[1] = nx; }
        const unsigned old = xb_add(&bar[XB_XSUB(b.x)], 1u);
        const unsigned gen = old / nloc;
        if (old + 1u == (gen + 1u) * nloc) {
            __builtin_amdgcn_fence(__ATOMIC_RELEASE, "agent");
            asm volatile("s_waitcnt vmcnt(0)" ::: "memory");
            const unsigned og = xb_add(&bar[XB_TOP], 1u);
            const unsigned tg = og / nx;
            if (og + 1u == (tg + 1u) * nx) xb_add(&bar[XB_TOPGEN], 1u);
            else XB_SPIN(xb_ld(&bar[XB_TOPGEN]) == tg, bar);
            __builtin_amdgcn_fence(__ATOMIC_ACQUIRE, "agent");
            xb_add(&bar[XB_XGEN(b.x)], 1u);
            asm volatile("s_waitcnt vmcnt(0)" ::: "memory");
        } else {
            XB_SPIN(xb_ld(&bar[XB_XGEN(b.x)]) == gen, bar);
            __builtin_amdgcn_fence(__ATOMIC_ACQUIRE, "agent");
            asm volatile("s_waitcnt vmcnt(0)" ::: "memory");
        }
    }
    __syncthreads();
}

struct Args { const float* in[26]; float* out; unsigned char* ws; int ph_lo, ph_hi, li, pad; };
struct Frame {
    LAS unsigned char* lds; volatile LAS unsigned* MISC; unsigned* ctl;
    int G, bid;
    const Args* a;
};
#define PHASE_IDS() int tid_ = threadIdx.x; asm volatile("" : "+v"(tid_)); const int tid = tid_, lane = tid & 63, wave = __builtin_amdgcn_readfirstlane(tid >> 6); (void)lane; (void)wave
#define IN_X 0
#define IN_C 1
#define IN_POS 2
#define IN_WADA 3
#define IN_BADA 4
#define IN_GMIXPRE 5
#define IN_GMIXPOST 6
#define IN_WIN 7
#define IN_GQA 8
#define IN_WQB 9
#define IN_GKVA 10
#define IN_WKVB 11
#define IN_LQ1 12
#define IN_LK1 13
#define IN_LQ2 14
#define IN_LK2 15
#define IN_GSUBLN 16
#define IN_WO 17
#define IN_GFFNPRE 18
#define IN_GFFNPOST 19
#define IN_WROUTER 20
#define IN_BROUTER 21
#define IN_WGU 22
#define IN_BGU 23
#define IN_WDN 24
#define IN_BDN 25

template <class Map>
__device__ __forceinline__ void transpose_item(const float* W, int K, int N, bf16_t* WT, const float* gain, Map dst, LAS float* scr, int item, int lane) {
    const int nblk = N / 32, kb = item / nblk, nb = item % nblk, k0 = 64 * kb, n0 = 32 * nb;
    { float v[32];
#pragma unroll
      for (int i = 0; i < 32; ++i) v[i] = W[(size_t)(k0 + 2 * i + (lane >> 5)) * N + n0 + (lane & 31)];
#pragma unroll
      for (int i = 0; i < 32; ++i) scr[(2 * i + (lane >> 5)) * 33 + (lane & 31)] = v[i]; }
    LDS_WAIT(); asm volatile("" ::: "memory");
    const int c = lane & 7;
    float gk[8];
#pragma unroll
    for (int i = 0; i < 8; ++i) gk[i] = gain ? gain[k0 + 8 * c + i] : 1.f;
#pragma unroll
    for (int j = 0; j < 4; ++j) { const int n = (lane >> 3) + 8 * j; const LAS float* s = scr + (8 * c) * 33 + n;
        u32x4 o; o.x = cvt_pk_bf16(s[0 * 33] * gk[0], s[1 * 33] * gk[1]); o.y = cvt_pk_bf16(s[2 * 33] * gk[2], s[3 * 33] * gk[3]); o.z = cvt_pk_bf16(s[4 * 33] * gk[4], s[5 * 33] * gk[5]); o.w = cvt_pk_bf16(s[6 * 33] * gk[6], s[7 * 33] * gk[7]);
        *(GAS u32x4*)(WT + (size_t)dst(n0 + n) * K + k0 + 8 * c) = o; }
    LDS_WAIT(); asm volatile("" ::: "memory");
}
template <class Map>
__device__ __forceinline__ void transpose8_stream(const float* W, int N, unsigned char* WT, Map dst, LAS float* scr, int first, int stride, int lane) {
    const int nblk = N / 32, per_e = 8 * nblk, total = NE * per_e;
    if (first >= total) return;
    float v[32];
    auto src = [&](int it, int hb) -> const float* { const int e = it / per_e, r = it - e * per_e, kb = r / nblk, nb = r - kb * nblk; return W + ((size_t)e * 1024 + 128 * kb + 64 * hb + (lane >> 5)) * N + 32 * nb + (lane & 31); };
    { const float* p = src(first, 0);
#pragma unroll
      for (int i = 0; i < 32; ++i) v[i] = p[(size_t)(2 * i) * N]; }
    for (int it = first; it < total; it += stride) {
#pragma unroll
        for (int hb = 0; hb < 2; ++hb) {
            float w[32];
#pragma unroll
            for (int i = 0; i < 32; ++i) w[i] = v[i];
            const int nit = hb == 0 ? it : it + stride;
            if (nit < total) { const float* p = src(nit, hb ^ 1);
#pragma unroll
                for (int i = 0; i < 32; ++i) v[i] = p[(size_t)(2 * i) * N]; }
#pragma unroll
            for (int i = 0; i < 32; ++i) { const int kk = 64 * hb + 2 * i + (lane >> 5); scr[kk * 32 + ((lane & 31) ^ (kk & 31))] = w[i]; }
        }
        LDS_WAIT(); asm volatile("" ::: "memory");
        const int e = it / per_e, r = it - e * per_e, kb = r / nblk, nb = r - kb * nblk, c = lane & 7;
#pragma unroll
        for (int j = 0; j < 4; ++j) { const int n = (lane >> 3) + 8 * j; float t[16];
#pragma unroll
            for (int i = 0; i < 16; ++i) { const int kk = 16 * c + i; t[i] = scr[kk * 32 + (n ^ (kk & 31))] * W8_SCALE; }
            u32x4 o; o.x = pack4_fp8(t[0], t[1], t[2], t[3]); o.y = pack4_fp8(t[4], t[5], t[6], t[7]); o.z = pack4_fp8(t[8], t[9], t[10], t[11]); o.w = pack4_fp8(t[12], t[13], t[14], t[15]);
            *(GAS u32x4*)(WT + ((size_t)e * N + dst(32 * nb + n)) * 1024 + 128 * kb + 16 * c) = o; }
        LDS_WAIT(); asm volatile("" ::: "memory");
    }
}
__device__ __forceinline__ int il4(int i, int x2) { return 8 * (i >> 2) + 4 * x2 + (i & 3); }
struct MapWin { __device__ int operator()(int n) const {
    if (n < 384) return n;
    if (n < 416) { const int r = n - 384; return PC_KR + il4(r & 15, r >> 4); }
    if (n < 1440) { const int r = n - 416, hj = r >> 6, d = r & 63; return PC_QD + hj * 64 + il4(d & 31, d >> 5); }
    return PC_VD + (n - 1440); } };
struct MapWqb { __device__ int operator()(int n) const { const int h = n / 96, d = n - h * 96; if (d < 64) return h * 64 + d; const int r = d - 64; return 512 + h * 32 + il4(r & 15, r >> 4); } };
struct MapId { __device__ int operator()(int n) const { return n; } };
struct MapWgu { __device__ int operator()(int n) const { const int which = n >> 10, j = n & 1023; return 8 * (j >> 2) + 4 * which + (j & 3); } };

__device__ __forceinline__ void p0_prologue(Frame& F) {
    PHASE_IDS();
    float* mod = (float*)(F.a->ws + WS_MOD);
    if (F.bid < 192) {
        LAS float* cact = (LAS float*)(F.lds);
        LAS float* red = (LAS float*)(F.lds + 65536);
        const float* c = F.a->in[IN_C];
        { float cv[32];
#pragma unroll
          for (int i = 0; i < 32; ++i) cv[i] = c[tid + 512 * i];
#pragma unroll
          for (int i = 0; i < 32; ++i) cact[tid + 512 * i] = cv[i] / (1.f + __expf(-cv[i])); }
        __syncthreads();
        const int n0 = 32 * F.bid, col = tid & 31, kg = tid >> 5;
        float acc[16];
#pragma unroll
        for (int b = 0; b < 16; ++b) acc[b] = 0.f;
        const float* wp = F.a->in[IN_WADA] + (size_t)(kg * 64) * 6144 + n0 + col;
#pragma unroll
        for (int q = 0; q < 2; ++q) { float w[32];
#pragma unroll
            for (int kk = 0; kk < 32; ++kk) w[kk] = wp[(size_t)(32 * q + kk) * 6144];
#pragma unroll
            for (int kk = 0; kk < 32; ++kk)
#pragma unroll
                for (int b = 0; b < 16; ++b) acc[b] += cact[b * 1024 + kg * 64 + 32 * q + kk] * w[kk]; }
#pragma unroll
        for (int b = 0; b < 16; ++b) red[(kg * 16 + b) * 32 + col] = acc[b];
        __syncthreads();
        { const int b = tid >> 5; float s = 0.f;
#pragma unroll
          for (int k2 = 0; k2 < 16; ++k2) s += red[(k2 * 16 + b) * 32 + col];
          mod[b * 6144 + n0 + col] = s + F.a->in[IN_BADA][n0 + col]; }
        __syncthreads();
    }
    { float* ssq = (float*)(F.a->ws + WS_SSQ); for (int i = F.bid * 512 + tid; i < 3 * T; i += F.G * 512) ssq[i] = 0.f;
      u32x4* wz = (u32x4*)((bf16_t*)(F.a->ws + WS_WIN) + (size_t)416 * 1024); for (int i = F.bid * 512 + tid; i < 96 * 1024 / 8; i += F.G * 512) wz[i] = (u32x4){0u, 0u, 0u, 0u}; }
    { const int* pos = (const int*)F.a->in[IN_POS]; float2* tabm = (float2*)(F.a->ws + WS_TABM); float2* tabd = (float2*)(F.a->ws + WS_TABD);
      for (int gid = F.bid * 512 + tid; gid < T * 48; gid += F.G * 512) { const int t = gid / 48, i = gid - t * 48; const float p = (float)pos[t];
          if (i < 16) { const float inv = powf(10000.f, -(float)(2 * i) / 32.f); const double a = (double)(p * inv); tabm[t * 16 + i] = make_float2((float)cos(a), (float)sin(a)); }
          else { const int j = i - 16; const float inv = powf(10000.f, -(float)(2 * j) / 64.f); const double a = (double)(p * inv); tabd[t * 32 + j] = make_float2((float)cos(a), (float)sin(a)); } } }
    LAS float* scr = (LAS float*)(F.lds + RING_OFF + wave * 16384);
    const int gw = F.bid * NWAVES + wave, NGW = F.G * NWAVES;
    constexpr int I_WIN = 16 * 61, I_WQB = 4 * 24, I_WKVB = 2 * 32, I_WO = 16 * 32;
    constexpr int NITEMS = I_WIN + I_WQB + I_WKVB + I_WO;
    for (int it = gw; it < NITEMS; it += NGW) {
        int r = it;
        if (r < I_WIN) { transpose_item(F.a->in[IN_WIN], 1024, INC, (bf16_t*)(F.a->ws + WS_WIN), nullptr, MapWin{}, scr, r, lane); continue; } r -= I_WIN;
        if (r < I_WQB) { transpose_item(F.a->in[IN_WQB], 256, 768, (bf16_t*)(F.a->ws + WS_WQB), F.a->in[IN_GQA], MapWqb{}, scr, r, lane); continue; } r -= I_WQB;
        if (r < I_WKVB) { transpose_item(F.a->in[IN_WKVB], 128, 1024, (bf16_t*)(F.a->ws + WS_WKVB), F.a->in[IN_GKVA], MapId{}, scr, r, lane); continue; } r -= I_WKVB;
        transpose_item(F.a->in[IN_WO], 1024, 1024, (bf16_t*)(F.a->ws + WS_WO), nullptr, MapId{}, scr, r, lane);
    }
    transpose8_stream(F.a->in[IN_WGU], 2048, (unsigned char*)(F.a->ws + WS_WGU), MapWgu{}, scr, gw, NGW, lane);
    transpose8_stream(F.a->in[IN_WDN], 1024, (unsigned char*)(F.a->ws + WS_WD), MapId{}, scr, gw, NGW, lane);
}
__device__ __forceinline__ void p0b_norm(Frame& F) {
    PHASE_IDS();
    const float* mod = (const float*)(F.a->ws + WS_MOD); bf16_t* H = (bf16_t*)(F.a->ws + WS_H);
    const int tok0 = F.bid * 128 + wave * 16, b = (F.bid * 128) / S;
    f32x4 g[4], sh[4];
#pragma unroll
    for (int j = 0; j < 4; ++j) { const int c = 4 * lane + 256 * j; g[j] = *(const f32x4*)(F.a->in[IN_GMIXPRE] + c) * (*(const f32x4*)(mod + b * 6144 + 1024 + c) + 1.f); sh[j] = *(const f32x4*)(mod + b * 6144 + c); }
    for (int i = 0; i < 16; i += 4) {
        f32x4 v[4][4];
#pragma unroll
        for (int r = 0; r < 4; ++r)
#pragma unroll
            for (int j = 0; j < 4; ++j) v[r][j] = *((const GAS f32x4*)(F.a->in[IN_X] + (size_t)(tok0 + i + r) * D) + lane + 64 * j);
#pragma unroll
        for (int r = 0; r < 4; ++r) { float ss = 0.f;
#pragma unroll
            for (int j = 0; j < 4; ++j) ss += (v[r][j].x * v[r][j].x + v[r][j].y * v[r][j].y) + (v[r][j].z * v[r][j].z + v[r][j].w * v[r][j].w);
            const float rs = rsqrtf(wave_sum(ss) * (1.f / D) + 1e-6f);
            GAS u32x2* o8 = (GAS u32x2*)(H + (size_t)(tok0 + i + r) * D) + lane;
#pragma unroll
            for (int j = 0; j < 4; ++j) { const f32x4 h = (v[r][j] * rs) * g[j] + sh[j]; u32x2 w; w.x = cvt_pk_bf16(h[0], h[1]); w.y = cvt_pk_bf16(h[2], h[3]); o8[64 * j] = w; } }
    }
}
__device__ __forceinline__ void p5_rows(Frame& F) {
    PHASE_IDS();
    LAS float* wt = (LAS float*)(F.lds + RING_OFF);
    for (int idx = tid; idx < NE * 1024; idx += 512) { const int e = idx >> 10, k = idx & 1023; wt[idx] = F.a->in[IN_WROUTER][k * NE + e]; }
    LAS int* se = (LAS int*)(F.lds + X_SE); LAS float* sg = (LAS float*)(F.lds + X_SG);
    const float* mod = (const float*)(F.a->ws + WS_MOD); const float* ssq_y = (const float*)(F.a->ws + WS_SSQ) + 2 * T;
    const bf16_t* Y = (const bf16_t*)(F.a->ws + WS_Y); unsigned char* H2 = (unsigned char*)(F.a->ws + WS_H);
    const int tok0 = F.bid * 128 + wave * 16, b = (F.bid * 128) / S;
    f32x4 gpost[4], gmod[4], gpre[4], shf[4], scf[4];
#pragma unroll
    for (int j = 0; j < 4; ++j) { const int c = 4 * lane + 256 * j; gpost[j] = *(const f32x4*)(F.a->in[IN_GMIXPOST] + c); gmod[j] = *(const f32x4*)(mod + b * 6144 + 2048 + c);
        gpre[j] = *(const f32x4*)(F.a->in[IN_GFFNPRE] + c); shf[j] = *(const f32x4*)(mod + b * 6144 + 3072 + c); scf[j] = *(const f32x4*)(mod + b * 6144 + 4096 + c) + 1.f; }
#pragma unroll
    for (int j = 0; j < 4; ++j) { gpost[j] = gpost[j] * gmod[j]; gpre[j] = gpre[j] * scf[j]; }
    f32x4 xn[4]; u32x2 yn[4]; float sn;
#define P5_LOAD(row) do { _Pragma("unroll") for (int j = 0; j < 4; ++j) { xn[j] = *(const GAS f32x4*)(F.a->in[IN_X] + (size_t)(row) * D + 4 * lane + 256 * j); yn[j] = *(const GAS u32x2*)(Y + (size_t)(row) * D + 4 * lane + 256 * j); } sn = ssq_y[row]; } while (0)
    P5_LOAD(tok0);
    __syncthreads();
    for (int i = 0; i < 16; ++i) {
        const int row = tok0 + i;
        f32x4 xv[4]; u32x2 yv[4];
#pragma unroll
        for (int j = 0; j < 4; ++j) { xv[j] = xn[j]; yv[j] = yn[j]; }
        const float rsy = rsqrtf(sn * (1.f / D) + 1e-6f);
        if (i + 1 < 16) P5_LOAD(row + 1);
        f32x4 x1[4]; float ss = 0.f;
#pragma unroll
        for (int j = 0; j < 4; ++j) { const f32x4 yy = {bflo(yv[j].x), bfhi(yv[j].x), bflo(yv[j].y), bfhi(yv[j].y)}; x1[j] = xv[j] + (yy * rsy) * gpost[j];
            ss += (x1[j][0] * x1[j][0] + x1[j][1] * x1[j][1]) + (x1[j][2] * x1[j][2] + x1[j][3] * x1[j][3]);
            *(GAS f32x4*)(F.a->out + (size_t)row * D + 4 * lane + 256 * j) = x1[j]; }
        const float r1 = rsqrtf(wave_sum(ss) * (1.f / D) + 1e-6f);
        f32x4 h2[4];
#pragma unroll
        for (int j = 0; j < 4; ++j) { h2[j] = (x1[j] * r1) * gpre[j] + shf[j]; *(GAS unsigned*)(H2 + (size_t)row * D + 4 * lane + 256 * j) = pack4_fp8(h2[j][0], h2[j][1], h2[j][2], h2[j][3]); }
        float v[32];
#pragma unroll
        for (int e = 0; e < NE; ++e) { const LAS f32x4* wp = (const LAS f32x4*)(wt + e * 1024 + 4 * lane); float p = 0.f;
#pragma unroll
            for (int j = 0; j < 4; ++j) { const f32x4 w = wp[64 * j]; p += (h2[j][0] * w[0] + h2[j][1] * w[1]) + (h2[j][2] * w[2] + h2[j][3] * w[3]); }
            v[e] = p; }
#ifdef P5_SHFL
#pragma unroll
        for (int j = 0; j < 16; ++j) { const bool up = (lane & 32) != 0; const float keep = up ? v[16 + j] : v[j], send = up ? v[j] : v[16 + j]; v[j] = keep + __shfl_xor(send, 32); }
#pragma unroll
        for (int j = 0; j < 8; ++j) { const bool up = (lane & 16) != 0; const float keep = up ? v[8 + j] : v[j], send = up ? v[j] : v[8 + j]; v[j] = keep + __shfl_xor(send, 16); }
#pragma unroll
        for (int j = 0; j < 4; ++j) { const bool up = (lane & 8) != 0; const float keep = up ? v[4 + j] : v[j], send = up ? v[j] : v[4 + j]; v[j] = keep + __shfl_xor(send, 8); }
#pragma unroll
        for (int j = 0; j < 2; ++j) { const bool up = (lane & 4) != 0; const float keep = up ? v[2 + j] : v[j], send = up ? v[j] : v[2 + j]; v[j] = keep + __shfl_xor(send, 4); }
        { const bool up = (lane & 2) != 0; const float keep = up ? v[1] : v[0], send = up ? v[0] : v[1]; v[0] = keep + __shfl_xor(send, 2); }
        float lg = v[0] + __shfl_xor(v[0], 1);
#else
#pragma unroll
        for (int j = 0; j < 16; ++j) v[j] = swap32_sum(v[j], v[16 + j]);
#pragma unroll
        for (int j = 0; j < 8; ++j) v[j] = swap16_sum(v[j], v[8 + j]);
#pragma unroll
        for (int j = 0; j < 4; ++j) { const bool up = (lane & 8) != 0; const float keep = up ? v[4 + j] : v[j], send = up ? v[j] : v[4 + j]; v[j] = keep + lane_xor8(send); }
#pragma unroll
        for (int j = 0; j < 2; ++j) { const bool up = (lane & 4) != 0; const float keep = up ? v[2 + j] : v[j], send = up ? v[j] : v[2 + j]; v[j] = keep + lane_xor4(send); }
        { const bool up = (lane & 2) != 0; const float keep = up ? v[1] : v[0], send = up ? v[0] : v[1]; v[0] = keep + DPPF(send, 0x4E); }
        float lg = v[0] + DPPF(v[0], 0xB1);
#endif
        const int my_e = lane >> 1;
        lg += F.a->in[IN_BROUTER][my_e];
        float vals[4]; int idx[4];
#pragma unroll
        for (int k = 0; k < 4; ++k) { const float mx = wave_max(lg);
            const unsigned long long bm = __ballot(lg == mx); const int wl = __builtin_ctzll(bm); vals[k] = mx; idx[k] = wl >> 1; if (my_e == idx[k]) lg = -INFINITY; }
        float ex[4], den = 0.f;
#pragma unroll
        for (int k = 0; k < 4; ++k) { ex[k] = __expf(vals[k] - vals[0]); den += ex[k]; }
        const float inv = 1.f / den;
        if (lane < 4) { const int a = (wave * 16 + i) * 4 + lane; se[a] = lane == 0 ? idx[0] : lane == 1 ? idx[1] : lane == 2 ? idx[2] : idx[3]; sg[a] = (lane == 0 ? ex[0] : lane == 1 ? ex[1] : lane == 2 ? ex[2] : ex[3]) * inv; }
    }
#undef P5_LOAD
    __syncthreads();
    LAS int* srank = (LAS int*)(F.lds + X_SRANK); LAS int* wcnt = (LAS int*)(F.lds + X_WCNT);
    const int e_my = se[tid]; int rk = 0;
    for (int e = 0; e < NE; ++e) { const unsigned long long bm = __ballot(e_my == e); if (e_my == e) rk = __builtin_popcountll(bm & ((1ull << lane) - 1ull)); if (lane == 0) wcnt[wave * 32 + e] = __builtin_popcountll(bm); }
    __syncthreads();
    int base = 0;
    for (int w = 0; w < wave; ++w) base += wcnt[w * 32 + e_my];
    srank[tid] = base + rk;
    { const int a = F.bid * 512 + tid; ((int*)(F.a->ws + WS_SE))[a] = e_my; ((float*)(F.a->ws + WS_SG))[a] = sg[tid]; ((int*)(F.a->ws + WS_SRANK))[a] = base + rk; }
    if (tid < NE) { int tot = 0; for (int w = 0; w < 8; ++w) tot += wcnt[w * 32 + tid]; ((int*)(F.a->ws + WS_CNT))[F.bid * NE + tid] = tot; }
}
__device__ __forceinline__ void p9_final(Frame& F) {
    PHASE_IDS();
    const float* mod = (const float*)(F.a->ws + WS_MOD); const bf16_t* YR = (const bf16_t*)(F.a->ws + WS_YR); const int* pos = (const int*)(F.a->ws + WS_POS);
    const int tok0 = F.bid * 128 + wave * 16, b = (F.bid * 128) / S;
    f32x4 gf[4];
#pragma unroll
    for (int j = 0; j < 4; ++j) { const int c = 4 * lane + 256 * j; gf[j] = *(const f32x4*)(F.a->in[IN_GFFNPOST] + c) * *(const f32x4*)(mod + b * 6144 + 5120 + c); }
    u32x2 yn[4][4]; f32x4 xn[4];
#define P9_LOAD(row) do { _Pragma("unroll") for (int s_ = 0; s_ < 4; ++s_) { const int pr = __builtin_amdgcn_readfirstlane(pos[(row) * 4 + s_]); _Pragma("unroll") for (int j = 0; j < 4; ++j) yn[s_][j] = *(const GAS u32x2*)(YR + (size_t)pr * D + 4 * lane + 256 * j); } \
        _Pragma("unroll") for (int j = 0; j < 4; ++j) xn[j] = *(const GAS f32x4*)(F.a->out + (size_t)(row) * D + 4 * lane + 256 * j); } while (0)
    P9_LOAD(tok0);
    for (int i = 0; i < 16; ++i) {
        const int row = tok0 + i;
        f32x4 y[4], x1[4]; float ss = 0.f;
#pragma unroll
        for (int j = 0; j < 4; ++j) { y[j] = (f32x4){0.f, 0.f, 0.f, 0.f};
#pragma unroll
            for (int s_ = 0; s_ < 4; ++s_) { const u32x2 w = yn[s_][j]; y[j] += (f32x4){bflo(w.x), bfhi(w.x), bflo(w.y), bfhi(w.y)}; }
            x1[j] = xn[j]; ss += (y[j][0] * y[j][0] + y[j][1] * y[j][1]) + (y[j][2] * y[j][2] + y[j][3] * y[j][3]); }
        if (i + 1 < 16) P9_LOAD(row + 1);
        const float r = rsqrtf(wave_sum(ss) * (1.f / D) + 1e-6f);
#pragma unroll
        for (int j = 0; j < 4; ++j) *(GAS f32x4*)(F.a->out + (size_t)row * D + 4 * lane + 256 * j) = x1[j] + (y[j] * r) * gf[j];
    }
#undef P9_LOAD
}
namespace att {
#define SBAR() __builtin_amdgcn_sched_barrier(0)
typedef short s16x4 __attribute__((ext_vector_type(4)));
typedef short v4i16_t __attribute__((ext_vector_type(4)));
typedef __attribute__((address_space(3))) const char* lds_cptr;
__device__ __forceinline__ int crow(int r, int hi) { return (r & 3) + 8 * (r >> 2) + 4 * hi; }
__device__ __forceinline__ void glds16(const void* gsrc, unsigned lds_dst) { unsigned keep;
    asm volatile("s_mov_b32 %0, m0\n\ts_mov_b32 m0, %2\n\ts_nop 0\n\tglobal_load_lds_dwordx4 %1, off\n\ts_mov_b32 m0, %0" : "=&s"(keep) : "v"(gsrc), "s"(lds_dst) : "memory"); }
__device__ __forceinline__ s16x4 vtr(lds_cptr p) { return __builtin_bit_cast(s16x4, __builtin_amdgcn_ds_read_tr16_b64_v4i16((__attribute__((address_space(3))) v4i16_t*)p)); }
typedef float f32x2_t __attribute__((ext_vector_type(2))); typedef __bf16 bf16x2_t __attribute__((ext_vector_type(2)));
__device__ __forceinline__ unsigned cvtpk_s(float lo, float hi) { f32x2_t v = {lo, hi}; bf16x2_t b = __builtin_convertvector(v, bf16x2_t); return __builtin_bit_cast(unsigned, b); }
#define WAIT_BAR0() asm volatile("s_waitcnt vmcnt(0) lgkmcnt(0)\n\ts_barrier" ::: "memory")

struct Src {
    const bf16_t* q0; const bf16_t* q1; int qp;
    const bf16_t* k0; const bf16_t* k1; int kp0, kp1;
    const bf16_t* v; int vp;
};
template <int DQK, int DV> struct Geo {
    static constexpr int NKC = DQK / 8, NVB = DV / 32, KSLOT = NKC * 1024, VSLOT = NVB * 4096, NPIECE = NKC + 4 * NVB;
    static constexpr int NSLOT = 3, LDS_K = 0, LDS_V = NSLOT * KSLOT, LDS_WS = LDS_V + NSLOT * VSLOT, LDS_OST = 0  , LDS_TOTAL = LDS_WS + 8 * 256;
    static_assert(8 * 32 * DV * 2 <= LDS_WS && LDS_TOTAL <= 131072, "attention LDS map");
};
constexpr float THR = 8.f;
#ifndef ATT_VPM
#define ATT_VPM 8
#endif

template <int DQK, int DV, int MODE>
__device__ __forceinline__ void attn_unit(LAS char* shm, const Src sc, int qb, bf16_t* obase, float* td, float lam, const float* gsub) {
    typedef Geo<DQK, DV> G;
    int tid_ = threadIdx.x; asm volatile("" : "+v"(tid_));
    const int tid = tid_, lane = tid & 63, r32 = lane & 31, hi = lane >> 5; const int wid = __builtin_amdgcn_readfirstlane(tid >> 6);
    const int q0 = qb * 256, NT = 4 * (qb + 1);
    const unsigned lds0 = (unsigned)(uintptr_t)shm;
    LAS float* wsf = (LAS float*)(shm + G::LDS_WS) + wid * 64;
    const char* ksrc[2]; const char* vsrc[2]; long kstep[2], vstep;
#pragma unroll
    for (int i = 0; i < 2; ++i) { const int p = wid + 8 * i; ksrc[i] = nullptr; kstep[i] = 0; vsrc[i] = nullptr;
        if (p < G::NKC) { const bf16_t* base = p < 8 ? sc.k0 + 8 * p : sc.k1 + 8 * (p - 8); const int pitch = p < 8 ? sc.kp0 : sc.kp1; ksrc[i] = (const char*)(base + (long)lane * pitch); kstep[i] = 128L * pitch; }
        if (p < 4 * G::NVB) { const int db = p >> 2, rg = p & 3; vsrc[i] = (const char*)(sc.v + (long)(16 * rg + (lane >> 2)) * sc.vp + 32 * db + 8 * (lane & 3)); } }
    vstep = 128L * sc.vp;
#define DMA_K(slot) do { _Pragma("unroll") for (int i_ = 0; i_ < 2; ++i_) if (wid + 8 * i_ < G::NKC) { glds16(ksrc[i_], (unsigned)__builtin_amdgcn_readfirstlane(lds0 + G::LDS_K + (wid + 8 * i_) * 1024 + (slot) * G::KSLOT)); ksrc[i_] += kstep[i_]; } } while (0)
#define DMA_V(slot) do { _Pragma("unroll") for (int i_ = 0; i_ < 2; ++i_) if (wid + 8 * i_ < 4 * G::NVB) { glds16(vsrc[i_], (unsigned)__builtin_amdgcn_readfirstlane(lds0 + G::LDS_V + (wid + 8 * i_) * 1024 + (slot) * G::VSLOT)); vsrc[i_] += vstep; } } while (0)
    DMA_K(0); DMA_V(0); DMA_K(1); DMA_V(1); DMA_K(2);
    bf16x8 qr[DQK / 16];
    { const long qrow = (long)(q0 + wid * 32 + r32) * sc.qp;
#pragma unroll
      for (int d0 = 0; d0 < DQK / 16; ++d0) qr[d0] = d0 < 4 ? *reinterpret_cast<const bf16x8*>(sc.q0 + qrow + d0 * 16 + hi * 8) : *reinterpret_cast<const bf16x8*>(sc.q1 + qrow + (d0 - 4) * 16 + hi * 8); }
    float m_run = 0.f, l_reg = 0.f; bool first = true;
    f32x16 negm = f32x16{};
    f32x16 o[G::NVB];
#pragma unroll
    for (int d = 0; d < G::NVB; ++d) o[d] = f32x16{};
    const int qrel = wid * 32 + r32;
    const lds_cptr shm3 = (lds_cptr)shm;
    const lds_cptr kp0 = shm3 + G::LDS_K + hi * 1024 + r32 * 16;
    const lds_cptr vp0 = shm3 + G::LDS_V + ((lane >> 4) & 1) * 32 + (lane & 3) * 8 + (4 * hi + ((lane & 15) >> 2)) * 64;
#define QKT(P0, P1, slot) do { const lds_cptr kp_ = kp0 + (slot) * G::KSLOT; _Pragma("unroll") for (int d0 = 0; d0 < DQK / 16; ++d0) { \
        const bf16x8 b0_ = *(const __attribute__((address_space(3))) bf16x8*)(kp_ + d0 * 2048), b1_ = *(const __attribute__((address_space(3))) bf16x8*)(kp_ + d0 * 2048 + 512); \
        if (d0 == 0) { P0 = __builtin_amdgcn_mfma_f32_32x32x16_bf16(b0_, qr[0], negm, 0, 0, 0); P1 = __builtin_amdgcn_mfma_f32_32x32x16_bf16(b1_, qr[0], negm, 0, 0, 0); } \
        else { P0 = __builtin_amdgcn_mfma_f32_32x32x16_bf16(b0_, qr[d0], P0, 0, 0, 0); P1 = __builtin_amdgcn_mfma_f32_32x32x16_bf16(b1_, qr[d0], P1, 0, 0, 0); } } } while (0)
#define ACTIVE(t_) (!((t_) - (NT - 4) >= 0 && 64 * ((t_) - (NT - 4)) > 32 * wid + 31))
    int s_cur = 0, s_nx1 = 1, s_nx2 = 2;
    const bool three = (wid + 8 < G::NKC ? 2 : 1) + (wid + 8 < 4 * G::NVB ? 2 : 1) == 3;
    f32x16 sc0 = f32x16{}, sc1 = f32x16{}, sn0 = f32x16{}, sn1 = f32x16{};
    asm volatile("s_waitcnt vmcnt(0) lgkmcnt(0)\n\ts_barrier" ::: "memory");
    QKT(sc0, sc1, 0);
    for (int t = 0; t < NT; ++t) {
        if (t + 3 < NT) { if (three) asm volatile("s_waitcnt vmcnt(3) lgkmcnt(0)\n\ts_barrier" ::: "memory"); else asm volatile("s_waitcnt vmcnt(2) lgkmcnt(0)\n\ts_barrier" ::: "memory"); }
        else WAIT_BAR0();
        if (t + 3 < NT) DMA_K(s_cur);
        if (t + 2 < NT) DMA_V(s_nx2);
        const int jb = t - (NT - 4);
        const bool act = ACTIVE(t), nxt = (t + 1 < NT) && ACTIVE(t + 1);
        if (!act) { const int tmp = s_cur; s_cur = s_nx1; s_nx1 = s_nx2; s_nx2 = tmp; continue; }
        if (jb >= 0) { const int kb = 64 * jb + 4 * hi;
#pragma unroll
            for (int r = 0; r < 16; ++r) { const int kv = kb + (r & 3) + 8 * (r >> 2); if (kv > qrel) sc0[r] = -INFINITY; if (kv + 32 > qrel) sc1[r] = -INFINITY; } }
        float rm = fmaxf(sc0[0], sc1[0]);
#pragma unroll
        for (int r = 1; r < 16; ++r) rm = fmaxf(rm, fmaxf(sc0[r], sc1[r]));
        rm = swap32_max(rm, rm);
        if (first || __any(rm > THR)) {
            const float dl = first ? rm : fmaxf(rm, 0.f), f = first ? 1.f : __builtin_amdgcn_exp2f(-dl); m_run += dl; l_reg *= f; first = false;
#pragma unroll
            for (int r = 0; r < 16; ++r) { sc0[r] -= dl; sc1[r] -= dl; negm[r] = -m_run; }
            if (hi == 0) wsf[r32] = f;
            asm volatile("s_waitcnt lgkmcnt(0)" ::: "memory");
#pragma unroll
            for (int g = 0; g < 4; ++g) { const f32x4 fv = *(const LAS f32x4*)(wsf + 8 * g + 4 * hi);
#pragma unroll
                for (int d = 0; d < G::NVB; ++d) { o[d][4 * g] *= fv[0]; o[d][4 * g + 1] *= fv[1]; o[d][4 * g + 2] *= fv[2]; o[d][4 * g + 3] *= fv[3]; } }
        }
        u32x4 pw[4];
        if (nxt) {
            constexpr int ND0 = DQK / 16, NG = 2 * ND0;
            const lds_cptr kpn = kp0 + s_nx1 * G::KSLOT;
            float sacc = 0.f;
            bf16x8 kb0 = *(const __attribute__((address_space(3))) bf16x8*)(kpn), kb1 = *(const __attribute__((address_space(3))) bf16x8*)(kpn + 512), nb0 = kb0, nb1 = kb1;
#define ATT_GAP(g_) do { _Pragma("unroll") for (int e_ = ((g_) * 32) / NG; e_ < (((g_) + 1) * 32) / NG; ++e_) { \
                if (e_ < 16) { sc0[e_] = __builtin_amdgcn_exp2f(sc0[e_]); sacc += sc0[e_]; } else { sc1[e_ - 16] = __builtin_amdgcn_exp2f(sc1[e_ - 16]); sacc += sc1[e_ - 16]; } } \
                asm volatile("" : "+v"(sacc), "+v"(sc0), "+v"(sc1)); SBAR(); } while (0)
#pragma unroll
            for (int d0 = 0; d0 < ND0; ++d0) {
                if (d0 + 1 < ND0) { nb0 = *(const __attribute__((address_space(3))) bf16x8*)(kpn + (d0 + 1) * 2048); nb1 = *(const __attribute__((address_space(3))) bf16x8*)(kpn + (d0 + 1) * 2048 + 512); }
                sn0 = d0 == 0 ? __builtin_amdgcn_mfma_f32_32x32x16_bf16(kb0, qr[0], negm, 0, 0, 0) : __builtin_amdgcn_mfma_f32_32x32x16_bf16(kb0, qr[d0], sn0, 0, 0, 0);
                ATT_GAP(2 * d0);
                sn1 = d0 == 0 ? __builtin_amdgcn_mfma_f32_32x32x16_bf16(kb1, qr[0], negm, 0, 0, 0) : __builtin_amdgcn_mfma_f32_32x32x16_bf16(kb1, qr[d0], sn1, 0, 0, 0);
                ATT_GAP(2 * d0 + 1);
                kb0 = nb0; kb1 = nb1;
            }
#undef ATT_GAP
            l_reg += sacc;
#pragma unroll
            for (int k = 0; k < 4; ++k) { pw[0][k] = cvtpk_s(sc0[2 * k], sc0[2 * k + 1]); pw[1][k] = cvtpk_s(sc0[8 + 2 * k], sc0[8 + 2 * k + 1]); pw[2][k] = cvtpk_s(sc1[2 * k], sc1[2 * k + 1]); pw[3][k] = cvtpk_s(sc1[8 + 2 * k], sc1[8 + 2 * k + 1]); }
        } else {
            float sacc = 0.f;
#pragma unroll
            for (int r = 0; r < 16; ++r) { sc0[r] = __builtin_amdgcn_exp2f(sc0[r]); sc1[r] = __builtin_amdgcn_exp2f(sc1[r]); sacc += sc0[r] + sc1[r]; }
            l_reg += sacc;
#pragma unroll
            for (int k = 0; k < 4; ++k) { pw[0][k] = cvtpk_s(sc0[2 * k], sc0[2 * k + 1]); pw[1][k] = cvtpk_s(sc0[8 + 2 * k], sc0[8 + 2 * k + 1]); pw[2][k] = cvtpk_s(sc1[2 * k], sc1[2 * k + 1]); pw[3][k] = cvtpk_s(sc1[8 + 2 * k], sc1[8 + 2 * k + 1]); }
        }
        const lds_cptr vpp = vp0 + s_cur * G::VSLOT;
#pragma unroll
        for (int d = 0; d < G::NVB; ++d) {
#pragma unroll
            for (int ks = 0; ks < 4; ++ks) { const s16x4 lo = vtr(vpp + d * 4096 + ks * 1024), hh = vtr(vpp + d * 4096 + ks * 1024 + 512);
                const bf16x8 vf = {lo[0], lo[1], lo[2], lo[3], hh[0], hh[1], hh[2], hh[3]};
                o[d] = __builtin_amdgcn_mfma_f32_32x32x16_bf16(__builtin_bit_cast(bf16x8, pw[ks]), vf, o[d], 0, 0, 0); } }
        sc0 = sn0; sc1 = sn1;
        { const int tmp = s_cur; s_cur = s_nx1; s_nx1 = s_nx2; s_nx2 = tmp; }
    }
#undef QKT
#undef ACTIVE
#undef DMA_K
#undef DMA_V
    l_reg = swap32_sum(l_reg, l_reg);
    if (hi == 0) wsf[32 + r32] = l_reg;
    asm volatile("s_waitcnt lgkmcnt(0)" ::: "memory");
    float rli[16];
#pragma unroll
    for (int r = 0; r < 16; ++r) rli[r] = __builtin_amdgcn_rcpf(wsf[32 + crow(r, hi)]);
    const long orow0 = (long)(q0 + wid * 32);
    if (MODE == 1) {
#pragma unroll
        for (int r = 0; r < 16; ++r)
#pragma unroll
            for (int d = 0; d < G::NVB; ++d) td[(orow0 + crow(r, hi)) * 512 + d * 32 + r32] = o[d][r] * rli[r];
    } else {
        if (MODE == 2) {
            float ssr[16];
#pragma unroll
            for (int r = 0; r < 16; ++r) { float ss = 0.f;
#pragma unroll
                for (int d = 0; d < G::NVB; ++d) { const float v = td[(orow0 + crow(r, hi)) * 512 + d * 32 + r32] - lam * (o[d][r] * rli[r]); o[d][r] = v; ss += v * v; }
#pragma unroll
                for (int x = 1; x < 32; x <<= 1) ss += __shfl_xor(ss, x);
                ssr[r] = rsqrtf(ss * (1.f / DV) + 1e-5f) * (1.f - LAMBDA_INIT); }
#pragma unroll
            for (int d = 0; d < G::NVB; ++d) { const float gv = gsub[d * 32 + r32];
#pragma unroll
                for (int r = 0; r < 16; ++r) o[d][r] *= ssr[r] * gv; }
#pragma unroll
            for (int r = 0; r < 16; ++r) rli[r] = 1.f;
        }
        asm volatile("s_waitcnt lgkmcnt(0)\n\ts_barrier" ::: "memory");
        LAS bf16_t* stg = (LAS bf16_t*)(shm + G::LDS_OST) + wid * 32 * DV;
#pragma unroll
        for (int r = 0; r < 16; ++r) { const int orow = crow(r, hi);
#pragma unroll
            for (int d = 0; d < G::NVB; ++d) stg[orow * DV + d * 32 + r32] = (bf16_t)(cvtpk_s(o[d][r] * rli[r], 0.f) & 0xffffu); }
        asm volatile("s_waitcnt lgkmcnt(0)" ::: "memory");
        constexpr int CPR = DV / 8;
#pragma unroll
        for (int i = 0; i < 32 * CPR / 64; ++i) { const int idx = i * 64 + lane, row = idx / CPR, ch = idx % CPR; const u32x4 v = *(const LAS u32x4*)(stg + row * DV + ch * 8);
            *(u32x4*)(obase + (orow0 + row) * 1024 + ch * 8) = v; }
    }
    __builtin_amdgcn_s_setprio(0);
    asm volatile("s_waitcnt vmcnt(0) lgkmcnt(0)\n\ts_barrier" ::: "memory");
}
#undef SBAR
#undef WAIT_BAR0
}

__device__ __forceinline__ void attn_phase_all(Frame& F) {
    LAS char* shm = (LAS char*)(F.lds + RING_OFF);
    const int vcu = (F.bid & 7) * (F.G >> 3) + (F.bid >> 3);
    const bf16_t* QM = (const bf16_t*)(F.a->ws + WS_QM); const bf16_t* KVM = (const bf16_t*)(F.a->ws + WS_KVM); const bf16_t* PR = (const bf16_t*)(F.a->ws + WS_PROJ); bf16_t* ATT = (bf16_t*)(F.a->ws + WS_ATT);
    { const int p = vcu >> 1, b = p >> 3, h = p & 7, half = vcu & 1; const long r0 = (long)b * S;
      att::Src sc{QM + r0 * 768 + h * 64, QM + r0 * 768 + 512 + h * 32, 768, KVM + r0 * 1024 + h * 128, PR + r0 * PJ + PC_KR, 1024, PJ, KVM + r0 * 1024 + h * 128 + 64, 1024};
      for (int i = 0; i < 4; ++i) { const int qb = half == 0 ? (i == 0 ? 7 : i == 1 ? 5 : i == 2 ? 2 : 0) : (i == 0 ? 6 : i == 1 ? 4 : i == 2 ? 3 : 1);
          att::attn_unit<96, 64, 0>(shm, sc, qb, ATT + r0 * 1024 + h * 64, nullptr, 0.f, nullptr); } }
    { const int p = vcu >> 2, b = p >> 2, h = p & 3, s4 = vcu & 3; const long r0 = (long)b * S;
      float lam; { const float* l1 = F.a->in[IN_LQ1]; const float* k1 = F.a->in[IN_LK1]; const float* l2 = F.a->in[IN_LQ2]; const float* k2 = F.a->in[IN_LK2]; float s1 = 0.f, s2 = 0.f;
          for (int i = 0; i < 64; ++i) { s1 += l1[i] * k1[i]; s2 += l2[i] * k2[i]; } lam = __expf(s1) - __expf(s2) + LAMBDA_INIT; }
      float* td = (float*)(F.a->ws + WS_Y) + r0 * 512 + h * 128;
      for (int i = 0; i < 2; ++i) { const int qb = i == 0 ? 7 - s4 : s4;
          att::Src s0{PR + r0 * PJ + PC_QD + (2 * h) * 64, nullptr, PJ, PR + r0 * PJ + PC_KD + (2 * h) * 64, nullptr, PJ, PJ, PR + r0 * PJ + PC_VD + h * 128, PJ};
          att::Src s1{PR + r0 * PJ + PC_QD + (2 * h + 1) * 64, nullptr, PJ, PR + r0 * PJ + PC_KD + (2 * h + 1) * 64, nullptr, PJ, PJ, PR + r0 * PJ + PC_VD + h * 128, PJ};
          att::attn_unit<64, 128, 1>(shm, s0, qb, nullptr, td, 0.f, nullptr);
          att::attn_unit<64, 128, 2>(shm, s1, qb, ATT + r0 * 1024 + 512 + h * 128, td, lam, F.a->in[IN_GSUBLN]); } }
}
__device__ __forceinline__ void offsets_from_counts(Frame& F) {
    PHASE_IDS();
    int* cnt = (int*)(F.a->ws + WS_CNT);
    LAS int* part = (LAS int*)(F.lds + RING_OFF);
    LAS int* tile_e = (LAS int*)(F.lds + X_TILEE); LAS int* m2 = (LAS int*)(F.lds + X_MISC2);
    { const int e = tid & 31, p = tid >> 5; int tot = 0, pre = 0;
      for (int w = p * 16; w < p * 16 + 16; ++w) { const int c = __hip_atomic_load(cnt + w * NE + e, RLX_AGENT); tot += c; if (w < F.bid) pre += c; }
      part[(p * 32 + e) * 2] = tot; part[(p * 32 + e) * 2 + 1] = pre; }
    __syncthreads();
    if (tid < NE) { int tot = 0, pre = 0; for (int p = 0; p < 16; ++p) { tot += part[(p * 32 + tid) * 2]; pre += part[(p * 32 + tid) * 2 + 1]; } m2[96 + tid] = tot; m2[64 + tid] = pre; }
    __syncthreads();
    if (tid < NE) { int st = 0; for (int e = 0; e < tid; ++e) st += (m2[96 + e] + 255) & ~255; m2[32 + tid] = st; const int pad = (m2[96 + tid] + 255) & ~255;
        for (int r = st; r < st + pad; r += 256) tile_e[r >> 8] = tid; if (tid == NE - 1) m2[0] = (st + pad) >> 8; }
    __syncthreads();
}
__device__ __forceinline__ void p6_scatter(Frame& F) {
    offsets_from_counts(F);
    PHASE_IDS();
    LAS int* m2 = (LAS int*)(F.lds + X_MISC2);
    int* rowtok = (int*)(F.a->ws + WS_ROWTOK); float* roww = (float*)(F.a->ws + WS_ROWW); int* pos = (int*)(F.a->ws + WS_POS);
    { const int a = F.bid * 512 + tid; const int e = ((const int*)(F.a->ws + WS_SE))[a]; const float gt = ((const float*)(F.a->ws + WS_SG))[a]; const int rk = ((const int*)(F.a->ws + WS_SRANK))[a];
      const int dst = m2[32 + e] + m2[64 + e] + rk, tok = F.bid * 128 + (tid >> 2);
      rowtok[dst] = tok; roww[dst] = gt; pos[tok * 4 + (tid & 3)] = dst; }
    if (F.bid < NE && tid < 256) { const int e = F.bid, tot = m2[96 + e], st = m2[32 + e], pad = (tot + 255) & ~255; const int r = st + tot + tid; if (r < st + pad) { rowtok[r] = 0; roww[r] = 0.f; } }
}

#ifdef DEV_NAIVE_ATTN
template <int MODE>
__global__ void __launch_bounds__(256) k_attn_ref(const bf16_t* QM, const bf16_t* KVM, const bf16_t* PROJ, bf16_t* ATT, float* TD, const float* lq1, const float* lk1, const float* lq2, const float* lk2, const float* gsub) {
    constexpr int DQK = MODE == 0 ? 96 : 64, DV = MODE == 0 ? 64 : 128, NH = MODE == 0 ? 8 : 4;
    __shared__ float Ks[32][DQK]; __shared__ float Vs[32][DV];
    const int bh = blockIdx.y, b = bh / NH, h = bh % NH, q = blockIdx.x * 256 + threadIdx.x, tid = threadIdx.x, t = b * S + q;
    float lam = 0.f;
    if (MODE == 1) { float s1 = 0.f, s2 = 0.f; for (int i = 0; i < 64; ++i) { s1 += lq1[i] * lk1[i]; s2 += lq2[i] * lk2[i]; } lam = expf(s1) - expf(s2) + LAMBDA_INIT; }
    float res[DV];
    for (int j = 0; j < (MODE == 0 ? 1 : 2); ++j) {
        float qv[DQK]; float o[DV];
#pragma unroll
        for (int d = 0; d < DQK; ++d) qv[d] = MODE == 0 ? bf2f(QM[(size_t)t * 768 + (d < 64 ? h * 64 + d : 512 + h * 32 + d - 64)]) : bf2f(PROJ[(size_t)t * PJ + PC_QD + (2 * h + j) * 64 + d]);
#pragma unroll
        for (int d = 0; d < DV; ++d) o[d] = 0.f;
        float m = -1e30f, l = 0.f;
        const int kend = blockIdx.x * 256 + 256;
        for (int k0 = 0; k0 < kend; k0 += 32) {
            __syncthreads();
            for (int i = tid; i < 32 * DQK; i += 256) { const int kk = i / DQK, d = i % DQK; const size_t tk = (size_t)b * S + k0 + kk;
                Ks[kk][d] = MODE == 0 ? (d < 64 ? bf2f(KVM[tk * 1024 + h * 128 + d]) : bf2f(PROJ[tk * PJ + PC_KR + d - 64])) : bf2f(PROJ[tk * PJ + PC_KD + (2 * h + j) * 64 + d]); }
            for (int i = tid; i < 32 * DV; i += 256) { const int kk = i / DV, d = i % DV; const size_t tk = (size_t)b * S + k0 + kk;
                Vs[kk][d] = MODE == 0 ? bf2f(KVM[tk * 1024 + h * 128 + 64 + d]) : bf2f(PROJ[tk * PJ + PC_VD + h * 128 + d]); }
            __syncthreads();
            for (int kk = 0; kk < 32; ++kk) {
                if (k0 + kk > q) break;
                float s = 0.f;
#pragma unroll
                for (int d = 0; d < DQK; ++d) s += qv[d] * Ks[kk][d];
                const float mn = fmaxf(m, s), al = exp2f(m - mn), p = exp2f(s - mn);
                l = l * al + p; m = mn;
#pragma unroll
                for (int d = 0; d < DV; ++d) o[d] = o[d] * al + p * Vs[kk][d];
            }
        }
        const float inv = 1.f / l;
        if (MODE == 0) {
#pragma unroll
            for (int d = 0; d < DV; ++d) ATT[(size_t)t * D + h * 64 + d] = (bf16_t)(cvt_pk_bf16(o[d] * inv, 0.f) & 0xffffu);
        } else if (j == 0) {
#pragma unroll
            for (int d = 0; d < DV; ++d) TD[((size_t)t * 4 + h) * 128 + d] = o[d] * inv;
        } else { float ss = 0.f;
#pragma unroll
            for (int d = 0; d < DV; ++d) { res[d] = TD[((size_t)t * 4 + h) * 128 + d] - lam * (o[d] * inv); ss += res[d] * res[d]; }
            const float r = rsqrtf(ss * (1.f / 128.f) + 1e-5f) * (1.f - LAMBDA_INIT);
#pragma unroll
            for (int d = 0; d < DV; ++d) ATT[(size_t)t * D + 512 + h * 128 + d] = (bf16_t)(cvt_pk_bf16(res[d] * r * gsub[d], 0.f) & 0xffffu);
        }
    }
}
#endif

constexpr int N_PHASES = 11;
__global__ void __launch_bounds__(NWAVES * 64, 2) mk_fwd(Args args) {
    extern __shared__ __attribute__((aligned(16))) unsigned char lds[];
    Frame F;
    F.lds = (LAS unsigned char*)lds; F.MISC = (volatile LAS unsigned*)(F.lds + MISC_OFF);
    F.G = gridDim.x; F.bid = blockIdx.x;
    F.a = &args; F.ctl = (unsigned*)(args.ws + WS_CTL);
    for (int u = threadIdx.x; u < (X_TILEE - LDSCTL_OFF) / 4; u += NWAVES * 64) ((LAS unsigned*)(F.lds + LDSCTL_OFF))[u] = 0u;
    __syncthreads();
    const int lo = args.ph_lo, hi = args.ph_hi;
#ifdef LEAK_LO
    if (LEAK_LO == 0 && threadIdx.x == 0) F.MISC[16] = (unsigned)__builtin_amdgcn_s_memrealtime();
#endif
    XcdBarrier bar; bar.bar = F.ctl + CW_BAR; bar.x = 0; bar.st = nullptr;
    if (hi - lo > 1) bar = xcd_barrier_post(F.ctl + CW_BAR + args.li * XCD_BAR_WORDS, F.MISC + 8);
#ifndef PH_MASK
#define PH_MASK 0x7ff
#endif
#define IN(k) (((PH_MASK >> (k)) & 1) && lo <= (k) && (k) < hi)
#ifdef LEAK_LO
#define SEAM(k) do { if (IN(k) && IN((k) + 1)) xcd_barrier(bar); if (((k) + 1 == LEAK_LO || (k) + 1 == LEAK_HI) && threadIdx.x == 0) F.MISC[(k) + 1 == LEAK_LO ? 16 : 17] = (unsigned)__builtin_amdgcn_s_memrealtime(); } while (0)
#else
#define SEAM(k) do { if (IN(k) && IN((k) + 1)) xcd_barrier(bar); } while (0)
#endif
    LAS unsigned char* ring = F.lds + RING_OFF;
    if (IN(0)) { p0_prologue(F); } SEAM(0);
    if (IN(1)) { p0b_norm(F); } SEAM(1);
    if (IN(2)) {
        pg8::Gemm g{(const bf16_t*)(F.a->ws + WS_H), (const bf16_t*)(F.a->ws + WS_WIN), nullptr, 0, D, D, D, 0}; pg8::StaticOrder So; So.init(T, PJ, F.G, F.bid);
        epi::EpiProj E{(bf16_t*)(F.a->ws + WS_PROJ), (const f32x4*)(F.a->ws + WS_TABM), (const f32x4*)(F.a->ws + WS_TABD), (float*)(F.a->ws + WS_SSQ), (float*)(F.a->ws + WS_SSQ) + T};
        pg8::gemm_phase<epi::EpiProj, pg8::StaticOrder, false>(ring, g, So, E);
    } SEAM(2);
    if (IN(3)) {
#ifndef NO_Q
        { pg8::Gemm g{(const bf16_t*)(F.a->ws + WS_PROJ) + PC_CQ, (const bf16_t*)(F.a->ws + WS_WQB), nullptr, 0, PJ, 256, 256, 0}; pg8::StaticOrder So; So.init(T, 768, F.G, F.bid);
          epi::EpiQ E{(bf16_t*)(F.a->ws + WS_QM), (const f32x4*)(F.a->ws + WS_TABM), (const float*)(F.a->ws + WS_SSQ)};
          pg8::gemm_phase<epi::EpiQ, pg8::StaticOrder, false>(ring, g, So, E); }
#endif
#ifndef NO_KV
        { pg8::Gemm g{(const bf16_t*)(F.a->ws + WS_PROJ) + PC_CKV, (const bf16_t*)(F.a->ws + WS_WKVB), nullptr, 0, PJ, 128, 128, 0}; pg8::StaticOrder So; So.init(T, 1024, F.G, F.bid);
          epi::EpiKV E{(bf16_t*)(F.a->ws + WS_KVM), (const float*)(F.a->ws + WS_SSQ) + T};
          pg8::gemm_phase<epi::EpiKV, pg8::StaticOrder, false>(ring, g, So, E); }
#endif
    } SEAM(3);
    if (IN(4)) {
#ifndef DEV_NAIVE_ATTN
        attn_phase_all(F);
#endif
    } SEAM(4);
    if (IN(5)) {
        pg8::Gemm g{(const bf16_t*)(F.a->ws + WS_ATT), (const bf16_t*)(F.a->ws + WS_WO), nullptr, 0, D, D, D, 0}; pg8::StaticOrder So; So.init(T, D, F.G, F.bid);
        epi::EpiY E{(bf16_t*)(F.a->ws + WS_Y), (float*)(F.a->ws + WS_SSQ) + 2 * T};
        pg8::gemm_phase<epi::EpiY, pg8::StaticOrder, false>(ring, g, So, E);
    } SEAM(5);
    if (IN(6)) { p5_rows(F); } SEAM(6);
    if (IN(7)) { p6_scatter(F); } SEAM(7);
    if (IN(8)) {
        offsets_from_counts(F);
        pg8::GroupedOrder So{(const LAS int*)(F.lds + X_TILEE), __builtin_amdgcn_readfirstlane(((LAS int*)(F.lds + X_MISC2))[0]), 8, F.G, F.bid};
        pg8::Gemm g{(const bf16_t*)(F.a->ws + WS_H), (const bf16_t*)(F.a->ws + WS_WGU), (const int*)(F.a->ws + WS_ROWTOK), (size_t)2048 * 512, 512, 512, 512, 0};
        epi::EpiAct E{(unsigned char*)(F.a->ws + WS_ACT), F.a->in[IN_BGU]};
        pg8::gemm_phase<epi::EpiAct, pg8::GroupedOrder, true, true>(ring, g, So, E, F.lds + X_IDX);
    } SEAM(8);
    if (IN(9)) {
        offsets_from_counts(F);
        pg8::GroupedOrder So{(const LAS int*)(F.lds + X_TILEE), __builtin_amdgcn_readfirstlane(((LAS int*)(F.lds + X_MISC2))[0]), 4, F.G, F.bid};
        pg8::Gemm g{(const bf16_t*)(F.a->ws + WS_ACT), (const bf16_t*)(F.a->ws + WS_WD), nullptr, (size_t)1024 * 512, 512, 512, 512, 0};
        epi::EpiDown E{(bf16_t*)(F.a->ws + WS_YR), F.a->in[IN_BDN], (const float*)(F.a->ws + WS_ROWW)};
        pg8::gemm_phase<epi::EpiDown, pg8::GroupedOrder, false, true>(ring, g, So, E);
    } SEAM(9);
    if (IN(10)) { p9_final(F); }
#ifdef LEAK_LO
    if (blockIdx.x == 0 && threadIdx.x == 0) { if (LEAK_HI == 11) F.MISC[17] = (unsigned)__builtin_amdgcn_s_memrealtime(); asm volatile("s_waitcnt vmcnt(0) lgkmcnt(0)" ::: "memory"); args.out[0] += (float)(F.MISC[17] - F.MISC[16]) * LEAK_SCALE; }
#endif
#undef IN
#undef SEAM
}

extern "C" void kernel_launch(void* const* d_in, const int* in_sizes, int n_in, void* d_out, int out_size, void* d_ws, size_t ws_size, hipStream_t stream) {
    static int grid = 0;
    if (grid == 0) {
        if (n_in != 26 || in_sizes[0] != T * D || out_size != T * D || ws_size < WS_END) { fprintf(stderr, "kernel_launch: unexpected shapes (n_in %d, ws %zu); nothing launched\n", n_in, ws_size); grid = -1; return; }
        int dev = 0, cus = 0;
        if (hipGetDevice(&dev) != hipSuccess || hipDeviceGetAttribute(&cus, hipDeviceAttributeMultiprocessorCount, dev) != hipSuccess) { grid = -1; return; }
        if (hipFuncSetAttribute((const void*)mk_fwd, hipFuncAttributeMaxDynamicSharedMemorySize, LDS_BYTES) != hipSuccess) { fprintf(stderr, "kernel_launch: hipFuncSetAttribute failed\n"); grid = -1; return; }
        grid = cus;
        if (grid != 256) fprintf(stderr, "kernel_launch: %d CUs; this kernel is built for 256\n", grid);
    }
    if (grid < 0) return;
    (void)hipMemsetAsync((char*)d_ws + WS_CTL, 0, CTL_ZERO_BYTES, stream);
    Args a{};
    for (int i = 0; i < 26; ++i) a.in[i] = (const float*)d_in[i];
    a.out = (float*)d_out; a.ws = (unsigned char*)d_ws;
#ifndef MK_CUTS
#define MK_CUTS {0, N_PHASES}
#endif
    const int cuts[] = MK_CUTS; const int ncut = (int)(sizeof(cuts) / sizeof(int)) - 1;
    for (int li = 0; li < ncut; ++li) {
        a.ph_lo = cuts[li]; a.ph_hi = cuts[li + 1]; a.li = li;
        hipLaunchKernelGGL(mk_fwd, dim3(grid), dim3(NWAVES * 64), LDS_BYTES, stream, a);
#ifdef DEV_NAIVE_ATTN
        if (cuts[li + 1] == 5) {
            unsigned char* ws = (unsigned char*)d_ws;
            k_attn_ref<0><<<dim3(S / 256, NB * 8), 256, 0, stream>>>((const bf16_t*)(ws + WS_QM), (const bf16_t*)(ws + WS_KVM), (const bf16_t*)(ws + WS_PROJ), (bf16_t*)(ws + WS_ATT), nullptr, nullptr, nullptr, nullptr, nullptr, nullptr);
            k_attn_ref<1><<<dim3(S / 256, NB * 4), 256, 0, stream>>>((const bf16_t*)(ws + WS_QM), (const bf16_t*)(ws + WS_KVM), (const bf16_t*)(ws + WS_PROJ), (bf16_t*)(ws + WS_ATT), (float*)(ws + WS_Y),
                (const float*)d_in[IN_LQ1], (const float*)d_in[IN_LK1], (const float*)d_in[IN_LQ2], (const float*)d_in[IN_LK2], (const float*)d_in[IN_GSUBLN]);
        }
#endif
    }
}
```

```cpp
#include <hip/hip_runtime.h>
#include <cstdio>
#include <cstdint>

#define GAS __attribute__((address_space(1)))
#define LAS __attribute__((address_space(3)))
typedef unsigned short bf16_t;
typedef short bf16x8 __attribute__((ext_vector_type(8)));
typedef float f32x4 __attribute__((ext_vector_type(4)));
typedef float f32x2 __attribute__((ext_vector_type(2)));
typedef float f32x16 __attribute__((ext_vector_type(16)));
typedef unsigned u32x4 __attribute__((ext_vector_type(4)));
typedef unsigned u32x2 __attribute__((ext_vector_type(2)));
typedef int i32x4 __attribute__((ext_vector_type(4)));
typedef GAS unsigned gu32;
#define RLX_AGENT __ATOMIC_RELAXED, __HIP_MEMORY_SCOPE_AGENT
#define LDS_WAIT() asm volatile("s_waitcnt lgkmcnt(0)" ::: "memory")
#define VM_WAIT() asm volatile("s_waitcnt vmcnt(0)" ::: "memory")

constexpr int D = 1024, NB = 16, S = 2048, T = NB * S;
constexpr int INC = 1952;
constexpr int PJ = 2048;
constexpr int PC_CQ = 0, PC_CKV = 256, PC_KR = 384, PC_QD = 512, PC_KD = 1024, PC_VD = 1536;
constexpr int NE = 32, TOPK = 4, NA = T * TOPK, NROWS = (NA / 256 + NE) * 256, NTILE_MAX = NROWS / 256;
constexpr float LAMBDA_INIT = 0.2f, LOG2E = 1.4426950408889634f;
constexpr float C2M = 0.10206207261596577f * LOG2E;
constexpr float C2D = 0.125f * LOG2E;
#ifndef FP8_SCALE_OPND
#define FP8_SCALE_OPND 0x7f7f7f7f
#endif
constexpr float YR_SCALE = 16.f, YR_INV = 1.f / 16.f;
constexpr float W8_SCALE = 64.f, W8_INV = 1.f / 64.f;

__device__ __forceinline__ unsigned cvt_pk_bf16(float lo, float hi) { unsigned r; asm volatile("v_cvt_pk_bf16_f32 %0, %1, %2" : "=v"(r) : "v"(lo), "v"(hi)); return r; }
__device__ __forceinline__ float sat8(float v) { return __builtin_amdgcn_fmed3f(v, -448.f, 448.f); }
__device__ __forceinline__ unsigned pack4_fp8s(float a, float b, float c, float d);
__device__ __forceinline__ unsigned pack4_fp8(float a, float b, float c, float d) { int w = 0; w = __builtin_amdgcn_cvt_pk_fp8_f32(a, b, w, false); w = __builtin_amdgcn_cvt_pk_fp8_f32(c, d, w, true); return (unsigned)w; }
__device__ __forceinline__ unsigned pack4_fp8s(float a, float b, float c, float d) { return pack4_fp8(sat8(a), sat8(b), sat8(c), sat8(d)); }
__device__ __forceinline__ float bf2f(unsigned short h) { return __uint_as_float((unsigned)h << 16); }
__device__ __forceinline__ float bflo(unsigned w) { return __uint_as_float(w << 16); }
__device__ __forceinline__ float bfhi(unsigned w) { return __uint_as_float(w & 0xffff0000u); }
#define DPPF(v, ctrl) __builtin_bit_cast(float, __builtin_amdgcn_update_dpp(0, __builtin_bit_cast(int, (float)(v)), (ctrl), 0xf, 0xf, true))
__device__ __forceinline__ void swap16(float a, float b, float& x, float& y) { auto r = __builtin_amdgcn_permlane16_swap(__builtin_bit_cast(unsigned, a), __builtin_bit_cast(unsigned, b), false, false); unsigned r0 = r[0], r1 = r[1]; asm volatile("" : "+v"(r0), "+v"(r1)); x = __builtin_bit_cast(float, r0); y = __builtin_bit_cast(float, r1); }
__device__ __forceinline__ void swap32(float a, float b, float& x, float& y) { auto r = __builtin_amdgcn_permlane32_swap(__builtin_bit_cast(unsigned, a), __builtin_bit_cast(unsigned, b), false, false); unsigned r0 = r[0], r1 = r[1]; asm volatile("" : "+v"(r0), "+v"(r1)); x = __builtin_bit_cast(float, r0); y = __builtin_bit_cast(float, r1); }
__device__ __forceinline__ float swap16_sum(float a, float b) { float x, y; swap16(a, b, x, y); return x + y; }
__device__ __forceinline__ float swap32_sum(float a, float b) { float x, y; swap32(a, b, x, y); return x + y; }
__device__ __forceinline__ float swap32_max(float a, float b) { float x, y; swap32(a, b, x, y); return fmaxf(x, y); }
__device__ __forceinline__ float wave_sum(float v) {
    v += DPPF(v, 0xB1); v += DPPF(v, 0x4E); v += DPPF(v, 0x141); v += DPPF(v, 0x140);
    v = swap16_sum(v, v); return swap32_sum(v, v);
}
__device__ __forceinline__ float wave_max(float v) {
    v = fmaxf(v, DPPF(v, 0xB1)); v = fmaxf(v, DPPF(v, 0x4E)); v = fmaxf(v, DPPF(v, 0x141)); v = fmaxf(v, DPPF(v, 0x140));
    { float x, y; swap16(v, v, x, y); v = fmaxf(x, y); }
    return swap32_max(v, v);
}
__device__ __forceinline__ float lane_xor8(float v) { return DPPF(DPPF(v, 0x141), 0x140); }
__device__ __forceinline__ float lane_xor4(float v) { return DPPF(DPPF(v, 0x1B), 0x141); }

namespace pg8 {
constexpr int BM = 256, BK = 64, HALF = 128, HTB = HALF * BK * 2, STAGE_BYTES = 8 * HTB, NXCD = 8, WGM = 8;
__host__ __device__ __forceinline__ int lds_byte(int r, int c) { const int st = (r >> 4) * 2 + (c >> 5), rr = r & 15, cc = c & 31, ob = rr * 64 + cc * 2; return st * 1024 + (ob ^ (((ob >> 9) & 1) << 5)); }
__host__ __device__ __forceinline__ void stage_rc(int b, int& R, int& C) { const int st = b / 1024, sb = b % 1024, swz = sb ^ (((sb >> 9) & 1) << 5); R = (st >> 1) * 16 + swz / 64; C = (st & 1) * 32 + (swz % 64) / 2; }
__host__ __device__ __forceinline__ int perm32(int rho) { const int n = rho >> 4, i = rho & 15; return 8 * (i >> 2) + 4 * n + (i & 3); }

__host__ __device__ __forceinline__ int perm16(int R) { return 64 * (R >> 5) + 16 * ((R & 15) >> 2) + 4 * ((R >> 4) & 1) + (R & 3); }
template <class E, class = void> struct has_perm16 { static constexpr bool value = false; };
template <class E> struct has_perm16<E, decltype((void)E::PERM16)> { static constexpr bool value = E::PERM16; };
struct Unit { int pm, pn, e; };
struct Gemm { const bf16_t* A; const bf16_t* Bt; const int* rowidx; size_t b_estride; int lda, ldb, K, pad; };

struct StaticOrder {
    int nM, nN, nwg, G, c;
    __host__ __device__ void init(int M, int N, int G_, int c_) { nM = M / BM; nN = N / BM; nwg = nM * nN; G = G_; c = c_; }
    __host__ __device__ bool next(int i, Unit& u) const {
        const long L = (long)i * G + c; if (L >= nwg) return false;
        int wgid = (int)L; { const int q = nwg / NXCD, r = nwg % NXCD, xcd = wgid % NXCD, off = wgid / NXCD; wgid = (xcd < r ? xcd * (q + 1) : r * (q + 1) + (xcd - r) * q) + off; }
        const int nig = WGM * nN, gid = wgid / nig, fm = gid * WGM, gsz = (nM - fm) < WGM ? (nM - fm) : WGM;
        u.pm = fm + ((wgid % nig) % gsz); u.pn = (wgid % nig) / gsz; u.e = 0; return true;
    }
};
struct GroupedOrder {
    const LAS int* tile_e; int ntiles, ncol, G, c;
    __device__ bool next(int i, Unit& u) const {
        const int L = i * G + c, xcd = L & 7, j = L >> 3, block = j >> 5, within = j & 31, rpc = 32 / ncol;
        const int r = within / ncol, pn = within % ncol, rt = (block * 8 + xcd) * rpc + r;
        if (rt >= ntiles) return false;
        u.pm = rt; u.pn = pn; u.e = __builtin_amdgcn_readfirstlane(tile_e[rt]); return true;
    }
};

template <class Epi, class Sched, bool GATHER = false, bool FP8 = false>
__device__ __forceinline__ void gemm_phase(LAS unsigned char* lds, const Gemm g, const Sched& S, const Epi& E, LAS unsigned char* idxl = nullptr) {
    int tid_ = threadIdx.x; asm volatile("" : "+v"(tid_));
    const int tid = tid_, wid = __builtin_amdgcn_readfirstlane(tid >> 6), lane = tid & 63, wr = wid >> 2, wc = wid & 3, fr = lane & 15, fq = lane >> 4;
    const int K = g.K, nt = K / BK;
    int Rr[2], Cc[2];
    unsigned voffA[2][2], voffB[2];
#pragma unroll
    for (int i = 0; i < 2; ++i) { stage_rc(tid * 16 + i * 8192, Rr[i], Cc[i]); const int Rb = has_perm16<Epi>::value ? perm16(Rr[i]) : Epi::PERM ? ((Rr[i] & ~31) + perm32(Rr[i] & 31)) : Rr[i];
        voffA[0][i] = (unsigned)(Rr[i] * g.lda + Cc[i]) * 2u; voffA[1][i] = (unsigned)((Rr[i] + HALF) * g.lda + Cc[i]) * 2u; voffB[i] = (unsigned)(Rb * g.ldb + Cc[i]) * 2u; }
    const unsigned kstep = BK * 2, hstepB = (unsigned)((has_perm16<Epi>::value ? 8 : HALF) * g.ldb * 2), tstepA = (unsigned)(BM * g.lda * 2), tstepB = (unsigned)(BM * g.ldb * 2);
    const __amdgpu_buffer_rsrc_t rA = __builtin_amdgcn_make_buffer_rsrc((void*)g.A, 0, 0x7ffffff0, 0x00020000), rB = __builtin_amdgcn_make_buffer_rsrc((void*)g.Bt, 0, 0x7ffffff0, 0x00020000);
    const unsigned ldsw = (unsigned)wid * 1024u;
    const int aoff = lds_byte(wr * 64 + fr, fq * 8), boff = lds_byte(wc * 32 + fr, fq * 8);
#define PG8_SA(b, h) (((b) * 2 + (h)) * HTB)
#define PG8_SB(b, h) ((4 + (b) * 2 + (h)) * HTB)
#define PG8_STAGE(bufoff, rs, soff, voff) do { _Pragma("unroll") for (int _i = 0; _i < 2; ++_i) \
        __builtin_amdgcn_raw_ptr_buffer_load_lds(rs, (LAS void*)(lds + (bufoff) + ldsw + _i * 8192), 16, (int)(voff)[_i], (int)(soff), 0, 0); } while (0)
#define PG8_LDA(dst, b, h) do { _Pragma("unroll") for (int m = 0; m < 4; ++m) _Pragma("unroll") for (int k = 0; k < 2; ++k) dst[m][k] = *(const LAS bf16x8*)(lds + PG8_SA(b, h) + aoff + m * 2048 + k * 1024); } while (0)
#define PG8_LDB(dst, b, h) do { _Pragma("unroll") for (int n = 0; n < 2; ++n) _Pragma("unroll") for (int k = 0; k < 2; ++k) dst[n][k] = *(const LAS bf16x8*)(lds + PG8_SB(b, h) + boff + n * 2048 + k * 1024); } while (0)
#define PG8_MMA(ai, bj, At, Bt) do { __builtin_amdgcn_s_setprio(1); _Pragma("unroll") for (int m = 0; m < 4; ++m) _Pragma("unroll") for (int n = 0; n < 2; ++n) { \
        if constexpr (FP8) acc[ai][bj][m][n] = __builtin_amdgcn_mfma_scale_f32_16x16x128_f8f6f4(PG8_CAT(Bt[n][0], Bt[n][1]), PG8_CAT(At[m][0], At[m][1]), acc[ai][bj][m][n], 0, 0, 0, FP8_SCALE_OPND, 0, FP8_SCALE_OPND); \
        else { _Pragma("unroll") for (int k = 0; k < 2; ++k) acc[ai][bj][m][n] = __builtin_amdgcn_mfma_f32_16x16x32_bf16(Bt[n][k], At[m][k], acc[ai][bj][m][n], 0, 0, 0); } } __builtin_amdgcn_s_setprio(0); } while (0)
#define PG8_CAT(x0, x1) __builtin_shufflevector(__builtin_bit_cast(i32x4, x0), __builtin_bit_cast(i32x4, x1), 0, 1, 2, 3, 4, 5, 6, 7)
#define PG8_WAIT_V(n) asm volatile("s_waitcnt vmcnt(" #n ")" ::: "memory")
#define PG8_WAIT_L(n) asm volatile("s_waitcnt lgkmcnt(" #n ")" ::: "memory")
#define PG8_BAR __builtin_amdgcn_s_barrier()
#define PG8_SCHED __builtin_amdgcn_sched_barrier(0)
    Unit cur, nxt; int ui = 0;
    if (!S.next(0, cur)) return;
    f32x4 acc[2][2][4][2];
#pragma unroll
    for (int a = 0; a < 2; ++a)
#pragma unroll
        for (int b = 0; b < 2; ++b)
#pragma unroll
            for (int m = 0; m < 4; ++m)
#pragma unroll
                for (int n = 0; n < 2; ++n) acc[a][b][m][n] = (f32x4){0.f, 0.f, 0.f, 0.f};
    bf16x8 At[4][2], B0[2][2], B1[2][2];
    unsigned gA[2][2];
    unsigned cA, cB = (unsigned)cur.e * (unsigned)(g.b_estride * 2) + (unsigned)cur.pn * tstepB;
    if constexpr (GATHER) { cA = 0u;
#pragma unroll
        for (int h = 0; h < 2; ++h)
#pragma unroll
            for (int i = 0; i < 2; ++i) gA[h][i] = (unsigned)g.rowidx[cur.pm * BM + h * HALF + Rr[i]] * (unsigned)(g.lda * 2) + (unsigned)Cc[i] * 2u;
    } else { cA = (unsigned)cur.pm * tstepA;
#pragma unroll
        for (int h = 0; h < 2; ++h)
#pragma unroll
            for (int i = 0; i < 2; ++i) gA[h][i] = voffA[h][i]; }
    PG8_STAGE(PG8_SB(0, 0), rB, cB, voffB); PG8_STAGE(PG8_SB(0, 1), rB, cB + hstepB, voffB); PG8_STAGE(PG8_SA(0, 0), rA, cA, gA[0]); PG8_STAGE(PG8_SA(0, 1), rA, cA, gA[1]);
    if (wr == 1) PG8_BAR;
    PG8_WAIT_V(2); PG8_BAR;
    PG8_STAGE(PG8_SB(1, 0), rB, cB + kstep, voffB); PG8_STAGE(PG8_SA(1, 0), rA, cA + kstep, gA[0]); PG8_STAGE(PG8_SB(1, 1), rB, cB + hstepB + kstep, voffB);
    PG8_WAIT_V(6); PG8_BAR;
    for (;;) {
        const bool has_next = S.next(ui + 1, nxt);
        unsigned nA; const unsigned nB = has_next ? (unsigned)nxt.e * (unsigned)(g.b_estride * 2) + (unsigned)nxt.pn * tstepB : cB;
        if constexpr (GATHER) nA = cA; else nA = has_next ? (unsigned)nxt.pm * tstepA : cA;
#pragma nounroll
        for (int t = 0; t < nt; t += 2) {
            const bool last = (t == nt - 2);
            const unsigned a1 = cA + (unsigned)(t + 1) * kstep;
            const unsigned a2 = last ? nA : cA + (unsigned)(t + 2) * kstep, b2 = last ? nB : cB + (unsigned)(t + 2) * kstep;
            const unsigned a3 = a2 + kstep, b3 = b2 + kstep;
            if constexpr (GATHER) { if (t == 0 && has_next && wid < 4)
                __builtin_amdgcn_global_load_lds((const unsigned*)(g.rowidx + nxt.pm * BM + wid * 64 + lane), (LAS unsigned*)(idxl + ((ui + 1) & 1) * 1024 + wid * 256), 4, 0, 0); }
            PG8_LDB(B0, 0, 0); PG8_LDB(B1, 0, 1); PG8_SCHED; PG8_LDA(At, 0, 0); PG8_STAGE(PG8_SA(1, 1), rA, a1, gA[1]);
            if constexpr (GATHER) { if (last && has_next) { int t3 = threadIdx.x; asm volatile("" : "+v"(t3));
#pragma unroll
                for (int i = 0; i < 2; ++i) { int R3, C3; stage_rc(t3 * 16 + i * 8192, R3, C3);
#pragma unroll
                    for (int h = 0; h < 2; ++h) gA[h][i] = *(const LAS unsigned*)(idxl + ((ui + 1) & 1) * 1024 + (h * HALF + R3) * 4) * (unsigned)(g.lda * 2) + (unsigned)C3 * 2u; } } }
            PG8_WAIT_V(8); PG8_WAIT_L(0); PG8_BAR; PG8_MMA(0, 0, At, B0); PG8_MMA(0, 1, At, B1); PG8_BAR; PG8_SCHED;
            PG8_LDA(At, 0, 1); PG8_STAGE(PG8_SB(0, 0), rB, b2, voffB); PG8_STAGE(PG8_SB(0, 1), rB, b2 + hstepB, voffB); PG8_STAGE(PG8_SA(0, 0), rA, a2, gA[0]);
            PG8_WAIT_V(8); PG8_WAIT_L(0); PG8_BAR; PG8_MMA(1, 0, At, B0); PG8_MMA(1, 1, At, B1); PG8_BAR; PG8_SCHED;
            PG8_LDB(B0, 1, 0); PG8_LDB(B1, 1, 1); PG8_SCHED; PG8_LDA(At, 1, 0); PG8_STAGE(PG8_SA(0, 1), rA, a2, gA[1]);
            PG8_WAIT_V(8); PG8_WAIT_L(0); PG8_BAR; PG8_MMA(0, 0, At, B0); PG8_MMA(0, 1, At, B1); PG8_BAR; PG8_SCHED;
            PG8_LDA(At, 1, 1); PG8_STAGE(PG8_SB(1, 0), rB, b3, voffB); PG8_STAGE(PG8_SB(1, 1), rB, b3 + hstepB, voffB); PG8_STAGE(PG8_SA(1, 0), rA, a3, gA[0]);
            PG8_WAIT_V(8); PG8_WAIT_L(0); PG8_BAR; PG8_MMA(1, 0, At, B0); PG8_MMA(1, 1, At, B1); PG8_BAR; PG8_SCHED;
        }
        if (wr == 0) PG8_BAR;
        { int t2 = threadIdx.x; asm volatile("" : "+v"(t2)); E(acc, cur, wr, wc, t2 & 15, (t2 >> 4) & 3); }
        if (!has_next) break;
#pragma unroll
        for (int a = 0; a < 2; ++a)
#pragma unroll
            for (int b = 0; b < 2; ++b)
#pragma unroll
                for (int m = 0; m < 4; ++m)
#pragma unroll
                    for (int n = 0; n < 2; ++n) acc[a][b][m][n] = (f32x4){0.f, 0.f, 0.f, 0.f};
        cur = nxt; cA = nA; cB = nB; ++ui;
        if (wr == 1) PG8_BAR;
    }
    PG8_WAIT_V(0);
    PG8_BAR;
#undef PG8_SA
#undef PG8_SB
#undef PG8_STAGE
#undef PG8_LDA
#undef PG8_LDB
#undef PG8_MMA
#undef PG8_CAT
#undef PG8_WAIT_V
#undef PG8_WAIT_L
#undef PG8_BAR
#undef PG8_SCHED
}
}
namespace epi {
using pg8::Unit; using pg8::HALF; using pg8::BM;
__device__ __forceinline__ u32x4 pack8(f32x4 a, f32x4 b) { u32x4 w; w.x = cvt_pk_bf16(a[0], a[1]); w.y = cvt_pk_bf16(a[2], a[3]); w.z = cvt_pk_bf16(b[0], b[1]); w.w = cvt_pk_bf16(b[2], b[3]); return w; }
__device__ __forceinline__ u32x2 pack4(f32x4 a) { u32x2 w; w.x = cvt_pk_bf16(a[0], a[1]); w.y = cvt_pk_bf16(a[2], a[3]); return w; }
__device__ __forceinline__ void rope4(f32x4& a, f32x4& b, const f32x4 t0, const f32x4 t1) {
    const f32x4 c = {t0[0], t0[2], t1[0], t1[2]}, s = {t0[1], t0[3], t1[1], t1[3]};
    const f32x4 na = a * c - b * s, nb = b * c + a * s; a = na; b = nb;
}
__device__ __forceinline__ void ssq_add(float* ssq, int row, float ss, int fq) { ss += __shfl_xor(ss, 16); ss += __shfl_xor(ss, 32); if (fq == 0) atomicAdd(ssq + row, ss); }
__device__ __forceinline__ float sq8(f32x4 a, f32x4 b) { return (a[0] * a[0] + a[1] * a[1]) + (a[2] * a[2] + a[3] * a[3]) + (b[0] * b[0] + b[1] * b[1]) + (b[2] * b[2] + b[3] * b[3]); }

struct EpiProj {
    static constexpr bool PERM = true;
    bf16_t* P; const f32x4* tabm; const f32x4* tabd; float* ssq_q; float* ssq_kv;
    __device__ __forceinline__ void operator()(const f32x4 (&acc)[2][2][4][2], const Unit& u, int wr, int wc, int fr, int fq) const {
        const int row0 = u.pm * BM + wr * 64 + fr, pn = u.pn;
#pragma unroll
        for (int ai = 0; ai < 2; ++ai)
#pragma unroll
            for (int m = 0; m < 4; ++m) { const int row = row0 + ai * HALF + m * 16; bf16_t* rp = P + (size_t)row * PJ;
                if (pn == 0) { float ss = 0.f;
#pragma unroll
                    for (int bj = 0; bj < 2; ++bj) { const f32x4 v0 = acc[ai][bj][m][0], v1 = acc[ai][bj][m][1]; ss += sq8(v0, v1); *(u32x4*)(rp + bj * HALF + wc * 32 + 8 * fq) = pack8(v0, v1); }
                    ssq_add(ssq_q, row, ss, fq);
                } else if (pn == 1) {
                    { const f32x4 v0 = acc[ai][0][m][0], v1 = acc[ai][0][m][1]; *(u32x4*)(rp + 256 + wc * 32 + 8 * fq) = pack8(v0, v1); ssq_add(ssq_kv, row, sq8(v0, v1), fq); }
                    if (wc == 0) { f32x4 a = acc[ai][1][m][0], b = acc[ai][1][m][1]; const f32x4 t0 = tabm[(size_t)row * 8 + 2 * fq], t1 = tabm[(size_t)row * 8 + 2 * fq + 1]; rope4(a, b, t0, t1);
                        *(u32x2*)(rp + PC_KR + 4 * fq) = pack4(a); *(u32x2*)(rp + PC_KR + 16 + 4 * fq) = pack4(b); }
                } else if (pn < 6) { const int g = 4 * (wc & 1) + fq; const f32x4 t0 = tabd[(size_t)row * 16 + 2 * g], t1 = tabd[(size_t)row * 16 + 2 * g + 1]; const float sc = pn < 4 ? C2D : 1.f;
#pragma unroll
                    for (int bj = 0; bj < 2; ++bj) { f32x4 a = acc[ai][bj][m][0] * sc, b = acc[ai][bj][m][1] * sc; rope4(a, b, t0, t1);
                        bf16_t* bp = rp + pn * 256 + bj * HALF + (wc >> 1) * 64 + 4 * g; *(u32x2*)bp = pack4(a); *(u32x2*)(bp + 32) = pack4(b); }
                } else {
#pragma unroll
                    for (int bj = 0; bj < 2; ++bj) *(u32x4*)(rp + pn * 256 + bj * HALF + wc * 32 + 8 * fq) = pack8(acc[ai][bj][m][0], acc[ai][bj][m][1]);
                }
            }
    }
};
struct EpiQ {
    static constexpr bool PERM = true;
    bf16_t* Q; const f32x4* tabm; const float* ssq_q;
    __device__ __forceinline__ void operator()(const f32x4 (&acc)[2][2][4][2], const Unit& u, int wr, int wc, int fr, int fq) const {
        const int row0 = u.pm * BM + wr * 64 + fr;
        if (u.pn < 2) {
#pragma unroll
            for (int ai = 0; ai < 2; ++ai)
#pragma unroll
                for (int m = 0; m < 4; ++m) { const int row = row0 + ai * HALF + m * 16; const float rs = rsqrtf(ssq_q[row] * (1.f / 256.f) + 1e-6f) * C2M; bf16_t* rp = Q + (size_t)row * 768 + u.pn * BM + wc * 32 + 8 * fq;
#pragma unroll
                    for (int bj = 0; bj < 2; ++bj) *(u32x4*)(rp + bj * HALF) = pack8(acc[ai][bj][m][0] * rs, acc[ai][bj][m][1] * rs); }
        } else {
#pragma unroll
            for (int ai = 0; ai < 2; ++ai)
#pragma unroll
                for (int m = 0; m < 4; ++m) { const int row = row0 + ai * HALF + m * 16; const float rs = rsqrtf(ssq_q[row] * (1.f / 256.f) + 1e-6f) * C2M; bf16_t* rp = Q + (size_t)row * 768 + 512 + wc * 32 + 4 * fq;
                    const f32x4 t0 = tabm[(size_t)row * 8 + 2 * fq], t1 = tabm[(size_t)row * 8 + 2 * fq + 1];
#pragma unroll
                    for (int bj = 0; bj < 2; ++bj) { f32x4 a = acc[ai][bj][m][0] * rs, b = acc[ai][bj][m][1] * rs; rope4(a, b, t0, t1); *(u32x2*)(rp + bj * 128) = pack4(a); *(u32x2*)(rp + bj * 128 + 16) = pack4(b); }
                    asm volatile("" ::: "memory"); }
        }
    }
};
struct EpiKV {
    static constexpr bool PERM = true;
    bf16_t* KV; const float* ssq_kv;
    __device__ __forceinline__ void operator()(const f32x4 (&acc)[2][2][4][2], const Unit& u, int wr, int wc, int fr, int fq) const {
        const int row0 = u.pm * BM + wr * 64 + fr;
#pragma unroll
        for (int ai = 0; ai < 2; ++ai)
#pragma unroll
            for (int m = 0; m < 4; ++m) { const int row = row0 + ai * HALF + m * 16; const float rs = rsqrtf(ssq_kv[row] * (1.f / 128.f) + 1e-6f); bf16_t* rp = KV + (size_t)row * 1024 + u.pn * BM + wc * 32 + 8 * fq;
#pragma unroll
                for (int bj = 0; bj < 2; ++bj) *(u32x4*)(rp + bj * HALF) = pack8(acc[ai][bj][m][0] * rs, acc[ai][bj][m][1] * rs); }
    }
};
struct EpiY {
    static constexpr bool PERM = true;
    bf16_t* Y; float* ssq_y;
    __device__ __forceinline__ void operator()(const f32x4 (&acc)[2][2][4][2], const Unit& u, int wr, int wc, int fr, int fq) const {
        const int row0 = u.pm * BM + wr * 64 + fr;
#pragma unroll
        for (int ai = 0; ai < 2; ++ai)
#pragma unroll
            for (int m = 0; m < 4; ++m) { const int row = row0 + ai * HALF + m * 16; bf16_t* rp = Y + (size_t)row * 1024 + u.pn * BM + wc * 32 + 8 * fq; float ss = 0.f;
#pragma unroll
                for (int bj = 0; bj < 2; ++bj) { const f32x4 v0 = acc[ai][bj][m][0], v1 = acc[ai][bj][m][1]; ss += sq8(v0, v1); *(u32x4*)(rp + bj * HALF) = pack8(v0, v1); }
                ssq_add(ssq_y, row, ss, fq); }
    }
};
struct EpiAct {
    static constexpr bool PERM = true;
    unsigned char* ACT; const float* bgu;
    __device__ __forceinline__ void operator()(const f32x4 (&acc)[2][2][4][2], const Unit& u, int wr, int wc, int fr, int fq) const {
        const __amdgpu_buffer_rsrc_t rA = __builtin_amdgcn_make_buffer_rsrc((void*)ACT, 0, 0x7ffffff0, 0x00020000), rB = __builtin_amdgcn_make_buffer_rsrc((void*)bgu, 0, NE * 2048 * 4, 0x00020000);
        const int row0 = u.pm * BM + wr * 64 + fr, j0 = u.pn * 128 + wc * 32 + 8 * fq;
        f32x4 bg[2], bu[2];
#pragma unroll
        for (int n = 0; n < 2; ++n) { bg[n] = __builtin_bit_cast(f32x4, __builtin_amdgcn_raw_buffer_load_b128(rB, (u.e * 2048 + j0 + 4 * n) * 4, 0, 0)); bu[n] = __builtin_bit_cast(f32x4, __builtin_amdgcn_raw_buffer_load_b128(rB, (u.e * 2048 + 1024 + j0 + 4 * n) * 4, 0, 0)); }
#pragma unroll
        for (int ai = 0; ai < 2; ++ai)
#pragma unroll
            for (int m = 0; m < 4; ++m) { const int row = row0 + ai * HALF + m * 16; u32x2 o;
#pragma unroll
                for (int n = 0; n < 2; ++n) { const f32x4 gv = acc[ai][0][m][n] * W8_INV + bg[n], uv = acc[ai][1][m][n] * W8_INV + bu[n]; float a4[4];
#pragma unroll
                    for (int i = 0; i < 4; ++i) { const float gg = fminf(gv[i], 7.f), uu = fminf(fmaxf(uv[i], -7.f), 7.f); a4[i] = gg * __builtin_amdgcn_rcpf(1.f + __builtin_amdgcn_exp2f(-1.702f * LOG2E * gg)) * (uu + 1.f); }
                    o[n] = pack4_fp8(a4[0], a4[1], a4[2], a4[3]); }
                __builtin_amdgcn_raw_buffer_store_b64(o, rA, row * 1024 + j0, 0, 0); }
    }
};
struct EpiDown {
    static constexpr bool PERM = true, PERM16 = true;
    unsigned char* YR; const float* bd; const float* roww;
    __device__ __forceinline__ void operator()(const f32x4 (&acc)[2][2][4][2], const Unit& u, int wr, int wc, int fr, int fq) const {
        const __amdgpu_buffer_rsrc_t rY = __builtin_amdgcn_make_buffer_rsrc((void*)YR, 0, 0x7ffffff0, 0x00020000), rB = __builtin_amdgcn_make_buffer_rsrc((void*)bd, 0, NE * 1024 * 4, 0x00020000),
                                     rW = __builtin_amdgcn_make_buffer_rsrc((void*)roww, 0, NROWS * 4, 0x00020000);
        const int row0 = u.pm * BM + wr * 64 + fr, col = u.pn * BM + wc * 64 + 16 * fq, boff = (u.e * 1024 + col) * 4;
#pragma unroll
        for (int ai = 0; ai < 2; ++ai) {
            f32x4 bv[2][2];
#pragma unroll
            for (int bj = 0; bj < 2; ++bj)
#pragma unroll
                for (int n = 0; n < 2; ++n) bv[bj][n] = __builtin_bit_cast(f32x4, __builtin_amdgcn_raw_buffer_load_b128(rB, boff + (8 * bj + 4 * n) * 4, 0, 0));
#pragma unroll
            for (int m = 0; m < 4; ++m) { const int row = row0 + ai * HALF + m * 16; const float ww = YR_SCALE * __builtin_bit_cast(float, __builtin_amdgcn_raw_buffer_load_b32(rW, row * 4, 0, 0)), w8 = ww * W8_INV; u32x4 o;
#pragma unroll
                for (int bj = 0; bj < 2; ++bj)
#pragma unroll
                    for (int n = 0; n < 2; ++n) { const f32x4 v = acc[ai][bj][m][n] * w8 + bv[bj][n] * ww; o[2 * bj + n] = pack4_fp8s(v[0], v[1], v[2], v[3]); }
                __builtin_amdgcn_raw_buffer_store_b128(o, rY, row * 1024 + col, 0, 0); }
            asm volatile("" ::: "memory"); }
    }
};
}
constexpr size_t MiB = 1u << 20;
constexpr size_t WS_CTL = 0, CTL_ZERO_BYTES = 64 * 1024;
constexpr size_t WS_MOD = 1 * MiB;
constexpr size_t WS_SSQ = 1 * MiB + 512 * 1024;
constexpr size_t WS_TABM = 2 * MiB, WS_TABD = 6 * MiB;
constexpr size_t WS_SE = 14 * MiB, WS_SG = 14 * MiB + 512 * 1024, WS_SRANK = 18 * MiB + 512 * 1024;
constexpr size_t WS_POS = 15 * MiB;
constexpr size_t WS_ROWTOK = 16 * MiB, WS_ROWW = 17 * MiB;
constexpr size_t WS_CNT = 18 * MiB;
constexpr size_t WS_TD0 = 19 * MiB;
constexpr size_t WS_WIN = 20 * MiB, WS_WQB = 24 * MiB, WS_WKVB = 25 * MiB, WS_WO = 26 * MiB;
constexpr size_t WS_WGU = 28 * MiB, WS_WD = 156 * MiB;
constexpr size_t WS_H = 220 * MiB;
constexpr size_t WS_PROJ = 284 * MiB;
constexpr size_t WS_QM = 412 * MiB, WS_KVM = 460 * MiB, WS_ATT = 524 * MiB, WS_Y = 588 * MiB;
constexpr size_t WS_X1 = 524 * MiB;
constexpr size_t WS_ACT = 284 * MiB;
constexpr size_t WS_YR = 588 * MiB;
constexpr size_t WS_END = 860 * MiB;
static_assert(WS_ACT + (size_t)NROWS * 1024 * 2 <= WS_YR && WS_YR + (size_t)NROWS * 1024 * 2 <= WS_END, "ws map");
constexpr int CW_BAR = 4096;

constexpr int RING_OFF = 0, RING_BYTES = 131072;
constexpr int LDSCTL_OFF = RING_BYTES, MISC_OFF = LDSCTL_OFF + 320;
constexpr int XTRA_OFF = MISC_OFF + 128;
constexpr int X_TILEE = XTRA_OFF;
constexpr int X_SE = X_TILEE + 2304, X_SG = X_SE + 2048, X_SRANK = X_SG + 2048, X_WCNT = X_SRANK + 2048, X_MISC2 = X_WCNT + 1024;
constexpr int X_IDX = X_MISC2 + 1024;
constexpr int LDS_BYTES = 147456;
static_assert(X_IDX + 2048 <= LDS_BYTES, "LDS map");
constexpr int NWAVES = 8;

#define XB_TMO      128
#define XB_XCNT(j)  (256  + 64 * (j))
#define XB_XSUB(j)  (1280 + 64 * (j))
#define XB_XGEN(j)  (2304 + 64 * (j))
#define XB_TOP      3328
#define XB_TOPGEN   3392
#define XCD_BAR_WORDS 3456
#define XB_SPIN_CAP (1u << 18)
__device__ __forceinline__ unsigned xb_ld(unsigned* p)              { return __hip_atomic_load(p, __ATOMIC_RELAXED, __HIP_MEMORY_SCOPE_AGENT); }
__device__ __forceinline__ unsigned xb_add(unsigned* p, unsigned v) { return __hip_atomic_fetch_add(p, v, __ATOMIC_RELAXED, __HIP_MEMORY_SCOPE_AGENT); }
__device__ __forceinline__ unsigned xb_xcc_id() { return (unsigned)__builtin_amdgcn_s_getreg((3 << 11) | 20) & 0xFu; }
#define XB_SPIN(cond, bar) do { unsigned _sp = 0; while (cond) { __builtin_amdgcn_s_sleep(1); \
    if ((++_sp & 255u) == 0u) { if (xb_ld(&(bar)[XB_TMO])) break; if (_sp > XB_SPIN_CAP) { atomicAdd(&(bar)[XB_TMO], 1u); break; } } } } while (0)
struct XcdBarrier { unsigned* bar; unsigned x; volatile LAS unsigned* st; };
__device__ __forceinline__ XcdBarrier xcd_barrier_post(unsigned* bar, volatile LAS unsigned* st) {
    XcdBarrier b; b.bar = bar; b.x = xb_xcc_id(); b.st = st;
    if (threadIdx.x == 0) (void)xb_add(&bar[XB_XCNT(b.x)], 1u);
    return b;
}
__device__ __forceinline__ void xcd_barrier_complete(unsigned* bar, unsigned x, unsigned& nloc, unsigned& nx) {
    const unsigned G = gridDim.x * gridDim.y * gridDim.z;
    unsigned sum, cnt, mine, sp = 0u;
    for (;;) {
        sum = 0u; cnt = 0u; mine = 0u;
#pragma unroll
        for (unsigned j = 0; j < 16; ++j) { const unsigned c = xb_ld(&bar[XB_XCNT(j)]); sum += c; cnt += (c > 0u) ? 1u : 0u; mine = (j == x) ? c : mine; }
        if (sum == G) break;
        __builtin_amdgcn_s_sleep(1);
        if ((++sp & 255u) == 0u) { if (xb_ld(&bar[XB_TMO])) break; if (sp > XB_SPIN_CAP) { atomicAdd(&bar[XB_TMO], 1u); break; } }
    }
    nloc = mine > 0u ? mine : 1u; nx = cnt > 0u ? cnt : 1u;
}
__device__ __forceinline__ void xcd_barrier(const XcdBarrier& b) {
    asm volatile("s_waitcnt vmcnt(0)" ::: "memory");
    __syncthreads();
    if (threadIdx.x == 0) {
        unsigned* bar = b.bar;
        __builtin_amdgcn_s_waitcnt(0);
        unsigned nloc = b.st[0], nx = b.st[1];
        if (nloc == 0u) { xcd_barrier_complete(bar, b.x, nloc, nx); b.st[0] = nloc; b.st[1] = nx; }
        const unsigned old = xb_add(&bar[XB_XSUB(b.x)], 1u);
        const unsigned gen = old / nloc;
        if (old + 1u == (gen + 1u) * nloc) {
            __builtin_amdgcn_fence(__ATOMIC_RELEASE, "agent");
            asm volatile("s_waitcnt vmcnt(0)" ::: "memory");
            const unsigned og = xb_add(&bar[XB_TOP], 1u);
            const unsigned tg = og / nx;
            if (og + 1u == (tg + 1u) * nx) xb_add(&bar[XB_TOPGEN], 1u);
            else XB_SPIN(xb_ld(&bar[XB_TOPGEN]) == tg, bar);
            __builtin_amdgcn_fence(__ATOMIC_ACQUIRE, "agent");
            xb_add(&bar[XB_XGEN(b.x)], 1u);
            asm volatile("s_waitcnt vmcnt(0)" ::: "memory");
        } else {
            XB_SPIN(xb_ld(&bar[XB_XGEN(b.x)]) == gen, bar);
            __builtin_amdgcn_fence(__ATOMIC_ACQUIRE, "agent");
            asm volatile("s_waitcnt vmcnt(0)" ::: "memory");
        }
    }
    __syncthreads();
}

struct Args { const float* in[26]; float* out; unsigned char* ws; int ph_lo, ph_hi, li, pad; };
struct Frame {
    LAS unsigned char* lds; volatile LAS unsigned* MISC; unsigned* ctl;
    int G, bid;
    const Args* a;
};
#define PHASE_IDS() int tid_ = threadIdx.x; asm volatile("" : "+v"(tid_)); const int tid = tid_, lane = tid & 63, wave = __builtin_amdgcn_readfirstlane(tid >> 6); (void)lane; (void)wave
#define IN_X 0
#define IN_C 1
#define IN_POS 2
#define IN_WADA 3
#define IN_BADA 4
#define IN_GMIXPRE 5
#define IN_GMIXPOST 6
#define IN_WIN 7
#define IN_GQA 8
#define IN_WQB 9
#define IN_GKVA 10
#define IN_WKVB 11
#define IN_LQ1 12
#define IN_LK1 13
#define IN_LQ2 14
#define IN_LK2 15
#define IN_GSUBLN 16
#define IN_WO 17
#define IN_GFFNPRE 18
#define IN_GFFNPOST 19
#define IN_WROUTER 20
#define IN_BROUTER 21
#define IN_WGU 22
#define IN_BGU 23
#define IN_WDN 24
#define IN_BDN 25

template <class Map>
__device__ __forceinline__ void transpose_item(const float* W, int K, int N, bf16_t* WT, const float* gain, Map dst, LAS float* scr, int item, int lane) {
    const int nblk = N / 32, kb = item / nblk, nb = item % nblk, k0 = 64 * kb, n0 = 32 * nb;
    { float v[32];
#pragma unroll
      for (int i = 0; i < 32; ++i) v[i] = W[(size_t)(k0 + 2 * i + (lane >> 5)) * N + n0 + (lane & 31)];
#pragma unroll
      for (int i = 0; i < 32; ++i) scr[(2 * i + (lane >> 5)) * 33 + (lane & 31)] = v[i]; }
    LDS_WAIT(); asm volatile("" ::: "memory");
    const int c = lane & 7;
    float gk[8];
#pragma unroll
    for (int i = 0; i < 8; ++i) gk[i] = gain ? gain[k0 + 8 * c + i] : 1.f;
#pragma unroll
    for (int j = 0; j < 4; ++j) { const int n = (lane >> 3) + 8 * j; const LAS float* s = scr + (8 * c) * 33 + n;
        u32x4 o; o.x = cvt_pk_bf16(s[0 * 33] * gk[0], s[1 * 33] * gk[1]); o.y = cvt_pk_bf16(s[2 * 33] * gk[2], s[3 * 33] * gk[3]); o.z = cvt_pk_bf16(s[4 * 33] * gk[4], s[5 * 33] * gk[5]); o.w = cvt_pk_bf16(s[6 * 33] * gk[6], s[7 * 33] * gk[7]);
        *(GAS u32x4*)(WT + (size_t)dst(n0 + n) * K + k0 + 8 * c) = o; }
    LDS_WAIT(); asm volatile("" ::: "memory");
}
template <class Map>
__device__ __forceinline__ void transpose8_stream(const float* W, int N, unsigned char* WT, Map dst, LAS float* scr, int first, int stride, int lane) {
    const int nblk = N / 32, per_e = 8 * nblk, total = NE * per_e;
    if (first >= total) return;
    float v[32];
    auto src = [&](int it, int hb) -> const float* { const int e = it / per_e, r = it - e * per_e, kb = r / nblk, nb = r - kb * nblk; return W + ((size_t)e * 1024 + 128 * kb + 64 * hb + (lane >> 5)) * N + 32 * nb + (lane & 31); };
    { const float* p = src(first, 0);
#pragma unroll
      for (int i = 0; i < 32; ++i) v[i] = p[(size_t)(2 * i) * N]; }
    for (int it = first; it < total; it += stride) {
#pragma unroll
        for (int hb = 0; hb < 2; ++hb) {
            float w[32];
#pragma unroll
            for (int i = 0; i < 32; ++i) w[i] = v[i];
            const int nit = hb == 0 ? it : it + stride;
            if (nit < total) { const float* p = src(nit, hb ^ 1);
#pragma unroll
                for (int i = 0; i < 32; ++i) v[i] = p[(size_t)(2 * i) * N]; }
#pragma unroll
            for (int i = 0; i < 32; ++i) { const int kk = 64 * hb + 2 * i + (lane >> 5); scr[kk * 32 + ((lane & 31) ^ (kk & 31) ^ (((kk >> 5) & 3) << 2))] = w[i]; }
        }
        LDS_WAIT(); asm volatile("" ::: "memory");
        const int e = it / per_e, r = it - e * per_e, kb = r / nblk, nb = r - kb * nblk, c = lane & 7;
#pragma unroll
        for (int j = 0; j < 4; ++j) { const int n = (lane >> 3) + 8 * j; float t[16];
#pragma unroll
            for (int i = 0; i < 16; ++i) { const int kk = 16 * c + i; t[i] = scr[kk * 32 + (n ^ (kk & 31) ^ (((kk >> 5) & 3) << 2))] * W8_SCALE; }
            u32x4 o; o.x = pack4_fp8(t[0], t[1], t[2], t[3]); o.y = pack4_fp8(t[4], t[5], t[6], t[7]); o.z = pack4_fp8(t[8], t[9], t[10], t[11]); o.w = pack4_fp8(t[12], t[13], t[14], t[15]);
            *(GAS u32x4*)(WT + ((size_t)e * N + dst(32 * nb + n)) * 1024 + 128 * kb + 16 * c) = o; }
        LDS_WAIT(); asm volatile("" ::: "memory");
    }
}
__device__ __forceinline__ int il4(int i, int x2) { return 8 * (i >> 2) + 4 * x2 + (i & 3); }
struct MapWin { __device__ int operator()(int n) const {
    if (n < 384) return n;
    if (n < 416) { const int r = n - 384; return PC_KR + il4(r & 15, r >> 4); }
    if (n < 1440) { const int r = n - 416, hj = r >> 6, d = r & 63; return PC_QD + hj * 64 + il4(d & 31, d >> 5); }
    return PC_VD + (n - 1440); } };
struct MapWqb { __device__ int operator()(int n) const { const int h = n / 96, d = n - h * 96; if (d < 64) return h * 64 + d; const int r = d - 64; return 512 + h * 32 + il4(r & 15, r >> 4); } };
struct MapId { __device__ int operator()(int n) const { return n; } };
struct MapWgu { __device__ int operator()(int n) const { const int which = n >> 10, j = n & 1023; return (j >> 7) * 256 + which * 128 + (j & 127); } };

__device__ __forceinline__ void p0_prologue(Frame& F) {
    PHASE_IDS();
    float* mod = (float*)(F.a->ws + WS_MOD);
    if (F.bid < 192) {
        LAS float* cact = (LAS float*)(F.lds);
        LAS float* red = (LAS float*)(F.lds + 65536);
        const float* c = F.a->in[IN_C];
        { float cv[32];
#pragma unroll
          for (int i = 0; i < 32; ++i) cv[i] = c[tid + 512 * i];
#pragma unroll
          for (int i = 0; i < 32; ++i) cact[tid + 512 * i] = cv[i] / (1.f + __expf(-cv[i])); }
        __syncthreads();
        const int n0 = 32 * F.bid, col = tid & 31, kg = tid >> 5;
        float acc[16];
#pragma unroll
        for (int b = 0; b < 16; ++b) acc[b] = 0.f;
        const float* wp = F.a->in[IN_WADA] + (size_t)(kg * 64) * 6144 + n0 + col;
#pragma unroll
        for (int q = 0; q < 2; ++q) { float w[32];
#pragma unroll
            for (int kk = 0; kk < 32; ++kk) w[kk] = wp[(size_t)(32 * q + kk) * 6144];
#pragma unroll
            for (int kk = 0; kk < 32; ++kk)
#pragma unroll
                for (int b = 0; b < 16; ++b) acc[b] += cact[b * 1024 + kg * 64 + 32 * q + kk] * w[kk]; }
#pragma unroll
        for (int b = 0; b < 16; ++b) red[(kg * 16 + b) * 32 + col] = acc[b];
        __syncthreads();
        { const int b = tid >> 5; float s = 0.f;
#pragma unroll
          for (int k2 = 0; k2 < 16; ++k2) s += red[(k2 * 16 + b) * 32 + col];
          mod[b * 6144 + n0 + col] = s + F.a->in[IN_BADA][n0 + col]; }
        __syncthreads();
    }
    { float* ssq = (float*)(F.a->ws + WS_SSQ); for (int i = F.bid * 512 + tid; i < 3 * T; i += F.G * 512) ssq[i] = 0.f;
      u32x4* wz = (u32x4*)((bf16_t*)(F.a->ws + WS_WIN) + (size_t)416 * 1024); for (int i = F.bid * 512 + tid; i < 96 * 1024 / 8; i += F.G * 512) wz[i] = (u32x4){0u, 0u, 0u, 0u}; }
    { const int* pos = (const int*)F.a->in[IN_POS]; float2* tabm = (float2*)(F.a->ws + WS_TABM); float2* tabd = (float2*)(F.a->ws + WS_TABD);
      for (int gid = F.bid * 512 + tid; gid < T * 48; gid += F.G * 512) { const int t = gid / 48, i = gid - t * 48; const float p = (float)pos[t];
          if (i < 16) { const float inv = powf(10000.f, -(float)(2 * i) / 32.f); const double a = (double)(p * inv); tabm[t * 16 + i] = make_float2((float)cos(a), (float)sin(a)); }
          else { const int j = i - 16; const float inv = powf(10000.f, -(float)(2 * j) / 64.f); const double a = (double)(p * inv); tabd[t * 32 + j] = make_float2((float)cos(a), (float)sin(a)); } } }
    LAS float* scr = (LAS float*)(F.lds + RING_OFF + wave * 16384);
    const int gw = F.bid * NWAVES + wave, NGW = F.G * NWAVES;
    constexpr int I_WIN = 16 * 61, I_WQB = 4 * 24, I_WKVB = 2 * 32, I_WO = 16 * 32;
    constexpr int NITEMS = I_WIN + I_WQB + I_WKVB + I_WO;
    for (int it = gw; it < NITEMS; it += NGW) {
        int r = it;
        if (r < I_WIN) { transpose_item(F.a->in[IN_WIN], 1024, INC, (bf16_t*)(F.a->ws + WS_WIN), nullptr, MapWin{}, scr, r, lane); continue; } r -= I_WIN;
        if (r < I_WQB) { transpose_item(F.a->in[IN_WQB], 256, 768, (bf16_t*)(F.a->ws + WS_WQB), F.a->in[IN_GQA], MapWqb{}, scr, r, lane); continue; } r -= I_WQB;
        if (r < I_WKVB) { transpose_item(F.a->in[IN_WKVB], 128, 1024, (bf16_t*)(F.a->ws + WS_WKVB), F.a->in[IN_GKVA], MapId{}, scr, r, lane); continue; } r -= I_WKVB;
        transpose_item(F.a->in[IN_WO], 1024, 1024, (bf16_t*)(F.a->ws + WS_WO), nullptr, MapId{}, scr, r, lane);
    }
    transpose8_stream(F.a->in[IN_WGU], 2048, (unsigned char*)(F.a->ws + WS_WGU), MapWgu{}, scr, gw, NGW, lane);
    transpose8_stream(F.a->in[IN_WDN], 1024, (unsigned char*)(F.a->ws + WS_WD), MapId{}, scr, gw, NGW, lane);
}
__device__ __forceinline__ void p0b_norm(Frame& F) {
    PHASE_IDS();
    const float* mod = (const float*)(F.a->ws + WS_MOD); bf16_t* H = (bf16_t*)(F.a->ws + WS_H);
    const int tok0 = F.bid * 128 + wave * 16, b = (F.bid * 128) / S;
    f32x4 g[4], sh[4];
#pragma unroll
    for (int j = 0; j < 4; ++j) { const int c = 4 * lane + 256 * j; g[j] = *(const f32x4*)(F.a->in[IN_GMIXPRE] + c) * (*(const f32x4*)(mod + b * 6144 + 1024 + c) + 1.f); sh[j] = *(const f32x4*)(mod + b * 6144 + c); }
    for (int i = 0; i < 16; i += 4) {
        f32x4 v[4][4];
#pragma unroll
        for (int r = 0; r < 4; ++r)
#pragma unroll
            for (int j = 0; j < 4; ++j) v[r][j] = *((const GAS f32x4*)(F.a->in[IN_X] + (size_t)(tok0 + i + r) * D) + lane + 64 * j);
#pragma unroll
        for (int r = 0; r < 4; ++r) { float ss = 0.f;
#pragma unroll
            for (int j = 0; j < 4; ++j) ss += (v[r][j].x * v[r][j].x + v[r][j].y * v[r][j].y) + (v[r][j].z * v[r][j].z + v[r][j].w * v[r][j].w);
            const float rs = rsqrtf(wave_sum(ss) * (1.f / D) + 1e-6f);
            GAS u32x2* o8 = (GAS u32x2*)(H + (size_t)(tok0 + i + r) * D) + lane;
#pragma unroll
            for (int j = 0; j < 4; ++j) { const f32x4 h = (v[r][j] * rs) * g[j] + sh[j]; u32x2 w; w.x = cvt_pk_bf16(h[0], h[1]); w.y = cvt_pk_bf16(h[2], h[3]); o8[64 * j] = w; } }
    }
}
__device__ __forceinline__ void p5_rows(Frame& F) {
    PHASE_IDS();
    LAS float* wt = (LAS float*)(F.lds + RING_OFF);
    for (int idx = tid; idx < NE * 1024; idx += 512) { const int e = idx >> 10, k = idx & 1023; wt[idx] = F.a->in[IN_WROUTER][k * NE + e]; }
    LAS int* se = (LAS int*)(F.lds + X_SE); LAS float* sg = (LAS float*)(F.lds + X_SG);
    const float* mod = (const float*)(F.a->ws + WS_MOD); const float* ssq_y = (const float*)(F.a->ws + WS_SSQ) + 2 * T;
    const bf16_t* Y = (const bf16_t*)(F.a->ws + WS_Y); unsigned char* H2 = (unsigned char*)(F.a->ws + WS_H); bf16_t* X1 = (bf16_t*)(F.a->ws + WS_X1);
    const int tok0 = F.bid * 128 + wave * 16, b = (F.bid * 128) / S;
    f32x4 gpost[4], gmod[4], gpre[4], shf[4], scf[4];
#pragma unroll
    for (int j = 0; j < 4; ++j) { const int c = 4 * lane + 256 * j; gpost[j] = *(const f32x4*)(F.a->in[IN_GMIXPOST] + c); gmod[j] = *(const f32x4*)(mod + b * 6144 + 2048 + c);
        gpre[j] = *(const f32x4*)(F.a->in[IN_GFFNPRE] + c); shf[j] = *(const f32x4*)(mod + b * 6144 + 3072 + c); scf[j] = *(const f32x4*)(mod + b * 6144 + 4096 + c) + 1.f; }
#pragma unroll
    for (int j = 0; j < 4; ++j) { gpost[j] = gpost[j] * gmod[j]; gpre[j] = gpre[j] * scf[j]; }
    __syncthreads();
#pragma nounroll
    for (int i = 0; i < 16; i += 2) {
        const int row = tok0 + i;
        f32x2 hp[4][4];
        {   f32x4 xv[2][4]; u32x2 yv[2][4]; float rsy[2];
#pragma unroll
            for (int q = 0; q < 2; ++q) {
#pragma unroll
                for (int j = 0; j < 4; ++j) { xv[q][j] = *(const GAS f32x4*)(F.a->in[IN_X] + (size_t)(row + q) * D + 4 * lane + 256 * j); yv[q][j] = *(const GAS u32x2*)(Y + (size_t)(row + q) * D + 4 * lane + 256 * j); }
                rsy[q] = rsqrtf(ssq_y[row + q] * (1.f / D) + 1e-6f); }
#pragma unroll
            for (int q = 0; q < 2; ++q) { f32x4 x1[4]; float ss = 0.f;
#pragma unroll
                for (int j = 0; j < 4; ++j) { const f32x4 yy = {bflo(yv[q][j].x), bfhi(yv[q][j].x), bflo(yv[q][j].y), bfhi(yv[q][j].y)}; x1[j] = xv[q][j] + (yy * rsy[q]) * gpost[j];
                    ss += (x1[j][0] * x1[j][0] + x1[j][1] * x1[j][1]) + (x1[j][2] * x1[j][2] + x1[j][3] * x1[j][3]);
                    { u32x2 w; w.x = cvt_pk_bf16(x1[j][0], x1[j][1]); w.y = cvt_pk_bf16(x1[j][2], x1[j][3]); *(GAS u32x2*)(X1 + (size_t)(row + q) * D + 4 * lane + 256 * j) = w; } }
                const float r1 = rsqrtf(wave_sum(ss) * (1.f / D) + 1e-6f);
#pragma unroll
                for (int j = 0; j < 4; ++j) { const f32x4 h = (x1[j] * r1) * gpre[j] + shf[j]; *(GAS unsigned*)(H2 + (size_t)(row + q) * D + 4 * lane + 256 * j) = pack4_fp8s(h[0], h[1], h[2], h[3]);
#pragma unroll
                    for (int c = 0; c < 4; ++c) hp[j][c][q] = h[c]; } } }
        f32x2 v[32];
#pragma unroll
        for (int e = 0; e < NE; ++e) { const LAS f32x4* wp = (const LAS f32x4*)(wt + e * 1024 + 4 * lane); f32x2 p = {0.f, 0.f};
#pragma unroll
            for (int j = 0; j < 4; ++j) { const f32x4 w = wp[64 * j]; p = p + hp[j][0] * w[0]; p = p + hp[j][1] * w[1]; p = p + hp[j][2] * w[2]; p = p + hp[j][3] * w[3]; }
            v[e] = p; if ((e & 3) == 3) __builtin_amdgcn_sched_barrier(0); }
        const int my_e = lane >> 1; const float brt = F.a->in[IN_BROUTER][my_e];
#define P5_REDUCE(Q) do { float u_[16]; \
            _Pragma("unroll") for (int j = 0; j < 16; ++j) u_[j] = swap32_sum(v[j][Q], v[16 + j][Q]); \
            _Pragma("unroll") for (int j = 0; j < 8; ++j) u_[j] = swap16_sum(u_[j], u_[8 + j]); \
            _Pragma("unroll") for (int j = 0; j < 4; ++j) { const bool up = (lane & 8) != 0; const float keep = up ? u_[4 + j] : u_[j], send = up ? u_[j] : u_[4 + j]; u_[j] = keep + lane_xor8(send); } \
            _Pragma("unroll") for (int j = 0; j < 2; ++j) { const bool up = (lane & 4) != 0; const float keep = up ? u_[2 + j] : u_[j], send = up ? u_[j] : u_[2 + j]; u_[j] = keep + lane_xor4(send); } \
            { const bool up = (lane & 2) != 0; const float keep = up ? u_[1] : u_[0], send = up ? u_[0] : u_[1]; u_[0] = keep + DPPF(send, 0x4E); } \
            float lg = u_[0] + DPPF(u_[0], 0xB1) + brt; \
            float vals[4]; int idx[4]; \
            _Pragma("unroll") for (int k = 0; k < 4; ++k) { const float mx = wave_max(lg); const unsigned long long bm = __ballot(lg == mx); const int wl = __builtin_ctzll(bm); vals[k] = mx; idx[k] = wl >> 1; if (my_e == idx[k]) lg = -INFINITY; } \
            float ex[4], den = 0.f; \
            _Pragma("unroll") for (int k = 0; k < 4; ++k) { ex[k] = __expf(vals[k] - vals[0]); den += ex[k]; } \
            const float inv = 1.f / den; \
            if (lane < 4) { const int a = (wave * 16 + i + Q) * 4 + lane; se[a] = lane == 0 ? idx[0] : lane == 1 ? idx[1] : lane == 2 ? idx[2] : idx[3]; sg[a] = (lane == 0 ? ex[0] : lane == 1 ? ex[1] : lane == 2 ? ex[2] : ex[3]) * inv; } \
            __builtin_amdgcn_sched_barrier(0); } while (0)
        P5_REDUCE(0);
        P5_REDUCE(1);
#undef P5_REDUCE
    }
#define P5_LOAD(x)
#undef P5_LOAD
    __syncthreads();
    LAS int* srank = (LAS int*)(F.lds + X_SRANK); LAS int* wcnt = (LAS int*)(F.lds + X_WCNT);
    const int e_my = se[tid]; int rk = 0;
    for (int e = 0; e < NE; ++e) { const unsigned long long bm = __ballot(e_my == e); if (e_my == e) rk = __builtin_popcountll(bm & ((1ull << lane) - 1ull)); if (lane == 0) wcnt[wave * 32 + e] = __builtin_popcountll(bm); }
    __syncthreads();
    int base = 0;
    for (int w = 0; w < wave; ++w) base += wcnt[w * 32 + e_my];
    srank[tid] = base + rk;
    { const int a = F.bid * 512 + tid; ((int*)(F.a->ws + WS_SE))[a] = e_my; ((float*)(F.a->ws + WS_SG))[a] = sg[tid]; ((int*)(F.a->ws + WS_SRANK))[a] = base + rk; }
    if (tid < NE) { int tot = 0; for (int w = 0; w < 8; ++w) tot += wcnt[w * 32 + tid]; ((int*)(F.a->ws + WS_CNT))[F.bid * NE + tid] = tot; }
}
__device__ __forceinline__ void p9_final(Frame& F) {
    PHASE_IDS();
    const float* mod = (const float*)(F.a->ws + WS_MOD); const unsigned char* YR = (const unsigned char*)(F.a->ws + WS_YR); const int* pos = (const int*)(F.a->ws + WS_POS);
    const int tok0 = F.bid * 128 + wave * 16, b = (F.bid * 128) / S;
    f32x4 gf[4];
#pragma unroll
    for (int j = 0; j < 4; ++j) { const int c = 4 * lane + 256 * j; gf[j] = *(const f32x4*)(F.a->in[IN_GFFNPOST] + c) * *(const f32x4*)(mod + b * 6144 + 5120 + c); }
    unsigned yn[4][4]; u32x2 xn[4]; const bf16_t* X1 = (const bf16_t*)(F.a->ws + WS_X1);
#define P9_LOAD(row) do { _Pragma("unroll") for (int s_ = 0; s_ < 4; ++s_) { const int pr = __builtin_amdgcn_readfirstlane(pos[(row) * 4 + s_]); _Pragma("unroll") for (int j = 0; j < 4; ++j) yn[s_][j] = *(const GAS unsigned*)(YR + (size_t)pr * D + 4 * lane + 256 * j); } \
        _Pragma("unroll") for (int j = 0; j < 4; ++j) xn[j] = *(const GAS u32x2*)(X1 + (size_t)(row) * D + 4 * lane + 256 * j); } while (0)
    P9_LOAD(tok0);
    for (int i = 0; i < 16; ++i) {
        const int row = tok0 + i;
        f32x4 y[4], x1[4]; float ss = 0.f;
#pragma unroll
        for (int j = 0; j < 4; ++j) { y[j] = (f32x4){0.f, 0.f, 0.f, 0.f};
#pragma unroll
            for (int s_ = 0; s_ < 4; ++s_) { const unsigned w = yn[s_][j]; const f32x2 lo = __builtin_amdgcn_cvt_pk_f32_fp8((int)w, false), hi2 = __builtin_amdgcn_cvt_pk_f32_fp8((int)w, true); y[j] += (f32x4){lo[0], lo[1], hi2[0], hi2[1]}; }
            y[j] = y[j] * YR_INV; x1[j] = (f32x4){bflo(xn[j].x), bfhi(xn[j].x), bflo(xn[j].y), bfhi(xn[j].y)}; ss += (y[j][0] * y[j][0] + y[j][1] * y[j][1]) + (y[j][2] * y[j][2] + y[j][3] * y[j][3]); }
        if (i + 1 < 16) P9_LOAD(row + 1);
        const float r = rsqrtf(wave_sum(ss) * (1.f / D) + 1e-6f);
#pragma unroll
        for (int j = 0; j < 4; ++j) *(GAS f32x4*)(F.a->out + (size_t)row * D + 4 * lane + 256 * j) = x1[j] + (y[j] * r) * gf[j];
    }
#undef P9_LOAD
}
namespace att {
#define SBAR() __builtin_amdgcn_sched_barrier(0)
typedef short s16x4 __attribute__((ext_vector_type(4)));
typedef short v4i16_t __attribute__((ext_vector_type(4)));
typedef __attribute__((address_space(3))) const char* lds_cptr;
__device__ __forceinline__ int crow(int r, int hi) { return (r & 3) + 8 * (r >> 2) + 4 * hi; }
__device__ __forceinline__ void glds16(const void* gsrc, unsigned lds_dst) { unsigned keep;
    asm volatile("s_mov_b32 %0, m0\n\ts_mov_b32 m0, %2\n\ts_nop 0\n\tglobal_load_lds_dwordx4 %1, off\n\ts_mov_b32 m0, %0" : "=&s"(keep) : "v"(gsrc), "s"(lds_dst) : "memory"); }
__device__ __forceinline__ s16x4 vtr(lds_cptr p) { return __builtin_bit_cast(s16x4, __builtin_amdgcn_ds_read_tr16_b64_v4i16((__attribute__((address_space(3))) v4i16_t*)p)); }
typedef float f32x2_t __attribute__((ext_vector_type(2))); typedef __bf16 bf16x2_t __attribute__((ext_vector_type(2)));
__device__ __forceinline__ unsigned cvtpk_s(float lo, float hi) { f32x2_t v = {lo, hi}; bf16x2_t b = __builtin_convertvector(v, bf16x2_t); return __builtin_bit_cast(unsigned, b); }
#define WAIT_BAR0() asm volatile("s_waitcnt vmcnt(0) lgkmcnt(0)\n\ts_barrier" ::: "memory")

struct Src {
    const bf16_t* q0; const bf16_t* q1; int qp;
    const bf16_t* k0; const bf16_t* k1; int kp0, kp1;
    const bf16_t* v; int vp;
};
template <int DQK, int DV> struct Geo {
    static constexpr int NKC = DQK / 8, NVB = DV / 32, KSLOT = NKC * 1024, VSLOT = NVB * 4096, NPIECE = NKC + 4 * NVB;
    static constexpr int NSLOT = 3, LDS_K = 0, LDS_V = NSLOT * KSLOT, LDS_WS = LDS_V + NSLOT * VSLOT, LDS_OST = 0  , LDS_TOTAL = LDS_WS + 8 * 256;
    static_assert(8 * 32 * DV * 2 <= LDS_WS && LDS_TOTAL <= 131072, "attention LDS map");
};
constexpr float THR = 8.f;
#ifndef ATT_VPM
#define ATT_VPM 8
#endif

template <int DQK, int DV, int MODE>
__device__ __forceinline__ void attn_unit(LAS char* shm, const Src sc, int qb, bf16_t* obase, float* td, float lam, const float* gsub) {
    typedef Geo<DQK, DV> G;
    int tid_ = threadIdx.x; asm volatile("" : "+v"(tid_));
    const int tid = tid_, lane = tid & 63, r32 = lane & 31, hi = lane >> 5; const int wid = __builtin_amdgcn_readfirstlane(tid >> 6);
    const int q0 = qb * 256, NT = 4 * (qb + 1);
    const unsigned lds0 = (unsigned)(uintptr_t)shm;
    LAS float* wsf = (LAS float*)(shm + G::LDS_WS) + wid * 64;
    const char* ksrc[2]; const char* vsrc[2]; long kstep[2], vstep;
#pragma unroll
    for (int i = 0; i < 2; ++i) { const int p = wid + 8 * i; ksrc[i] = nullptr; kstep[i] = 0; vsrc[i] = nullptr;
        if (p < G::NKC) { const bf16_t* base = p < 8 ? sc.k0 + 8 * p : sc.k1 + 8 * (p - 8); const int pitch = p < 8 ? sc.kp0 : sc.kp1; ksrc[i] = (const char*)(base + (long)lane * pitch); kstep[i] = 128L * pitch; }
        if (p < 4 * G::NVB) { const int db = p >> 2, rg = p & 3; vsrc[i] = (const char*)(sc.v + (long)(16 * rg + (lane >> 2)) * sc.vp + 32 * db + 8 * (lane & 3)); } }
    vstep = 128L * sc.vp;
#define DMA_K(slot) do { _Pragma("unroll") for (int i_ = 0; i_ < 2; ++i_) if (wid + 8 * i_ < G::NKC) { glds16(ksrc[i_], (unsigned)__builtin_amdgcn_readfirstlane(lds0 + G::LDS_K + (wid + 8 * i_) * 1024 + (slot) * G::KSLOT)); ksrc[i_] += kstep[i_]; } } while (0)
#define DMA_V(slot) do { _Pragma("unroll") for (int i_ = 0; i_ < 2; ++i_) if (wid + 8 * i_ < 4 * G::NVB) { glds16(vsrc[i_], (unsigned)__builtin_amdgcn_readfirstlane(lds0 + G::LDS_V + (wid + 8 * i_) * 1024 + (slot) * G::VSLOT)); vsrc[i_] += vstep; } } while (0)
    DMA_K(0); DMA_V(0); DMA_K(1); DMA_V(1); DMA_K(2);
    bf16x8 qr[DQK / 16];
    { const long qrow = (long)(q0 + wid * 32 + r32) * sc.qp;
#pragma unroll
      for (int d0 = 0; d0 < DQK / 16; ++d0) qr[d0] = d0 < 4 ? *reinterpret_cast<const bf16x8*>(sc.q0 + qrow + d0 * 16 + hi * 8) : *reinterpret_cast<const bf16x8*>(sc.q1 + qrow + (d0 - 4) * 16 + hi * 8); }
    float m_run = 0.f, l_reg = 0.f; bool first = true;
    f32x16 negm = f32x16{};
    f32x16 o[G::NVB];
#pragma unroll
    for (int d = 0; d < G::NVB; ++d) o[d] = f32x16{};
    const int qrel = wid * 32 + r32;
    const lds_cptr shm3 = (lds_cptr)shm;
    const lds_cptr kp0 = shm3 + G::LDS_K + hi * 1024 + r32 * 16;
    const lds_cptr vp0 = shm3 + G::LDS_V + ((lane >> 4) & 1) * 32 + (lane & 3) * 8 + (4 * hi + ((lane & 15) >> 2)) * 64;
#define QKT(P0, P1, slot) do { const lds_cptr kp_ = kp0 + (slot) * G::KSLOT; _Pragma("unroll") for (int d0 = 0; d0 < DQK / 16; ++d0) { \
        const bf16x8 b0_ = *(const __attribute__((address_space(3))) bf16x8*)(kp_ + d0 * 2048), b1_ = *(const __attribute__((address_space(3))) bf16x8*)(kp_ + d0 * 2048 + 512); \
        if (d0 == 0) { P0 = __builtin_amdgcn_mfma_f32_32x32x16_bf16(b0_, qr[0], negm, 0, 0, 0); P1 = __builtin_amdgcn_mfma_f32_32x32x16_bf16(b1_, qr[0], negm, 0, 0, 0); } \
        else { P0 = __builtin_amdgcn_mfma_f32_32x32x16_bf16(b0_, qr[d0], P0, 0, 0, 0); P1 = __builtin_amdgcn_mfma_f32_32x32x16_bf16(b1_, qr[d0], P1, 0, 0, 0); } } } while (0)
#define ACTIVE(t_) (!((t_) - (NT - 4) >= 0 && 64 * ((t_) - (NT - 4)) > 32 * wid + 31))
    int s_cur = 0, s_nx1 = 1, s_nx2 = 2;
    const bool three = (wid + 8 < G::NKC ? 2 : 1) + (wid + 8 < 4 * G::NVB ? 2 : 1) == 3;
    f32x16 sc0 = f32x16{}, sc1 = f32x16{}, sn0 = f32x16{}, sn1 = f32x16{};
    asm volatile("s_waitcnt vmcnt(0) lgkmcnt(0)\n\ts_barrier" ::: "memory");
    QKT(sc0, sc1, 0);
    for (int t = 0; t < NT; ++t) {
        if (t + 3 < NT) { if (three) asm volatile("s_waitcnt vmcnt(3) lgkmcnt(0)\n\ts_barrier" ::: "memory"); else asm volatile("s_waitcnt vmcnt(2) lgkmcnt(0)\n\ts_barrier" ::: "memory"); }
        else WAIT_BAR0();
        if (t + 3 < NT) DMA_K(s_cur);
        if (t + 2 < NT) DMA_V(s_nx2);
        const int jb = t - (NT - 4);
        const bool act = ACTIVE(t), nxt = (t + 1 < NT) && ACTIVE(t + 1);
        if (!act) { const int tmp = s_cur; s_cur = s_nx1; s_nx1 = s_nx2; s_nx2 = tmp; continue; }
        if (jb >= 0) { const int kb = 64 * jb + 4 * hi;
#pragma unroll
            for (int r = 0; r < 16; ++r) { const int kv = kb + (r & 3) + 8 * (r >> 2); if (kv > qrel) sc0[r] = -INFINITY; if (kv + 32 > qrel) sc1[r] = -INFINITY; } }
        float rm = fmaxf(sc0[0], sc1[0]);
#pragma unroll
        for (int r = 1; r < 16; ++r) rm = fmaxf(rm, fmaxf(sc0[r], sc1[r]));
        rm = swap32_max(rm, rm);
        if (first || __any(rm > THR)) {
            const float dl = first ? rm : fmaxf(rm, 0.f), f = first ? 1.f : __builtin_amdgcn_exp2f(-dl); m_run += dl; l_reg *= f; first = false;
#pragma unroll
            for (int r = 0; r < 16; ++r) { sc0[r] -= dl; sc1[r] -= dl; negm[r] = -m_run; }
            if (hi == 0) wsf[r32] = f;
            asm volatile("s_waitcnt lgkmcnt(0)" ::: "memory");
#pragma unroll
            for (int g = 0; g < 4; ++g) { const f32x4 fv = *(const LAS f32x4*)(wsf + 8 * g + 4 * hi);
#pragma unroll
                for (int d = 0; d < G::NVB; ++d) { o[d][4 * g] *= fv[0]; o[d][4 * g + 1] *= fv[1]; o[d][4 * g + 2] *= fv[2]; o[d][4 * g + 3] *= fv[3]; } }
        }
        u32x4 pw[4];
        if (nxt) {
            constexpr int ND0 = DQK / 16, NG = 2 * ND0;
            const lds_cptr kpn = kp0 + s_nx1 * G::KSLOT;
            float sacc = 0.f;
            bf16x8 kb0 = *(const __attribute__((address_space(3))) bf16x8*)(kpn), kb1 = *(const __attribute__((address_space(3))) bf16x8*)(kpn + 512), nb0 = kb0, nb1 = kb1;
#define ATT_GAP(g_) do { _Pragma("unroll") for (int e_ = ((g_) * 32) / NG; e_ < (((g_) + 1) * 32) / NG; ++e_) { \
                if (e_ < 16) { sc0[e_] = __builtin_amdgcn_exp2f(sc0[e_]); sacc += sc0[e_]; } else { sc1[e_ - 16] = __builtin_amdgcn_exp2f(sc1[e_ - 16]); sacc += sc1[e_ - 16]; } } \
                asm volatile("" : "+v"(sacc), "+v"(sc0), "+v"(sc1)); SBAR(); } while (0)
#pragma unroll
            for (int d0 = 0; d0 < ND0; ++d0) {
                if (d0 + 1 < ND0) { nb0 = *(const __attribute__((address_space(3))) bf16x8*)(kpn + (d0 + 1) * 2048); nb1 = *(const __attribute__((address_space(3))) bf16x8*)(kpn + (d0 + 1) * 2048 + 512); }
                sn0 = d0 == 0 ? __builtin_amdgcn_mfma_f32_32x32x16_bf16(kb0, qr[0], negm, 0, 0, 0) : __builtin_amdgcn_mfma_f32_32x32x16_bf16(kb0, qr[d0], sn0, 0, 0, 0);
                ATT_GAP(2 * d0);
                sn1 = d0 == 0 ? __builtin_amdgcn_mfma_f32_32x32x16_bf16(kb1, qr[0], negm, 0, 0, 0) : __builtin_amdgcn_mfma_f32_32x32x16_bf16(kb1, qr[d0], sn1, 0, 0, 0);
                ATT_GAP(2 * d0 + 1);
                kb0 = nb0; kb1 = nb1;
            }
#undef ATT_GAP
            l_reg += sacc;
#pragma unroll
            for (int k = 0; k < 4; ++k) { pw[0][k] = cvtpk_s(sc0[2 * k], sc0[2 * k + 1]); pw[1][k] = cvtpk_s(sc0[8 + 2 * k], sc0[8 + 2 * k + 1]); pw[2][k] = cvtpk_s(sc1[2 * k], sc1[2 * k + 1]); pw[3][k] = cvtpk_s(sc1[8 + 2 * k], sc1[8 + 2 * k + 1]); }
        } else {
            float sacc = 0.f;
#pragma unroll
            for (int r = 0; r < 16; ++r) { sc0[r] = __builtin_amdgcn_exp2f(sc0[r]); sc1[r] = __builtin_amdgcn_exp2f(sc1[r]); sacc += sc0[r] + sc1[r]; }
            l_reg += sacc;
#pragma unroll
            for (int k = 0; k < 4; ++k) { pw[0][k] = cvtpk_s(sc0[2 * k], sc0[2 * k + 1]); pw[1][k] = cvtpk_s(sc0[8 + 2 * k], sc0[8 + 2 * k + 1]); pw[2][k] = cvtpk_s(sc1[2 * k], sc1[2 * k + 1]); pw[3][k] = cvtpk_s(sc1[8 + 2 * k], sc1[8 + 2 * k + 1]); }
        }
        const lds_cptr vpp = vp0 + s_cur * G::VSLOT;
#pragma unroll
        for (int d = 0; d < G::NVB; ++d) {
#pragma unroll
            for (int ks = 0; ks < 4; ++ks) { const s16x4 lo = vtr(vpp + d * 4096 + ks * 1024), hh = vtr(vpp + d * 4096 + ks * 1024 + 512);
                const bf16x8 vf = {lo[0], lo[1], lo[2], lo[3], hh[0], hh[1], hh[2], hh[3]};
                o[d] = __builtin_amdgcn_mfma_f32_32x32x16_bf16(__builtin_bit_cast(bf16x8, pw[ks]), vf, o[d], 0, 0, 0); } }
        sc0 = sn0; sc1 = sn1;
        { const int tmp = s_cur; s_cur = s_nx1; s_nx1 = s_nx2; s_nx2 = tmp; }
    }
#undef QKT
#undef ACTIVE
#undef DMA_K
#undef DMA_V
    l_reg = swap32_sum(l_reg, l_reg);
    if (hi == 0) wsf[32 + r32] = l_reg;
    asm volatile("s_waitcnt lgkmcnt(0)" ::: "memory");
    float rli[16];
#pragma unroll
    for (int r = 0; r < 16; ++r) rli[r] = __builtin_amdgcn_rcpf(wsf[32 + crow(r, hi)]);
    const long orow0 = (long)(q0 + wid * 32);
    if (MODE == 1) {
#pragma unroll
        for (int r = 0; r < 16; ++r)
#pragma unroll
            for (int d = 0; d < G::NVB; ++d) td[(orow0 + crow(r, hi)) * 512 + d * 32 + r32] = o[d][r] * rli[r];
    } else {
        if (MODE == 2) {
            float ssr[16];
#pragma unroll
            for (int r = 0; r < 16; ++r) { float ss = 0.f;
#pragma unroll
                for (int d = 0; d < G::NVB; ++d) { const float v = td[(orow0 + crow(r, hi)) * 512 + d * 32 + r32] - lam * (o[d][r] * rli[r]); o[d][r] = v; ss += v * v; }
#pragma unroll
                for (int x = 1; x < 32; x <<= 1) ss += __shfl_xor(ss, x);
                ssr[r] = rsqrtf(ss * (1.f / DV) + 1e-5f) * (1.f - LAMBDA_INIT); }
#pragma unroll
            for (int d = 0; d < G::NVB; ++d) { const float gv = gsub[d * 32 + r32];
#pragma unroll
                for (int r = 0; r < 16; ++r) o[d][r] *= ssr[r] * gv; }
#pragma unroll
            for (int r = 0; r < 16; ++r) rli[r] = 1.f;
        }
        asm volatile("s_waitcnt lgkmcnt(0)\n\ts_barrier" ::: "memory");
        LAS bf16_t* stg = (LAS bf16_t*)(shm + G::LDS_OST) + wid * 32 * DV;
#pragma unroll
        for (int r = 0; r < 16; ++r) { const int orow = crow(r, hi);
#pragma unroll
            for (int d = 0; d < G::NVB; ++d) stg[orow * DV + d * 32 + r32] = (bf16_t)(cvtpk_s(o[d][r] * rli[r], 0.f) & 0xffffu); }
        asm volatile("s_waitcnt lgkmcnt(0)" ::: "memory");
        constexpr int CPR = DV / 8;
#pragma unroll
        for (int i = 0; i < 32 * CPR / 64; ++i) { const int idx = i * 64 + lane, row = idx / CPR, ch = idx % CPR; const u32x4 v = *(const LAS u32x4*)(stg + row * DV + ch * 8);
            *(u32x4*)(obase + (orow0 + row) * 1024 + ch * 8) = v; }
    }
    __builtin_amdgcn_s_setprio(0);
    asm volatile("s_waitcnt vmcnt(0) lgkmcnt(0)\n\ts_barrier" ::: "memory");
}
#undef SBAR
#undef WAIT_BAR0
}

__device__ __forceinline__ void attn_phase_all(Frame& F) {
    LAS char* shm = (LAS char*)(F.lds + RING_OFF);
    const int vcu = (F.bid & 7) * (F.G >> 3) + (F.bid >> 3);
    const bf16_t* QM = (const bf16_t*)(F.a->ws + WS_QM); const bf16_t* KVM = (const bf16_t*)(F.a->ws + WS_KVM); const bf16_t* PR = (const bf16_t*)(F.a->ws + WS_PROJ); bf16_t* ATT = (bf16_t*)(F.a->ws + WS_ATT);
    { const int p = vcu >> 1, b = p >> 3, h = p & 7, half = vcu & 1; const long r0 = (long)b * S;
      att::Src sc{QM + r0 * 768 + h * 64, QM + r0 * 768 + 512 + h * 32, 768, KVM + r0 * 1024 + h * 128, PR + r0 * PJ + PC_KR, 1024, PJ, KVM + r0 * 1024 + h * 128 + 64, 1024};
      for (int i = 0; i < 4; ++i) { const int qb = half == 0 ? (i == 0 ? 7 : i == 1 ? 5 : i == 2 ? 2 : 0) : (i == 0 ? 6 : i == 1 ? 4 : i == 2 ? 3 : 1);
          att::attn_unit<96, 64, 0>(shm, sc, qb, ATT + r0 * 1024 + h * 64, nullptr, 0.f, nullptr); } }
    { const int p = vcu >> 2, b = p >> 2, h = p & 3, s4 = vcu & 3; const long r0 = (long)b * S;
      float lam; { const float* l1 = F.a->in[IN_LQ1]; const float* k1 = F.a->in[IN_LK1]; const float* l2 = F.a->in[IN_LQ2]; const float* k2 = F.a->in[IN_LK2]; float s1 = 0.f, s2 = 0.f;
          for (int i = 0; i < 64; ++i) { s1 += l1[i] * k1[i]; s2 += l2[i] * k2[i]; } lam = __expf(s1) - __expf(s2) + LAMBDA_INIT; }
      float* td = (float*)(F.a->ws + WS_Y) + r0 * 512 + h * 128;
      for (int i = 0; i < 2; ++i) { const int qb = i == 0 ? 7 - s4 : s4;
          att::Src s0{PR + r0 * PJ + PC_QD + (2 * h) * 64, nullptr, PJ, PR + r0 * PJ + PC_KD + (2 * h) * 64, nullptr, PJ, PJ, PR + r0 * PJ + PC_VD + h * 128, PJ};
          att::Src s1{PR + r0 * PJ + PC_QD + (2 * h + 1) * 64, nullptr, PJ, PR + r0 * PJ + PC_KD + (2 * h + 1) * 64, nullptr, PJ, PJ, PR + r0 * PJ + PC_VD + h * 128, PJ};
          att::attn_unit<64, 128, 1>(shm, s0, qb, nullptr, td, 0.f, nullptr);
          att::attn_unit<64, 128, 2>(shm, s1, qb, ATT + r0 * 1024 + 512 + h * 128, td, lam, F.a->in[IN_GSUBLN]); } }
}
__device__ __forceinline__ void offsets_from_counts(Frame& F) {
    PHASE_IDS();
    int* cnt = (int*)(F.a->ws + WS_CNT);
    LAS int* part = (LAS int*)(F.lds + RING_OFF);
    LAS int* tile_e = (LAS int*)(F.lds + X_TILEE); LAS int* m2 = (LAS int*)(F.lds + X_MISC2);
    { const int e = tid & 31, p = tid >> 5; int tot = 0, pre = 0;
      for (int w = p * 16; w < p * 16 + 16; ++w) { const int c = __hip_atomic_load(cnt + w * NE + e, RLX_AGENT); tot += c; if (w < F.bid) pre += c; }
      part[(p * 32 + e) * 2] = tot; part[(p * 32 + e) * 2 + 1] = pre; }
    __syncthreads();
    if (tid < NE) { int tot = 0, pre = 0; for (int p = 0; p < 16; ++p) { tot += part[(p * 32 + tid) * 2]; pre += part[(p * 32 + tid) * 2 + 1]; } m2[96 + tid] = tot; m2[64 + tid] = pre; }
    __syncthreads();
    if (tid < NE) { int st = 0; for (int e = 0; e < tid; ++e) st += (m2[96 + e] + 255) & ~255; m2[32 + tid] = st; const int pad = (m2[96 + tid] + 255) & ~255;
        for (int r = st; r < st + pad; r += 256) tile_e[r >> 8] = tid; if (tid == NE - 1) m2[0] = (st + pad) >> 8; }
    __syncthreads();
}
__device__ __forceinline__ void p6_scatter(Frame& F) {
    offsets_from_counts(F);
    PHASE_IDS();
    LAS int* m2 = (LAS int*)(F.lds + X_MISC2);
    int* rowtok = (int*)(F.a->ws + WS_ROWTOK); float* roww = (float*)(F.a->ws + WS_ROWW); int* pos = (int*)(F.a->ws + WS_POS);
    { const int a = F.bid * 512 + tid; const int e = ((const int*)(F.a->ws + WS_SE))[a]; const float gt = ((const float*)(F.a->ws + WS_SG))[a]; const int rk = ((const int*)(F.a->ws + WS_SRANK))[a];
      const int dst = m2[32 + e] + m2[64 + e] + rk, tok = F.bid * 128 + (tid >> 2);
      rowtok[dst] = tok; roww[dst] = gt; pos[tok * 4 + (tid & 3)] = dst; }
    if (F.bid < NE && tid < 256) { const int e = F.bid, tot = m2[96 + e], st = m2[32 + e], pad = (tot + 255) & ~255; const int r = st + tot + tid; if (r < st + pad) { rowtok[r] = 0; roww[r] = 0.f; } }
}

#ifdef DEV_NAIVE_ATTN
template <int MODE>
__global__ void __launch_bounds__(256) k_attn_ref(const bf16_t* QM, const bf16_t* KVM, const bf16_t* PROJ, bf16_t* ATT, float* TD, const float* lq1, const float* lk1, const float* lq2, const float* lk2, const float* gsub) {
    constexpr int DQK = MODE == 0 ? 96 : 64, DV = MODE == 0 ? 64 : 128, NH = MODE == 0 ? 8 : 4;
    __shared__ float Ks[32][DQK]; __shared__ float Vs[32][DV];
    const int bh = blockIdx.y, b = bh / NH, h = bh % NH, q = blockIdx.x * 256 + threadIdx.x, tid = threadIdx.x, t = b * S + q;
    float lam = 0.f;
    if (MODE == 1) { float s1 = 0.f, s2 = 0.f; for (int i = 0; i < 64; ++i) { s1 += lq1[i] * lk1[i]; s2 += lq2[i] * lk2[i]; } lam = expf(s1) - expf(s2) + LAMBDA_INIT; }
    float res[DV];
    for (int j = 0; j < (MODE == 0 ? 1 : 2); ++j) {
        float qv[DQK]; float o[DV];
#pragma unroll
        for (int d = 0; d < DQK; ++d) qv[d] = MODE == 0 ? bf2f(QM[(size_t)t * 768 + (d < 64 ? h * 64 + d : 512 + h * 32 + d - 64)]) : bf2f(PROJ[(size_t)t * PJ + PC_QD + (2 * h + j) * 64 + d]);
#pragma unroll
        for (int d = 0; d < DV; ++d) o[d] = 0.f;
        float m = -1e30f, l = 0.f;
        const int kend = blockIdx.x * 256 + 256;
        for (int k0 = 0; k0 < kend; k0 += 32) {
            __syncthreads();
            for (int i = tid; i < 32 * DQK; i += 256) { const int kk = i / DQK, d = i % DQK; const size_t tk = (size_t)b * S + k0 + kk;
                Ks[kk][d] = MODE == 0 ? (d < 64 ? bf2f(KVM[tk * 1024 + h * 128 + d]) : bf2f(PROJ[tk * PJ + PC_KR + d - 64])) : bf2f(PROJ[tk * PJ + PC_KD + (2 * h + j) * 64 + d]); }
            for (int i = tid; i < 32 * DV; i += 256) { const int kk = i / DV, d = i % DV; const size_t tk = (size_t)b * S + k0 + kk;
                Vs[kk][d] = MODE == 0 ? bf2f(KVM[tk * 1024 + h * 128 + 64 + d]) : bf2f(PROJ[tk * PJ + PC_VD + h * 128 + d]); }
            __syncthreads();
            for (int kk = 0; kk < 32; ++kk) {
                if (k0 + kk > q) break;
                float s = 0.f;
#pragma unroll
                for (int d = 0; d < DQK; ++d) s += qv[d] * Ks[kk][d];
                const float mn = fmaxf(m, s), al = exp2f(m - mn), p = exp2f(s - mn);
                l = l * al + p; m = mn;
#pragma unroll
                for (int d = 0; d < DV; ++d) o[d] = o[d] * al + p * Vs[kk][d];
            }
        }
        const float inv = 1.f / l;
        if (MODE == 0) {
#pragma unroll
            for (int d = 0; d < DV; ++d) ATT[(size_t)t * D + h * 64 + d] = (bf16_t)(cvt_pk_bf16(o[d] * inv, 0.f) & 0xffffu);
        } else if (j == 0) {
#pragma unroll
            for (int d = 0; d < DV; ++d) TD[((size_t)t * 4 + h) * 128 + d] = o[d] * inv;
        } else { float ss = 0.f;
#pragma unroll
            for (int d = 0; d < DV; ++d) { res[d] = TD[((size_t)t * 4 + h) * 128 + d] - lam * (o[d] * inv); ss += res[d] * res[d]; }
            const float r = rsqrtf(ss * (1.f / 128.f) + 1e-5f) * (1.f - LAMBDA_INIT);
#pragma unroll
            for (int d = 0; d < DV; ++d) ATT[(size_t)t * D + 512 + h * 128 + d] = (bf16_t)(cvt_pk_bf16(res[d] * r * gsub[d], 0.f) & 0xffffu);
        }
    }
}
#endif

constexpr int N_PHASES = 11;
__global__ void __launch_bounds__(NWAVES * 64, 2) mk_fwd(Args args) {
    extern __shared__ __attribute__((aligned(16))) unsigned char lds[];
    Frame F;
    F.lds = (LAS unsigned char*)lds; F.MISC = (volatile LAS unsigned*)(F.lds + MISC_OFF);
    F.G = gridDim.x; F.bid = blockIdx.x;
    F.a = &args; F.ctl = (unsigned*)(args.ws + WS_CTL);
    for (int u = threadIdx.x; u < (X_TILEE - LDSCTL_OFF) / 4; u += NWAVES * 64) ((LAS unsigned*)(F.lds + LDSCTL_OFF))[u] = 0u;
    __syncthreads();
    const int lo = args.ph_lo, hi = args.ph_hi;
#ifdef LEAK_LO
    if (LEAK_LO == 0 && threadIdx.x == 0) F.MISC[16] = (unsigned)__builtin_amdgcn_s_memrealtime();
#endif
    XcdBarrier bar; bar.bar = F.ctl + CW_BAR; bar.x = 0; bar.st = nullptr;
    if (hi - lo > 1) bar = xcd_barrier_post(F.ctl + CW_BAR + args.li * XCD_BAR_WORDS, F.MISC + 8);
#ifndef PH_MASK
#define PH_MASK 0x7ff
#endif
#define IN(k) (((PH_MASK >> (k)) & 1) && lo <= (k) && (k) < hi)
#ifdef LEAK_LO
#define SEAM(k) do { if (IN(k) && IN((k) + 1)) xcd_barrier(bar); if (((k) + 1 == LEAK_LO || (k) + 1 == LEAK_HI) && threadIdx.x == 0) F.MISC[(k) + 1 == LEAK_LO ? 16 : 17] = (unsigned)__builtin_amdgcn_s_memrealtime(); } while (0)
#else
#define SEAM(k) do { if (IN(k) && IN((k) + 1)) xcd_barrier(bar); } while (0)
#endif
    LAS unsigned char* ring = F.lds + RING_OFF;
    if (IN(0)) { p0_prologue(F); } SEAM(0);
    if (IN(1)) { p0b_norm(F); } SEAM(1);
    if (IN(2)) {
        pg8::Gemm g{(const bf16_t*)(F.a->ws + WS_H), (const bf16_t*)(F.a->ws + WS_WIN), nullptr, 0, D, D, D, 0}; pg8::StaticOrder So; So.init(T, PJ, F.G, F.bid);
        epi::EpiProj E{(bf16_t*)(F.a->ws + WS_PROJ), (const f32x4*)(F.a->ws + WS_TABM), (const f32x4*)(F.a->ws + WS_TABD), (float*)(F.a->ws + WS_SSQ), (float*)(F.a->ws + WS_SSQ) + T};
        pg8::gemm_phase<epi::EpiProj, pg8::StaticOrder, false>(ring, g, So, E);
    } SEAM(2);
    if (IN(3)) {
#ifndef NO_Q
        { pg8::Gemm g{(const bf16_t*)(F.a->ws + WS_PROJ) + PC_CQ, (const bf16_t*)(F.a->ws + WS_WQB), nullptr, 0, PJ, 256, 256, 0}; pg8::StaticOrder So; So.init(T, 768, F.G, F.bid);
          epi::EpiQ E{(bf16_t*)(F.a->ws + WS_QM), (const f32x4*)(F.a->ws + WS_TABM), (const float*)(F.a->ws + WS_SSQ)};
          pg8::gemm_phase<epi::EpiQ, pg8::StaticOrder, false>(ring, g, So, E); }
#endif
#ifndef NO_KV
        { pg8::Gemm g{(const bf16_t*)(F.a->ws + WS_PROJ) + PC_CKV, (const bf16_t*)(F.a->ws + WS_WKVB), nullptr, 0, PJ, 128, 128, 0}; pg8::StaticOrder So; So.init(T, 1024, F.G, F.bid);
          epi::EpiKV E{(bf16_t*)(F.a->ws + WS_KVM), (const float*)(F.a->ws + WS_SSQ) + T};
          pg8::gemm_phase<epi::EpiKV, pg8::StaticOrder, false>(ring, g, So, E); }
#endif
    } SEAM(3);
    if (IN(4)) {
#ifndef DEV_NAIVE_ATTN
        attn_phase_all(F);
#endif
    } SEAM(4);
    if (IN(5)) {
        pg8::Gemm g{(const bf16_t*)(F.a->ws + WS_ATT), (const bf16_t*)(F.a->ws + WS_WO), nullptr, 0, D, D, D, 0}; pg8::StaticOrder So; So.init(T, D, F.G, F.bid);
        epi::EpiY E{(bf16_t*)(F.a->ws + WS_Y), (float*)(F.a->ws + WS_SSQ) + 2 * T};
        pg8::gemm_phase<epi::EpiY, pg8::StaticOrder, false>(ring, g, So, E);
    } SEAM(5);
    if (IN(6)) { p5_rows(F); } SEAM(6);
    if (IN(7)) { p6_scatter(F); } SEAM(7);
    if (IN(8)) {
        offsets_from_counts(F);
        pg8::GroupedOrder So{(const LAS int*)(F.lds + X_TILEE), __builtin_amdgcn_readfirstlane(((LAS int*)(F.lds + X_MISC2))[0]), 8, F.G, F.bid};
        pg8::Gemm g{(const bf16_t*)(F.a->ws + WS_H), (const bf16_t*)(F.a->ws + WS_WGU), (const int*)(F.a->ws + WS_ROWTOK), (size_t)2048 * 512, 512, 512, 512, 0};
        epi::EpiAct E{(unsigned char*)(F.a->ws + WS_ACT), F.a->in[IN_BGU]};
        pg8::gemm_phase<epi::EpiAct, pg8::GroupedOrder, true, true>(ring, g, So, E, F.lds + X_IDX);
    } SEAM(8);
    if (IN(9)) {
        offsets_from_counts(F);
        pg8::GroupedOrder So{(const LAS int*)(F.lds + X_TILEE), __builtin_amdgcn_readfirstlane(((LAS int*)(F.lds + X_MISC2))[0]), 4, F.G, F.bid};
        pg8::Gemm g{(const bf16_t*)(F.a->ws + WS_ACT), (const bf16_t*)(F.a->ws + WS_WD), nullptr, (size_t)1024 * 512, 512, 512, 512, 0};
        epi::EpiDown E{(unsigned char*)(F.a->ws + WS_YR), F.a->in[IN_BDN], (const float*)(F.a->ws + WS_ROWW)};
        pg8::gemm_phase<epi::EpiDown, pg8::GroupedOrder, false, true>(ring, g, So, E);
    } SEAM(9);
    if (IN(10)) { p9_final(F); }
#ifdef LEAK_LO
    if (blockIdx.x == 0 && threadIdx.x == 0) { if (LEAK_HI == 11) F.MISC[17] = (unsigned)__builtin_amdgcn_s_memrealtime(); asm volatile("s_waitcnt vmcnt(0) lgkmcnt(0)" ::: "memory"); args.out[0] += (float)(F.MISC[17] - F.MISC[16]) * LEAK_SCALE; }
#endif
#undef IN
#undef SEAM
}

extern "C" void kernel_launch(void* const* d_in, const int* in_sizes, int n_in, void* d_out, int out_size, void* d_ws, size_t ws_size, hipStream_t stream) {
    static int grid = 0;
    if (grid == 0) {
        if (n_in != 26 || in_sizes[0] != T * D || out_size != T * D || ws_size < WS_END) { fprintf(stderr, "kernel_launch: unexpected shapes (n_in %d, ws %zu); nothing launched\n", n_in, ws_size); grid = -1; return; }
        int dev = 0, cus = 0;
        if (hipGetDevice(&dev) != hipSuccess || hipDeviceGetAttribute(&cus, hipDeviceAttributeMultiprocessorCount, dev) != hipSuccess) { grid = -1; return; }
        if (hipFuncSetAttribute((const void*)mk_fwd, hipFuncAttributeMaxDynamicSharedMemorySize, LDS_BYTES) != hipSuccess) { fprintf(stderr, "kernel_launch: hipFuncSetAttribute failed\n"); grid = -1; return; }
        grid = cus;
        if (grid != 256) fprintf(stderr, "kernel_launch: %d CUs; this kernel is built for 256\n", grid);
    }
    if (grid < 0) return;
    (void)hipMemsetAsync((char*)d_ws + WS_CTL, 0, CTL_ZERO_BYTES, stream);
    Args a{};
    for (int i = 0; i < 26; ++i) a.in[i] = (const float*)d_in[i];
    a.out = (float*)d_out; a.ws = (unsigned char*)d_ws;
#ifndef MK_CUTS
#define MK_CUTS {0, N_PHASES}
#endif
    const int cuts[] = MK_CUTS; const int ncut = (int)(sizeof(cuts) / sizeof(int)) - 1;
    for (int li = 0; li < ncut; ++li) {
        a.ph_lo = cuts[li]; a.ph_hi = cuts[li + 1]; a.li = li;
        hipLaunchKernelGGL(mk_fwd, dim3(grid), dim3(NWAVES * 64), LDS_BYTES, stream, a);
#ifdef DEV_NAIVE_ATTN
        if (cuts[li + 1] == 5) {
            unsigned char* ws = (unsigned char*)d_ws;
            k_attn_ref<0><<<dim3(S / 256, NB * 8), 256, 0, stream>>>((const bf16_t*)(ws + WS_QM), (const bf16_t*)(ws + WS_KVM), (const bf16_t*)(ws + WS_PROJ), (bf16_t*)(ws + WS_ATT), nullptr, nullptr, nullptr, nullptr, nullptr, nullptr);
            k_attn_ref<1><<<dim3(S / 256, NB * 4), 256, 0, stream>>>((const bf16_t*)(ws + WS_QM), (const bf16_t*)(ws + WS_KVM), (const bf16_t*)(ws + WS_PROJ), (bf16_t*)(ws + WS_ATT), (float*)(ws + WS_Y),
                (const float*)d_in[IN_LQ1], (const float*)d_in[IN_LK1], (const float*)d_in[IN_LQ2], (const float*)d_in[IN_LK2], (const float*)d_in[IN_GSUBLN]);
        }
#endif
    }
}
```

```cpp
#include <hip/hip_runtime.h>
#include <cstdio>
#include <cstdint>

#define GAS __attribute__((address_space(1)))
#define LAS __attribute__((address_space(3)))
typedef unsigned short bf16_t;
typedef short bf16x8 __attribute__((ext_vector_type(8)));
typedef float f32x4 __attribute__((ext_vector_type(4)));
typedef float f32x2 __attribute__((ext_vector_type(2)));
typedef float f32x16 __attribute__((ext_vector_type(16)));
typedef unsigned u32x4 __attribute__((ext_vector_type(4)));
typedef unsigned u32x2 __attribute__((ext_vector_type(2)));
typedef int i32x4 __attribute__((ext_vector_type(4)));
typedef GAS unsigned gu32;
#define RLX_AGENT __ATOMIC_RELAXED, __HIP_MEMORY_SCOPE_AGENT
#define LDS_WAIT() asm volatile("s_waitcnt lgkmcnt(0)" ::: "memory")
#define VM_WAIT() asm volatile("s_waitcnt vmcnt(0)" ::: "memory")

constexpr int D = 1024, NB = 16, S = 2048, T = NB * S;
constexpr int INC = 1952;
constexpr int PJ = 2048;
constexpr int PC_CQ = 0, PC_CKV = 256, PC_KR = 384, PC_QD = 512, PC_KD = 1024, PC_VD = 1536;
constexpr int NE = 32, TOPK = 4, NA = T * TOPK, NROWS = (NA / 256 + NE) * 256, NTILE_MAX = NROWS / 256;
constexpr float LAMBDA_INIT = 0.2f, LOG2E = 1.4426950408889634f;
constexpr float C2M = 0.10206207261596577f * LOG2E;
constexpr float C2D = 0.125f * LOG2E;
#ifndef FP8_SCALE_OPND
#define FP8_SCALE_OPND 0x7f7f7f7f
#endif
constexpr float YR_SCALE = 16.f, YR_INV = 1.f / 16.f;
constexpr float W8_SCALE = 64.f, W8_INV = 1.f / 64.f;

__device__ __forceinline__ unsigned cvt_pk_bf16(float lo, float hi) { unsigned r; asm volatile("v_cvt_pk_bf16_f32 %0, %1, %2" : "=v"(r) : "v"(lo), "v"(hi)); return r; }
__device__ __forceinline__ float sat8(float v) { return __builtin_amdgcn_fmed3f(v, -448.f, 448.f); }
__device__ __forceinline__ unsigned pack4_fp8s(float a, float b, float c, float d);
__device__ __forceinline__ unsigned pack4_fp8(float a, float b, float c, float d) { int w = 0; w = __builtin_amdgcn_cvt_pk_fp8_f32(a, b, w, false); w = __builtin_amdgcn_cvt_pk_fp8_f32(c, d, w, true); return (unsigned)w; }
__device__ __forceinline__ unsigned pack4_fp8s(float a, float b, float c, float d) { return pack4_fp8(sat8(a), sat8(b), sat8(c), sat8(d)); }
__device__ __forceinline__ float bf2f(unsigned short h) { return __uint_as_float((unsigned)h << 16); }
__device__ __forceinline__ float bflo(unsigned w) { return __uint_as_float(w << 16); }
__device__ __forceinline__ float bfhi(unsigned w) { return __uint_as_float(w & 0xffff0000u); }
#define DPPF(v, ctrl) __builtin_bit_cast(float, __builtin_amdgcn_update_dpp(0, __builtin_bit_cast(int, (float)(v)), (ctrl), 0xf, 0xf, true))
__device__ __forceinline__ void swap16(float a, float b, float& x, float& y) { auto r = __builtin_amdgcn_permlane16_swap(__builtin_bit_cast(unsigned, a), __builtin_bit_cast(unsigned, b), false, false); unsigned r0 = r[0], r1 = r[1]; asm volatile("" : "+v"(r0), "+v"(r1)); x = __builtin_bit_cast(float, r0); y = __builtin_bit_cast(float, r1); }
__device__ __forceinline__ void swap32(float a, float b, float& x, float& y) { auto r = __builtin_amdgcn_permlane32_swap(__builtin_bit_cast(unsigned, a), __builtin_bit_cast(unsigned, b), false, false); unsigned r0 = r[0], r1 = r[1]; asm volatile("" : "+v"(r0), "+v"(r1)); x = __builtin_bit_cast(float, r0); y = __builtin_bit_cast(float, r1); }
__device__ __forceinline__ float swap16_sum(float a, float b) { float x, y; swap16(a, b, x, y); return x + y; }
__device__ __forceinline__ float swap32_sum(float a, float b) { float x, y; swap32(a, b, x, y); return x + y; }
__device__ __forceinline__ float swap32_max(float a, float b) { float x, y; swap32(a, b, x, y); return fmaxf(x, y); }
__device__ __forceinline__ float wave_sum(float v) {
    v += DPPF(v, 0xB1); v += DPPF(v, 0x4E); v += DPPF(v, 0x141); v += DPPF(v, 0x140);
    v = swap16_sum(v, v); return swap32_sum(v, v);
}
__device__ __forceinline__ float wave_max(float v) {
    v = fmaxf(v, DPPF(v, 0xB1)); v = fmaxf(v, DPPF(v, 0x4E)); v = fmaxf(v, DPPF(v, 0x141)); v = fmaxf(v, DPPF(v, 0x140));
    { float x, y; swap16(v, v, x, y); v = fmaxf(x, y); }
    return swap32_max(v, v);
}
__device__ __forceinline__ float lane_xor8(float v) { return DPPF(DPPF(v, 0x141), 0x140); }
__device__ __forceinline__ float lane_xor4(float v) { return DPPF(DPPF(v, 0x1B), 0x141); }

namespace pg8 {
constexpr int BM = 256, BK = 64, HALF = 128, HTB = HALF * BK * 2, STAGE_BYTES = 8 * HTB, NXCD = 8, WGM = 8;
__host__ __device__ __forceinline__ int lds_byte(int r, int c) { const int st = (r >> 4) * 2 + (c >> 5), rr = r & 15, cc = c & 31, ob = rr * 64 + cc * 2; return st * 1024 + (ob ^ (((ob >> 9) & 1) << 5)); }
__host__ __device__ __forceinline__ void stage_rc(int b, int& R, int& C) { const int st = b / 1024, sb = b % 1024, swz = sb ^ (((sb >> 9) & 1) << 5); R = (st >> 1) * 16 + swz / 64; C = (st & 1) * 32 + (swz % 64) / 2; }
__host__ __device__ __forceinline__ int perm32(int rho) { const int n = rho >> 4, i = rho & 15; return 8 * (i >> 2) + 4 * n + (i & 3); }

__host__ __device__ __forceinline__ int perm16(int R) { return 64 * (R >> 5) + 16 * ((R & 15) >> 2) + 4 * ((R >> 4) & 1) + (R & 3); }
template <class E, class = void> struct has_perm16 { static constexpr bool value = false; };
template <class E> struct has_perm16<E, decltype((void)E::PERM16)> { static constexpr bool value = E::PERM16; };
struct Unit { int pm, pn, e; };
struct Gemm { const bf16_t* A; const bf16_t* Bt; const int* rowidx; size_t b_estride; int lda, ldb, K, pad; };

struct StaticOrder {
    int nM, nN, nwg, G, c;
    __host__ __device__ void init(int M, int N, int G_, int c_) { nM = M / BM; nN = N / BM; nwg = nM * nN; G = G_; c = c_; }
    __host__ __device__ bool next(int i, Unit& u) const {
        const long L = (long)i * G + c; if (L >= nwg) return false;
        int wgid = (int)L; { const int q = nwg / NXCD, r = nwg % NXCD, xcd = wgid % NXCD, off = wgid / NXCD; wgid = (xcd < r ? xcd * (q + 1) : r * (q + 1) + (xcd - r) * q) + off; }
        const int nig = WGM * nN, gid = wgid / nig, fm = gid * WGM, gsz = (nM - fm) < WGM ? (nM - fm) : WGM;
        u.pm = fm + ((wgid % nig) % gsz); u.pn = (wgid % nig) / gsz; u.e = 0; return true;
    }
};
struct GroupedOrder {
    const LAS int* tile_e; int ntiles, ncol, G, c;
    __device__ bool next(int i, Unit& u) const {
        const int L = i * G + c, xcd = L & 7, j = L >> 3, block = j >> 5, within = j & 31, rpc = 32 / ncol;
        const int r = within / ncol, pn = within % ncol, rt = (block * 8 + xcd) * rpc + r;
        if (rt >= ntiles) return false;
        u.pm = rt; u.pn = pn; u.e = __builtin_amdgcn_readfirstlane(tile_e[rt]); return true;
    }
};

template <class Epi, class Sched, bool GATHER = false, bool FP8 = false>
__device__ __forceinline__ void gemm_phase(LAS unsigned char* lds, const Gemm g, const Sched& S, const Epi& E, LAS unsigned char* idxl = nullptr) {
    int tid_ = threadIdx.x; asm volatile("" : "+v"(tid_));
    const int tid = tid_, wid = __builtin_amdgcn_readfirstlane(tid >> 6), lane = tid & 63, wr = wid >> 2, wc = wid & 3, fr = lane & 15, fq = lane >> 4;
    const int K = g.K, nt = K / BK;
    int Rr[2], Cc[2];
    unsigned voffA[2][2], voffB[2];
#pragma unroll
    for (int i = 0; i < 2; ++i) { stage_rc(tid * 16 + i * 8192, Rr[i], Cc[i]); const int Rb = has_perm16<Epi>::value ? perm16(Rr[i]) : Epi::PERM ? ((Rr[i] & ~31) + perm32(Rr[i] & 31)) : Rr[i];
        voffA[0][i] = (unsigned)(Rr[i] * g.lda + Cc[i]) * 2u; voffA[1][i] = (unsigned)((Rr[i] + HALF) * g.lda + Cc[i]) * 2u; voffB[i] = (unsigned)(Rb * g.ldb + Cc[i]) * 2u; }
    const unsigned kstep = BK * 2, hstepB = (unsigned)((has_perm16<Epi>::value ? 8 : HALF) * g.ldb * 2), tstepA = (unsigned)(BM * g.lda * 2), tstepB = (unsigned)(BM * g.ldb * 2);
    const __amdgpu_buffer_rsrc_t rA = __builtin_amdgcn_make_buffer_rsrc((void*)g.A, 0, 0x7ffffff0, 0x00020000), rB = __builtin_amdgcn_make_buffer_rsrc((void*)g.Bt, 0, 0x7ffffff0, 0x00020000);
    const unsigned ldsw = (unsigned)wid * 1024u;
    const int aoff = lds_byte(wr * 64 + fr, fq * 8), boff = lds_byte(wc * 32 + fr, fq * 8);
#define PG8_SA(b, h) (((b) * 2 + (h)) * HTB)
#define PG8_SB(b, h) ((4 + (b) * 2 + (h)) * HTB)
#define PG8_STAGE(bufoff, rs, soff, voff) do { _Pragma("unroll") for (int _i = 0; _i < 2; ++_i) \
        __builtin_amdgcn_raw_ptr_buffer_load_lds(rs, (LAS void*)(lds + (bufoff) + ldsw + _i * 8192), 16, (int)(voff)[_i], (int)(soff), 0, 0); } while (0)
#define PG8_LDA(dst, b, h) do { _Pragma("unroll") for (int m = 0; m < 4; ++m) _Pragma("unroll") for (int k = 0; k < 2; ++k) dst[m][k] = *(const LAS bf16x8*)(lds + PG8_SA(b, h) + aoff + m * 2048 + k * 1024); } while (0)
#define PG8_LDB(dst, b, h) do { _Pragma("unroll") for (int n = 0; n < 2; ++n) _Pragma("unroll") for (int k = 0; k < 2; ++k) dst[n][k] = *(const LAS bf16x8*)(lds + PG8_SB(b, h) + boff + n * 2048 + k * 1024); } while (0)
#define PG8_MMA(ai, bj, At, Bt) do { __builtin_amdgcn_s_setprio(1); _Pragma("unroll") for (int m = 0; m < 4; ++m) _Pragma("unroll") for (int n = 0; n < 2; ++n) { \
        if constexpr (FP8) acc[ai][bj][m][n] = __builtin_amdgcn_mfma_scale_f32_16x16x128_f8f6f4(PG8_CAT(Bt[n][0], Bt[n][1]), PG8_CAT(At[m][0], At[m][1]), acc[ai][bj][m][n], 0, 0, 0, FP8_SCALE_OPND, 0, FP8_SCALE_OPND); \
        else { _Pragma("unroll") for (int k = 0; k < 2; ++k) acc[ai][bj][m][n] = __builtin_amdgcn_mfma_f32_16x16x32_bf16(Bt[n][k], At[m][k], acc[ai][bj][m][n], 0, 0, 0); } } __builtin_amdgcn_s_setprio(0); } while (0)
#define PG8_CAT(x0, x1) __builtin_shufflevector(__builtin_bit_cast(i32x4, x0), __builtin_bit_cast(i32x4, x1), 0, 1, 2, 3, 4, 5, 6, 7)
#define PG8_WAIT_V(n) asm volatile("s_waitcnt vmcnt(" #n ")" ::: "memory")
#define PG8_WAIT_L(n) asm volatile("s_waitcnt lgkmcnt(" #n ")" ::: "memory")
#define PG8_BAR __builtin_amdgcn_s_barrier()
#define PG8_SCHED __builtin_amdgcn_sched_barrier(0)
    Unit cur, nxt; int ui = 0;
    if (!S.next(0, cur)) return;
    f32x4 acc[2][2][4][2];
#pragma unroll
    for (int a = 0; a < 2; ++a)
#pragma unroll
        for (int b = 0; b < 2; ++b)
#pragma unroll
            for (int m = 0; m < 4; ++m)
#pragma unroll
                for (int n = 0; n < 2; ++n) acc[a][b][m][n] = (f32x4){0.f, 0.f, 0.f, 0.f};
    bf16x8 At[4][2], B0[2][2], B1[2][2];
    unsigned gA[2][2];
    unsigned cA, cB = (unsigned)cur.e * (unsigned)(g.b_estride * 2) + (unsigned)cur.pn * tstepB;
    if constexpr (GATHER) { cA = 0u;
#pragma unroll
        for (int h = 0; h < 2; ++h)
#pragma unroll
            for (int i = 0; i < 2; ++i) gA[h][i] = (unsigned)g.rowidx[cur.pm * BM + h * HALF + Rr[i]] * (unsigned)(g.lda * 2) + (unsigned)Cc[i] * 2u;
    } else { cA = (unsigned)cur.pm * tstepA;
#pragma unroll
        for (int h = 0; h < 2; ++h)
#pragma unroll
            for (int i = 0; i < 2; ++i) gA[h][i] = voffA[h][i]; }
    PG8_STAGE(PG8_SB(0, 0), rB, cB, voffB); PG8_STAGE(PG8_SB(0, 1), rB, cB + hstepB, voffB); PG8_STAGE(PG8_SA(0, 0), rA, cA, gA[0]); PG8_STAGE(PG8_SA(0, 1), rA, cA, gA[1]);
    if (wr == 1) PG8_BAR;
    PG8_WAIT_V(2); PG8_BAR;
    PG8_STAGE(PG8_SB(1, 0), rB, cB + kstep, voffB); PG8_STAGE(PG8_SA(1, 0), rA, cA + kstep, gA[0]); PG8_STAGE(PG8_SB(1, 1), rB, cB + hstepB + kstep, voffB);
    PG8_WAIT_V(6); PG8_BAR;
    for (;;) {
        const bool has_next = S.next(ui + 1, nxt);
        unsigned nA; const unsigned nB = has_next ? (unsigned)nxt.e * (unsigned)(g.b_estride * 2) + (unsigned)nxt.pn * tstepB : cB;
        if constexpr (GATHER) nA = cA; else nA = has_next ? (unsigned)nxt.pm * tstepA : cA;
#pragma nounroll
        for (int t = 0; t < nt; t += 2) {
            const bool last = (t == nt - 2);
            const unsigned a1 = cA + (unsigned)(t + 1) * kstep;
            const unsigned a2 = last ? nA : cA + (unsigned)(t + 2) * kstep, b2 = last ? nB : cB + (unsigned)(t + 2) * kstep;
            const unsigned a3 = a2 + kstep, b3 = b2 + kstep;
            if constexpr (GATHER) { if (t == 0 && has_next && wid < 4)
                __builtin_amdgcn_global_load_lds((const unsigned*)(g.rowidx + nxt.pm * BM + wid * 64 + lane), (LAS unsigned*)(idxl + ((ui + 1) & 1) * 1024 + wid * 256), 4, 0, 0); }
            PG8_LDB(B0, 0, 0); PG8_LDB(B1, 0, 1); PG8_SCHED; PG8_LDA(At, 0, 0); PG8_STAGE(PG8_SA(1, 1), rA, a1, gA[1]);
            if constexpr (GATHER) { if (last && has_next) { int t3 = threadIdx.x; asm volatile("" : "+v"(t3));
#pragma unroll
                for (int i = 0; i < 2; ++i) { int R3, C3; stage_rc(t3 * 16 + i * 8192, R3, C3);
#pragma unroll
                    for (int h = 0; h < 2; ++h) gA[h][i] = *(const LAS unsigned*)(idxl + ((ui + 1) & 1) * 1024 + (h * HALF + R3) * 4) * (unsigned)(g.lda * 2) + (unsigned)C3 * 2u; } } }
            PG8_WAIT_V(8); PG8_WAIT_L(0); PG8_BAR; PG8_MMA(0, 0, At, B0); PG8_MMA(0, 1, At, B1); PG8_BAR; PG8_SCHED;
            PG8_LDA(At, 0, 1); PG8_STAGE(PG8_SB(0, 0), rB, b2, voffB); PG8_STAGE(PG8_SB(0, 1), rB, b2 + hstepB, voffB); PG8_STAGE(PG8_SA(0, 0), rA, a2, gA[0]);
            PG8_WAIT_V(8); PG8_WAIT_L(0); PG8_BAR; PG8_MMA(1, 0, At, B0); PG8_MMA(1, 1, At, B1); PG8_BAR; PG8_SCHED;
            PG8_LDB(B0, 1, 0); PG8_LDB(B1, 1, 1); PG8_SCHED; PG8_LDA(At, 1, 0); PG8_STAGE(PG8_SA(0, 1), rA, a2, gA[1]);
            PG8_WAIT_V(8); PG8_WAIT_L(0); PG8_BAR; PG8_MMA(0, 0, At, B0); PG8_MMA(0, 1, At, B1); PG8_BAR; PG8_SCHED;
            PG8_LDA(At, 1, 1); PG8_STAGE(PG8_SB(1, 0), rB, b3, voffB); PG8_STAGE(PG8_SB(1, 1), rB, b3 + hstepB, voffB); PG8_STAGE(PG8_SA(1, 0), rA, a3, gA[0]);
            PG8_WAIT_V(8); PG8_WAIT_L(0); PG8_BAR; PG8_MMA(1, 0, At, B0); PG8_MMA(1, 1, At, B1); PG8_BAR; PG8_SCHED;
        }
#ifndef PG8_NOALIGN
        if (wr == 0) PG8_BAR;
#endif
        { int t2 = threadIdx.x; asm volatile("" : "+v"(t2)); E(acc, cur, wr, wc, t2 & 15, (t2 >> 4) & 3); }
        if (!has_next) break;
#pragma unroll
        for (int a = 0; a < 2; ++a)
#pragma unroll
            for (int b = 0; b < 2; ++b)
#pragma unroll
                for (int m = 0; m < 4; ++m)
#pragma unroll
                    for (int n = 0; n < 2; ++n) acc[a][b][m][n] = (f32x4){0.f, 0.f, 0.f, 0.f};
        cur = nxt; cA = nA; cB = nB; ++ui;
#ifndef PG8_NOALIGN
        if (wr == 1) PG8_BAR;
#endif
    }
    PG8_WAIT_V(0);
#ifdef PG8_NOALIGN
    if (wr == 0) PG8_BAR;
#endif
    PG8_BAR;
#undef PG8_SA
#undef PG8_SB
#undef PG8_STAGE
#undef PG8_LDA
#undef PG8_LDB
#undef PG8_MMA
#undef PG8_CAT
#undef PG8_WAIT_V
#undef PG8_WAIT_L
#undef PG8_BAR
#undef PG8_SCHED
}
}
namespace epi {
using pg8::Unit; using pg8::HALF; using pg8::BM;
__device__ __forceinline__ u32x4 pack8(f32x4 a, f32x4 b) { u32x4 w; w.x = cvt_pk_bf16(a[0], a[1]); w.y = cvt_pk_bf16(a[2], a[3]); w.z = cvt_pk_bf16(b[0], b[1]); w.w = cvt_pk_bf16(b[2], b[3]); return w; }
__device__ __forceinline__ u32x2 pack4(f32x4 a) { u32x2 w; w.x = cvt_pk_bf16(a[0], a[1]); w.y = cvt_pk_bf16(a[2], a[3]); return w; }
__device__ __forceinline__ void rope4(f32x4& a, f32x4& b, const f32x4 t0, const f32x4 t1) {
    const f32x4 c = {t0[0], t0[2], t1[0], t1[2]}, s = {t0[1], t0[3], t1[1], t1[3]};
    const f32x4 na = a * c - b * s, nb = b * c + a * s; a = na; b = nb;
}
__device__ __forceinline__ void ssq_add(float* ssq, int row, float ss, int fq) { ss += __shfl_xor(ss, 16); ss += __shfl_xor(ss, 32); if (fq == 0) atomicAdd(ssq + row, ss); }
__device__ __forceinline__ float sq8(f32x4 a, f32x4 b) { return (a[0] * a[0] + a[1] * a[1]) + (a[2] * a[2] + a[3] * a[3]) + (b[0] * b[0] + b[1] * b[1]) + (b[2] * b[2] + b[3] * b[3]); }

struct EpiProj {
    static constexpr bool PERM = true;
    bf16_t* P; const f32x4* tabm; const f32x4* tabd; float* ssq_q; float* ssq_kv;
    __device__ __forceinline__ void operator()(const f32x4 (&acc)[2][2][4][2], const Unit& u, int wr, int wc, int fr, int fq) const {
        const int row0 = u.pm * BM + wr * 64 + fr, pn = u.pn;
#pragma unroll
        for (int ai = 0; ai < 2; ++ai)
#pragma unroll
            for (int m = 0; m < 4; ++m) { const int row = row0 + ai * HALF + m * 16; bf16_t* rp = P + (size_t)row * PJ;
                if (pn == 0) { float ss = 0.f;
#pragma unroll
                    for (int bj = 0; bj < 2; ++bj) { const f32x4 v0 = acc[ai][bj][m][0], v1 = acc[ai][bj][m][1]; ss += sq8(v0, v1); *(u32x4*)(rp + bj * HALF + wc * 32 + 8 * fq) = pack8(v0, v1); }
                    ssq_add(ssq_q, row, ss, fq);
                } else if (pn == 1) {
                    { const f32x4 v0 = acc[ai][0][m][0], v1 = acc[ai][0][m][1]; *(u32x4*)(rp + 256 + wc * 32 + 8 * fq) = pack8(v0, v1); ssq_add(ssq_kv, row, sq8(v0, v1), fq); }
                    if (wc == 0) { f32x4 a = acc[ai][1][m][0], b = acc[ai][1][m][1]; const f32x4 t0 = tabm[(size_t)row * 8 + 2 * fq], t1 = tabm[(size_t)row * 8 + 2 * fq + 1]; rope4(a, b, t0, t1);
                        *(u32x2*)(rp + PC_KR + 4 * fq) = pack4(a); *(u32x2*)(rp + PC_KR + 16 + 4 * fq) = pack4(b); }
                } else if (pn < 6) { const int g = 4 * (wc & 1) + fq; const f32x4 t0 = tabd[(size_t)row * 16 + 2 * g], t1 = tabd[(size_t)row * 16 + 2 * g + 1]; const float sc = pn < 4 ? C2D : 1.f;
#pragma unroll
                    for (int bj = 0; bj < 2; ++bj) { f32x4 a = acc[ai][bj][m][0] * sc, b = acc[ai][bj][m][1] * sc; rope4(a, b, t0, t1);
                        bf16_t* bp = rp + pn * 256 + bj * HALF + (wc >> 1) * 64 + 4 * g; *(u32x2*)bp = pack4(a); *(u32x2*)(bp + 32) = pack4(b); }
                } else {
#pragma unroll
                    for (int bj = 0; bj < 2; ++bj) *(u32x4*)(rp + pn * 256 + bj * HALF + wc * 32 + 8 * fq) = pack8(acc[ai][bj][m][0], acc[ai][bj][m][1]);
                }
            }
    }
};
struct EpiQ {
    static constexpr bool PERM = true;
    bf16_t* Q; const f32x4* tabm; const float* ssq_q;
    __device__ __forceinline__ void operator()(const f32x4 (&acc)[2][2][4][2], const Unit& u, int wr, int wc, int fr, int fq) const {
        const int row0 = u.pm * BM + wr * 64 + fr;
        if (u.pn < 2) {
#pragma unroll
            for (int ai = 0; ai < 2; ++ai)
#pragma unroll
                for (int m = 0; m < 4; ++m) { const int row = row0 + ai * HALF + m * 16; const float rs = rsqrtf(ssq_q[row] * (1.f / 256.f) + 1e-6f) * C2M; bf16_t* rp = Q + (size_t)row * 768 + u.pn * BM + wc * 32 + 8 * fq;
#pragma unroll
                    for (int bj = 0; bj < 2; ++bj) *(u32x4*)(rp + bj * HALF) = pack8(acc[ai][bj][m][0] * rs, acc[ai][bj][m][1] * rs); }
        } else {
#pragma unroll
            for (int ai = 0; ai < 2; ++ai)
#pragma unroll
                for (int m = 0; m < 4; ++m) { const int row = row0 + ai * HALF + m * 16; const float rs = rsqrtf(ssq_q[row] * (1.f / 256.f) + 1e-6f) * C2M; bf16_t* rp = Q + (size_t)row * 768 + 512 + wc * 32 + 4 * fq;
                    const f32x4 t0 = tabm[(size_t)row * 8 + 2 * fq], t1 = tabm[(size_t)row * 8 + 2 * fq + 1];
#pragma unroll
                    for (int bj = 0; bj < 2; ++bj) { f32x4 a = acc[ai][bj][m][0] * rs, b = acc[ai][bj][m][1] * rs; rope4(a, b, t0, t1); *(u32x2*)(rp + bj * 128) = pack4(a); *(u32x2*)(rp + bj * 128 + 16) = pack4(b); }
                    asm volatile("" ::: "memory"); }
        }
    }
};
struct EpiKV {
    static constexpr bool PERM = true;
    bf16_t* KV; const float* ssq_kv;
    __device__ __forceinline__ void operator()(const f32x4 (&acc)[2][2][4][2], const Unit& u, int wr, int wc, int fr, int fq) const {
        const int row0 = u.pm * BM + wr * 64 + fr;
#pragma unroll
        for (int ai = 0; ai < 2; ++ai)
#pragma unroll
            for (int m = 0; m < 4; ++m) { const int row = row0 + ai * HALF + m * 16; const float rs = rsqrtf(ssq_kv[row] * (1.f / 128.f) + 1e-6f); bf16_t* rp = KV + (size_t)row * 1024 + u.pn * BM + wc * 32 + 8 * fq;
#pragma unroll
                for (int bj = 0; bj < 2; ++bj) *(u32x4*)(rp + bj * HALF) = pack8(acc[ai][bj][m][0] * rs, acc[ai][bj][m][1] * rs); }
    }
};
struct EpiY {
    static constexpr bool PERM = true;
    bf16_t* Y;
    __device__ __forceinline__ void operator()(const f32x4 (&acc)[2][2][4][2], const Unit& u, int wr, int wc, int fr, int fq) const {
        const __amdgpu_buffer_rsrc_t rY = __builtin_amdgcn_make_buffer_rsrc((void*)Y, 0, T * 1024 * 2, 0x00020000);
        const int row0 = u.pm * BM + wr * 64 + fr, col = u.pn * BM + wc * 32 + 8 * fq;
#pragma unroll
        for (int ai = 0; ai < 2; ++ai)
#pragma unroll
            for (int m = 0; m < 4; ++m) { const int row = row0 + ai * HALF + m * 16;
#pragma unroll
                for (int bj = 0; bj < 2; ++bj) __builtin_amdgcn_raw_buffer_store_b128(pack8(acc[ai][bj][m][0], acc[ai][bj][m][1]), rY, (row * 1024 + col + bj * HALF) * 2, 0, 0); }
    }
};
struct EpiAct {
    static constexpr bool PERM = true;
    unsigned char* ACT; const float* bgu;
    __device__ __forceinline__ void operator()(const f32x4 (&acc)[2][2][4][2], const Unit& u, int wr, int wc, int fr, int fq) const {
        const __amdgpu_buffer_rsrc_t rA = __builtin_amdgcn_make_buffer_rsrc((void*)ACT, 0, 0x7ffffff0, 0x00020000), rB = __builtin_amdgcn_make_buffer_rsrc((void*)bgu, 0, NE * 2048 * 4, 0x00020000);
        const int row0 = u.pm * BM + wr * 64 + fr, j0 = u.pn * 128 + wc * 32 + 8 * fq;
        f32x4 bg[2], bu[2];
#pragma unroll
        for (int n = 0; n < 2; ++n) { bg[n] = __builtin_bit_cast(f32x4, __builtin_amdgcn_raw_buffer_load_b128(rB, (u.e * 2048 + j0 + 4 * n) * 4, 0, 0)); bu[n] = __builtin_bit_cast(f32x4, __builtin_amdgcn_raw_buffer_load_b128(rB, (u.e * 2048 + 1024 + j0 + 4 * n) * 4, 0, 0)); }
#pragma unroll
        for (int ai = 0; ai < 2; ++ai)
#pragma unroll
            for (int m = 0; m < 4; ++m) { const int row = row0 + ai * HALF + m * 16; u32x2 o;
#pragma unroll
                for (int n = 0; n < 2; ++n) { const f32x4 gv = acc[ai][0][m][n] * W8_INV + bg[n], uv = acc[ai][1][m][n] * W8_INV + bu[n]; float a4[4];
#pragma unroll
                    for (int i = 0; i < 4; ++i) { const float gg = fminf(gv[i], 7.f), uu = fminf(fmaxf(uv[i], -7.f), 7.f); a4[i] = gg * __builtin_amdgcn_rcpf(1.f + __builtin_amdgcn_exp2f(-1.702f * LOG2E * gg)) * (uu + 1.f); }
                    o[n] = pack4_fp8(a4[0], a4[1], a4[2], a4[3]); }
                __builtin_amdgcn_raw_buffer_store_b64(o, rA, row * 1024 + j0, 0, 0); }
    }
};
struct EpiDown {
    static constexpr bool PERM = true, PERM16 = true;
    unsigned char* YR; const float* bd; const float* roww;
    __device__ __forceinline__ void operator()(const f32x4 (&acc)[2][2][4][2], const Unit& u, int wr, int wc, int fr, int fq) const {
        const __amdgpu_buffer_rsrc_t rY = __builtin_amdgcn_make_buffer_rsrc((void*)YR, 0, 0x7ffffff0, 0x00020000), rB = __builtin_amdgcn_make_buffer_rsrc((void*)bd, 0, NE * 1024 * 4, 0x00020000),
                                     rW = __builtin_amdgcn_make_buffer_rsrc((void*)roww, 0, NROWS * 4, 0x00020000);
        const int row0 = u.pm * BM + wr * 64 + fr, col = u.pn * BM + wc * 64 + 16 * fq, boff = (u.e * 1024 + col) * 4;
#pragma unroll
        for (int ai = 0; ai < 2; ++ai) {
            f32x4 bv[2][2];
#pragma unroll
            for (int bj = 0; bj < 2; ++bj)
#pragma unroll
                for (int n = 0; n < 2; ++n) bv[bj][n] = __builtin_bit_cast(f32x4, __builtin_amdgcn_raw_buffer_load_b128(rB, boff + (8 * bj + 4 * n) * 4, 0, 0));
#pragma unroll
            for (int m = 0; m < 4; ++m) { const int row = row0 + ai * HALF + m * 16; const float ww = YR_SCALE * __builtin_bit_cast(float, __builtin_amdgcn_raw_buffer_load_b32(rW, row * 4, 0, 0)), w8 = ww * W8_INV; u32x4 o;
#pragma unroll
                for (int bj = 0; bj < 2; ++bj)
#pragma unroll
                    for (int n = 0; n < 2; ++n) { const f32x4 v = acc[ai][bj][m][n] * w8 + bv[bj][n] * ww; o[2 * bj + n] = pack4_fp8s(v[0], v[1], v[2], v[3]); }
                __builtin_amdgcn_raw_buffer_store_b128(o, rY, row * 1024 + col, 0, 0); }
            asm volatile("" ::: "memory"); }
    }
};
}
constexpr size_t MiB = 1u << 20;
constexpr size_t WS_CTL = 0, CTL_ZERO_BYTES = 64 * 1024;
constexpr size_t WS_MOD = 1 * MiB;
constexpr size_t WS_SSQ = 1 * MiB + 512 * 1024;
constexpr size_t WS_TABM = 2 * MiB, WS_TABD = 6 * MiB;
constexpr size_t WS_SE = 14 * MiB, WS_SG = 14 * MiB + 512 * 1024, WS_SRANK = 18 * MiB + 512 * 1024;
constexpr size_t WS_POS = 15 * MiB;
constexpr size_t WS_ROWTOK = 16 * MiB, WS_ROWW = 17 * MiB;
constexpr size_t WS_CNT = 18 * MiB;
constexpr size_t WS_TD0 = 19 * MiB;
constexpr size_t WS_WIN = 20 * MiB, WS_WQB = 24 * MiB, WS_WKVB = 25 * MiB, WS_WO = 26 * MiB;
constexpr size_t WS_WGU = 28 * MiB, WS_WD = 156 * MiB;
constexpr size_t WS_H = 220 * MiB;
constexpr size_t WS_PROJ = 284 * MiB;
constexpr size_t WS_QM = 412 * MiB, WS_KVM = 460 * MiB, WS_ATT = 524 * MiB, WS_Y = 588 * MiB;
constexpr size_t WS_X1 = 524 * MiB;
constexpr size_t WS_ACT = 284 * MiB;
constexpr size_t WS_YR = 588 * MiB;
constexpr size_t WS_END = 860 * MiB;
static_assert(WS_ACT + (size_t)NROWS * 1024 * 2 <= WS_YR && WS_YR + (size_t)NROWS * 1024 * 2 <= WS_END, "ws map");
constexpr int CW_BAR = 4096;

constexpr int RING_OFF = 0, RING_BYTES = 131072;
constexpr int LDSCTL_OFF = RING_BYTES, MISC_OFF = LDSCTL_OFF + 320;
constexpr int XTRA_OFF = MISC_OFF + 128;
constexpr int X_TILEE = XTRA_OFF;
constexpr int X_SE = X_TILEE + 2304, X_SG = X_SE + 2048, X_SRANK = X_SG + 2048, X_WCNT = X_SRANK + 2048, X_MISC2 = X_WCNT + 1024;
constexpr int X_IDX = X_MISC2 + 1024;
constexpr int X_CONST = 147456;
constexpr int LDS_BYTES = 163840;
static_assert(X_IDX + 2048 <= X_CONST && X_CONST + 12288 <= LDS_BYTES, "LDS map");
constexpr int NWAVES = 8;

#define XB_TMO      128
#define XB_XCNT(j)  (256  + 64 * (j))
#define XB_XSUB(j)  (1280 + 64 * (j))
#define XB_XGEN(j)  (2304 + 64 * (j))
#define XB_TOP      3328
#define XB_TOPGEN   3392
#define XCD_BAR_WORDS 3456
#define XB_SPIN_CAP (1u << 18)
__device__ __forceinline__ unsigned xb_ld(unsigned* p)              { return __hip_atomic_load(p, __ATOMIC_RELAXED, __HIP_MEMORY_SCOPE_AGENT); }
__device__ __forceinline__ unsigned xb_add(unsigned* p, unsigned v) { return __hip_atomic_fetch_add(p, v, __ATOMIC_RELAXED, __HIP_MEMORY_SCOPE_AGENT); }
__device__ __forceinline__ unsigned xb_xcc_id() { return (unsigned)__builtin_amdgcn_s_getreg((3 << 11) | 20) & 0xFu; }
#define XB_SPIN(cond, bar) do { unsigned _sp = 0; while (cond) { __builtin_amdgcn_s_sleep(1); \
    if ((++_sp & 255u) == 0u) { if (xb_ld(&(bar)[XB_TMO])) break; if (_sp > XB_SPIN_CAP) { atomicAdd(&(bar)[XB_TMO], 1u); break; } } } } while (0)
struct XcdBarrier { unsigned* bar; unsigned x; volatile LAS unsigned* st; };
__device__ __forceinline__ XcdBarrier xcd_barrier_post(unsigned* bar, volatile LAS unsigned* st) {
    XcdBarrier b; b.bar = bar; b.x = xb_xcc_id(); b.st = st;
    if (threadIdx.x == 0) (void)xb_add(&bar[XB_XCNT(b.x)], 1u);
    return b;
}
__device__ __forceinline__ void xcd_barrier_complete(unsigned* bar, unsigned x, unsigned& nloc, unsigned& nx) {
    const unsigned G = gridDim.x * gridDim.y * gridDim.z;
    unsigned sum, cnt, mine, sp = 0u;
    for (;;) {
        sum = 0u; cnt = 0u; mine = 0u;
#pragma unroll
        for (unsigned j = 0; j < 16; ++j) { const unsigned c = xb_ld(&bar[XB_XCNT(j)]); sum += c; cnt += (c > 0u) ? 1u : 0u; mine = (j == x) ? c : mine; }
        if (sum == G) break;
        __builtin_amdgcn_s_sleep(1);
        if ((++sp & 255u) == 0u) { if (xb_ld(&bar[XB_TMO])) break; if (sp > XB_SPIN_CAP) { atomicAdd(&bar[XB_TMO], 1u); break; } }
    }
    nloc = mine > 0u ? mine : 1u; nx = cnt > 0u ? cnt : 1u;
}
__device__ __forceinline__ void xcd_barrier(const XcdBarrier& b) {
    asm volatile("s_waitcnt vmcnt(0)" ::: "memory");
    __syncthreads();
    if (threadIdx.x == 0) {
        unsigned* bar = b.bar;
        __builtin_amdgcn_s_waitcnt(0);
        unsigned nloc = b.st[0], nx = b.st[1];
        if (nloc == 0u) { xcd_barrier_complete(bar, b.x, nloc, nx); b.st[0] = nloc; b.st[1] = nx; }
        const unsigned old = xb_add(&bar[XB_XSUB(b.x)], 1u);
        const unsigned gen = old / nloc;
        if (old + 1u == (gen + 1u) * nloc) {
            __builtin_amdgcn_fence(__ATOMIC_RELEASE, "agent");
            asm volatile("s_waitcnt vmcnt(0)" ::: "memory");
            const unsigned og = xb_add(&bar[XB_TOP], 1u);
            const unsigned tg = og / nx;
            if (og + 1u == (tg + 1u) * nx) xb_add(&bar[XB_TOPGEN], 1u);
            else XB_SPIN(xb_ld(&bar[XB_TOPGEN]) == tg, bar);
            __builtin_amdgcn_fence(__ATOMIC_ACQUIRE, "agent");
            xb_add(&bar[XB_XGEN(b.x)], 1u);
            asm volatile("s_waitcnt vmcnt(0)" ::: "memory");
        } else {
            XB_SPIN(xb_ld(&bar[XB_XGEN(b.x)]) == gen, bar);
            __builtin_amdgcn_fence(__ATOMIC_ACQUIRE, "agent");
            asm volatile("s_waitcnt vmcnt(0)" ::: "memory");
        }
    }
    __syncthreads();
}

struct Args { const float* in[26]; float* out; unsigned char* ws; int ph_lo, ph_hi, li, pad; };
struct Frame {
    LAS unsigned char* lds; volatile LAS unsigned* MISC; unsigned* ctl;
    int G, bid;
    const Args* a;
};
#define PHASE_IDS() int tid_ = threadIdx.x; asm volatile("" : "+v"(tid_)); const int tid = tid_, lane = tid & 63, wave = __builtin_amdgcn_readfirstlane(tid >> 6); (void)lane; (void)wave
#define IN_X 0
#define IN_C 1
#define IN_POS 2
#define IN_WADA 3
#define IN_BADA 4
#define IN_GMIXPRE 5
#define IN_GMIXPOST 6
#define IN_WIN 7
#define IN_GQA 8
#define IN_WQB 9
#define IN_GKVA 10
#define IN_WKVB 11
#define IN_LQ1 12
#define IN_LK1 13
#define IN_LQ2 14
#define IN_LK2 15
#define IN_GSUBLN 16
#define IN_WO 17
#define IN_GFFNPRE 18
#define IN_GFFNPOST 19
#define IN_WROUTER 20
#define IN_BROUTER 21
#define IN_WGU 22
#define IN_BGU 23
#define IN_WDN 24
#define IN_BDN 25

template <class Map>
__device__ __forceinline__ void transpose_item(const float* W, int K, int N, bf16_t* WT, const float* gain, Map dst, LAS float* scr, int item, int lane) {
    const int nblk = N / 32, kb = item / nblk, nb = item % nblk, k0 = 64 * kb, n0 = 32 * nb;
    { float v[32];
#pragma unroll
      for (int i = 0; i < 32; ++i) v[i] = W[(size_t)(k0 + 2 * i + (lane >> 5)) * N + n0 + (lane & 31)];
#pragma unroll
      for (int i = 0; i < 32; ++i) scr[(2 * i + (lane >> 5)) * 33 + (lane & 31)] = v[i]; }
    LDS_WAIT(); asm volatile("" ::: "memory");
    const int c = lane & 7;
    float gk[8];
#pragma unroll
    for (int i = 0; i < 8; ++i) gk[i] = gain ? gain[k0 + 8 * c + i] : 1.f;
#pragma unroll
    for (int j = 0; j < 4; ++j) { const int n = (lane >> 3) + 8 * j; const LAS float* s = scr + (8 * c) * 33 + n;
        u32x4 o; o.x = cvt_pk_bf16(s[0 * 33] * gk[0], s[1 * 33] * gk[1]); o.y = cvt_pk_bf16(s[2 * 33] * gk[2], s[3 * 33] * gk[3]); o.z = cvt_pk_bf16(s[4 * 33] * gk[4], s[5 * 33] * gk[5]); o.w = cvt_pk_bf16(s[6 * 33] * gk[6], s[7 * 33] * gk[7]);
        *(GAS u32x4*)(WT + (size_t)dst(n0 + n) * K + k0 + 8 * c) = o; }
    LDS_WAIT(); asm volatile("" ::: "memory");
}
template <class Map>
__device__ __forceinline__ void transpose8_stream(const float* W, int N, unsigned char* WT, Map dst, LAS float* scr, int first, int stride, int lane) {
    const int nblk = N / 32, per_e = 8 * nblk, total = NE * per_e;
    if (first >= total) return;
    float v[32];
    auto src = [&](int it, int hb) -> const float* { const int e = it / per_e, r = it - e * per_e, kb = r / nblk, nb = r - kb * nblk; return W + ((size_t)e * 1024 + 128 * kb + 64 * hb + (lane >> 5)) * N + 32 * nb + (lane & 31); };
    { const float* p = src(first, 0);
#pragma unroll
      for (int i = 0; i < 32; ++i) v[i] = p[(size_t)(2 * i) * N]; }
    for (int it = first; it < total; it += stride) {
#pragma unroll
        for (int hb = 0; hb < 2; ++hb) {
            float w[32];
#pragma unroll
            for (int i = 0; i < 32; ++i) w[i] = v[i];
            const int nit = hb == 0 ? it : it + stride;
            if (nit < total) { const float* p = src(nit, hb ^ 1);
#pragma unroll
                for (int i = 0; i < 32; ++i) v[i] = p[(size_t)(2 * i) * N]; }
#pragma unroll
            for (int i = 0; i < 32; ++i) { const int kk = 64 * hb + 2 * i + (lane >> 5); scr[kk * 32 + ((lane & 31) ^ (kk & 31) ^ (((kk >> 5) & 3) << 2))] = w[i]; }
        }
        LDS_WAIT(); asm volatile("" ::: "memory");
        const int e = it / per_e, r = it - e * per_e, kb = r / nblk, nb = r - kb * nblk, c = lane & 7;
#pragma unroll
        for (int j = 0; j < 4; ++j) { const int n = (lane >> 3) + 8 * j; float t[16];
#pragma unroll
            for (int i = 0; i < 16; ++i) { const int kk = 16 * c + i; t[i] = scr[kk * 32 + (n ^ (kk & 31) ^ (((kk >> 5) & 3) << 2))] * W8_SCALE; }
            u32x4 o; o.x = pack4_fp8(t[0], t[1], t[2], t[3]); o.y = pack4_fp8(t[4], t[5], t[6], t[7]); o.z = pack4_fp8(t[8], t[9], t[10], t[11]); o.w = pack4_fp8(t[12], t[13], t[14], t[15]);
            *(GAS u32x4*)(WT + ((size_t)e * N + dst(32 * nb + n)) * 1024 + 128 * kb + 16 * c) = o; }
        LDS_WAIT(); asm volatile("" ::: "memory");
    }
}
__device__ __forceinline__ int il4(int i, int x2) { return 8 * (i >> 2) + 4 * x2 + (i & 3); }
struct MapWin { __device__ int operator()(int n) const {
    if (n < 384) return n;
    if (n < 416) { const int r = n - 384; return PC_KR + il4(r & 15, r >> 4); }
    if (n < 1440) { const int r = n - 416, hj = r >> 6, d = r & 63; return PC_QD + hj * 64 + il4(d & 31, d >> 5); }
    return PC_VD + (n - 1440); } };
struct MapWqb { __device__ int operator()(int n) const { const int h = n / 96, d = n - h * 96; if (d < 64) return h * 64 + d; const int r = d - 64; return 512 + h * 32 + il4(r & 15, r >> 4); } };
struct MapId { __device__ int operator()(int n) const { return n; } };
struct MapWgu { __device__ int operator()(int n) const { const int which = n >> 10, j = n & 1023; return (j >> 7) * 256 + which * 128 + (j & 127); } };

__device__ __forceinline__ void p0_prologue(Frame& F) {
    PHASE_IDS();
    float* mod = (float*)(F.a->ws + WS_MOD);
    if (F.bid < 192) {
        LAS float* cact = (LAS float*)(F.lds);
        LAS float* red = (LAS float*)(F.lds + 65536);
        const float* c = F.a->in[IN_C];
        { float cv[32];
#pragma unroll
          for (int i = 0; i < 32; ++i) cv[i] = c[tid + 512 * i];
#pragma unroll
          for (int i = 0; i < 32; ++i) cact[tid + 512 * i] = cv[i] / (1.f + __expf(-cv[i])); }
        __syncthreads();
        const int n0 = 32 * F.bid, col = tid & 31, kg = tid >> 5;
        float acc[16];
#pragma unroll
        for (int b = 0; b < 16; ++b) acc[b] = 0.f;
        const float* wp = F.a->in[IN_WADA] + (size_t)(kg * 64) * 6144 + n0 + col;
#pragma unroll
        for (int q = 0; q < 2; ++q) { float w[32];
#pragma unroll
            for (int kk = 0; kk < 32; ++kk) w[kk] = wp[(size_t)(32 * q + kk) * 6144];
#pragma unroll
            for (int kk = 0; kk < 32; ++kk)
#pragma unroll
                for (int b = 0; b < 16; ++b) acc[b] += cact[b * 1024 + kg * 64 + 32 * q + kk] * w[kk]; }
#pragma unroll
        for (int b = 0; b < 16; ++b) red[(kg * 16 + b) * 32 + col] = acc[b];
        __syncthreads();
        { const int b = tid >> 5; float s = 0.f;
#pragma unroll
          for (int k2 = 0; k2 < 16; ++k2) s += red[(k2 * 16 + b) * 32 + col];
          mod[b * 6144 + n0 + col] = s + F.a->in[IN_BADA][n0 + col]; }
        __syncthreads();
    }
    { float* ssq = (float*)(F.a->ws + WS_SSQ); for (int i = F.bid * 512 + tid; i < 3 * T; i += F.G * 512) ssq[i] = 0.f;
      u32x4* wz = (u32x4*)((bf16_t*)(F.a->ws + WS_WIN) + (size_t)416 * 1024); for (int i = F.bid * 512 + tid; i < 96 * 1024 / 8; i += F.G * 512) wz[i] = (u32x4){0u, 0u, 0u, 0u}; }
    { const int* pos = (const int*)F.a->in[IN_POS]; float2* tabm = (float2*)(F.a->ws + WS_TABM); float2* tabd = (float2*)(F.a->ws + WS_TABD);
      for (int gid = F.bid * 512 + tid; gid < T * 48; gid += F.G * 512) { const int t = gid / 48, i = gid - t * 48; const float p = (float)pos[t];
          if (i < 16) { const float inv = powf(10000.f, -(float)(2 * i) / 32.f); const double a = (double)(p * inv); tabm[t * 16 + i] = make_float2((float)cos(a), (float)sin(a)); }
          else { const int j = i - 16; const float inv = powf(10000.f, -(float)(2 * j) / 64.f); const double a = (double)(p * inv); tabd[t * 32 + j] = make_float2((float)cos(a), (float)sin(a)); } } }
    LAS float* scr = (LAS float*)(F.lds + RING_OFF + wave * 16384);
    const int gw = F.bid * NWAVES + wave, NGW = F.G * NWAVES;
    constexpr int I_WIN = 16 * 61, I_WQB = 4 * 24, I_WKVB = 2 * 32, I_WO = 16 * 32;
    constexpr int NITEMS = I_WIN + I_WQB + I_WKVB + I_WO;
    for (int it = gw; it < NITEMS; it += NGW) {
        int r = it;
        if (r < I_WIN) { transpose_item(F.a->in[IN_WIN], 1024, INC, (bf16_t*)(F.a->ws + WS_WIN), nullptr, MapWin{}, scr, r, lane); continue; } r -= I_WIN;
        if (r < I_WQB) { transpose_item(F.a->in[IN_WQB], 256, 768, (bf16_t*)(F.a->ws + WS_WQB), F.a->in[IN_GQA], MapWqb{}, scr, r, lane); continue; } r -= I_WQB;
        if (r < I_WKVB) { transpose_item(F.a->in[IN_WKVB], 128, 1024, (bf16_t*)(F.a->ws + WS_WKVB), F.a->in[IN_GKVA], MapId{}, scr, r, lane); continue; } r -= I_WKVB;
        transpose_item(F.a->in[IN_WO], 1024, 1024, (bf16_t*)(F.a->ws + WS_WO), nullptr, MapId{}, scr, r, lane);
    }
    transpose8_stream(F.a->in[IN_WGU], 2048, (unsigned char*)(F.a->ws + WS_WGU), MapWgu{}, scr, gw, NGW, lane);
    transpose8_stream(F.a->in[IN_WDN], 1024, (unsigned char*)(F.a->ws + WS_WD), MapId{}, scr, gw, NGW, lane);
}
__device__ __forceinline__ void p0b_norm(Frame& F) {
    PHASE_IDS();
    const float* mod = (const float*)(F.a->ws + WS_MOD); bf16_t* H = (bf16_t*)(F.a->ws + WS_H);
    const int tok0 = F.bid * 128 + wave * 16, b = (F.bid * 128) / S;
    f32x4 g[4], sh[4];
#pragma unroll
    for (int j = 0; j < 4; ++j) { const int c = 4 * lane + 256 * j; g[j] = *(const f32x4*)(F.a->in[IN_GMIXPRE] + c) * (*(const f32x4*)(mod + b * 6144 + 1024 + c) + 1.f); sh[j] = *(const f32x4*)(mod + b * 6144 + c); }
    for (int i = 0; i < 16; i += 4) {
        f32x4 v[4][4];
#pragma unroll
        for (int r = 0; r < 4; ++r)
#pragma unroll
            for (int j = 0; j < 4; ++j) v[r][j] = *((const GAS f32x4*)(F.a->in[IN_X] + (size_t)(tok0 + i + r) * D) + lane + 64 * j);
#pragma unroll
        for (int r = 0; r < 4; ++r) { float ss = 0.f;
#pragma unroll
            for (int j = 0; j < 4; ++j) ss += (v[r][j].x * v[r][j].x + v[r][j].y * v[r][j].y) + (v[r][j].z * v[r][j].z + v[r][j].w * v[r][j].w);
            const float rs = rsqrtf(wave_sum(ss) * (1.f / D) + 1e-6f);
            GAS u32x2* o8 = (GAS u32x2*)(H + (size_t)(tok0 + i + r) * D) + lane;
#pragma unroll
            for (int j = 0; j < 4; ++j) { const f32x4 h = (v[r][j] * rs) * g[j] + sh[j]; u32x2 w; w.x = cvt_pk_bf16(h[0], h[1]); w.y = cvt_pk_bf16(h[2], h[3]); o8[64 * j] = w; } }
    }
}
__device__ __forceinline__ void p5_rows(Frame& F) {
    PHASE_IDS();
    LAS float* wt = (LAS float*)(F.lds + RING_OFF);
    for (int idx = tid; idx < NE * 1024; idx += 512) { const int e = idx >> 10, k = idx & 1023; wt[idx] = F.a->in[IN_WROUTER][k * NE + e]; }
    LAS int* se = (LAS int*)(F.lds + X_SE); LAS float* sg = (LAS float*)(F.lds + X_SG);
    const float* mod = (const float*)(F.a->ws + WS_MOD); const float* ssq_y = (const float*)(F.a->ws + WS_SSQ) + 2 * T;
    const bf16_t* Y = (const bf16_t*)(F.a->ws + WS_Y); unsigned char* H2 = (unsigned char*)(F.a->ws + WS_H); bf16_t* X1 = (bf16_t*)(F.a->ws + WS_X1);
    const int tok0 = F.bid * 128 + wave * 16, b = (F.bid * 128) / S;
    LAS float* cst = (LAS float*)(F.lds + X_CONST);
    for (int c = tid; c < 1024; c += 512) { cst[c] = F.a->in[IN_GMIXPOST][c] * mod[b * 6144 + 2048 + c]; cst[1024 + c] = F.a->in[IN_GFFNPRE][c] * (mod[b * 6144 + 4096 + c] + 1.f); cst[2048 + c] = mod[b * 6144 + 3072 + c]; }
    f32x4 xn[2][4]; u32x2 yn[2][4];
#define P5_PRE(r_) do { _Pragma("unroll") for (int q_ = 0; q_ < 2; ++q_) { _Pragma("unroll") for (int j = 0; j < 4; ++j) { xn[q_][j] = *(const GAS f32x4*)(F.a->in[IN_X] + (size_t)((r_) + q_) * D + 4 * lane + 256 * j); yn[q_][j] = *(const GAS u32x2*)(Y + (size_t)((r_) + q_) * D + 4 * lane + 256 * j); } } } while (0)
    P5_PRE(tok0);
    __syncthreads();
#pragma nounroll
    for (int i = 0; i < 16; i += 2) {
        const int row = tok0 + i;
        f32x2 hp[4][4];
        {   f32x4 xv[2][4]; u32x2 yv[2][4]; float rsy[2];
#pragma unroll
            for (int q = 0; q < 2; ++q) { float sy = 0.f;
#pragma unroll
                for (int j = 0; j < 4; ++j) { xv[q][j] = xn[q][j]; yv[q][j] = yn[q][j]; const float a0 = bflo(yv[q][j].x), a1 = bfhi(yv[q][j].x), a2 = bflo(yv[q][j].y), a3 = bfhi(yv[q][j].y); sy += (a0 * a0 + a1 * a1) + (a2 * a2 + a3 * a3); }
                rsy[q] = rsqrtf(wave_sum(sy) * (1.f / D) + 1e-6f); }
            if (i + 2 < 16) P5_PRE(row + 2);
            f32x4 gpost[4], gpre[4], shf[4];
#pragma unroll
            for (int j = 0; j < 4; ++j) { gpost[j] = *(const LAS f32x4*)(cst + 4 * lane + 256 * j); gpre[j] = *(const LAS f32x4*)(cst + 1024 + 4 * lane + 256 * j); shf[j] = *(const LAS f32x4*)(cst + 2048 + 4 * lane + 256 * j); }
#pragma unroll
            for (int q = 0; q < 2; ++q) { f32x4 x1[4]; float ss = 0.f;
#pragma unroll
                for (int j = 0; j < 4; ++j) { const f32x4 yy = {bflo(yv[q][j].x), bfhi(yv[q][j].x), bflo(yv[q][j].y), bfhi(yv[q][j].y)}; x1[j] = xv[q][j] + (yy * rsy[q]) * gpost[j];
                    ss += (x1[j][0] * x1[j][0] + x1[j][1] * x1[j][1]) + (x1[j][2] * x1[j][2] + x1[j][3] * x1[j][3]);
                    { u32x2 w; w.x = cvt_pk_bf16(x1[j][0], x1[j][1]); w.y = cvt_pk_bf16(x1[j][2], x1[j][3]); *(GAS u32x2*)(X1 + (size_t)(row + q) * D + 4 * lane + 256 * j) = w; } }
                const float r1 = rsqrtf(wave_sum(ss) * (1.f / D) + 1e-6f);
#pragma unroll
                for (int j = 0; j < 4; ++j) { const f32x4 h = (x1[j] * r1) * gpre[j] + shf[j]; *(GAS unsigned*)(H2 + (size_t)(row + q) * D + 4 * lane + 256 * j) = pack4_fp8s(h[0], h[1], h[2], h[3]);
#pragma unroll
                    for (int c = 0; c < 4; ++c) hp[j][c][q] = h[c]; } } }
        f32x2 v[32];
#pragma unroll
        for (int e = 0; e < NE; ++e) { const LAS f32x4* wp = (const LAS f32x4*)(wt + e * 1024 + 4 * lane); f32x2 p = {0.f, 0.f};
#pragma unroll
            for (int j = 0; j < 4; ++j) { const f32x4 w = wp[64 * j]; p = p + hp[j][0] * w[0]; p = p + hp[j][1] * w[1]; p = p + hp[j][2] * w[2]; p = p + hp[j][3] * w[3]; }
            v[e] = p; if ((e & 3) == 3) __builtin_amdgcn_sched_barrier(0); }
        const int my_e = lane >> 1; const float brt = F.a->in[IN_BROUTER][my_e];
#define P5_REDUCE(Q) do { float u_[16]; \
            _Pragma("unroll") for (int j = 0; j < 16; ++j) u_[j] = swap32_sum(v[j][Q], v[16 + j][Q]); \
            _Pragma("unroll") for (int j = 0; j < 8; ++j) u_[j] = swap16_sum(u_[j], u_[8 + j]); \
            _Pragma("unroll") for (int j = 0; j < 4; ++j) { const bool up = (lane & 8) != 0; const float keep = up ? u_[4 + j] : u_[j], send = up ? u_[j] : u_[4 + j]; u_[j] = keep + lane_xor8(send); } \
            _Pragma("unroll") for (int j = 0; j < 2; ++j) { const bool up = (lane & 4) != 0; const float keep = up ? u_[2 + j] : u_[j], send = up ? u_[j] : u_[2 + j]; u_[j] = keep + lane_xor4(send); } \
            { const bool up = (lane & 2) != 0; const float keep = up ? u_[1] : u_[0], send = up ? u_[0] : u_[1]; u_[0] = keep + DPPF(send, 0x4E); } \
            float lg = u_[0] + DPPF(u_[0], 0xB1) + brt; \
            float vals[4]; int idx[4]; \
            _Pragma("unroll") for (int k = 0; k < 4; ++k) { const float mx = wave_max(lg); const unsigned long long bm = __ballot(lg == mx); const int wl = __builtin_ctzll(bm); vals[k] = mx; idx[k] = wl >> 1; if (my_e == idx[k]) lg = -INFINITY; } \
            float ex[4], den = 0.f; \
            _Pragma("unroll") for (int k = 0; k < 4; ++k) { ex[k] = __expf(vals[k] - vals[0]); den += ex[k]; } \
            const float inv = 1.f / den; \
            if (lane < 4) { const int a = (wave * 16 + i + Q) * 4 + lane; se[a] = lane == 0 ? idx[0] : lane == 1 ? idx[1] : lane == 2 ? idx[2] : idx[3]; sg[a] = (lane == 0 ? ex[0] : lane == 1 ? ex[1] : lane == 2 ? ex[2] : ex[3]) * inv; } \
            __builtin_amdgcn_sched_barrier(0); } while (0)
        P5_REDUCE(0);
        P5_REDUCE(1);
#undef P5_REDUCE
    }
#undef P5_PRE
#define P5_LOAD(x)
#undef P5_LOAD
    __syncthreads();
    LAS int* srank = (LAS int*)(F.lds + X_SRANK); LAS int* wcnt = (LAS int*)(F.lds + X_WCNT);
    const int e_my = se[tid]; int rk = 0;
    for (int e = 0; e < NE; ++e) { const unsigned long long bm = __ballot(e_my == e); if (e_my == e) rk = __builtin_popcountll(bm & ((1ull << lane) - 1ull)); if (lane == 0) wcnt[wave * 32 + e] = __builtin_popcountll(bm); }
    __syncthreads();
    int base = 0;
    for (int w = 0; w < wave; ++w) base += wcnt[w * 32 + e_my];
    srank[tid] = base + rk;
    { const int a = F.bid * 512 + tid; ((int*)(F.a->ws + WS_SE))[a] = e_my; ((float*)(F.a->ws + WS_SG))[a] = sg[tid]; ((int*)(F.a->ws + WS_SRANK))[a] = base + rk; }
    if (tid < NE) { int tot = 0; for (int w = 0; w < 8; ++w) tot += wcnt[w * 32 + tid]; ((int*)(F.a->ws + WS_CNT))[F.bid * NE + tid] = tot; }
}
__device__ __forceinline__ void p9_final(Frame& F) {
    PHASE_IDS();
    const float* mod = (const float*)(F.a->ws + WS_MOD); const unsigned char* YR = (const unsigned char*)(F.a->ws + WS_YR); const int* pos = (const int*)(F.a->ws + WS_POS);
    const int tok0 = F.bid * 128 + wave * 16, b = (F.bid * 128) / S;
    f32x4 gf[4];
#pragma unroll
    for (int j = 0; j < 4; ++j) { const int c = 4 * lane + 256 * j; gf[j] = *(const f32x4*)(F.a->in[IN_GFFNPOST] + c) * *(const f32x4*)(mod + b * 6144 + 5120 + c); }
    unsigned yn[4][4]; u32x2 xn[4]; const bf16_t* X1 = (const bf16_t*)(F.a->ws + WS_X1);
#define P9_LOAD(row) do { _Pragma("unroll") for (int s_ = 0; s_ < 4; ++s_) { const int pr = __builtin_amdgcn_readfirstlane(pos[(row) * 4 + s_]); _Pragma("unroll") for (int j = 0; j < 4; ++j) yn[s_][j] = *(const GAS unsigned*)(YR + (size_t)pr * D + 4 * lane + 256 * j); } \
        _Pragma("unroll") for (int j = 0; j < 4; ++j) xn[j] = *(const GAS u32x2*)(X1 + (size_t)(row) * D + 4 * lane + 256 * j); } while (0)
    P9_LOAD(tok0);
    for (int i = 0; i < 16; ++i) {
        const int row = tok0 + i;
        f32x4 y[4], x1[4]; float ss = 0.f;
#pragma unroll
        for (int j = 0; j < 4; ++j) { y[j] = (f32x4){0.f, 0.f, 0.f, 0.f};
#pragma unroll
            for (int s_ = 0; s_ < 4; ++s_) { const unsigned w = yn[s_][j]; const f32x2 lo = __builtin_amdgcn_cvt_pk_f32_fp8((int)w, false), hi2 = __builtin_amdgcn_cvt_pk_f32_fp8((int)w, true); y[j] += (f32x4){lo[0], lo[1], hi2[0], hi2[1]}; }
            y[j] = y[j] * YR_INV; x1[j] = (f32x4){bflo(xn[j].x), bfhi(xn[j].x), bflo(xn[j].y), bfhi(xn[j].y)}; ss += (y[j][0] * y[j][0] + y[j][1] * y[j][1]) + (y[j][2] * y[j][2] + y[j][3] * y[j][3]); }
        if (i + 1 < 16) P9_LOAD(row + 1);
        const float r = rsqrtf(wave_sum(ss) * (1.f / D) + 1e-6f);
#pragma unroll
        for (int j = 0; j < 4; ++j) *(GAS f32x4*)(F.a->out + (size_t)row * D + 4 * lane + 256 * j) = x1[j] + (y[j] * r) * gf[j];
    }
#undef P9_LOAD
}
namespace att {
#define SBAR() __builtin_amdgcn_sched_barrier(0)
typedef short s16x4 __attribute__((ext_vector_type(4)));
typedef short v4i16_t __attribute__((ext_vector_type(4)));
typedef __attribute__((address_space(3))) const char* lds_cptr;
__device__ __forceinline__ int crow(int r, int hi) { return (r & 3) + 8 * (r >> 2) + 4 * hi; }
__device__ __forceinline__ void glds16(const void* gsrc, unsigned lds_dst) { unsigned keep;
    asm volatile("s_mov_b32 %0, m0\n\ts_mov_b32 m0, %2\n\ts_nop 0\n\tglobal_load_lds_dwordx4 %1, off\n\ts_mov_b32 m0, %0" : "=&s"(keep) : "v"(gsrc), "s"(lds_dst) : "memory"); }
__device__ __forceinline__ s16x4 vtr(lds_cptr p) { return __builtin_bit_cast(s16x4, __builtin_amdgcn_ds_read_tr16_b64_v4i16((__attribute__((address_space(3))) v4i16_t*)p)); }
typedef float f32x2_t __attribute__((ext_vector_type(2))); typedef __bf16 bf16x2_t __attribute__((ext_vector_type(2)));
__device__ __forceinline__ unsigned cvtpk_s(float lo, float hi) { f32x2_t v = {lo, hi}; bf16x2_t b = __builtin_convertvector(v, bf16x2_t); return __builtin_bit_cast(unsigned, b); }
#define WAIT_BAR0() asm volatile("s_waitcnt vmcnt(0) lgkmcnt(0)\n\ts_barrier" ::: "memory")

struct Src {
    const bf16_t* q0; const bf16_t* q1; int qp;
    const bf16_t* k0; const bf16_t* k1; int kp0, kp1;
    const bf16_t* v; int vp;
};
template <int DQK, int DV> struct Geo {
    static constexpr int NKC = DQK / 8, NVB = DV / 32, KSLOT = NKC * 1024, VSLOT = NVB * 4096, NPIECE = NKC + 4 * NVB;
    static constexpr int NSLOT = 3, LDS_K = 0, LDS_V = NSLOT * KSLOT, LDS_WS = LDS_V + NSLOT * VSLOT, LDS_OST = 0  , LDS_TOTAL = LDS_WS + 8 * 256;
    static_assert(8 * 32 * DV * 2 <= LDS_WS && LDS_TOTAL <= 131072, "attention LDS map");
};
constexpr float THR = 8.f;
#ifndef ATT_VPM
#define ATT_VPM 8
#endif

template <int DQK, int DV, int MODE>
__device__ __forceinline__ void attn_unit(LAS char* shm, const Src sc, int qb, bf16_t* obase, float* td, float lam, const float* gsub) {
    typedef Geo<DQK, DV> G;
    int tid_ = threadIdx.x; asm volatile("" : "+v"(tid_));
    const int tid = tid_, lane = tid & 63, r32 = lane & 31, hi = lane >> 5; const int wid = __builtin_amdgcn_readfirstlane(tid >> 6);
    const int q0 = qb * 256, NT = 4 * (qb + 1);
    const unsigned lds0 = (unsigned)(uintptr_t)shm;
    LAS float* wsf = (LAS float*)(shm + G::LDS_WS) + wid * 64;
    const char* ksrc[2]; const char* vsrc[2]; long kstep[2], vstep;
#pragma unroll
    for (int i = 0; i < 2; ++i) { const int p = wid + 8 * i; ksrc[i] = nullptr; kstep[i] = 0; vsrc[i] = nullptr;
        if (p < G::NKC) { const bf16_t* base = p < 8 ? sc.k0 + 8 * p : sc.k1 + 8 * (p - 8); const int pitch = p < 8 ? sc.kp0 : sc.kp1; ksrc[i] = (const char*)(base + (long)lane * pitch); kstep[i] = 128L * pitch; }
        if (p < 4 * G::NVB) { const int db = p >> 2, rg = p & 3; vsrc[i] = (const char*)(sc.v + (long)(16 * rg + (lane >> 2)) * sc.vp + 32 * db + 8 * (lane & 3)); } }
    vstep = 128L * sc.vp;
#define DMA_K(slot) do { _Pragma("unroll") for (int i_ = 0; i_ < 2; ++i_) if (wid + 8 * i_ < G::NKC) { glds16(ksrc[i_], (unsigned)__builtin_amdgcn_readfirstlane(lds0 + G::LDS_K + (wid + 8 * i_) * 1024 + (slot) * G::KSLOT)); ksrc[i_] += kstep[i_]; } } while (0)
#define DMA_V(slot) do { _Pragma("unroll") for (int i_ = 0; i_ < 2; ++i_) if (wid + 8 * i_ < 4 * G::NVB) { glds16(vsrc[i_], (unsigned)__builtin_amdgcn_readfirstlane(lds0 + G::LDS_V + (wid + 8 * i_) * 1024 + (slot) * G::VSLOT)); vsrc[i_] += vstep; } } while (0)
    DMA_K(0); DMA_V(0); DMA_K(1); DMA_V(1); DMA_K(2);
    bf16x8 qr[DQK / 16];
    { const long qrow = (long)(q0 + wid * 32 + r32) * sc.qp;
#pragma unroll
      for (int d0 = 0; d0 < DQK / 16; ++d0) qr[d0] = d0 < 4 ? *reinterpret_cast<const bf16x8*>(sc.q0 + qrow + d0 * 16 + hi * 8) : *reinterpret_cast<const bf16x8*>(sc.q1 + qrow + (d0 - 4) * 16 + hi * 8); }
    float m_run = 0.f, l_reg = 0.f; bool first = true;
    f32x16 negm = f32x16{};
    f32x16 o[G::NVB];
#pragma unroll
    for (int d = 0; d < G::NVB; ++d) o[d] = f32x16{};
    const int qrel = wid * 32 + r32;
    const lds_cptr shm3 = (lds_cptr)shm;
    const lds_cptr kp0 = shm3 + G::LDS_K + hi * 1024 + r32 * 16;
    const lds_cptr vp0 = shm3 + G::LDS_V + ((lane >> 4) & 1) * 32 + (lane & 3) * 8 + (4 * hi + ((lane & 15) >> 2)) * 64;
#define QKT(P0, P1, slot) do { const lds_cptr kp_ = kp0 + (slot) * G::KSLOT; _Pragma("unroll") for (int d0 = 0; d0 < DQK / 16; ++d0) { \
        const bf16x8 b0_ = *(const __attribute__((address_space(3))) bf16x8*)(kp_ + d0 * 2048), b1_ = *(const __attribute__((address_space(3))) bf16x8*)(kp_ + d0 * 2048 + 512); \
        if (d0 == 0) { P0 = __builtin_amdgcn_mfma_f32_32x32x16_bf16(b0_, qr[0], negm, 0, 0, 0); P1 = __builtin_amdgcn_mfma_f32_32x32x16_bf16(b1_, qr[0], negm, 0, 0, 0); } \
        else { P0 = __builtin_amdgcn_mfma_f32_32x32x16_bf16(b0_, qr[d0], P0, 0, 0, 0); P1 = __builtin_amdgcn_mfma_f32_32x32x16_bf16(b1_, qr[d0], P1, 0, 0, 0); } } } while (0)
#define ACTIVE(t_) (!((t_) - (NT - 4) >= 0 && 64 * ((t_) - (NT - 4)) > 32 * wid + 31))
    int s_cur = 0, s_nx1 = 1, s_nx2 = 2;
    const bool three = (wid + 8 < G::NKC ? 2 : 1) + (wid + 8 < 4 * G::NVB ? 2 : 1) == 3;
    f32x16 sc0 = f32x16{}, sc1 = f32x16{}, sn0 = f32x16{}, sn1 = f32x16{};
    asm volatile("s_waitcnt vmcnt(0) lgkmcnt(0)\n\ts_barrier" ::: "memory");
    QKT(sc0, sc1, 0);
    for (int t = 0; t < NT; ++t) {
        if (t + 3 < NT) { if (three) asm volatile("s_waitcnt vmcnt(3) lgkmcnt(0)\n\ts_barrier" ::: "memory"); else asm volatile("s_waitcnt vmcnt(2) lgkmcnt(0)\n\ts_barrier" ::: "memory"); }
        else WAIT_BAR0();
        if (t + 3 < NT) DMA_K(s_cur);
        if (t + 2 < NT) DMA_V(s_nx2);
        const int jb = t - (NT - 4);
        const bool act = ACTIVE(t), nxt = (t + 1 < NT) && ACTIVE(t + 1);
        if (!act) { const int tmp = s_cur; s_cur = s_nx1; s_nx1 = s_nx2; s_nx2 = tmp; continue; }
        if (jb >= 0) { const int kb = 64 * jb + 4 * hi;
#pragma unroll
            for (int r = 0; r < 16; ++r) { const int kv = kb + (r & 3) + 8 * (r >> 2); if (kv > qrel) sc0[r] = -INFINITY; if (kv + 32 > qrel) sc1[r] = -INFINITY; } }
        float rm = fmaxf(sc0[0], sc1[0]);
#pragma unroll
        for (int r = 1; r < 16; ++r) rm = fmaxf(rm, fmaxf(sc0[r], sc1[r]));
        rm = swap32_max(rm, rm);
        if (first || __any(rm > THR)) {
            const float dl = first ? rm : fmaxf(rm, 0.f), f = first ? 1.f : __builtin_amdgcn_exp2f(-dl); m_run += dl; l_reg *= f; first = false;
#pragma unroll
            for (int r = 0; r < 16; ++r) { sc0[r] -= dl; sc1[r] -= dl; negm[r] = -m_run; }
            if (hi == 0) wsf[r32] = f;
            asm volatile("s_waitcnt lgkmcnt(0)" ::: "memory");
#pragma unroll
            for (int g = 0; g < 4; ++g) { const f32x4 fv = *(const LAS f32x4*)(wsf + 8 * g + 4 * hi);
#pragma unroll
                for (int d = 0; d < G::NVB; ++d) { o[d][4 * g] *= fv[0]; o[d][4 * g + 1] *= fv[1]; o[d][4 * g + 2] *= fv[2]; o[d][4 * g + 3] *= fv[3]; } }
        }
        u32x4 pw[4];
        if (nxt) {
            constexpr int ND0 = DQK / 16, NG = 2 * ND0;
            const lds_cptr kpn = kp0 + s_nx1 * G::KSLOT;
            float sacc = 0.f;
            bf16x8 kb0 = *(const __attribute__((address_space(3))) bf16x8*)(kpn), kb1 = *(const __attribute__((address_space(3))) bf16x8*)(kpn + 512), nb0 = kb0, nb1 = kb1;
#define ATT_GAP(g_) do { _Pragma("unroll") for (int e_ = ((g_) * 32) / NG; e_ < (((g_) + 1) * 32) / NG; ++e_) { \
                if (e_ < 16) { sc0[e_] = __builtin_amdgcn_exp2f(sc0[e_]); sacc += sc0[e_]; } else { sc1[e_ - 16] = __builtin_amdgcn_exp2f(sc1[e_ - 16]); sacc += sc1[e_ - 16]; } } \
                asm volatile("" : "+v"(sacc), "+v"(sc0), "+v"(sc1)); SBAR(); } while (0)
#pragma unroll
            for (int d0 = 0; d0 < ND0; ++d0) {
                if (d0 + 1 < ND0) { nb0 = *(const __attribute__((address_space(3))) bf16x8*)(kpn + (d0 + 1) * 2048); nb1 = *(const __attribute__((address_space(3))) bf16x8*)(kpn + (d0 + 1) * 2048 + 512); }
                sn0 = d0 == 0 ? __builtin_amdgcn_mfma_f32_32x32x16_bf16(kb0, qr[0], negm, 0, 0, 0) : __builtin_amdgcn_mfma_f32_32x32x16_bf16(kb0, qr[d0], sn0, 0, 0, 0);
                ATT_GAP(2 * d0);
                sn1 = d0 == 0 ? __builtin_amdgcn_mfma_f32_32x32x16_bf16(kb1, qr[0], negm, 0, 0, 0) : __builtin_amdgcn_mfma_f32_32x32x16_bf16(kb1, qr[d0], sn1, 0, 0, 0);
                ATT_GAP(2 * d0 + 1);
                kb0 = nb0; kb1 = nb1;
            }
#undef ATT_GAP
            l_reg += sacc;
#pragma unroll
            for (int k = 0; k < 4; ++k) { pw[0][k] = cvtpk_s(sc0[2 * k], sc0[2 * k + 1]); pw[1][k] = cvtpk_s(sc0[8 + 2 * k], sc0[8 + 2 * k + 1]); pw[2][k] = cvtpk_s(sc1[2 * k], sc1[2 * k + 1]); pw[3][k] = cvtpk_s(sc1[8 + 2 * k], sc1[8 + 2 * k + 1]); }
        } else {
            float sacc = 0.f;
#pragma unroll
            for (int r = 0; r < 16; ++r) { sc0[r] = __builtin_amdgcn_exp2f(sc0[r]); sc1[r] = __builtin_amdgcn_exp2f(sc1[r]); sacc += sc0[r] + sc1[r]; }
            l_reg += sacc;
#pragma unroll
            for (int k = 0; k < 4; ++k) { pw[0][k] = cvtpk_s(sc0[2 * k], sc0[2 * k + 1]); pw[1][k] = cvtpk_s(sc0[8 + 2 * k], sc0[8 + 2 * k + 1]); pw[2][k] = cvtpk_s(sc1[2 * k], sc1[2 * k + 1]); pw[3][k] = cvtpk_s(sc1[8 + 2 * k], sc1[8 + 2 * k + 1]); }
        }
        const lds_cptr vpp = vp0 + s_cur * G::VSLOT;
#pragma unroll
        for (int d = 0; d < G::NVB; ++d) {
#pragma unroll
            for (int ks = 0; ks < 4; ++ks) { const s16x4 lo = vtr(vpp + d * 4096 + ks * 1024), hh = vtr(vpp + d * 4096 + ks * 1024 + 512);
                const bf16x8 vf = {lo[0], lo[1], lo[2], lo[3], hh[0], hh[1], hh[2], hh[3]};
                o[d] = __builtin_amdgcn_mfma_f32_32x32x16_bf16(__builtin_bit_cast(bf16x8, pw[ks]), vf, o[d], 0, 0, 0); } }
        sc0 = sn0; sc1 = sn1;
        { const int tmp = s_cur; s_cur = s_nx1; s_nx1 = s_nx2; s_nx2 = tmp; }
    }
#undef QKT
#undef ACTIVE
#undef DMA_K
#undef DMA_V
    l_reg = swap32_sum(l_reg, l_reg);
    if (hi == 0) wsf[32 + r32] = l_reg;
    asm volatile("s_waitcnt lgkmcnt(0)" ::: "memory");
    float rli[16];
#pragma unroll
    for (int r = 0; r < 16; ++r) rli[r] = __builtin_amdgcn_rcpf(wsf[32 + crow(r, hi)]);
    const long orow0 = (long)(q0 + wid * 32);
    if (MODE == 1) {
#pragma unroll
        for (int r = 0; r < 16; ++r)
#pragma unroll
            for (int d = 0; d < G::NVB; ++d) td[(orow0 + crow(r, hi)) * 512 + d * 32 + r32] = o[d][r] * rli[r];
    } else {
        if (MODE == 2) {
            float ssr[16];
#pragma unroll
            for (int r = 0; r < 16; ++r) { float ss = 0.f;
#pragma unroll
                for (int d = 0; d < G::NVB; ++d) { const float v = td[(orow0 + crow(r, hi)) * 512 + d * 32 + r32] - lam * (o[d][r] * rli[r]); o[d][r] = v; ss += v * v; }
#pragma unroll
                for (int x = 1; x < 32; x <<= 1) ss += __shfl_xor(ss, x);
                ssr[r] = rsqrtf(ss * (1.f / DV) + 1e-5f) * (1.f - LAMBDA_INIT); }
#pragma unroll
            for (int d = 0; d < G::NVB; ++d) { const float gv = gsub[d * 32 + r32];
#pragma unroll
                for (int r = 0; r < 16; ++r) o[d][r] *= ssr[r] * gv; }
#pragma unroll
            for (int r = 0; r < 16; ++r) rli[r] = 1.f;
        }
        asm volatile("s_waitcnt lgkmcnt(0)\n\ts_barrier" ::: "memory");
        LAS bf16_t* stg = (LAS bf16_t*)(shm + G::LDS_OST) + wid * 32 * DV;
#pragma unroll
        for (int r = 0; r < 16; ++r) { const int orow = crow(r, hi);
#pragma unroll
            for (int d = 0; d < G::NVB; ++d) stg[orow * DV + d * 32 + r32] = (bf16_t)(cvtpk_s(o[d][r] * rli[r], 0.f) & 0xffffu); }
        asm volatile("s_waitcnt lgkmcnt(0)" ::: "memory");
        constexpr int CPR = DV / 8;
#pragma unroll
        for (int i = 0; i < 32 * CPR / 64; ++i) { const int idx = i * 64 + lane, row = idx / CPR, ch = idx % CPR; const u32x4 v = *(const LAS u32x4*)(stg + row * DV + ch * 8);
            *(u32x4*)(obase + (orow0 + row) * 1024 + ch * 8) = v; }
    }
    __builtin_amdgcn_s_setprio(0);
    asm volatile("s_waitcnt vmcnt(0) lgkmcnt(0)\n\ts_barrier" ::: "memory");
}
#undef SBAR
#undef WAIT_BAR0
}

__device__ __forceinline__ void attn_phase_all(Frame& F) {
    LAS char* shm = (LAS char*)(F.lds + RING_OFF);
    const int vcu = (F.bid & 7) * (F.G >> 3) + (F.bid >> 3);
    const bf16_t* QM = (const bf16_t*)(F.a->ws + WS_QM); const bf16_t* KVM = (const bf16_t*)(F.a->ws + WS_KVM); const bf16_t* PR = (const bf16_t*)(F.a->ws + WS_PROJ); bf16_t* ATT = (bf16_t*)(F.a->ws + WS_ATT);
    { const int p = vcu >> 1, b = p >> 3, h = p & 7, half = vcu & 1; const long r0 = (long)b * S;
      att::Src sc{QM + r0 * 768 + h * 64, QM + r0 * 768 + 512 + h * 32, 768, KVM + r0 * 1024 + h * 128, PR + r0 * PJ + PC_KR, 1024, PJ, KVM + r0 * 1024 + h * 128 + 64, 1024};
      for (int i = 0; i < 4; ++i) { const int qb = half == 0 ? (i == 0 ? 7 : i == 1 ? 5 : i == 2 ? 2 : 0) : (i == 0 ? 6 : i == 1 ? 4 : i == 2 ? 3 : 1);
          att::attn_unit<96, 64, 0>(shm, sc, qb, ATT + r0 * 1024 + h * 64, nullptr, 0.f, nullptr); } }
    { const int p = vcu >> 2, b = p >> 2, h = p & 3, s4 = vcu & 3; const long r0 = (long)b * S;
      float lam; { const float* l1 = F.a->in[IN_LQ1]; const float* k1 = F.a->in[IN_LK1]; const float* l2 = F.a->in[IN_LQ2]; const float* k2 = F.a->in[IN_LK2]; float s1 = 0.f, s2 = 0.f;
          for (int i = 0; i < 64; ++i) { s1 += l1[i] * k1[i]; s2 += l2[i] * k2[i]; } lam = __expf(s1) - __expf(s2) + LAMBDA_INIT; }
      float* td = (float*)(F.a->ws + WS_Y) + r0 * 512 + h * 128;
      for (int i = 0; i < 2; ++i) { const int qb = i == 0 ? 7 - s4 : s4;
          att::Src s0{PR + r0 * PJ + PC_QD + (2 * h) * 64, nullptr, PJ, PR + r0 * PJ + PC_KD + (2 * h) * 64, nullptr, PJ, PJ, PR + r0 * PJ + PC_VD + h * 128, PJ};
          att::Src s1{PR + r0 * PJ + PC_QD + (2 * h + 1) * 64, nullptr, PJ, PR + r0 * PJ + PC_KD + (2 * h + 1) * 64, nullptr, PJ, PJ, PR + r0 * PJ + PC_VD + h * 128, PJ};
          att::attn_unit<64, 128, 1>(shm, s0, qb, nullptr, td, 0.f, nullptr);
          att::attn_unit<64, 128, 2>(shm, s1, qb, ATT + r0 * 1024 + 512 + h * 128, td, lam, F.a->in[IN_GSUBLN]); } }
}
__device__ __forceinline__ void offsets_from_counts(Frame& F) {
    PHASE_IDS();
    int* cnt = (int*)(F.a->ws + WS_CNT);
    LAS int* part = (LAS int*)(F.lds + RING_OFF);
    LAS int* tile_e = (LAS int*)(F.lds + X_TILEE); LAS int* m2 = (LAS int*)(F.lds + X_MISC2);
    { const int e = tid & 31, p = tid >> 5; int tot = 0, pre = 0;
      for (int w = p * 16; w < p * 16 + 16; ++w) { const int c = __hip_atomic_load(cnt + w * NE + e, RLX_AGENT); tot += c; if (w < F.bid) pre += c; }
      part[(p * 32 + e) * 2] = tot; part[(p * 32 + e) * 2 + 1] = pre; }
    __syncthreads();
    if (tid < NE) { int tot = 0, pre = 0; for (int p = 0; p < 16; ++p) { tot += part[(p * 32 + tid) * 2]; pre += part[(p * 32 + tid) * 2 + 1]; } m2[96 + tid] = tot; m2[64 + tid] = pre; }
    __syncthreads();
    if (tid < NE) { int st = 0; for (int e = 0; e < tid; ++e) st += (m2[96 + e] + 255) & ~255; m2[32 + tid] = st; const int pad = (m2[96 + tid] + 255) & ~255;
        for (int r = st; r < st + pad; r += 256) tile_e[r >> 8] = tid; if (tid == NE - 1) m2[0] = (st + pad) >> 8; }
    __syncthreads();
}
__device__ __forceinline__ void p6_scatter(Frame& F) {
    offsets_from_counts(F);
    PHASE_IDS();
    LAS int* m2 = (LAS int*)(F.lds + X_MISC2);
    int* rowtok = (int*)(F.a->ws + WS_ROWTOK); float* roww = (float*)(F.a->ws + WS_ROWW); int* pos = (int*)(F.a->ws + WS_POS);
    { const int a = F.bid * 512 + tid; const int e = ((const int*)(F.a->ws + WS_SE))[a]; const float gt = ((const float*)(F.a->ws + WS_SG))[a]; const int rk = ((const int*)(F.a->ws + WS_SRANK))[a];
      const int dst = m2[32 + e] + m2[64 + e] + rk, tok = F.bid * 128 + (tid >> 2);
      rowtok[dst] = tok; roww[dst] = gt; pos[tok * 4 + (tid & 3)] = dst; }
    if (F.bid < NE && tid < 256) { const int e = F.bid, tot = m2[96 + e], st = m2[32 + e], pad = (tot + 255) & ~255; const int r = st + tot + tid; if (r < st + pad) { rowtok[r] = 0; roww[r] = 0.f; } }
}

#ifdef DEV_NAIVE_ATTN
template <int MODE>
__global__ void __launch_bounds__(256) k_attn_ref(const bf16_t* QM, const bf16_t* KVM, const bf16_t* PROJ, bf16_t* ATT, float* TD, const float* lq1, const float* lk1, const float* lq2, const float* lk2, const float* gsub) {
    constexpr int DQK = MODE == 0 ? 96 : 64, DV = MODE == 0 ? 64 : 128, NH = MODE == 0 ? 8 : 4;
    __shared__ float Ks[32][DQK]; __shared__ float Vs[32][DV];
    const int bh = blockIdx.y, b = bh / NH, h = bh % NH, q = blockIdx.x * 256 + threadIdx.x, tid = threadIdx.x, t = b * S + q;
    float lam = 0.f;
    if (MODE == 1) { float s1 = 0.f, s2 = 0.f; for (int i = 0; i < 64; ++i) { s1 += lq1[i] * lk1[i]; s2 += lq2[i] * lk2[i]; } lam = expf(s1) - expf(s2) + LAMBDA_INIT; }
    float res[DV];
    for (int j = 0; j < (MODE == 0 ? 1 : 2); ++j) {
        float qv[DQK]; float o[DV];
#pragma unroll
        for (int d = 0; d < DQK; ++d) qv[d] = MODE == 0 ? bf2f(QM[(size_t)t * 768 + (d < 64 ? h * 64 + d : 512 + h * 32 + d - 64)]) : bf2f(PROJ[(size_t)t * PJ + PC_QD + (2 * h + j) * 64 + d]);
#pragma unroll
        for (int d = 0; d < DV; ++d) o[d] = 0.f;
        float m = -1e30f, l = 0.f;
        const int kend = blockIdx.x * 256 + 256;
        for (int k0 = 0; k0 < kend; k0 += 32) {
            __syncthreads();
            for (int i = tid; i < 32 * DQK; i += 256) { const int kk = i / DQK, d = i % DQK; const size_t tk = (size_t)b * S + k0 + kk;
                Ks[kk][d] = MODE == 0 ? (d < 64 ? bf2f(KVM[tk * 1024 + h * 128 + d]) : bf2f(PROJ[tk * PJ + PC_KR + d - 64])) : bf2f(PROJ[tk * PJ + PC_KD + (2 * h + j) * 64 + d]); }
            for (int i = tid; i < 32 * DV; i += 256) { const int kk = i / DV, d = i % DV; const size_t tk = (size_t)b * S + k0 + kk;
                Vs[kk][d] = MODE == 0 ? bf2f(KVM[tk * 1024 + h * 128 + 64 + d]) : bf2f(PROJ[tk * PJ + PC_VD + h * 128 + d]); }
            __syncthreads();
            for (int kk = 0; kk < 32; ++kk) {
                if (k0 + kk > q) break;
                float s = 0.f;
#pragma unroll
                for (int d = 0; d < DQK; ++d) s += qv[d] * Ks[kk][d];
                const float mn = fmaxf(m, s), al = exp2f(m - mn), p = exp2f(s - mn);
                l = l * al + p; m = mn;
#pragma unroll
                for (int d = 0; d < DV; ++d) o[d] = o[d] * al + p * Vs[kk][d];
            }
        }
        const float inv = 1.f / l;
        if (MODE == 0) {
#pragma unroll
            for (int d = 0; d < DV; ++d) ATT[(size_t)t * D + h * 64 + d] = (bf16_t)(cvt_pk_bf16(o[d] * inv, 0.f) & 0xffffu);
        } else if (j == 0) {
#pragma unroll
            for (int d = 0; d < DV; ++d) TD[((size_t)t * 4 + h) * 128 + d] = o[d] * inv;
        } else { float ss = 0.f;
#pragma unroll
            for (int d = 0; d < DV; ++d) { res[d] = TD[((size_t)t * 4 + h) * 128 + d] - lam * (o[d] * inv); ss += res[d] * res[d]; }
            const float r = rsqrtf(ss * (1.f / 128.f) + 1e-5f) * (1.f - LAMBDA_INIT);
#pragma unroll
            for (int d = 0; d < DV; ++d) ATT[(size_t)t * D + 512 + h * 128 + d] = (bf16_t)(cvt_pk_bf16(res[d] * r * gsub[d], 0.f) & 0xffffu);
        }
    }
}
#endif

constexpr int N_PHASES = 11;
__global__ void __launch_bounds__(NWAVES * 64, 2) mk_fwd(Args args) {
    extern __shared__ __attribute__((aligned(16))) unsigned char lds[];
    Frame F;
    F.lds = (LAS unsigned char*)lds; F.MISC = (volatile LAS unsigned*)(F.lds + MISC_OFF);
    F.G = gridDim.x; F.bid = blockIdx.x;
    F.a = &args; F.ctl = (unsigned*)(args.ws + WS_CTL);
    for (int u = threadIdx.x; u < (X_TILEE - LDSCTL_OFF) / 4; u += NWAVES * 64) ((LAS unsigned*)(F.lds + LDSCTL_OFF))[u] = 0u;
    __syncthreads();
    const int lo = args.ph_lo, hi = args.ph_hi;
#ifdef LEAK_LO
    if (LEAK_LO == 0 && threadIdx.x == 0) F.MISC[16] = (unsigned)__builtin_amdgcn_s_memrealtime();
#endif
    XcdBarrier bar; bar.bar = F.ctl + CW_BAR; bar.x = 0; bar.st = nullptr;
    if (hi - lo > 1) bar = xcd_barrier_post(F.ctl + CW_BAR + args.li * XCD_BAR_WORDS, F.MISC + 8);
#ifndef PH_MASK
#define PH_MASK 0x7ff
#endif
#define IN(k) (((PH_MASK >> (k)) & 1) && lo <= (k) && (k) < hi)
#ifdef LEAK_LO
#define SEAM(k) do { if (IN(k) && IN((k) + 1)) xcd_barrier(bar); if (((k) + 1 == LEAK_LO || (k) + 1 == LEAK_HI) && threadIdx.x == 0) F.MISC[(k) + 1 == LEAK_LO ? 16 : 17] = (unsigned)__builtin_amdgcn_s_memrealtime(); } while (0)
#else
#define SEAM(k) do { if (IN(k) && IN((k) + 1)) xcd_barrier(bar); } while (0)
#endif
    LAS unsigned char* ring = F.lds + RING_OFF;
    if (IN(0)) { p0_prologue(F); } SEAM(0);
    if (IN(1)) { p0b_norm(F); } SEAM(1);
    if (IN(2)) {
        pg8::Gemm g{(const bf16_t*)(F.a->ws + WS_H), (const bf16_t*)(F.a->ws + WS_WIN), nullptr, 0, D, D, D, 0}; pg8::StaticOrder So; So.init(T, PJ, F.G, F.bid);
        epi::EpiProj E{(bf16_t*)(F.a->ws + WS_PROJ), (const f32x4*)(F.a->ws + WS_TABM), (const f32x4*)(F.a->ws + WS_TABD), (float*)(F.a->ws + WS_SSQ), (float*)(F.a->ws + WS_SSQ) + T};
        pg8::gemm_phase<epi::EpiProj, pg8::StaticOrder, false>(ring, g, So, E);
    } SEAM(2);
    if (IN(3)) {
#ifndef NO_Q
        { pg8::Gemm g{(const bf16_t*)(F.a->ws + WS_PROJ) + PC_CQ, (const bf16_t*)(F.a->ws + WS_WQB), nullptr, 0, PJ, 256, 256, 0}; pg8::StaticOrder So; So.init(T, 768, F.G, F.bid);
          epi::EpiQ E{(bf16_t*)(F.a->ws + WS_QM), (const f32x4*)(F.a->ws + WS_TABM), (const float*)(F.a->ws + WS_SSQ)};
          pg8::gemm_phase<epi::EpiQ, pg8::StaticOrder, false>(ring, g, So, E); }
#endif
#ifndef NO_KV
        { pg8::Gemm g{(const bf16_t*)(F.a->ws + WS_PROJ) + PC_CKV, (const bf16_t*)(F.a->ws + WS_WKVB), nullptr, 0, PJ, 128, 128, 0}; pg8::StaticOrder So; So.init(T, 1024, F.G, F.bid);
          epi::EpiKV E{(bf16_t*)(F.a->ws + WS_KVM), (const float*)(F.a->ws + WS_SSQ) + T};
          pg8::gemm_phase<epi::EpiKV, pg8::StaticOrder, false>(ring, g, So, E); }
#endif
    } SEAM(3);
    if (IN(4)) {
#ifndef DEV_NAIVE_ATTN
        attn_phase_all(F);
#endif
    } SEAM(4);
    if (IN(5)) {
        pg8::Gemm g{(const bf16_t*)(F.a->ws + WS_ATT), (const bf16_t*)(F.a->ws + WS_WO), nullptr, 0, D, D, D, 0}; pg8::StaticOrder So; So.init(T, D, F.G, F.bid);
        epi::EpiY E{(bf16_t*)(F.a->ws + WS_Y)};
        pg8::gemm_phase<epi::EpiY, pg8::StaticOrder, false>(ring, g, So, E);
    } SEAM(5);
    if (IN(6)) { p5_rows(F); } SEAM(6);
    if (IN(7)) { p6_scatter(F); } SEAM(7);
    if (IN(8)) {
        offsets_from_counts(F);
        pg8::GroupedOrder So{(const LAS int*)(F.lds + X_TILEE), __builtin_amdgcn_readfirstlane(((LAS int*)(F.lds + X_MISC2))[0]), 8, F.G, F.bid};
        pg8::Gemm g{(const bf16_t*)(F.a->ws + WS_H), (const bf16_t*)(F.a->ws + WS_WGU), (const int*)(F.a->ws + WS_ROWTOK), (size_t)2048 * 512, 512, 512, 512, 0};
        epi::EpiAct E{(unsigned char*)(F.a->ws + WS_ACT), F.a->in[IN_BGU]};
        pg8::gemm_phase<epi::EpiAct, pg8::GroupedOrder, true, true>(ring, g, So, E, F.lds + X_IDX);
    } SEAM(8);
    if (IN(9)) {
        offsets_from_counts(F);
        pg8::GroupedOrder So{(const LAS int*)(F.lds + X_TILEE), __builtin_amdgcn_readfirstlane(((LAS int*)(F.lds + X_MISC2))[0]), 4, F.G, F.bid};
        pg8::Gemm g{(const bf16_t*)(F.a->ws + WS_ACT), (const bf16_t*)(F.a->ws + WS_WD), nullptr, (size_t)1024 * 512, 512, 512, 512, 0};
        epi::EpiDown E{(unsigned char*)(F.a->ws + WS_YR), F.a->in[IN_BDN], (const float*)(F.a->ws + WS_ROWW)};
        pg8::gemm_phase<epi::EpiDown, pg8::GroupedOrder, false, true>(ring, g, So, E);
    } SEAM(9);
    if (IN(10)) { p9_final(F); }
#ifdef LEAK_LO
    if (blockIdx.x == 0 && threadIdx.x == 0) { if (LEAK_HI == 11) F.MISC[17] = (unsigned)__builtin_amdgcn_s_memrealtime(); asm volatile("s_waitcnt vmcnt(0) lgkmcnt(0)" ::: "memory"); args.out[0] += (float)(F.MISC[17] - F.MISC[16]) * LEAK_SCALE; }
#endif
#undef IN
#undef SEAM
}

extern "C" void kernel_launch(void* const* d_in, const int* in_sizes, int n_in, void* d_out, int out_size, void* d_ws, size_t ws_size, hipStream_t stream) {
    static int grid = 0;
    if (grid == 0) {
        if (n_in != 26 || in_sizes[0] != T * D || out_size != T * D || ws_size < WS_END) { fprintf(stderr, "kernel_launch: unexpected shapes (n_in %d, ws %zu); nothing launched\n", n_in, ws_size); grid = -1; return; }
        int dev = 0, cus = 0;
        if (hipGetDevice(&dev) != hipSuccess || hipDeviceGetAttribute(&cus, hipDeviceAttributeMultiprocessorCount, dev) != hipSuccess) { grid = -1; return; }
        if (hipFuncSetAttribute((const void*)mk_fwd, hipFuncAttributeMaxDynamicSharedMemorySize, LDS_BYTES) != hipSuccess) { fprintf(stderr, "kernel_launch: hipFuncSetAttribute failed\n"); grid = -1; return; }
        grid = cus;
        if (grid != 256) fprintf(stderr, "kernel_launch: %d CUs; this kernel is built for 256\n", grid);
    }
    if (grid < 0) return;
    (void)hipMemsetAsync((char*)d_ws + WS_CTL, 0, CTL_ZERO_BYTES, stream);
    Args a{};
    for (int i = 0; i < 26; ++i) a.in[i] = (const float*)d_in[i];
    a.out = (float*)d_out; a.ws = (unsigned char*)d_ws;
#ifndef MK_CUTS
#define MK_CUTS {0, N_PHASES}
#endif
    const int cuts[] = MK_CUTS; const int ncut = (int)(sizeof(cuts) / sizeof(int)) - 1;
    for (int li = 0; li < ncut; ++li) {
        a.ph_lo = cuts[li]; a.ph_hi = cuts[li + 1]; a.li = li;
        hipLaunchKernelGGL(mk_fwd, dim3(grid), dim3(NWAVES * 64), LDS_BYTES, stream, a);
#ifdef DEV_NAIVE_ATTN
        if (cuts[li + 1] == 5) {
            unsigned char* ws = (unsigned char*)d_ws;
            k_attn_ref<0><<<dim3(S / 256, NB * 8), 256, 0, stream>>>((const bf16_t*)(ws + WS_QM), (const bf16_t*)(ws + WS_KVM), (const bf16_t*)(ws + WS_PROJ), (bf16_t*)(ws + WS_ATT), nullptr, nullptr, nullptr, nullptr, nullptr, nullptr);
            k_attn_ref<1><<<dim3(S / 256, NB * 4), 256, 0, stream>>>((const bf16_t*)(ws + WS_QM), (const bf16_t*)(ws + WS_KVM), (const bf16_t*)(ws + WS_PROJ), (bf16_t*)(ws + WS_ATT), (float*)(ws + WS_Y),
                (const float*)d_in[IN_LQ1], (const float*)d_in[IN_LK1], (const float*)d_in[IN_LQ2], (const float*)d_in[IN_LK2], (const float*)d_in[IN_GSUBLN]);
        }
#endif
    }
}
```

```cpp
#include <hip/hip_runtime.h>
#include <cstdio>
#include <cstdint>

#define GAS __attribute__((address_space(1)))
#define LAS __attribute__((address_space(3)))
typedef unsigned short bf16_t;
typedef short bf16x8 __attribute__((ext_vector_type(8)));
typedef float f32x4 __attribute__((ext_vector_type(4)));
typedef float f32x2 __attribute__((ext_vector_type(2)));
typedef float f32x16 __attribute__((ext_vector_type(16)));
typedef unsigned u32x4 __attribute__((ext_vector_type(4)));
typedef unsigned u32x2 __attribute__((ext_vector_type(2)));
typedef int i32x4 __attribute__((ext_vector_type(4)));
typedef GAS unsigned gu32;
#define RLX_AGENT __ATOMIC_RELAXED, __HIP_MEMORY_SCOPE_AGENT
#define LDS_WAIT() asm volatile("s_waitcnt lgkmcnt(0)" ::: "memory")
#define VM_WAIT() asm volatile("s_waitcnt vmcnt(0)" ::: "memory")

constexpr int D = 1024, NB = 16, S = 2048, T = NB * S;
constexpr int INC = 1952;
constexpr int PJ = 2048;
constexpr int PC_CQ = 0, PC_CKV = 256, PC_KR = 384, PC_QD = 512, PC_KD = 1024, PC_VD = 1536;
constexpr int NE = 32, TOPK = 4, NA = T * TOPK, NROWS = (NA / 256 + NE) * 256, NTILE_MAX = NROWS / 256;
constexpr float LAMBDA_INIT = 0.2f, LOG2E = 1.4426950408889634f;
constexpr float C2M = 0.10206207261596577f * LOG2E;
constexpr float C2D = 0.125f * LOG2E;
#ifndef FP8_SCALE_OPND
#define FP8_SCALE_OPND 0x7f7f7f7f
#endif
constexpr float YR_SCALE = 16.f, YR_INV = 1.f / 16.f;
constexpr float W8_SCALE = 64.f, W8_INV = 1.f / 64.f;

__device__ __forceinline__ unsigned cvt_pk_bf16(float lo, float hi) { unsigned r; asm volatile("v_cvt_pk_bf16_f32 %0, %1, %2" : "=v"(r) : "v"(lo), "v"(hi)); return r; }
__device__ __forceinline__ float sat8(float v) { return __builtin_amdgcn_fmed3f(v, -448.f, 448.f); }
__device__ __forceinline__ unsigned pack4_fp8s(float a, float b, float c, float d);
__device__ __forceinline__ unsigned pack4_fp8(float a, float b, float c, float d) { int w = 0; w = __builtin_amdgcn_cvt_pk_fp8_f32(a, b, w, false); w = __builtin_amdgcn_cvt_pk_fp8_f32(c, d, w, true); return (unsigned)w; }
__device__ __forceinline__ unsigned pack4_fp8s(float a, float b, float c, float d) { return pack4_fp8(sat8(a), sat8(b), sat8(c), sat8(d)); }
__device__ __forceinline__ float bf2f(unsigned short h) { return __uint_as_float((unsigned)h << 16); }
__device__ __forceinline__ float bflo(unsigned w) { return __uint_as_float(w << 16); }
__device__ __forceinline__ float bfhi(unsigned w) { return __uint_as_float(w & 0xffff0000u); }
#define DPPF(v, ctrl) __builtin_bit_cast(float, __builtin_amdgcn_update_dpp(0, __builtin_bit_cast(int, (float)(v)), (ctrl), 0xf, 0xf, true))
__device__ __forceinline__ void swap16(float a, float b, float& x, float& y) { auto r = __builtin_amdgcn_permlane16_swap(__builtin_bit_cast(unsigned, a), __builtin_bit_cast(unsigned, b), false, false); unsigned r0 = r[0], r1 = r[1]; asm volatile("" : "+v"(r0), "+v"(r1)); x = __builtin_bit_cast(float, r0); y = __builtin_bit_cast(float, r1); }
__device__ __forceinline__ void swap32(float a, float b, float& x, float& y) { auto r = __builtin_amdgcn_permlane32_swap(__builtin_bit_cast(unsigned, a), __builtin_bit_cast(unsigned, b), false, false); unsigned r0 = r[0], r1 = r[1]; asm volatile("" : "+v"(r0), "+v"(r1)); x = __builtin_bit_cast(float, r0); y = __builtin_bit_cast(float, r1); }
__device__ __forceinline__ float swap16_sum(float a, float b) { float x, y; swap16(a, b, x, y); return x + y; }
__device__ __forceinline__ float swap32_sum(float a, float b) { float x, y; swap32(a, b, x, y); return x + y; }
__device__ __forceinline__ float swap32_max(float a, float b) { float x, y; swap32(a, b, x, y); return fmaxf(x, y); }
__device__ __forceinline__ float wave_sum(float v) {
    v += DPPF(v, 0xB1); v += DPPF(v, 0x4E); v += DPPF(v, 0x141); v += DPPF(v, 0x140);
    v = swap16_sum(v, v); return swap32_sum(v, v);
}
__device__ __forceinline__ float wave_max(float v) {
    v = fmaxf(v, DPPF(v, 0xB1)); v = fmaxf(v, DPPF(v, 0x4E)); v = fmaxf(v, DPPF(v, 0x141)); v = fmaxf(v, DPPF(v, 0x140));
    { float x, y; swap16(v, v, x, y); v = fmaxf(x, y); }
    return swap32_max(v, v);
}
__device__ __forceinline__ float lane_xor8(float v) { return DPPF(DPPF(v, 0x141), 0x140); }
__device__ __forceinline__ float lane_xor4(float v) { return DPPF(DPPF(v, 0x1B), 0x141); }

namespace pg8 {
constexpr int BM = 256, BK = 64, HALF = 128, HTB = HALF * BK * 2, STAGE_BYTES = 8 * HTB, NXCD = 8, WGM = 8;
__host__ __device__ __forceinline__ int lds_byte(int r, int c) { const int st = (r >> 4) * 2 + (c >> 5), rr = r & 15, cc = c & 31, ob = rr * 64 + cc * 2; return st * 1024 + (ob ^ (((ob >> 9) & 1) << 5)); }
__host__ __device__ __forceinline__ void stage_rc(int b, int& R, int& C) { const int st = b / 1024, sb = b % 1024, swz = sb ^ (((sb >> 9) & 1) << 5); R = (st >> 1) * 16 + swz / 64; C = (st & 1) * 32 + (swz % 64) / 2; }
__host__ __device__ __forceinline__ int perm32(int rho) { const int n = rho >> 4, i = rho & 15; return 8 * (i >> 2) + 4 * n + (i & 3); }

__host__ __device__ __forceinline__ int perm16(int R) { return 64 * (R >> 5) + 16 * ((R & 15) >> 2) + 4 * ((R >> 4) & 1) + (R & 3); }
template <class E, class = void> struct has_perm16 { static constexpr bool value = false; };
template <class E> struct has_perm16<E, decltype((void)E::PERM16)> { static constexpr bool value = E::PERM16; };
struct Unit { int pm, pn, e; };
struct Gemm { const bf16_t* A; const bf16_t* Bt; const int* rowidx; size_t b_estride; int lda, ldb, K, pad; };

struct StaticOrder {
    int nM, nN, nwg, G, c;
    __host__ __device__ void init(int M, int N, int G_, int c_) { nM = M / BM; nN = N / BM; nwg = nM * nN; G = G_; c = c_; }
    __host__ __device__ bool next(int i, Unit& u) const {
        const long L = (long)i * G + c; if (L >= nwg) return false;
        int wgid = (int)L; { const int q = nwg / NXCD, r = nwg % NXCD, xcd = wgid % NXCD, off = wgid / NXCD; wgid = (xcd < r ? xcd * (q + 1) : r * (q + 1) + (xcd - r) * q) + off; }
        const int nig = WGM * nN, gid = wgid / nig, fm = gid * WGM, gsz = (nM - fm) < WGM ? (nM - fm) : WGM;
        u.pm = fm + ((wgid % nig) % gsz); u.pn = (wgid % nig) / gsz; u.e = 0; return true;
    }
};
struct GroupedOrder {
    const LAS int* tile_e; int ntiles, ncol, G, c;
    __device__ bool next(int i, Unit& u) const {
        const int L = i * G + c, xcd = L & 7, j = L >> 3, block = j >> 5, within = j & 31, rpc = 32 / ncol;
        const int r = within / ncol, pn = within % ncol, rt = (block * 8 + xcd) * rpc + r;
        if (rt >= ntiles) return false;
        u.pm = rt; u.pn = pn; u.e = __builtin_amdgcn_readfirstlane(tile_e[rt]); return true;
    }
};

template <class Epi, class Sched, bool GATHER = false, bool FP8 = false>
__device__ __forceinline__ void gemm_phase(LAS unsigned char* lds, const Gemm g, const Sched& S, const Epi& E, LAS unsigned char* idxl = nullptr) {
    int tid_ = threadIdx.x; asm volatile("" : "+v"(tid_));
    const int tid = tid_, wid = __builtin_amdgcn_readfirstlane(tid >> 6), lane = tid & 63, wr = wid >> 2, wc = wid & 3, fr = lane & 15, fq = lane >> 4;
    const int K = g.K, nt = K / BK;
    int Rr[2], Cc[2];
    unsigned voffA[2][2], voffB[2];
#pragma unroll
    for (int i = 0; i < 2; ++i) { stage_rc(tid * 16 + i * 8192, Rr[i], Cc[i]); const int Rb = has_perm16<Epi>::value ? perm16(Rr[i]) : Epi::PERM ? ((Rr[i] & ~31) + perm32(Rr[i] & 31)) : Rr[i];
        voffA[0][i] = (unsigned)(Rr[i] * g.lda + Cc[i]) * 2u; voffA[1][i] = (unsigned)((Rr[i] + HALF) * g.lda + Cc[i]) * 2u; voffB[i] = (unsigned)(Rb * g.ldb + Cc[i]) * 2u; }
    const unsigned kstep = BK * 2, hstepB = (unsigned)((has_perm16<Epi>::value ? 8 : HALF) * g.ldb * 2), tstepA = (unsigned)(BM * g.lda * 2), tstepB = (unsigned)(BM * g.ldb * 2);
    const __amdgpu_buffer_rsrc_t rA = __builtin_amdgcn_make_buffer_rsrc((void*)g.A, 0, 0x7ffffff0, 0x00020000), rB = __builtin_amdgcn_make_buffer_rsrc((void*)g.Bt, 0, 0x7ffffff0, 0x00020000);
    const unsigned ldsw = (unsigned)wid * 1024u;
    const int aoff = lds_byte(wr * 64 + fr, fq * 8), boff = lds_byte(wc * 32 + fr, fq * 8);
#define PG8_SA(b, h) (((b) * 2 + (h)) * HTB)
#define PG8_SB(b, h) ((4 + (b) * 2 + (h)) * HTB)
#define PG8_STAGE(bufoff, rs, soff, voff) do { _Pragma("unroll") for (int _i = 0; _i < 2; ++_i) \
        __builtin_amdgcn_raw_ptr_buffer_load_lds(rs, (LAS void*)(lds + (bufoff) + ldsw + _i * 8192), 16, (int)(voff)[_i], (int)(soff), 0, 0); } while (0)
#define PG8_LDA(dst, b, h) do { _Pragma("unroll") for (int m = 0; m < 4; ++m) _Pragma("unroll") for (int k = 0; k < 2; ++k) dst[m][k] = *(const LAS bf16x8*)(lds + PG8_SA(b, h) + aoff + m * 2048 + k * 1024); } while (0)
#define PG8_LDB(dst, b, h) do { _Pragma("unroll") for (int n = 0; n < 2; ++n) _Pragma("unroll") for (int k = 0; k < 2; ++k) dst[n][k] = *(const LAS bf16x8*)(lds + PG8_SB(b, h) + boff + n * 2048 + k * 1024); } while (0)
#define PG8_MMA(ai, bj, At, Bt) do { __builtin_amdgcn_s_setprio(1); _Pragma("unroll") for (int m = 0; m < 4; ++m) _Pragma("unroll") for (int n = 0; n < 2; ++n) { \
        if constexpr (FP8) acc[ai][bj][m][n] = __builtin_amdgcn_mfma_scale_f32_16x16x128_f8f6f4(PG8_CAT(Bt[n][0], Bt[n][1]), PG8_CAT(At[m][0], At[m][1]), acc[ai][bj][m][n], 0, 0, 0, FP8_SCALE_OPND, 0, FP8_SCALE_OPND); \
        else { _Pragma("unroll") for (int k = 0; k < 2; ++k) acc[ai][bj][m][n] = __builtin_amdgcn_mfma_f32_16x16x32_bf16(Bt[n][k], At[m][k], acc[ai][bj][m][n], 0, 0, 0); } } __builtin_amdgcn_s_setprio(0); } while (0)
#define PG8_CAT(x0, x1) __builtin_shufflevector(__builtin_bit_cast(i32x4, x0), __builtin_bit_cast(i32x4, x1), 0, 1, 2, 3, 4, 5, 6, 7)
#define PG8_WAIT_V(n) asm volatile("s_waitcnt vmcnt(" #n ")" ::: "memory")
#define PG8_WAIT_L(n) asm volatile("s_waitcnt lgkmcnt(" #n ")" ::: "memory")
#define PG8_BAR __builtin_amdgcn_s_barrier()
#define PG8_SCHED __builtin_amdgcn_sched_barrier(0)
    Unit cur, nxt; int ui = 0;
    if (!S.next(0, cur)) return;
    f32x4 acc[2][2][4][2];
#pragma unroll
    for (int a = 0; a < 2; ++a)
#pragma unroll
        for (int b = 0; b < 2; ++b)
#pragma unroll
            for (int m = 0; m < 4; ++m)
#pragma unroll
                for (int n = 0; n < 2; ++n) acc[a][b][m][n] = (f32x4){0.f, 0.f, 0.f, 0.f};
    bf16x8 At[4][2], B0[2][2], B1[2][2];
    unsigned gA[2][2];
    unsigned cA, cB = (unsigned)cur.e * (unsigned)(g.b_estride * 2) + (unsigned)cur.pn * tstepB;
    if constexpr (GATHER) { cA = 0u;
#pragma unroll
        for (int h = 0; h < 2; ++h)
#pragma unroll
            for (int i = 0; i < 2; ++i) gA[h][i] = (unsigned)g.rowidx[cur.pm * BM + h * HALF + Rr[i]] * (unsigned)(g.lda * 2) + (unsigned)Cc[i] * 2u;
    } else { cA = (unsigned)cur.pm * tstepA;
#pragma unroll
        for (int h = 0; h < 2; ++h)
#pragma unroll
            for (int i = 0; i < 2; ++i) gA[h][i] = voffA[h][i]; }
    PG8_STAGE(PG8_SB(0, 0), rB, cB, voffB); PG8_STAGE(PG8_SB(0, 1), rB, cB + hstepB, voffB); PG8_STAGE(PG8_SA(0, 0), rA, cA, gA[0]); PG8_STAGE(PG8_SA(0, 1), rA, cA, gA[1]);
    if (wr == 1) PG8_BAR;
    PG8_WAIT_V(2); PG8_BAR;
    PG8_STAGE(PG8_SB(1, 0), rB, cB + kstep, voffB); PG8_STAGE(PG8_SA(1, 0), rA, cA + kstep, gA[0]); PG8_STAGE(PG8_SB(1, 1), rB, cB + hstepB + kstep, voffB);
    PG8_WAIT_V(6); PG8_BAR;
    for (;;) {
        const bool has_next = S.next(ui + 1, nxt);
        unsigned nA; const unsigned nB = has_next ? (unsigned)nxt.e * (unsigned)(g.b_estride * 2) + (unsigned)nxt.pn * tstepB : cB;
        if constexpr (GATHER) nA = cA; else nA = has_next ? (unsigned)nxt.pm * tstepA : cA;
#pragma nounroll
        for (int t = 0; t < nt; t += 2) {
            const bool last = (t == nt - 2);
            const unsigned a1 = cA + (unsigned)(t + 1) * kstep;
            const unsigned a2 = last ? nA : cA + (unsigned)(t + 2) * kstep, b2 = last ? nB : cB + (unsigned)(t + 2) * kstep;
            const unsigned a3 = a2 + kstep, b3 = b2 + kstep;
            if constexpr (GATHER) { if (t == 0 && has_next && wid < 4)
                __builtin_amdgcn_global_load_lds((const unsigned*)(g.rowidx + nxt.pm * BM + wid * 64 + lane), (LAS unsigned*)(idxl + ((ui + 1) & 1) * 1024 + wid * 256), 4, 0, 0); }
            PG8_LDB(B0, 0, 0); PG8_LDB(B1, 0, 1); PG8_SCHED; PG8_LDA(At, 0, 0); PG8_STAGE(PG8_SA(1, 1), rA, a1, gA[1]);
            if constexpr (GATHER) { if (last && has_next) { int t3 = threadIdx.x; asm volatile("" : "+v"(t3));
#pragma unroll
                for (int i = 0; i < 2; ++i) { int R3, C3; stage_rc(t3 * 16 + i * 8192, R3, C3);
#pragma unroll
                    for (int h = 0; h < 2; ++h) gA[h][i] = *(const LAS unsigned*)(idxl + ((ui + 1) & 1) * 1024 + (h * HALF + R3) * 4) * (unsigned)(g.lda * 2) + (unsigned)C3 * 2u; } } }
            PG8_WAIT_V(8); PG8_WAIT_L(0); PG8_BAR; PG8_MMA(0, 0, At, B0); PG8_MMA(0, 1, At, B1); PG8_BAR; PG8_SCHED;
            PG8_LDA(At, 0, 1); PG8_STAGE(PG8_SB(0, 0), rB, b2, voffB); PG8_STAGE(PG8_SB(0, 1), rB, b2 + hstepB, voffB); PG8_STAGE(PG8_SA(0, 0), rA, a2, gA[0]);
            PG8_WAIT_V(8); PG8_WAIT_L(0); PG8_BAR; PG8_MMA(1, 0, At, B0); PG8_MMA(1, 1, At, B1); PG8_BAR; PG8_SCHED;
            PG8_LDB(B0, 1, 0); PG8_LDB(B1, 1, 1); PG8_SCHED; PG8_LDA(At, 1, 0); PG8_STAGE(PG8_SA(0, 1), rA, a2, gA[1]);
            PG8_WAIT_V(8); PG8_WAIT_L(0); PG8_BAR; PG8_MMA(0, 0, At, B0); PG8_MMA(0, 1, At, B1); PG8_BAR; PG8_SCHED;
            PG8_LDA(At, 1, 1); PG8_STAGE(PG8_SB(1, 0), rB, b3, voffB); PG8_STAGE(PG8_SB(1, 1), rB, b3 + hstepB, voffB); PG8_STAGE(PG8_SA(1, 0), rA, a3, gA[0]);
            PG8_WAIT_V(8); PG8_WAIT_L(0); PG8_BAR; PG8_MMA(1, 0, At, B0); PG8_MMA(1, 1, At, B1); PG8_BAR; PG8_SCHED;
        }
#ifndef PG8_NOALIGN
        if (wr == 0) PG8_BAR;
#endif
        { int t2 = threadIdx.x; asm volatile("" : "+v"(t2)); E(acc, cur, wr, wc, t2 & 15, (t2 >> 4) & 3); }
        if (!has_next) break;
#pragma unroll
        for (int a = 0; a < 2; ++a)
#pragma unroll
            for (int b = 0; b < 2; ++b)
#pragma unroll
                for (int m = 0; m < 4; ++m)
#pragma unroll
                    for (int n = 0; n < 2; ++n) acc[a][b][m][n] = (f32x4){0.f, 0.f, 0.f, 0.f};
        cur = nxt; cA = nA; cB = nB; ++ui;
#ifndef PG8_NOALIGN
        if (wr == 1) PG8_BAR;
#endif
    }
    PG8_WAIT_V(0);
#ifdef PG8_NOALIGN
    if (wr == 0) PG8_BAR;
#endif
    PG8_BAR;
#undef PG8_SA
#undef PG8_SB
#undef PG8_STAGE
#undef PG8_LDA
#undef PG8_LDB
#undef PG8_MMA
#undef PG8_CAT
#undef PG8_WAIT_V
#undef PG8_WAIT_L
#undef PG8_BAR
#undef PG8_SCHED
}
}
namespace epi {
using pg8::Unit; using pg8::HALF; using pg8::BM;
__device__ __forceinline__ u32x4 pack8(f32x4 a, f32x4 b) { u32x4 w; w.x = cvt_pk_bf16(a[0], a[1]); w.y = cvt_pk_bf16(a[2], a[3]); w.z = cvt_pk_bf16(b[0], b[1]); w.w = cvt_pk_bf16(b[2], b[3]); return w; }
__device__ __forceinline__ u32x2 pack4(f32x4 a) { u32x2 w; w.x = cvt_pk_bf16(a[0], a[1]); w.y = cvt_pk_bf16(a[2], a[3]); return w; }
__device__ __forceinline__ void rope4(f32x4& a, f32x4& b, const f32x4 t0, const f32x4 t1) {
    const f32x4 c = {t0[0], t0[2], t1[0], t1[2]}, s = {t0[1], t0[3], t1[1], t1[3]};
    const f32x4 na = a * c - b * s, nb = b * c + a * s; a = na; b = nb;
}
__device__ __forceinline__ void ssq_add(float* ssq, int row, float ss, int fq) { ss += __shfl_xor(ss, 16); ss += __shfl_xor(ss, 32); if (fq == 0) atomicAdd(ssq + row, ss); }
__device__ __forceinline__ float sq8(f32x4 a, f32x4 b) { return (a[0] * a[0] + a[1] * a[1]) + (a[2] * a[2] + a[3] * a[3]) + (b[0] * b[0] + b[1] * b[1]) + (b[2] * b[2] + b[3] * b[3]); }

struct EpiProj {
    static constexpr bool PERM = true;
    bf16_t* P; const f32x4* tabm; const f32x4* tabd; float* ssq_q; float* ssq_kv;
    __device__ __forceinline__ void operator()(const f32x4 (&acc)[2][2][4][2], const Unit& u, int wr, int wc, int fr, int fq) const {
        const int row0 = u.pm * BM + wr * 64 + fr, pn = u.pn;
#pragma unroll
        for (int ai = 0; ai < 2; ++ai)
#pragma unroll
            for (int m = 0; m < 4; ++m) { const int row = row0 + ai * HALF + m * 16; bf16_t* rp = P + (size_t)row * PJ;
                if (pn == 0) { float ss = 0.f;
#pragma unroll
                    for (int bj = 0; bj < 2; ++bj) { const f32x4 v0 = acc[ai][bj][m][0], v1 = acc[ai][bj][m][1]; ss += sq8(v0, v1); *(u32x4*)(rp + bj * HALF + wc * 32 + 8 * fq) = pack8(v0, v1); }
                    ssq_add(ssq_q, row, ss, fq);
                } else if (pn == 1) {
                    { const f32x4 v0 = acc[ai][0][m][0], v1 = acc[ai][0][m][1]; *(u32x4*)(rp + 256 + wc * 32 + 8 * fq) = pack8(v0, v1); ssq_add(ssq_kv, row, sq8(v0, v1), fq); }
                    if (wc == 0) { f32x4 a = acc[ai][1][m][0], b = acc[ai][1][m][1]; const f32x4 t0 = tabm[(size_t)row * 8 + 2 * fq], t1 = tabm[(size_t)row * 8 + 2 * fq + 1]; rope4(a, b, t0, t1);
                        *(u32x2*)(rp + PC_KR + 4 * fq) = pack4(a); *(u32x2*)(rp + PC_KR + 16 + 4 * fq) = pack4(b); }
                } else if (pn < 6) { const int g = 4 * (wc & 1) + fq; const f32x4 t0 = tabd[(size_t)row * 16 + 2 * g], t1 = tabd[(size_t)row * 16 + 2 * g + 1]; const float sc = pn < 4 ? C2D : 1.f;
#pragma unroll
                    for (int bj = 0; bj < 2; ++bj) { f32x4 a = acc[ai][bj][m][0] * sc, b = acc[ai][bj][m][1] * sc; rope4(a, b, t0, t1);
                        bf16_t* bp = rp + pn * 256 + bj * HALF + (wc >> 1) * 64 + 4 * g; *(u32x2*)bp = pack4(a); *(u32x2*)(bp + 32) = pack4(b); }
                } else {
#pragma unroll
                    for (int bj = 0; bj < 2; ++bj) *(u32x4*)(rp + pn * 256 + bj * HALF + wc * 32 + 8 * fq) = pack8(acc[ai][bj][m][0], acc[ai][bj][m][1]);
                }
            }
    }
};
struct EpiQ {
    static constexpr bool PERM = true;
    bf16_t* Q; const f32x4* tabm; const float* ssq_q;
    __device__ __forceinline__ void operator()(const f32x4 (&acc)[2][2][4][2], const Unit& u, int wr, int wc, int fr, int fq) const {
        const int row0 = u.pm * BM + wr * 64 + fr;
        if (u.pn < 2) {
#pragma unroll
            for (int ai = 0; ai < 2; ++ai)
#pragma unroll
                for (int m = 0; m < 4; ++m) { const int row = row0 + ai * HALF + m * 16; const float rs = rsqrtf(ssq_q[row] * (1.f / 256.f) + 1e-6f) * C2M; bf16_t* rp = Q + (size_t)row * 768 + u.pn * BM + wc * 32 + 8 * fq;
#pragma unroll
                    for (int bj = 0; bj < 2; ++bj) *(u32x4*)(rp + bj * HALF) = pack8(acc[ai][bj][m][0] * rs, acc[ai][bj][m][1] * rs); }
        } else {
#pragma unroll
            for (int ai = 0; ai < 2; ++ai)
#pragma unroll
                for (int m = 0; m < 4; ++m) { const int row = row0 + ai * HALF + m * 16; const float rs = rsqrtf(ssq_q[row] * (1.f / 256.f) + 1e-6f) * C2M; bf16_t* rp = Q + (size_t)row * 768 + 512 + wc * 32 + 4 * fq;
                    const f32x4 t0 = tabm[(size_t)row * 8 + 2 * fq], t1 = tabm[(size_t)row * 8 + 2 * fq + 1];
#pragma unroll
                    for (int bj = 0; bj < 2; ++bj) { f32x4 a = acc[ai][bj][m][0] * rs, b = acc[ai][bj][m][1] * rs; rope4(a, b, t0, t1); *(u32x2*)(rp + bj * 128) = pack4(a); *(u32x2*)(rp + bj * 128 + 16) = pack4(b); }
                    asm volatile("" ::: "memory"); }
        }
    }
};
struct EpiKV {
    static constexpr bool PERM = true;
    bf16_t* KV; const float* ssq_kv;
    __device__ __forceinline__ void operator()(const f32x4 (&acc)[2][2][4][2], const Unit& u, int wr, int wc, int fr, int fq) const {
        const int row0 = u.pm * BM + wr * 64 + fr;
#pragma unroll
        for (int ai = 0; ai < 2; ++ai)
#pragma unroll
            for (int m = 0; m < 4; ++m) { const int row = row0 + ai * HALF + m * 16; const float rs = rsqrtf(ssq_kv[row] * (1.f / 128.f) + 1e-6f); bf16_t* rp = KV + (size_t)row * 1024 + u.pn * BM + wc * 32 + 8 * fq;
#pragma unroll
                for (int bj = 0; bj < 2; ++bj) *(u32x4*)(rp + bj * HALF) = pack8(acc[ai][bj][m][0] * rs, acc[ai][bj][m][1] * rs); }
    }
};
struct EpiY {
    static constexpr bool PERM = true;
    bf16_t* Y;
    __device__ __forceinline__ void operator()(const f32x4 (&acc)[2][2][4][2], const Unit& u, int wr, int wc, int fr, int fq) const {
        const __amdgpu_buffer_rsrc_t rY = __builtin_amdgcn_make_buffer_rsrc((void*)Y, 0, T * 1024 * 2, 0x00020000);
        const int row0 = u.pm * BM + wr * 64 + fr, col = u.pn * BM + wc * 32 + 8 * fq;
#pragma unroll
        for (int ai = 0; ai < 2; ++ai)
#pragma unroll
            for (int m = 0; m < 4; ++m) { const int row = row0 + ai * HALF + m * 16;
#pragma unroll
                for (int bj = 0; bj < 2; ++bj) __builtin_amdgcn_raw_buffer_store_b128(pack8(acc[ai][bj][m][0], acc[ai][bj][m][1]), rY, (row * 1024 + col + bj * HALF) * 2, 0, 0); }
    }
};
struct EpiAct {
    static constexpr bool PERM = true;
    unsigned char* ACT; const float* bgu;
    __device__ __forceinline__ void operator()(const f32x4 (&acc)[2][2][4][2], const Unit& u, int wr, int wc, int fr, int fq) const {
        const __amdgpu_buffer_rsrc_t rA = __builtin_amdgcn_make_buffer_rsrc((void*)ACT, 0, 0x7ffffff0, 0x00020000), rB = __builtin_amdgcn_make_buffer_rsrc((void*)bgu, 0, NE * 2048 * 4, 0x00020000);
        const int row0 = u.pm * BM + wr * 64 + fr, j0 = u.pn * 128 + wc * 32 + 8 * fq;
        f32x4 bg[2], bu[2];
#pragma unroll
        for (int n = 0; n < 2; ++n) { bg[n] = __builtin_bit_cast(f32x4, __builtin_amdgcn_raw_buffer_load_b128(rB, (u.e * 2048 + j0 + 4 * n) * 4, 0, 0)); bu[n] = __builtin_bit_cast(f32x4, __builtin_amdgcn_raw_buffer_load_b128(rB, (u.e * 2048 + 1024 + j0 + 4 * n) * 4, 0, 0)); }
#pragma unroll
        for (int ai = 0; ai < 2; ++ai)
#pragma unroll
            for (int m = 0; m < 4; ++m) { const int row = row0 + ai * HALF + m * 16; u32x2 o;
#pragma unroll
                for (int n = 0; n < 2; ++n) { const f32x4 gv = acc[ai][0][m][n] * W8_INV + bg[n], uv = acc[ai][1][m][n] * W8_INV + bu[n]; float a4[4];
#pragma unroll
                    for (int i = 0; i < 4; ++i) { const float gg = fminf(gv[i], 7.f), uu = fminf(fmaxf(uv[i], -7.f), 7.f); a4[i] = gg * __builtin_amdgcn_rcpf(1.f + __builtin_amdgcn_exp2f(-1.702f * LOG2E * gg)) * (uu + 1.f); }
                    o[n] = pack4_fp8(a4[0], a4[1], a4[2], a4[3]); }
                __builtin_amdgcn_raw_buffer_store_b64(o, rA, row * 1024 + j0, 0, 0); }
    }
};
struct EpiDown {
    static constexpr bool PERM = true, PERM16 = true;
    unsigned char* YR; const float* bd; const float* roww;
    __device__ __forceinline__ void operator()(const f32x4 (&acc)[2][2][4][2], const Unit& u, int wr, int wc, int fr, int fq) const {
        const __amdgpu_buffer_rsrc_t rY = __builtin_amdgcn_make_buffer_rsrc((void*)YR, 0, 0x7ffffff0, 0x00020000), rB = __builtin_amdgcn_make_buffer_rsrc((void*)bd, 0, NE * 1024 * 4, 0x00020000),
                                     rW = __builtin_amdgcn_make_buffer_rsrc((void*)roww, 0, NROWS * 4, 0x00020000);
        const int row0 = u.pm * BM + wr * 64 + fr, col = u.pn * BM + wc * 64 + 16 * fq, boff = (u.e * 1024 + col) * 4;
#pragma unroll
        for (int ai = 0; ai < 2; ++ai) {
            f32x4 bv[2][2];
#pragma unroll
            for (int bj = 0; bj < 2; ++bj)
#pragma unroll
                for (int n = 0; n < 2; ++n) bv[bj][n] = __builtin_bit_cast(f32x4, __builtin_amdgcn_raw_buffer_load_b128(rB, boff + (8 * bj + 4 * n) * 4, 0, 0));
#pragma unroll
            for (int m = 0; m < 4; ++m) { const int row = row0 + ai * HALF + m * 16; const float ww = YR_SCALE * __builtin_bit_cast(float, __builtin_amdgcn_raw_buffer_load_b32(rW, row * 4, 0, 0)), w8 = ww * W8_INV; u32x4 o;
#pragma unroll
                for (int bj = 0; bj < 2; ++bj)
#pragma unroll
                    for (int n = 0; n < 2; ++n) { const f32x4 v = acc[ai][bj][m][n] * w8 + bv[bj][n] * ww; o[2 * bj + n] = pack4_fp8s(v[0], v[1], v[2], v[3]); }
                __builtin_amdgcn_raw_buffer_store_b128(o, rY, row * 1024 + col, 0, 0); }
            asm volatile("" ::: "memory"); }
    }
};
}
constexpr size_t MiB = 1u << 20;
constexpr size_t WS_CTL = 0, CTL_ZERO_BYTES = 64 * 1024;
constexpr size_t WS_MOD = 1 * MiB;
constexpr size_t WS_SSQ = 1 * MiB + 512 * 1024;
constexpr size_t WS_TABM = 2 * MiB, WS_TABD = 6 * MiB;
constexpr size_t WS_SE = 14 * MiB, WS_SG = 14 * MiB + 512 * 1024, WS_SRANK = 18 * MiB + 512 * 1024;
constexpr size_t WS_POS = 15 * MiB;
constexpr size_t WS_ROWTOK = 16 * MiB, WS_ROWW = 17 * MiB;
constexpr size_t WS_CNT = 18 * MiB;
constexpr size_t WS_TD0 = 19 * MiB;
constexpr size_t WS_WIN = 20 * MiB, WS_WQB = 24 * MiB, WS_WKVB = 25 * MiB, WS_WO = 26 * MiB;
constexpr size_t WS_WGU = 28 * MiB, WS_WD = 156 * MiB;
constexpr size_t WS_H = 220 * MiB;
constexpr size_t WS_PROJ = 284 * MiB;
constexpr size_t WS_QM = 412 * MiB, WS_KVM = 460 * MiB, WS_ATT = 524 * MiB, WS_Y = 588 * MiB;
constexpr size_t WS_X1 = 524 * MiB;
constexpr size_t WS_ACT = 284 * MiB;
constexpr size_t WS_YR = 588 * MiB;
constexpr size_t WS_END = 860 * MiB;
static_assert(WS_ACT + (size_t)NROWS * 1024 * 2 <= WS_YR && WS_YR + (size_t)NROWS * 1024 * 2 <= WS_END, "ws map");
constexpr int CW_BAR = 4096;

constexpr int RING_OFF = 0, RING_BYTES = 131072;
constexpr int LDSCTL_OFF = RING_BYTES, MISC_OFF = LDSCTL_OFF + 320;
constexpr int XTRA_OFF = MISC_OFF + 128;
constexpr int X_TILEE = XTRA_OFF;
constexpr int X_SE = X_TILEE + 2304, X_SG = X_SE + 2048, X_SRANK = X_SG + 2048, X_WCNT = X_SRANK + 2048, X_MISC2 = X_WCNT + 1024;
constexpr int X_IDX = X_MISC2 + 1024;
constexpr int X_CONST = 147456;
constexpr int LDS_BYTES = 163840;
static_assert(X_IDX + 2048 <= X_CONST && X_CONST + 12288 <= LDS_BYTES, "LDS map");
constexpr int NWAVES = 8;

#define XB_TMO      128
#define XB_XCNT(j)  (256  + 64 * (j))
#define XB_XSUB(j)  (1280 + 64 * (j))
#define XB_XGEN(j)  (2304 + 64 * (j))
#define XB_TOP      3328
#define XB_TOPGEN   3392
#define XCD_BAR_WORDS 3456
#define XB_SPIN_CAP (1u << 18)
__device__ __forceinline__ unsigned xb_ld(unsigned* p)              { return __hip_atomic_load(p, __ATOMIC_RELAXED, __HIP_MEMORY_SCOPE_AGENT); }
__device__ __forceinline__ unsigned xb_add(unsigned* p, unsigned v) { return __hip_atomic_fetch_add(p, v, __ATOMIC_RELAXED, __HIP_MEMORY_SCOPE_AGENT); }
__device__ __forceinline__ unsigned xb_xcc_id() { return (unsigned)__builtin_amdgcn_s_getreg((3 << 11) | 20) & 0xFu; }
#define XB_SPIN(cond, bar) do { unsigned _sp = 0; while (cond) { __builtin_amdgcn_s_sleep(1); \
    if ((++_sp & 255u) == 0u) { if (xb_ld(&(bar)[XB_TMO])) break; if (_sp > XB_SPIN_CAP) { atomicAdd(&(bar)[XB_TMO], 1u); break; } } } } while (0)
struct XcdBarrier { unsigned* bar; unsigned x; volatile LAS unsigned* st; };
__device__ __forceinline__ XcdBarrier xcd_barrier_post(unsigned* bar, volatile LAS unsigned* st) {
    XcdBarrier b; b.bar = bar; b.x = xb_xcc_id(); b.st = st;
    if (threadIdx.x == 0) (void)xb_add(&bar[XB_XCNT(b.x)], 1u);
    return b;
}
__device__ __forceinline__ void xcd_barrier_complete(unsigned* bar, unsigned x, unsigned& nloc, unsigned& nx) {
    const unsigned G = gridDim.x * gridDim.y * gridDim.z;
    unsigned sum, cnt, mine, sp = 0u;
    for (;;) {
        sum = 0u; cnt = 0u; mine = 0u;
#pragma unroll
        for (unsigned j = 0; j < 16; ++j) { const unsigned c = xb_ld(&bar[XB_XCNT(j)]); sum += c; cnt += (c > 0u) ? 1u : 0u; mine = (j == x) ? c : mine; }
        if (sum == G) break;
        __builtin_amdgcn_s_sleep(1);
        if ((++sp & 255u) == 0u) { if (xb_ld(&bar[XB_TMO])) break; if (sp > XB_SPIN_CAP) { atomicAdd(&bar[XB_TMO], 1u); break; } }
    }
    nloc = mine > 0u ? mine : 1u; nx = cnt > 0u ? cnt : 1u;
}
__device__ __forceinline__ void xcd_barrier(const XcdBarrier& b) {
    asm volatile("s_waitcnt vmcnt(0)" ::: "memory");
    __syncthreads();
    if (threadIdx.x == 0) {
        unsigned* bar = b.bar;
        __builtin_amdgcn_s_waitcnt(0);
        unsigned nloc = b.st[0], nx = b.st[1];
        if (nloc == 0u) { xcd_barrier_complete(bar, b.x, nloc, nx); b.st[0] = nloc; b.st[1] = nx; }
        const unsigned old = xb_add(&bar[XB_XSUB(b.x)], 1u);
        const unsigned gen = old / nloc;
        if (old + 1u == (gen + 1u) * nloc) {
            __builtin_amdgcn_fence(__ATOMIC_RELEASE, "agent");
            asm volatile("s_waitcnt vmcnt(0)" ::: "memory");
            const unsigned og = xb_add(&bar[XB_TOP], 1u);
            const unsigned tg = og / nx;
            if (og + 1u == (tg + 1u) * nx) xb_add(&bar[XB_TOPGEN], 1u);
            else XB_SPIN(xb_ld(&bar[XB_TOPGEN]) == tg, bar);
            __builtin_amdgcn_fence(__ATOMIC_ACQUIRE, "agent");
            xb_add(&bar[XB_XGEN(b.x)], 1u);
            asm volatile("s_waitcnt vmcnt(0)" ::: "memory");
        } else {
            XB_SPIN(xb_ld(&bar[XB_XGEN(b.x)]) == gen, bar);
            __builtin_amdgcn_fence(__ATOMIC_ACQUIRE, "agent");
            asm volatile("s_waitcnt vmcnt(0)" ::: "memory");
        }
    }
    __syncthreads();
}

struct Args { const float* in[26]; float* out; unsigned char* ws; int ph_lo, ph_hi, li, pad; };
struct Frame {
    LAS unsigned char* lds; volatile LAS unsigned* MISC; unsigned* ctl;
    int G, bid;
    const Args* a;
};
#define PHASE_IDS() int tid_ = threadIdx.x; asm volatile("" : "+v"(tid_)); const int tid = tid_, lane = tid & 63, wave = __builtin_amdgcn_readfirstlane(tid >> 6); (void)lane; (void)wave
#define IN_X 0
#define IN_C 1
#define IN_POS 2
#define IN_WADA 3
#define IN_BADA 4
#define IN_GMIXPRE 5
#define IN_GMIXPOST 6
#define IN_WIN 7
#define IN_GQA 8
#define IN_WQB 9
#define IN_GKVA 10
#define IN_WKVB 11
#define IN_LQ1 12
#define IN_LK1 13
#define IN_LQ2 14
#define IN_LK2 15
#define IN_GSUBLN 16
#define IN_WO 17
#define IN_GFFNPRE 18
#define IN_GFFNPOST 19
#define IN_WROUTER 20
#define IN_BROUTER 21
#define IN_WGU 22
#define IN_BGU 23
#define IN_WDN 24
#define IN_BDN 25

template <class Map>
__device__ __forceinline__ void transpose_item(const float* W, int K, int N, bf16_t* WT, const float* gain, Map dst, LAS float* scr, int item, int lane) {
    const int nblk = N / 32, kb = item / nblk, nb = item % nblk, k0 = 64 * kb, n0 = 32 * nb;
    { float v[32];
#pragma unroll
      for (int i = 0; i < 32; ++i) v[i] = W[(size_t)(k0 + 2 * i + (lane >> 5)) * N + n0 + (lane & 31)];
#pragma unroll
      for (int i = 0; i < 32; ++i) scr[(2 * i + (lane >> 5)) * 33 + (lane & 31)] = v[i]; }
    LDS_WAIT(); asm volatile("" ::: "memory");
    const int c = lane & 7;
    float gk[8];
#pragma unroll
    for (int i = 0; i < 8; ++i) gk[i] = gain ? gain[k0 + 8 * c + i] : 1.f;
#pragma unroll
    for (int j = 0; j < 4; ++j) { const int n = (lane >> 3) + 8 * j; const LAS float* s = scr + (8 * c) * 33 + n;
        u32x4 o; o.x = cvt_pk_bf16(s[0 * 33] * gk[0], s[1 * 33] * gk[1]); o.y = cvt_pk_bf16(s[2 * 33] * gk[2], s[3 * 33] * gk[3]); o.z = cvt_pk_bf16(s[4 * 33] * gk[4], s[5 * 33] * gk[5]); o.w = cvt_pk_bf16(s[6 * 33] * gk[6], s[7 * 33] * gk[7]);
        *(GAS u32x4*)(WT + (size_t)dst(n0 + n) * K + k0 + 8 * c) = o; }
    LDS_WAIT(); asm volatile("" ::: "memory");
}
template <class Map>
__device__ __forceinline__ void transpose8_stream(const float* W, int N, unsigned char* WT, Map dst, LAS float* scr, int first, int stride, int lane) {
    const int nblk = N / 32, per_e = 8 * nblk, total = NE * per_e;
    if (first >= total) return;
    float v[32];
    auto src = [&](int it, int hb) -> const float* { const int e = it / per_e, r = it - e * per_e, kb = r / nblk, nb = r - kb * nblk; return W + ((size_t)e * 1024 + 128 * kb + 64 * hb + (lane >> 5)) * N + 32 * nb + (lane & 31); };
    { const float* p = src(first, 0);
#pragma unroll
      for (int i = 0; i < 32; ++i) v[i] = p[(size_t)(2 * i) * N]; }
    for (int it = first; it < total; it += stride) {
#pragma unroll
        for (int hb = 0; hb < 2; ++hb) {
            float w[32];
#pragma unroll
            for (int i = 0; i < 32; ++i) w[i] = v[i];
            const int nit = hb == 0 ? it : it + stride;
            if (nit < total) { const float* p = src(nit, hb ^ 1);
#pragma unroll
                for (int i = 0; i < 32; ++i) v[i] = p[(size_t)(2 * i) * N]; }
#pragma unroll
            for (int i = 0; i < 32; ++i) { const int kk = 64 * hb + 2 * i + (lane >> 5); scr[kk * 32 + ((lane & 31) ^ (kk & 31) ^ (((kk >> 5) & 3) << 2))] = w[i]; }
        }
        LDS_WAIT(); asm volatile("" ::: "memory");
        const int e = it / per_e, r = it - e * per_e, kb = r / nblk, nb = r - kb * nblk, c = lane & 7;
#pragma unroll
        for (int j = 0; j < 4; ++j) { const int n = (lane >> 3) + 8 * j; float t[16];
#pragma unroll
            for (int i = 0; i < 16; ++i) { const int kk = 16 * c + i; t[i] = scr[kk * 32 + (n ^ (kk & 31) ^ (((kk >> 5) & 3) << 2))] * W8_SCALE; }
            u32x4 o; o.x = pack4_fp8(t[0], t[1], t[2], t[3]); o.y = pack4_fp8(t[4], t[5], t[6], t[7]); o.z = pack4_fp8(t[8], t[9], t[10], t[11]); o.w = pack4_fp8(t[12], t[13], t[14], t[15]);
            *(GAS u32x4*)(WT + ((size_t)e * N + dst(32 * nb + n)) * 1024 + 128 * kb + 16 * c) = o; }
        LDS_WAIT(); asm volatile("" ::: "memory");
    }
}
__device__ __forceinline__ int il4(int i, int x2) { return 8 * (i >> 2) + 4 * x2 + (i & 3); }
struct MapWin { __device__ int operator()(int n) const {
    if (n < 384) return n;
    if (n < 416) { const int r = n - 384; return PC_KR + il4(r & 15, r >> 4); }
    if (n < 1440) { const int r = n - 416, hj = r >> 6, d = r & 63; return PC_QD + hj * 64 + il4(d & 31, d >> 5); }
    return PC_VD + (n - 1440); } };
struct MapWqb { __device__ int operator()(int n) const { const int h = n / 96, d = n - h * 96; if (d < 64) return h * 64 + d; const int r = d - 64; return 512 + h * 32 + il4(r & 15, r >> 4); } };
struct MapId { __device__ int operator()(int n) const { return n; } };
struct MapWgu { __device__ int operator()(int n) const { const int which = n >> 10, j = n & 1023; return (j >> 7) * 256 + which * 128 + (j & 127); } };

__device__ __forceinline__ void p0_prologue(Frame& F) {
    PHASE_IDS();
    float* mod = (float*)(F.a->ws + WS_MOD);
    if (F.bid < 192) {
        LAS float* cact = (LAS float*)(F.lds);
        LAS float* red = (LAS float*)(F.lds + 65536);
        const float* c = F.a->in[IN_C];
        { float cv[32];
#pragma unroll
          for (int i = 0; i < 32; ++i) cv[i] = c[tid + 512 * i];
#pragma unroll
          for (int i = 0; i < 32; ++i) cact[tid + 512 * i] = cv[i] / (1.f + __expf(-cv[i])); }
        __syncthreads();
        const int n0 = 32 * F.bid, col = tid & 31, kg = tid >> 5;
        float acc[16];
#pragma unroll
        for (int b = 0; b < 16; ++b) acc[b] = 0.f;
        const float* wp = F.a->in[IN_WADA] + (size_t)(kg * 64) * 6144 + n0 + col;
#pragma unroll
        for (int q = 0; q < 2; ++q) { float w[32];
#pragma unroll
            for (int kk = 0; kk < 32; ++kk) w[kk] = wp[(size_t)(32 * q + kk) * 6144];
#pragma unroll
            for (int kk = 0; kk < 32; ++kk)
#pragma unroll
                for (int b = 0; b < 16; ++b) acc[b] += cact[b * 1024 + kg * 64 + 32 * q + kk] * w[kk]; }
#pragma unroll
        for (int b = 0; b < 16; ++b) red[(kg * 16 + b) * 32 + col] = acc[b];
        __syncthreads();
        { const int b = tid >> 5; float s = 0.f;
#pragma unroll
          for (int k2 = 0; k2 < 16; ++k2) s += red[(k2 * 16 + b) * 32 + col];
          mod[b * 6144 + n0 + col] = s + F.a->in[IN_BADA][n0 + col]; }
        __syncthreads();
    }
    { float* ssq = (float*)(F.a->ws + WS_SSQ); for (int i = F.bid * 512 + tid; i < 3 * T; i += F.G * 512) ssq[i] = 0.f;
      u32x4* wz = (u32x4*)((bf16_t*)(F.a->ws + WS_WIN) + (size_t)416 * 1024); for (int i = F.bid * 512 + tid; i < 96 * 1024 / 8; i += F.G * 512) wz[i] = (u32x4){0u, 0u, 0u, 0u}; }
    { const int* pos = (const int*)F.a->in[IN_POS]; float2* tabm = (float2*)(F.a->ws + WS_TABM); float2* tabd = (float2*)(F.a->ws + WS_TABD);
      for (int gid = F.bid * 512 + tid; gid < T * 48; gid += F.G * 512) { const int t = gid / 48, i = gid - t * 48; const float p = (float)pos[t];
          if (i < 16) { const float inv = powf(10000.f, -(float)(2 * i) / 32.f); const double a = (double)(p * inv); tabm[t * 16 + i] = make_float2((float)cos(a), (float)sin(a)); }
          else { const int j = i - 16; const float inv = powf(10000.f, -(float)(2 * j) / 64.f); const double a = (double)(p * inv); tabd[t * 32 + j] = make_float2((float)cos(a), (float)sin(a)); } } }
    LAS float* scr = (LAS float*)(F.lds + RING_OFF + wave * 16384);
    const int gw = F.bid * NWAVES + wave, NGW = F.G * NWAVES;
    constexpr int I_WIN = 16 * 61, I_WQB = 4 * 24, I_WKVB = 2 * 32, I_WO = 16 * 32;
    constexpr int NITEMS = I_WIN + I_WQB + I_WKVB + I_WO;
    for (int it = gw; it < NITEMS; it += NGW) {
        int r = it;
        if (r < I_WIN) { transpose_item(F.a->in[IN_WIN], 1024, INC, (bf16_t*)(F.a->ws + WS_WIN), nullptr, MapWin{}, scr, r, lane); continue; } r -= I_WIN;
        if (r < I_WQB) { transpose_item(F.a->in[IN_WQB], 256, 768, (bf16_t*)(F.a->ws + WS_WQB), F.a->in[IN_GQA], MapWqb{}, scr, r, lane); continue; } r -= I_WQB;
        if (r < I_WKVB) { transpose_item(F.a->in[IN_WKVB], 128, 1024, (bf16_t*)(F.a->ws + WS_WKVB), F.a->in[IN_GKVA], MapId{}, scr, r, lane); continue; } r -= I_WKVB;
        transpose_item(F.a->in[IN_WO], 1024, 1024, (bf16_t*)(F.a->ws + WS_WO), nullptr, MapId{}, scr, r, lane);
    }
    transpose8_stream(F.a->in[IN_WGU], 2048, (unsigned char*)(F.a->ws + WS_WGU), MapWgu{}, scr, gw, NGW, lane);
    transpose8_stream(F.a->in[IN_WDN], 1024, (unsigned char*)(F.a->ws + WS_WD), MapId{}, scr, gw, NGW, lane);
}
__device__ __forceinline__ void p0b_norm(Frame& F) {
    PHASE_IDS();
    const float* mod = (const float*)(F.a->ws + WS_MOD); bf16_t* H = (bf16_t*)(F.a->ws + WS_H);
    const int tok0 = F.bid * 128 + wave * 16, b = (F.bid * 128) / S;
    f32x4 g[4], sh[4];
#pragma unroll
    for (int j = 0; j < 4; ++j) { const int c = 4 * lane + 256 * j; g[j] = *(const f32x4*)(F.a->in[IN_GMIXPRE] + c) * (*(const f32x4*)(mod + b * 6144 + 1024 + c) + 1.f); sh[j] = *(const f32x4*)(mod + b * 6144 + c); }
    for (int i = 0; i < 16; i += 4) {
        f32x4 v[4][4];
#pragma unroll
        for (int r = 0; r < 4; ++r)
#pragma unroll
            for (int j = 0; j < 4; ++j) v[r][j] = *((const GAS f32x4*)(F.a->in[IN_X] + (size_t)(tok0 + i + r) * D) + lane + 64 * j);
#pragma unroll
        for (int r = 0; r < 4; ++r) { float ss = 0.f;
#pragma unroll
            for (int j = 0; j < 4; ++j) ss += (v[r][j].x * v[r][j].x + v[r][j].y * v[r][j].y) + (v[r][j].z * v[r][j].z + v[r][j].w * v[r][j].w);
            const float rs = rsqrtf(wave_sum(ss) * (1.f / D) + 1e-6f);
            GAS u32x2* o8 = (GAS u32x2*)(H + (size_t)(tok0 + i + r) * D) + lane;
#pragma unroll
            for (int j = 0; j < 4; ++j) { const f32x4 h = (v[r][j] * rs) * g[j] + sh[j]; u32x2 w; w.x = cvt_pk_bf16(h[0], h[1]); w.y = cvt_pk_bf16(h[2], h[3]); o8[64 * j] = w; } }
    }
}
__device__ __forceinline__ void p5_rows(Frame& F) {
    PHASE_IDS();
    LAS float* wt = (LAS float*)(F.lds + RING_OFF);
    for (int idx = tid; idx < NE * 1024; idx += 512) { const int e = idx >> 10, k = idx & 1023; wt[idx] = F.a->in[IN_WROUTER][k * NE + e]; }
    LAS int* se = (LAS int*)(F.lds + X_SE); LAS float* sg = (LAS float*)(F.lds + X_SG);
    const float* mod = (const float*)(F.a->ws + WS_MOD); const float* ssq_y = (const float*)(F.a->ws + WS_SSQ) + 2 * T;
    const bf16_t* Y = (const bf16_t*)(F.a->ws + WS_Y); unsigned char* H2 = (unsigned char*)(F.a->ws + WS_H); bf16_t* X1 = (bf16_t*)(F.a->ws + WS_X1);
    const int tok0 = F.bid * 128 + wave * 16, b = (F.bid * 128) / S;
    LAS float* cst = (LAS float*)(F.lds + X_CONST);
    for (int c = tid; c < 1024; c += 512) { cst[c] = F.a->in[IN_GMIXPOST][c] * mod[b * 6144 + 2048 + c]; cst[1024 + c] = F.a->in[IN_GFFNPRE][c] * (mod[b * 6144 + 4096 + c] + 1.f); cst[2048 + c] = mod[b * 6144 + 3072 + c]; }
    f32x4 xn[2][4]; u32x2 yn[2][4];
#define P5_PRE(r_) do { _Pragma("unroll") for (int q_ = 0; q_ < 2; ++q_) { _Pragma("unroll") for (int j = 0; j < 4; ++j) { xn[q_][j] = *(const GAS f32x4*)(F.a->in[IN_X] + (size_t)((r_) + q_) * D + 4 * lane + 256 * j); yn[q_][j] = *(const GAS u32x2*)(Y + (size_t)((r_) + q_) * D + 4 * lane + 256 * j); } } } while (0)
    P5_PRE(tok0);
    __syncthreads();
#pragma nounroll
    for (int i = 0; i < 16; i += 2) {
        const int row = tok0 + i;
        f32x2 hp[4][4];
        {   f32x4 xv[2][4]; u32x2 yv[2][4]; float rsy[2];
#pragma unroll
            for (int q = 0; q < 2; ++q) { float sy = 0.f;
#pragma unroll
                for (int j = 0; j < 4; ++j) { xv[q][j] = xn[q][j]; yv[q][j] = yn[q][j]; const float a0 = bflo(yv[q][j].x), a1 = bfhi(yv[q][j].x), a2 = bflo(yv[q][j].y), a3 = bfhi(yv[q][j].y); sy += (a0 * a0 + a1 * a1) + (a2 * a2 + a3 * a3); }
                rsy[q] = rsqrtf(wave_sum(sy) * (1.f / D) + 1e-6f); }
            if (i + 2 < 16) P5_PRE(row + 2);
            f32x4 gpost[4], gpre[4], shf[4];
#pragma unroll
            for (int j = 0; j < 4; ++j) { gpost[j] = *(const LAS f32x4*)(cst + 4 * lane + 256 * j); gpre[j] = *(const LAS f32x4*)(cst + 1024 + 4 * lane + 256 * j); shf[j] = *(const LAS f32x4*)(cst + 2048 + 4 * lane + 256 * j); }
#pragma unroll
            for (int q = 0; q < 2; ++q) { f32x4 x1[4]; float ss = 0.f;
#pragma unroll
                for (int j = 0; j < 4; ++j) { const f32x4 yy = {bflo(yv[q][j].x), bfhi(yv[q][j].x), bflo(yv[q][j].y), bfhi(yv[q][j].y)}; x1[j] = xv[q][j] + (yy * rsy[q]) * gpost[j];
                    ss += (x1[j][0] * x1[j][0] + x1[j][1] * x1[j][1]) + (x1[j][2] * x1[j][2] + x1[j][3] * x1[j][3]);
                    { u32x2 w; w.x = cvt_pk_bf16(x1[j][0], x1[j][1]); w.y = cvt_pk_bf16(x1[j][2], x1[j][3]); *(GAS u32x2*)(X1 + (size_t)(row + q) * D + 4 * lane + 256 * j) = w; } }
                const float r1 = rsqrtf(wave_sum(ss) * (1.f / D) + 1e-6f);
#pragma unroll
                for (int j = 0; j < 4; ++j) { const f32x4 h = (x1[j] * r1) * gpre[j] + shf[j]; *(GAS unsigned*)(H2 + (size_t)(row + q) * D + 4 * lane + 256 * j) = pack4_fp8s(h[0], h[1], h[2], h[3]);
#pragma unroll
                    for (int c = 0; c < 4; ++c) hp[j][c][q] = h[c]; } } }
        f32x2 v[32];
#pragma unroll
        for (int e = 0; e < NE; ++e) { const LAS f32x4* wp = (const LAS f32x4*)(wt + e * 1024 + 4 * lane); f32x2 p = {0.f, 0.f};
#pragma unroll
            for (int j = 0; j < 4; ++j) { const f32x4 w = wp[64 * j]; p = p + hp[j][0] * w[0]; p = p + hp[j][1] * w[1]; p = p + hp[j][2] * w[2]; p = p + hp[j][3] * w[3]; }
            v[e] = p; if ((e & 3) == 3) __builtin_amdgcn_sched_barrier(0); }
        const int my_e = lane >> 1; const float brt = F.a->in[IN_BROUTER][my_e];
#define P5_REDUCE(Q) do { float u_[16]; \
            _Pragma("unroll") for (int j = 0; j < 16; ++j) u_[j] = swap32_sum(v[j][Q], v[16 + j][Q]); \
            _Pragma("unroll") for (int j = 0; j < 8; ++j) u_[j] = swap16_sum(u_[j], u_[8 + j]); \
            _Pragma("unroll") for (int j = 0; j < 4; ++j) { const bool up = (lane & 8) != 0; const float keep = up ? u_[4 + j] : u_[j], send = up ? u_[j] : u_[4 + j]; u_[j] = keep + lane_xor8(send); } \
            _Pragma("unroll") for (int j = 0; j < 2; ++j) { const bool up = (lane & 4) != 0; const float keep = up ? u_[2 + j] : u_[j], send = up ? u_[j] : u_[2 + j]; u_[j] = keep + lane_xor4(send); } \
            { const bool up = (lane & 2) != 0; const float keep = up ? u_[1] : u_[0], send = up ? u_[0] : u_[1]; u_[0] = keep + DPPF(send, 0x4E); } \
            float lg = u_[0] + DPPF(u_[0], 0xB1) + brt; \
            float vals[4]; int idx[4]; \
            _Pragma("unroll") for (int k = 0; k < 4; ++k) { const float mx = wave_max(lg); const unsigned long long bm = __ballot(lg == mx); const int wl = __builtin_ctzll(bm); vals[k] = mx; idx[k] = wl >> 1; if (my_e == idx[k]) lg = -INFINITY; } \
            float ex[4], den = 0.f; \
            _Pragma("unroll") for (int k = 0; k < 4; ++k) { ex[k] = __expf(vals[k] - vals[0]); den += ex[k]; } \
            const float inv = 1.f / den; \
            if (lane < 4) { const int a = (wave * 16 + i + Q) * 4 + lane; se[a] = lane == 0 ? idx[0] : lane == 1 ? idx[1] : lane == 2 ? idx[2] : idx[3]; sg[a] = (lane == 0 ? ex[0] : lane == 1 ? ex[1] : lane == 2 ? ex[2] : ex[3]) * inv; } \
            __builtin_amdgcn_sched_barrier(0); } while (0)
        P5_REDUCE(0);
        P5_REDUCE(1);
#undef P5_REDUCE
    }
#undef P5_PRE
#define P5_LOAD(x)
#undef P5_LOAD
    __syncthreads();
    LAS int* srank = (LAS int*)(F.lds + X_SRANK); LAS int* wcnt = (LAS int*)(F.lds + X_WCNT);
    const int e_my = se[tid]; int rk = 0;
    for (int e = 0; e < NE; ++e) { const unsigned long long bm = __ballot(e_my == e); if (e_my == e) rk = __builtin_popcountll(bm & ((1ull << lane) - 1ull)); if (lane == 0) wcnt[wave * 32 + e] = __builtin_popcountll(bm); }
    __syncthreads();
    int base = 0;
    for (int w = 0; w < wave; ++w) base += wcnt[w * 32 + e_my];
    srank[tid] = base + rk;
    { const int a = F.bid * 512 + tid; ((int*)(F.a->ws + WS_SE))[a] = e_my; ((float*)(F.a->ws + WS_SG))[a] = sg[tid]; ((int*)(F.a->ws + WS_SRANK))[a] = base + rk; }
    if (tid < NE) { int tot = 0; for (int w = 0; w < 8; ++w) tot += wcnt[w * 32 + tid]; ((int*)(F.a->ws + WS_CNT))[F.bid * NE + tid] = tot; }
}
__device__ __forceinline__ void p9_final(Frame& F) {
    PHASE_IDS();
    const float* mod = (const float*)(F.a->ws + WS_MOD); const unsigned char* YR = (const unsigned char*)(F.a->ws + WS_YR); const int* pos = (const int*)(F.a->ws + WS_POS);
    const int tok0 = F.bid * 128 + wave * 16, b = (F.bid * 128) / S;
    f32x4 gf[4];
#pragma unroll
    for (int j = 0; j < 4; ++j) { const int c = 4 * lane + 256 * j; gf[j] = *(const f32x4*)(F.a->in[IN_GFFNPOST] + c) * *(const f32x4*)(mod + b * 6144 + 5120 + c); }
    unsigned yn[4][4]; u32x2 xn[4]; const bf16_t* X1 = (const bf16_t*)(F.a->ws + WS_X1);
#define P9_LOAD(row) do { _Pragma("unroll") for (int s_ = 0; s_ < 4; ++s_) { const int pr = __builtin_amdgcn_readfirstlane(pos[(row) * 4 + s_]); _Pragma("unroll") for (int j = 0; j < 4; ++j) yn[s_][j] = *(const GAS unsigned*)(YR + (size_t)pr * D + 4 * lane + 256 * j); } \
        _Pragma("unroll") for (int j = 0; j < 4; ++j) xn[j] = *(const GAS u32x2*)(X1 + (size_t)(row) * D + 4 * lane + 256 * j); } while (0)
    P9_LOAD(tok0);
    for (int i = 0; i < 16; ++i) {
        const int row = tok0 + i;
        f32x4 y[4], x1[4]; float ss = 0.f;
#pragma unroll
        for (int j = 0; j < 4; ++j) { y[j] = (f32x4){0.f, 0.f, 0.f, 0.f};
#pragma unroll
            for (int s_ = 0; s_ < 4; ++s_) { const unsigned w = yn[s_][j]; const f32x2 lo = __builtin_amdgcn_cvt_pk_f32_fp8((int)w, false), hi2 = __builtin_amdgcn_cvt_pk_f32_fp8((int)w, true); y[j] += (f32x4){lo[0], lo[1], hi2[0], hi2[1]}; }
            y[j] = y[j] * YR_INV; x1[j] = (f32x4){bflo(xn[j].x), bfhi(xn[j].x), bflo(xn[j].y), bfhi(xn[j].y)}; ss += (y[j][0] * y[j][0] + y[j][1] * y[j][1]) + (y[j][2] * y[j][2] + y[j][3] * y[j][3]); }
        if (i + 1 < 16) P9_LOAD(row + 1);
        const float r = rsqrtf(wave_sum(ss) * (1.f / D) + 1e-6f);
#pragma unroll
        for (int j = 0; j < 4; ++j) *(GAS f32x4*)(F.a->out + (size_t)row * D + 4 * lane + 256 * j) = x1[j] + (y[j] * r) * gf[j];
    }
#undef P9_LOAD
}
namespace att {
#define SBAR() __builtin_amdgcn_sched_barrier(0)
typedef short s16x4 __attribute__((ext_vector_type(4)));
typedef short v4i16_t __attribute__((ext_vector_type(4)));
typedef __attribute__((address_space(3))) const char* lds_cptr;
__device__ __forceinline__ int crow(int r, int hi) { return (r & 3) + 8 * (r >> 2) + 4 * hi; }
__device__ __forceinline__ void glds16(const void* gsrc, unsigned lds_dst) { unsigned keep;
    asm volatile("s_mov_b32 %0, m0\n\ts_mov_b32 m0, %2\n\ts_nop 0\n\tglobal_load_lds_dwordx4 %1, off\n\ts_mov_b32 m0, %0" : "=&s"(keep) : "v"(gsrc), "s"(lds_dst) : "memory"); }
__device__ __forceinline__ s16x4 vtr(lds_cptr p) { return __builtin_bit_cast(s16x4, __builtin_amdgcn_ds_read_tr16_b64_v4i16((__attribute__((address_space(3))) v4i16_t*)p)); }
typedef float f32x2_t __attribute__((ext_vector_type(2))); typedef __bf16 bf16x2_t __attribute__((ext_vector_type(2)));
__device__ __forceinline__ unsigned cvtpk_s(float lo, float hi) { f32x2_t v = {lo, hi}; bf16x2_t b = __builtin_convertvector(v, bf16x2_t); return __builtin_bit_cast(unsigned, b); }
#define WAIT_BAR0() asm volatile("s_waitcnt vmcnt(0) lgkmcnt(0)\n\ts_barrier" ::: "memory")

struct Src {
    const bf16_t* q0; const bf16_t* q1; int qp;
    const bf16_t* k0; const bf16_t* k1; int kp0, kp1;
    const bf16_t* v; int vp;
};
template <int DQK, int DV> struct Geo {
    static constexpr int NKC = DQK / 8, NVB = DV / 32, KSLOT = NKC * 1024, VSLOT = NVB * 4096, NPIECE = NKC + 4 * NVB;
    static constexpr int NSLOT = 3, LDS_K = 0, LDS_V = NSLOT * KSLOT, LDS_WS = LDS_V + NSLOT * VSLOT, LDS_OST = 0  , LDS_TOTAL = LDS_WS + 8 * 256;
    static_assert(8 * 32 * DV * 2 <= LDS_WS && LDS_TOTAL <= 131072, "attention LDS map");
};
constexpr float THR = 8.f;
#ifndef ATT_VPM
#define ATT_VPM 8
#endif

template <int DQK, int DV, int MODE>
__device__ __forceinline__ void attn_unit(LAS char* shm, const Src sc, int qb, bf16_t* obase, float* td, float lam, const float* gsub) {
    typedef Geo<DQK, DV> G;
    int tid_ = threadIdx.x; asm volatile("" : "+v"(tid_));
    const int tid = tid_, lane = tid & 63, r32 = lane & 31, hi = lane >> 5; const int wid = __builtin_amdgcn_readfirstlane(tid >> 6);
    const int q0 = qb * 256, NT = 4 * (qb + 1);
    const unsigned lds0 = (unsigned)(uintptr_t)shm;
    LAS float* wsf = (LAS float*)(shm + G::LDS_WS) + wid * 64;
    const char* ksrc[2]; const char* vsrc[2]; long kstep[2], vstep;
#pragma unroll
    for (int i = 0; i < 2; ++i) { const int p = wid + 8 * i; ksrc[i] = nullptr; kstep[i] = 0; vsrc[i] = nullptr;
        if (p < G::NKC) { const bf16_t* base = p < 8 ? sc.k0 + 8 * p : sc.k1 + 8 * (p - 8); const int pitch = p < 8 ? sc.kp0 : sc.kp1; ksrc[i] = (const char*)(base + (long)lane * pitch); kstep[i] = 128L * pitch; }
        if (p < 4 * G::NVB) { const int db = p >> 2, rg = p & 3; vsrc[i] = (const char*)(sc.v + (long)(16 * rg + (lane >> 2)) * sc.vp + 32 * db + 8 * (lane & 3)); } }
    vstep = 128L * sc.vp;
#define DMA_K(slot) do { _Pragma("unroll") for (int i_ = 0; i_ < 2; ++i_) if (wid + 8 * i_ < G::NKC) { glds16(ksrc[i_], (unsigned)__builtin_amdgcn_readfirstlane(lds0 + G::LDS_K + (wid + 8 * i_) * 1024 + (slot) * G::KSLOT)); ksrc[i_] += kstep[i_]; } } while (0)
#define DMA_V(slot) do { _Pragma("unroll") for (int i_ = 0; i_ < 2; ++i_) if (wid + 8 * i_ < 4 * G::NVB) { glds16(vsrc[i_], (unsigned)__builtin_amdgcn_readfirstlane(lds0 + G::LDS_V + (wid + 8 * i_) * 1024 + (slot) * G::VSLOT)); vsrc[i_] += vstep; } } while (0)
    DMA_K(0); DMA_V(0); DMA_K(1); DMA_V(1); DMA_K(2);
    bf16x8 qr[DQK / 16];
    { const long qrow = (long)(q0 + wid * 32 + r32) * sc.qp;
#pragma unroll
      for (int d0 = 0; d0 < DQK / 16; ++d0) qr[d0] = d0 < 4 ? *reinterpret_cast<const bf16x8*>(sc.q0 + qrow + d0 * 16 + hi * 8) : *reinterpret_cast<const bf16x8*>(sc.q1 + qrow + (d0 - 4) * 16 + hi * 8); }
    float m_run = 0.f, l_reg = 0.f; bool first = true;
    f32x16 negm = f32x16{};
    f32x16 o[G::NVB];
#pragma unroll
    for (int d = 0; d < G::NVB; ++d) o[d] = f32x16{};
    const int qrel = wid * 32 + r32;
    const lds_cptr shm3 = (lds_cptr)shm;
    const lds_cptr kp0 = shm3 + G::LDS_K + hi * 1024 + r32 * 16;
    const lds_cptr vp0 = shm3 + G::LDS_V + ((lane >> 4) & 1) * 32 + (lane & 3) * 8 + (4 * hi + ((lane & 15) >> 2)) * 64;
#define QKT(P0, P1, slot) do { const lds_cptr kp_ = kp0 + (slot) * G::KSLOT; _Pragma("unroll") for (int d0 = 0; d0 < DQK / 16; ++d0) { \
        const bf16x8 b0_ = *(const __attribute__((address_space(3))) bf16x8*)(kp_ + d0 * 2048), b1_ = *(const __attribute__((address_space(3))) bf16x8*)(kp_ + d0 * 2048 + 512); \
        if (d0 == 0) { P0 = __builtin_amdgcn_mfma_f32_32x32x16_bf16(b0_, qr[0], negm, 0, 0, 0); P1 = __builtin_amdgcn_mfma_f32_32x32x16_bf16(b1_, qr[0], negm, 0, 0, 0); } \
        else { P0 = __builtin_amdgcn_mfma_f32_32x32x16_bf16(b0_, qr[d0], P0, 0, 0, 0); P1 = __builtin_amdgcn_mfma_f32_32x32x16_bf16(b1_, qr[d0], P1, 0, 0, 0); } } } while (0)
#define ACTIVE(t_) (!((t_) - (NT - 4) >= 0 && 64 * ((t_) - (NT - 4)) > 32 * wid + 31))
    int s_cur = 0, s_nx1 = 1, s_nx2 = 2;
    const bool three = (wid + 8 < G::NKC ? 2 : 1) + (wid + 8 < 4 * G::NVB ? 2 : 1) == 3;
    f32x16 sc0 = f32x16{}, sc1 = f32x16{}, sn0 = f32x16{}, sn1 = f32x16{};
    asm volatile("s_waitcnt vmcnt(0) lgkmcnt(0)\n\ts_barrier" ::: "memory");
    QKT(sc0, sc1, 0);
    for (int t = 0; t < NT; ++t) {
        if (t + 3 < NT) { if (three) asm volatile("s_waitcnt vmcnt(3) lgkmcnt(0)\n\ts_barrier" ::: "memory"); else asm volatile("s_waitcnt vmcnt(2) lgkmcnt(0)\n\ts_barrier" ::: "memory"); }
        else WAIT_BAR0();
        if (t + 3 < NT) DMA_K(s_cur);
        if (t + 2 < NT) DMA_V(s_nx2);
        const int jb = t - (NT - 4);
        const bool act = ACTIVE(t), nxt = (t + 1 < NT) && ACTIVE(t + 1);
        if (!act) { const int tmp = s_cur; s_cur = s_nx1; s_nx1 = s_nx2; s_nx2 = tmp; continue; }
        if (jb >= 0) { const int kb = 64 * jb + 4 * hi;
#pragma unroll
            for (int r = 0; r < 16; ++r) { const int kv = kb + (r & 3) + 8 * (r >> 2); if (kv > qrel) sc0[r] = -INFINITY; if (kv + 32 > qrel) sc1[r] = -INFINITY; } }
        float rm = fmaxf(sc0[0], sc1[0]);
#pragma unroll
        for (int r = 1; r < 16; ++r) rm = fmaxf(rm, fmaxf(sc0[r], sc1[r]));
        rm = swap32_max(rm, rm);
        if (first || __any(rm > THR)) {
            const float dl = first ? rm : fmaxf(rm, 0.f), f = first ? 1.f : __builtin_amdgcn_exp2f(-dl); m_run += dl; l_reg *= f; first = false;
#pragma unroll
            for (int r = 0; r < 16; ++r) { sc0[r] -= dl; sc1[r] -= dl; negm[r] = -m_run; }
            if (hi == 0) wsf[r32] = f;
            asm volatile("s_waitcnt lgkmcnt(0)" ::: "memory");
#pragma unroll
            for (int g = 0; g < 4; ++g) { const f32x4 fv = *(const LAS f32x4*)(wsf + 8 * g + 4 * hi);
#pragma unroll
                for (int d = 0; d < G::NVB; ++d) { o[d][4 * g] *= fv[0]; o[d][4 * g + 1] *= fv[1]; o[d][4 * g + 2] *= fv[2]; o[d][4 * g + 3] *= fv[3]; } }
        }
        u32x4 pw[4];
        if (nxt) {
            constexpr int ND0 = DQK / 16, NG = 2 * ND0;
            const lds_cptr kpn = kp0 + s_nx1 * G::KSLOT;
            float sacc = 0.f;
            bf16x8 kb0 = *(const __attribute__((address_space(3))) bf16x8*)(kpn), kb1 = *(const __attribute__((address_space(3))) bf16x8*)(kpn + 512), nb0 = kb0, nb1 = kb1;
#define ATT_GAP(g_) do { _Pragma("unroll") for (int e_ = ((g_) * 32) / NG; e_ < (((g_) + 1) * 32) / NG; ++e_) { \
                if (e_ < 16) { sc0[e_] = __builtin_amdgcn_exp2f(sc0[e_]); sacc += sc0[e_]; } else { sc1[e_ - 16] = __builtin_amdgcn_exp2f(sc1[e_ - 16]); sacc += sc1[e_ - 16]; } } \
                asm volatile("" : "+v"(sacc), "+v"(sc0), "+v"(sc1)); SBAR(); } while (0)
#pragma unroll
            for (int d0 = 0; d0 < ND0; ++d0) {
                if (d0 + 1 < ND0) { nb0 = *(const __attribute__((address_space(3))) bf16x8*)(kpn + (d0 + 1) * 2048); nb1 = *(const __attribute__((address_space(3))) bf16x8*)(kpn + (d0 + 1) * 2048 + 512); }
                sn0 = d0 == 0 ? __builtin_amdgcn_mfma_f32_32x32x16_bf16(kb0, qr[0], negm, 0, 0, 0) : __builtin_amdgcn_mfma_f32_32x32x16_bf16(kb0, qr[d0], sn0, 0, 0, 0);
                ATT_GAP(2 * d0);
                sn1 = d0 == 0 ? __builtin_amdgcn_mfma_f32_32x32x16_bf16(kb1, qr[0], negm, 0, 0, 0) : __builtin_amdgcn_mfma_f32_32x32x16_bf16(kb1, qr[d0], sn1, 0, 0, 0);
                ATT_GAP(2 * d0 + 1);
                kb0 = nb0; kb1 = nb1;
            }
#undef ATT_GAP
            l_reg += sacc;
#pragma unroll
            for (int k = 0; k < 4; ++k) { pw[0][k] = cvtpk_s(sc0[2 * k], sc0[2 * k + 1]); pw[1][k] = cvtpk_s(sc0[8 + 2 * k], sc0[8 + 2 * k + 1]); pw[2][k] = cvtpk_s(sc1[2 * k], sc1[2 * k + 1]); pw[3][k] = cvtpk_s(sc1[8 + 2 * k], sc1[8 + 2 * k + 1]); }
        } else {
            float sacc = 0.f;
#pragma unroll
            for (int r = 0; r < 16; ++r) { sc0[r] = __builtin_amdgcn_exp2f(sc0[r]); sc1[r] = __builtin_amdgcn_exp2f(sc1[r]); sacc += sc0[r] + sc1[r]; }
            l_reg += sacc;
#pragma unroll
            for (int k = 0; k < 4; ++k) { pw[0][k] = cvtpk_s(sc0[2 * k], sc0[2 * k + 1]); pw[1][k] = cvtpk_s(sc0[8 + 2 * k], sc0[8 + 2 * k + 1]); pw[2][k] = cvtpk_s(sc1[2 * k], sc1[2 * k + 1]); pw[3][k] = cvtpk_s(sc1[8 + 2 * k], sc1[8 + 2 * k + 1]); }
        }
        const lds_cptr vpp = vp0 + s_cur * G::VSLOT;
#pragma unroll
        for (int d = 0; d < G::NVB; ++d) {
#pragma unroll
            for (int ks = 0; ks < 4; ++ks) { const s16x4 lo = vtr(vpp + d * 4096 + ks * 1024), hh = vtr(vpp + d * 4096 + ks * 1024 + 512);
                const bf16x8 vf = {lo[0], lo[1], lo[2], lo[3], hh[0], hh[1], hh[2], hh[3]};
                o[d] = __builtin_amdgcn_mfma_f32_32x32x16_bf16(__builtin_bit_cast(bf16x8, pw[ks]), vf, o[d], 0, 0, 0); } }
        sc0 = sn0; sc1 = sn1;
        { const int tmp = s_cur; s_cur = s_nx1; s_nx1 = s_nx2; s_nx2 = tmp; }
    }
#undef QKT
#undef ACTIVE
#undef DMA_K
#undef DMA_V
    l_reg = swap32_sum(l_reg, l_reg);
    if (hi == 0) wsf[32 + r32] = l_reg;
    asm volatile("s_waitcnt lgkmcnt(0)" ::: "memory");
    float rli[16];
#pragma unroll
    for (int r = 0; r < 16; ++r) rli[r] = __builtin_amdgcn_rcpf(wsf[32 + crow(r, hi)]);
    const long orow0 = (long)(q0 + wid * 32);
    if (MODE == 1) {
#pragma unroll
        for (int r = 0; r < 16; ++r)
#pragma unroll
            for (int d = 0; d < G::NVB; ++d) td[(orow0 + crow(r, hi)) * 512 + d * 32 + r32] = o[d][r] * rli[r];
    } else {
        if (MODE == 2) {
            float ssr[16];
#pragma unroll
            for (int r = 0; r < 16; ++r) { float ss = 0.f;
#pragma unroll
                for (int d = 0; d < G::NVB; ++d) { const float v = td[(orow0 + crow(r, hi)) * 512 + d * 32 + r32] - lam * (o[d][r] * rli[r]); o[d][r] = v; ss += v * v; }
                ss += DPPF(ss, 0xB1); ss += DPPF(ss, 0x4E); ss += DPPF(ss, 0x141); ss += DPPF(ss, 0x140); ss = swap16_sum(ss, ss);
                ssr[r] = rsqrtf(ss * (1.f / DV) + 1e-5f) * (1.f - LAMBDA_INIT); }
#pragma unroll
            for (int d = 0; d < G::NVB; ++d) { const float gv = gsub[d * 32 + r32];
#pragma unroll
                for (int r = 0; r < 16; ++r) o[d][r] *= ssr[r] * gv; }
#pragma unroll
            for (int r = 0; r < 16; ++r) rli[r] = 1.f;
        }
        asm volatile("s_waitcnt lgkmcnt(0)\n\ts_barrier" ::: "memory");
        LAS bf16_t* stg = (LAS bf16_t*)(shm + G::LDS_OST) + wid * 32 * DV;
#pragma unroll
        for (int r = 0; r < 16; ++r) { const int orow = crow(r, hi);
#pragma unroll
            for (int d = 0; d < G::NVB; ++d) stg[orow * DV + d * 32 + r32] = (bf16_t)(cvtpk_s(o[d][r] * rli[r], 0.f) & 0xffffu); }
        asm volatile("s_waitcnt lgkmcnt(0)" ::: "memory");
        constexpr int CPR = DV / 8;
#pragma unroll
        for (int i = 0; i < 32 * CPR / 64; ++i) { const int idx = i * 64 + lane, row = idx / CPR, ch = idx % CPR; const u32x4 v = *(const LAS u32x4*)(stg + row * DV + ch * 8);
            *(u32x4*)(obase + (orow0 + row) * 1024 + ch * 8) = v; }
    }
    __builtin_amdgcn_s_setprio(0);
    asm volatile("s_waitcnt vmcnt(0) lgkmcnt(0)\n\ts_barrier" ::: "memory");
}
#undef SBAR
#undef WAIT_BAR0
}

__device__ __forceinline__ void attn_phase_all(Frame& F) {
    LAS char* shm = (LAS char*)(F.lds + RING_OFF);
    const int vcu = (F.bid & 7) * (F.G >> 3) + (F.bid >> 3);
    const bf16_t* QM = (const bf16_t*)(F.a->ws + WS_QM); const bf16_t* KVM = (const bf16_t*)(F.a->ws + WS_KVM); const bf16_t* PR = (const bf16_t*)(F.a->ws + WS_PROJ); bf16_t* ATT = (bf16_t*)(F.a->ws + WS_ATT);
    { const int p = vcu >> 1, b = p >> 3, h = p & 7, half = vcu & 1; const long r0 = (long)b * S;
      att::Src sc{QM + r0 * 768 + h * 64, QM + r0 * 768 + 512 + h * 32, 768, KVM + r0 * 1024 + h * 128, PR + r0 * PJ + PC_KR, 1024, PJ, KVM + r0 * 1024 + h * 128 + 64, 1024};
      for (int i = 0; i < 4; ++i) { const int qb = half == 0 ? (i == 0 ? 7 : i == 1 ? 5 : i == 2 ? 2 : 0) : (i == 0 ? 6 : i == 1 ? 4 : i == 2 ? 3 : 1);
#ifdef LEAK_UNIT
          if (i == LEAK_UNIT && threadIdx.x == 0) F.MISC[16] = (unsigned)__builtin_amdgcn_s_memrealtime();
#endif
          att::attn_unit<96, 64, 0>(shm, sc, qb, ATT + r0 * 1024 + h * 64, nullptr, 0.f, nullptr);
#ifdef LEAK_UNIT
          if (i == LEAK_UNIT && threadIdx.x == 0) F.MISC[17] = (unsigned)__builtin_amdgcn_s_memrealtime();
#endif
      } }
    { const int p = vcu >> 2, b = p >> 2, h = p & 3, s4 = vcu & 3; const long r0 = (long)b * S;
      float lam; { const float* l1 = F.a->in[IN_LQ1]; const float* k1 = F.a->in[IN_LK1]; const float* l2 = F.a->in[IN_LQ2]; const float* k2 = F.a->in[IN_LK2]; float s1 = 0.f, s2 = 0.f;
          for (int i = 0; i < 64; ++i) { s1 += l1[i] * k1[i]; s2 += l2[i] * k2[i]; } lam = __expf(s1) - __expf(s2) + LAMBDA_INIT; }
      float* td = (float*)(F.a->ws + WS_Y) + r0 * 512 + h * 128;
      for (int i = 0; i < 2; ++i) { const int qb = i == 0 ? 7 - s4 : s4;
          att::Src s0{PR + r0 * PJ + PC_QD + (2 * h) * 64, nullptr, PJ, PR + r0 * PJ + PC_KD + (2 * h) * 64, nullptr, PJ, PJ, PR + r0 * PJ + PC_VD + h * 128, PJ};
          att::Src s1{PR + r0 * PJ + PC_QD + (2 * h + 1) * 64, nullptr, PJ, PR + r0 * PJ + PC_KD + (2 * h + 1) * 64, nullptr, PJ, PJ, PR + r0 * PJ + PC_VD + h * 128, PJ};
          att::attn_unit<64, 128, 1>(shm, s0, qb, nullptr, td, 0.f, nullptr);
          att::attn_unit<64, 128, 2>(shm, s1, qb, ATT + r0 * 1024 + 512 + h * 128, td, lam, F.a->in[IN_GSUBLN]); } }
}
__device__ __forceinline__ void offsets_from_counts(Frame& F) {
    PHASE_IDS();
    int* cnt = (int*)(F.a->ws + WS_CNT);
    LAS int* part = (LAS int*)(F.lds + RING_OFF);
    LAS int* tile_e = (LAS int*)(F.lds + X_TILEE); LAS int* m2 = (LAS int*)(F.lds + X_MISC2);
    { const int e = tid & 31, p = tid >> 5; int tot = 0, pre = 0;
      for (int w = p * 16; w < p * 16 + 16; ++w) { const int c = __hip_atomic_load(cnt + w * NE + e, RLX_AGENT); tot += c; if (w < F.bid) pre += c; }
      part[(p * 32 + e) * 2] = tot; part[(p * 32 + e) * 2 + 1] = pre; }
    __syncthreads();
    if (tid < NE) { int tot = 0, pre = 0; for (int p = 0; p < 16; ++p) { tot += part[(p * 32 + tid) * 2]; pre += part[(p * 32 + tid) * 2 + 1]; } m2[96 + tid] = tot; m2[64 + tid] = pre; }
    __syncthreads();
    if (tid < NE) { int st = 0; for (int e = 0; e < tid; ++e) st += (m2[96 + e] + 255) & ~255; m2[32 + tid] = st; const int pad = (m2[96 + tid] + 255) & ~255;
        for (int r = st; r < st + pad; r += 256) tile_e[r >> 8] = tid; if (tid == NE - 1) m2[0] = (st + pad) >> 8; }
    __syncthreads();
}
__device__ __forceinline__ void p6_scatter(Frame& F) {
    offsets_from_counts(F);
    PHASE_IDS();
    LAS int* m2 = (LAS int*)(F.lds + X_MISC2);
    int* rowtok = (int*)(F.a->ws + WS_ROWTOK); float* roww = (float*)(F.a->ws + WS_ROWW); int* pos = (int*)(F.a->ws + WS_POS);
    { const int a = F.bid * 512 + tid; const int e = ((const int*)(F.a->ws + WS_SE))[a]; const float gt = ((const float*)(F.a->ws + WS_SG))[a]; const int rk = ((const int*)(F.a->ws + WS_SRANK))[a];
      const int dst = m2[32 + e] + m2[64 + e] + rk, tok = F.bid * 128 + (tid >> 2);
      rowtok[dst] = tok; roww[dst] = gt; pos[tok * 4 + (tid & 3)] = dst; }
    if (F.bid < NE && tid < 256) { const int e = F.bid, tot = m2[96 + e], st = m2[32 + e], pad = (tot + 255) & ~255; const int r = st + tot + tid; if (r < st + pad) { rowtok[r] = 0; roww[r] = 0.f; } }
}

#ifdef DEV_NAIVE_ATTN
template <int MODE>
__global__ void __launch_bounds__(256) k_attn_ref(const bf16_t* QM, const bf16_t* KVM, const bf16_t* PROJ, bf16_t* ATT, float* TD, const float* lq1, const float* lk1, const float* lq2, const float* lk2, const float* gsub) {
    constexpr int DQK = MODE == 0 ? 96 : 64, DV = MODE == 0 ? 64 : 128, NH = MODE == 0 ? 8 : 4;
    __shared__ float Ks[32][DQK]; __shared__ float Vs[32][DV];
    const int bh = blockIdx.y, b = bh / NH, h = bh % NH, q = blockIdx.x * 256 + threadIdx.x, tid = threadIdx.x, t = b * S + q;
    float lam = 0.f;
    if (MODE == 1) { float s1 = 0.f, s2 = 0.f; for (int i = 0; i < 64; ++i) { s1 += lq1[i] * lk1[i]; s2 += lq2[i] * lk2[i]; } lam = expf(s1) - expf(s2) + LAMBDA_INIT; }
    float res[DV];
    for (int j = 0; j < (MODE == 0 ? 1 : 2); ++j) {
        float qv[DQK]; float o[DV];
#pragma unroll
        for (int d = 0; d < DQK; ++d) qv[d] = MODE == 0 ? bf2f(QM[(size_t)t * 768 + (d < 64 ? h * 64 + d : 512 + h * 32 + d - 64)]) : bf2f(PROJ[(size_t)t * PJ + PC_QD + (2 * h + j) * 64 + d]);
#pragma unroll
        for (int d = 0; d < DV; ++d) o[d] = 0.f;
        float m = -1e30f, l = 0.f;
        const int kend = blockIdx.x * 256 + 256;
        for (int k0 = 0; k0 < kend; k0 += 32) {
            __syncthreads();
            for (int i = tid; i < 32 * DQK; i += 256) { const int kk = i / DQK, d = i % DQK; const size_t tk = (size_t)b * S + k0 + kk;
                Ks[kk][d] = MODE == 0 ? (d < 64 ? bf2f(KVM[tk * 1024 + h * 128 + d]) : bf2f(PROJ[tk * PJ + PC_KR + d - 64])) : bf2f(PROJ[tk * PJ + PC_KD + (2 * h + j) * 64 + d]); }
            for (int i = tid; i < 32 * DV; i += 256) { const int kk = i / DV, d = i % DV; const size_t tk = (size_t)b * S + k0 + kk;
                Vs[kk][d] = MODE == 0 ? bf2f(KVM[tk * 1024 + h * 128 + 64 + d]) : bf2f(PROJ[tk * PJ + PC_VD + h * 128 + d]); }
            __syncthreads();
            for (int kk = 0; kk < 32; ++kk) {
                if (k0 + kk > q) break;
                float s = 0.f;
#pragma unroll
                for (int d = 0; d < DQK; ++d) s += qv[d] * Ks[kk][d];
                const float mn = fmaxf(m, s), al = exp2f(m - mn), p = exp2f(s - mn);
                l = l * al + p; m = mn;
#pragma unroll
                for (int d = 0; d < DV; ++d) o[d] = o[d] * al + p * Vs[kk][d];
            }
        }
        const float inv = 1.f / l;
        if (MODE == 0) {
#pragma unroll
            for (int d = 0; d < DV; ++d) ATT[(size_t)t * D + h * 64 + d] = (bf16_t)(cvt_pk_bf16(o[d] * inv, 0.f) & 0xffffu);
        } else if (j == 0) {
#pragma unroll
            for (int d = 0; d < DV; ++d) TD[((size_t)t * 4 + h) * 128 + d] = o[d] * inv;
        } else { float ss = 0.f;
#pragma unroll
            for (int d = 0; d < DV; ++d) { res[d] = TD[((size_t)t * 4 + h) * 128 + d] - lam * (o[d] * inv); ss += res[d] * res[d]; }
            const float r = rsqrtf(ss * (1.f / 128.f) + 1e-5f) * (1.f - LAMBDA_INIT);
#pragma unroll
            for (int d = 0; d < DV; ++d) ATT[(size_t)t * D + 512 + h * 128 + d] = (bf16_t)(cvt_pk_bf16(res[d] * r * gsub[d], 0.f) & 0xffffu);
        }
    }
}
#endif

constexpr int N_PHASES = 11;
__global__ void __launch_bounds__(NWAVES * 64, 2) mk_fwd(Args args) {
    extern __shared__ __attribute__((aligned(16))) unsigned char lds[];
    Frame F;
    F.lds = (LAS unsigned char*)lds; F.MISC = (volatile LAS unsigned*)(F.lds + MISC_OFF);
    F.G = gridDim.x; F.bid = blockIdx.x;
    F.a = &args; F.ctl = (unsigned*)(args.ws + WS_CTL);
    for (int u = threadIdx.x; u < (X_TILEE - LDSCTL_OFF) / 4; u += NWAVES * 64) ((LAS unsigned*)(F.lds + LDSCTL_OFF))[u] = 0u;
    __syncthreads();
    const int lo = args.ph_lo, hi = args.ph_hi;
#ifdef LEAK_LO
    if (LEAK_LO == 0 && threadIdx.x == 0) F.MISC[16] = (unsigned)__builtin_amdgcn_s_memrealtime();
#endif
    XcdBarrier bar; bar.bar = F.ctl + CW_BAR; bar.x = 0; bar.st = nullptr;
    if (hi - lo > 1) bar = xcd_barrier_post(F.ctl + CW_BAR + args.li * XCD_BAR_WORDS, F.MISC + 8);
#ifndef PH_MASK
#define PH_MASK 0x7ff
#endif
#define IN(k) (((PH_MASK >> (k)) & 1) && lo <= (k) && (k) < hi)
#ifdef LEAK_LO
#define SEAM(k) do { if (IN(k) && IN((k) + 1)) xcd_barrier(bar); if (((k) + 1 == LEAK_LO || (k) + 1 == LEAK_HI) && threadIdx.x == 0) F.MISC[(k) + 1 == LEAK_LO ? 16 : 17] = (unsigned)__builtin_amdgcn_s_memrealtime(); } while (0)
#else
#define SEAM(k) do { if (IN(k) && IN((k) + 1)) xcd_barrier(bar); } while (0)
#endif
    LAS unsigned char* ring = F.lds + RING_OFF;
    if (IN(0)) { p0_prologue(F); } SEAM(0);
    if (IN(1)) { p0b_norm(F); } SEAM(1);
    if (IN(2)) {
        pg8::Gemm g{(const bf16_t*)(F.a->ws + WS_H), (const bf16_t*)(F.a->ws + WS_WIN), nullptr, 0, D, D, D, 0}; pg8::StaticOrder So; So.init(T, PJ, F.G, F.bid);
        epi::EpiProj E{(bf16_t*)(F.a->ws + WS_PROJ), (const f32x4*)(F.a->ws + WS_TABM), (const f32x4*)(F.a->ws + WS_TABD), (float*)(F.a->ws + WS_SSQ), (float*)(F.a->ws + WS_SSQ) + T};
        pg8::gemm_phase<epi::EpiProj, pg8::StaticOrder, false>(ring, g, So, E);
    } SEAM(2);
    if (IN(3)) {
#ifndef NO_Q
        { pg8::Gemm g{(const bf16_t*)(F.a->ws + WS_PROJ) + PC_CQ, (const bf16_t*)(F.a->ws + WS_WQB), nullptr, 0, PJ, 256, 256, 0}; pg8::StaticOrder So; So.init(T, 768, F.G, F.bid);
          epi::EpiQ E{(bf16_t*)(F.a->ws + WS_QM), (const f32x4*)(F.a->ws + WS_TABM), (const float*)(F.a->ws + WS_SSQ)};
          pg8::gemm_phase<epi::EpiQ, pg8::StaticOrder, false>(ring, g, So, E); }
#endif
#ifndef NO_KV
        { pg8::Gemm g{(const bf16_t*)(F.a->ws + WS_PROJ) + PC_CKV, (const bf16_t*)(F.a->ws + WS_WKVB), nullptr, 0, PJ, 128, 128, 0}; pg8::StaticOrder So; So.init(T, 1024, F.G, F.bid);
          epi::EpiKV E{(bf16_t*)(F.a->ws + WS_KVM), (const float*)(F.a->ws + WS_SSQ) + T};
          pg8::gemm_phase<epi::EpiKV, pg8::StaticOrder, false>(ring, g, So, E); }
#endif
    } SEAM(3);
    if (IN(4)) {
#ifndef DEV_NAIVE_ATTN
        attn_phase_all(F);
#endif
    } SEAM(4);
    if (IN(5)) {
        pg8::Gemm g{(const bf16_t*)(F.a->ws + WS_ATT), (const bf16_t*)(F.a->ws + WS_WO), nullptr, 0, D, D, D, 0}; pg8::StaticOrder So; So.init(T, D, F.G, F.bid);
        epi::EpiY E{(bf16_t*)(F.a->ws + WS_Y)};
        pg8::gemm_phase<epi::EpiY, pg8::StaticOrder, false>(ring, g, So, E);
    } SEAM(5);
    if (IN(6)) { p5_rows(F); } SEAM(6);
    if (IN(7)) { p6_scatter(F); } SEAM(7);
    if (IN(8)) {
        offsets_from_counts(F);
        pg8::GroupedOrder So{(const LAS int*)(F.lds + X_TILEE), __builtin_amdgcn_readfirstlane(((LAS int*)(F.lds + X_MISC2))[0]), 8, F.G, F.bid};
        pg8::Gemm g{(const bf16_t*)(F.a->ws + WS_H), (const bf16_t*)(F.a->ws + WS_WGU), (const int*)(F.a->ws + WS_ROWTOK), (size_t)2048 * 512, 512, 512, 512, 0};
        epi::EpiAct E{(unsigned char*)(F.a->ws + WS_ACT), F.a->in[IN_BGU]};
        pg8::gemm_phase<epi::EpiAct, pg8::GroupedOrder, true, true>(ring, g, So, E, F.lds + X_IDX);
    } SEAM(8);
    if (IN(9)) {
        offsets_from_counts(F);
        pg8::GroupedOrder So{(const LAS int*)(F.lds + X_TILEE), __builtin_amdgcn_readfirstlane(((LAS int*)(F.lds + X_MISC2))[0]), 4, F.G, F.bid};
        pg8::Gemm g{(const bf16_t*)(F.a->ws + WS_ACT), (const bf16_t*)(F.a->ws + WS_WD), nullptr, (size_t)1024 * 512, 512, 512, 512, 0};
        epi::EpiDown E{(unsigned char*)(F.a->ws + WS_YR), F.a->in[IN_BDN], (const float*)(F.a->ws + WS_ROWW)};
        pg8::gemm_phase<epi::EpiDown, pg8::GroupedOrder, false, true>(ring, g, So, E);
    } SEAM(9);
    if (IN(10)) { p9_final(F); }
#ifdef LEAK_LO
    if (blockIdx.x == 0 && threadIdx.x == 0) { if (LEAK_HI == 11) F.MISC[17] = (unsigned)__builtin_amdgcn_s_memrealtime(); asm volatile("s_waitcnt vmcnt(0) lgkmcnt(0)" ::: "memory"); args.out[0] += (float)(F.MISC[17] - F.MISC[16]) * LEAK_SCALE; }
#endif
#undef IN
#undef SEAM
}

extern "C" void kernel_launch(void* const* d_in, const int* in_sizes, int n_in, void* d_out, int out_size, void* d_ws, size_t ws_size, hipStream_t stream) {
    static int grid = 0;
    if (grid == 0) {
        if (n_in != 26 || in_sizes[0] != T * D || out_size != T * D || ws_size < WS_END) { fprintf(stderr, "kernel_launch: unexpected shapes (n_in %d, ws %zu); nothing launched\n", n_in, ws_size); grid = -1; return; }
        int dev = 0, cus = 0;
        if (hipGetDevice(&dev) != hipSuccess || hipDeviceGetAttribute(&cus, hipDeviceAttributeMultiprocessorCount, dev) != hipSuccess) { grid = -1; return; }
        if (hipFuncSetAttribute((const void*)mk_fwd, hipFuncAttributeMaxDynamicSharedMemorySize, LDS_BYTES) != hipSuccess) { fprintf(stderr, "kernel_launch: hipFuncSetAttribute failed\n"); grid = -1; return; }
        grid = cus;
        if (grid != 256) fprintf(stderr, "kernel_launch: %d CUs; this kernel is built for 256\n", grid);
    }
    if (grid < 0) return;
    (void)hipMemsetAsync((char*)d_ws + WS_CTL, 0, CTL_ZERO_BYTES, stream);
    Args a{};
    for (int i = 0; i < 26; ++i) a.in[i] = (const float*)d_in[i];
    a.out = (float*)d_out; a.ws = (unsigned char*)d_ws;
#ifndef MK_CUTS
#define MK_CUTS {0, N_PHASES}
#endif
    const int cuts[] = MK_CUTS; const int ncut = (int)(sizeof(cuts) / sizeof(int)) - 1;
    for (int li = 0; li < ncut; ++li) {
        a.ph_lo = cuts[li]; a.ph_hi = cuts[li + 1]; a.li = li;
        hipLaunchKernelGGL(mk_fwd, dim3(grid), dim3(NWAVES * 64), LDS_BYTES, stream, a);
#ifdef DEV_NAIVE_ATTN
        if (cuts[li + 1] == 5) {
            unsigned char* ws = (unsigned char*)d_ws;
            k_attn_ref<0><<<dim3(S / 256, NB * 8), 256, 0, stream>>>((const bf16_t*)(ws + WS_QM), (const bf16_t*)(ws + WS_KVM), (const bf16_t*)(ws + WS_PROJ), (bf16_t*)(ws + WS_ATT), nullptr, nullptr, nullptr, nullptr, nullptr, nullptr);
            k_attn_ref<1><<<dim3(S / 256, NB * 4), 256, 0, stream>>>((const bf16_t*)(ws + WS_QM), (const bf16_t*)(ws + WS_KVM), (const bf16_t*)(ws + WS_PROJ), (bf16_t*)(ws + WS_ATT), (float*)(ws + WS_Y),
                (const float*)d_in[IN_LQ1], (const float*)d_in[IN_LK1], (const float*)d_in[IN_LQ2], (const float*)d_in[IN_LK2], (const float*)d_in[IN_GSUBLN]);
        }
#endif
    }
}
```

```cpp
#include <hip/hip_runtime.h>
#include <cstdio>
#include <cstdint>

#define GAS __attribute__((address_space(1)))
#define LAS __attribute__((address_space(3)))
typedef unsigned short bf16_t;
typedef short bf16x8 __attribute__((ext_vector_type(8)));
typedef float f32x4 __attribute__((ext_vector_type(4)));
typedef float f32x2 __attribute__((ext_vector_type(2)));
typedef float f32x16 __attribute__((ext_vector_type(16)));
typedef unsigned u32x4 __attribute__((ext_vector_type(4)));
typedef unsigned u32x2 __attribute__((ext_vector_type(2)));
typedef int i32x4 __attribute__((ext_vector_type(4)));
typedef GAS unsigned gu32;
#define RLX_AGENT __ATOMIC_RELAXED, __HIP_MEMORY_SCOPE_AGENT
#define LDS_WAIT() asm volatile("s_waitcnt lgkmcnt(0)" ::: "memory")
#define VM_WAIT() asm volatile("s_waitcnt vmcnt(0)" ::: "memory")

constexpr int D = 1024, NB = 16, S = 2048, T = NB * S;
constexpr int INC = 1952;
constexpr int PJ = 2048;
constexpr int PC_CQ = 0, PC_CKV = 256, PC_KR = 384, PC_QD = 512, PC_KD = 1024, PC_VD = 1536;
constexpr int NE = 32, TOPK = 4, NA = T * TOPK, NROWS = (NA / 256 + NE) * 256, NTILE_MAX = NROWS / 256;
constexpr float LAMBDA_INIT = 0.2f, LOG2E = 1.4426950408889634f;
constexpr float C2M = 0.10206207261596577f * LOG2E;
constexpr float C2D = 0.125f * LOG2E;
#ifndef FP8_SCALE_OPND
#define FP8_SCALE_OPND 0x7f7f7f7f
#endif
constexpr float YR_SCALE = 16.f, YR_INV = 1.f / 16.f;
constexpr float W8_SCALE = 64.f, W8_INV = 1.f / 64.f;

__device__ __forceinline__ unsigned cvt_pk_bf16(float lo, float hi) { unsigned r; asm volatile("v_cvt_pk_bf16_f32 %0, %1, %2" : "=v"(r) : "v"(lo), "v"(hi)); return r; }
__device__ __forceinline__ float sat8(float v) { return __builtin_amdgcn_fmed3f(v, -448.f, 448.f); }
__device__ __forceinline__ unsigned pack4_fp8s(float a, float b, float c, float d);
__device__ __forceinline__ unsigned pack4_fp8(float a, float b, float c, float d) { int w = 0; w = __builtin_amdgcn_cvt_pk_fp8_f32(a, b, w, false); w = __builtin_amdgcn_cvt_pk_fp8_f32(c, d, w, true); return (unsigned)w; }
__device__ __forceinline__ unsigned pack4_fp8s(float a, float b, float c, float d) { return pack4_fp8(sat8(a), sat8(b), sat8(c), sat8(d)); }
__device__ __forceinline__ float bf2f(unsigned short h) { return __uint_as_float((unsigned)h << 16); }
__device__ __forceinline__ float bflo(unsigned w) { return __uint_as_float(w << 16); }
__device__ __forceinline__ float bfhi(unsigned w) { return __uint_as_float(w & 0xffff0000u); }
#define DPPF(v, ctrl) __builtin_bit_cast(float, __builtin_amdgcn_update_dpp(0, __builtin_bit_cast(int, (float)(v)), (ctrl), 0xf, 0xf, true))
__device__ __forceinline__ void swap16(float a, float b, float& x, float& y) { auto r = __builtin_amdgcn_permlane16_swap(__builtin_bit_cast(unsigned, a), __builtin_bit_cast(unsigned, b), false, false); unsigned r0 = r[0], r1 = r[1]; asm volatile("" : "+v"(r0), "+v"(r1)); x = __builtin_bit_cast(float, r0); y = __builtin_bit_cast(float, r1); }
__device__ __forceinline__ void swap32(float a, float b, float& x, float& y) { auto r = __builtin_amdgcn_permlane32_swap(__builtin_bit_cast(unsigned, a), __builtin_bit_cast(unsigned, b), false, false); unsigned r0 = r[0], r1 = r[1]; asm volatile("" : "+v"(r0), "+v"(r1)); x = __builtin_bit_cast(float, r0); y = __builtin_bit_cast(float, r1); }
__device__ __forceinline__ float swap16_sum(float a, float b) { float x, y; swap16(a, b, x, y); return x + y; }
__device__ __forceinline__ float swap32_sum(float a, float b) { float x, y; swap32(a, b, x, y); return x + y; }
__device__ __forceinline__ float swap32_max(float a, float b) { float x, y; swap32(a, b, x, y); return fmaxf(x, y); }
__device__ __forceinline__ float wave_sum(float v) {
    v += DPPF(v, 0xB1); v += DPPF(v, 0x4E); v += DPPF(v, 0x141); v += DPPF(v, 0x140);
    v = swap16_sum(v, v); return swap32_sum(v, v);
}
__device__ __forceinline__ float wave_max(float v) {
    v = fmaxf(v, DPPF(v, 0xB1)); v = fmaxf(v, DPPF(v, 0x4E)); v = fmaxf(v, DPPF(v, 0x141)); v = fmaxf(v, DPPF(v, 0x140));
    { float x, y; swap16(v, v, x, y); v = fmaxf(x, y); }
    return swap32_max(v, v);
}
__device__ __forceinline__ float lane_xor8(float v) { return DPPF(DPPF(v, 0x141), 0x140); }
__device__ __forceinline__ float lane_xor4(float v) { return DPPF(DPPF(v, 0x1B), 0x141); }

namespace pg8 {
constexpr int BM = 256, BK = 64, HALF = 128, HTB = HALF * BK * 2, STAGE_BYTES = 8 * HTB, NXCD = 8, WGM = 8;
__host__ __device__ __forceinline__ int lds_byte(int r, int c) { const int st = (r >> 4) * 2 + (c >> 5), rr = r & 15, cc = c & 31, ob = rr * 64 + cc * 2; return st * 1024 + (ob ^ (((ob >> 9) & 1) << 5)); }
__host__ __device__ __forceinline__ void stage_rc(int b, int& R, int& C) { const int st = b / 1024, sb = b % 1024, swz = sb ^ (((sb >> 9) & 1) << 5); R = (st >> 1) * 16 + swz / 64; C = (st & 1) * 32 + (swz % 64) / 2; }
__host__ __device__ __forceinline__ int perm32(int rho) { const int n = rho >> 4, i = rho & 15; return 8 * (i >> 2) + 4 * n + (i & 3); }

__host__ __device__ __forceinline__ int perm16(int R) { return 64 * (R >> 5) + 16 * ((R & 15) >> 2) + 4 * ((R >> 4) & 1) + (R & 3); }
template <class E, class = void> struct has_perm16 { static constexpr bool value = false; };
template <class E> struct has_perm16<E, decltype((void)E::PERM16)> { static constexpr bool value = E::PERM16; };
struct Unit { int pm, pn, e; };
struct Gemm { const bf16_t* A; const bf16_t* Bt; const int* rowidx; size_t b_estride; int lda, ldb, K, pad; };

struct StaticOrder {
    int nM, nN, nwg, G, c;
    __host__ __device__ void init(int M, int N, int G_, int c_) { nM = M / BM; nN = N / BM; nwg = nM * nN; G = G_; c = c_; }
    __host__ __device__ bool next(int i, Unit& u) const {
        const long L = (long)i * G + c; if (L >= nwg) return false;
        int wgid = (int)L; { const int q = nwg / NXCD, r = nwg % NXCD, xcd = wgid % NXCD, off = wgid / NXCD; wgid = (xcd < r ? xcd * (q + 1) : r * (q + 1) + (xcd - r) * q) + off; }
        const int nig = WGM * nN, gid = wgid / nig, fm = gid * WGM, gsz = (nM - fm) < WGM ? (nM - fm) : WGM;
        u.pm = fm + ((wgid % nig) % gsz); u.pn = (wgid % nig) / gsz; u.e = 0; return true;
    }
};
struct GroupedOrder {
    const LAS int* tile_e; int ntiles, ncol, G, c;
    __device__ bool next(int i, Unit& u) const {
        const int L = i * G + c, xcd = L & 7, j = L >> 3, block = j >> 5, within = j & 31, rpc = 32 / ncol;
        const int r = within / ncol, pn = within % ncol, rt = (block * 8 + xcd) * rpc + r;
        if (rt >= ntiles) return false;
        u.pm = rt; u.pn = pn; u.e = __builtin_amdgcn_readfirstlane(tile_e[rt]); return true;
    }
};

template <class Epi, class Sched, bool GATHER = false, bool FP8 = false>
__device__ __forceinline__ void gemm_phase(LAS unsigned char* lds, const Gemm g, const Sched& S, const Epi& E, LAS unsigned char* idxl = nullptr) {
    int tid_ = threadIdx.x; asm volatile("" : "+v"(tid_));
    const int tid = tid_, wid = __builtin_amdgcn_readfirstlane(tid >> 6), lane = tid & 63, wr = wid >> 2, wc = wid & 3, fr = lane & 15, fq = lane >> 4;
    const int K = g.K, nt = K / BK;
    int Rr[2], Cc[2];
    unsigned voffA[2][2], voffB[2];
#pragma unroll
    for (int i = 0; i < 2; ++i) { stage_rc(tid * 16 + i * 8192, Rr[i], Cc[i]); const int Rb = has_perm16<Epi>::value ? perm16(Rr[i]) : Epi::PERM ? ((Rr[i] & ~31) + perm32(Rr[i] & 31)) : Rr[i];
        voffA[0][i] = (unsigned)(Rr[i] * g.lda + Cc[i]) * 2u; voffA[1][i] = (unsigned)((Rr[i] + HALF) * g.lda + Cc[i]) * 2u; voffB[i] = (unsigned)(Rb * g.ldb + Cc[i]) * 2u; }
    const unsigned kstep = BK * 2, hstepB = (unsigned)((has_perm16<Epi>::value ? 8 : HALF) * g.ldb * 2), tstepA = (unsigned)(BM * g.lda * 2), tstepB = (unsigned)(BM * g.ldb * 2);
    const __amdgpu_buffer_rsrc_t rA = __builtin_amdgcn_make_buffer_rsrc((void*)g.A, 0, 0x7ffffff0, 0x00020000), rB = __builtin_amdgcn_make_buffer_rsrc((void*)g.Bt, 0, 0x7ffffff0, 0x00020000);
    const unsigned ldsw = (unsigned)wid * 1024u;
    const int aoff = lds_byte(wr * 64 + fr, fq * 8), boff = lds_byte(wc * 32 + fr, fq * 8);
#define PG8_SA(b, h) (((b) * 2 + (h)) * HTB)
#define PG8_SB(b, h) ((4 + (b) * 2 + (h)) * HTB)
#define PG8_STAGE(bufoff, rs, soff, voff) do { _Pragma("unroll") for (int _i = 0; _i < 2; ++_i) \
        __builtin_amdgcn_raw_ptr_buffer_load_lds(rs, (LAS void*)(lds + (bufoff) + ldsw + _i * 8192), 16, (int)(voff)[_i], (int)(soff), 0, 0); } while (0)
#define PG8_LDA(dst, b, h) do { _Pragma("unroll") for (int m = 0; m < 4; ++m) _Pragma("unroll") for (int k = 0; k < 2; ++k) dst[m][k] = *(const LAS bf16x8*)(lds + PG8_SA(b, h) + aoff + m * 2048 + k * 1024); } while (0)
#define PG8_LDB(dst, b, h) do { _Pragma("unroll") for (int n = 0; n < 2; ++n) _Pragma("unroll") for (int k = 0; k < 2; ++k) dst[n][k] = *(const LAS bf16x8*)(lds + PG8_SB(b, h) + boff + n * 2048 + k * 1024); } while (0)
#define PG8_MMA(ai, bj, At, Bt) do { __builtin_amdgcn_s_setprio(1); _Pragma("unroll") for (int m = 0; m < 4; ++m) _Pragma("unroll") for (int n = 0; n < 2; ++n) { \
        if constexpr (FP8) acc[ai][bj][m][n] = __builtin_amdgcn_mfma_scale_f32_16x16x128_f8f6f4(PG8_CAT(Bt[n][0], Bt[n][1]), PG8_CAT(At[m][0], At[m][1]), acc[ai][bj][m][n], 0, 0, 0, FP8_SCALE_OPND, 0, FP8_SCALE_OPND); \
        else { _Pragma("unroll") for (int k = 0; k < 2; ++k) acc[ai][bj][m][n] = __builtin_amdgcn_mfma_f32_16x16x32_bf16(Bt[n][k], At[m][k], acc[ai][bj][m][n], 0, 0, 0); } } __builtin_amdgcn_s_setprio(0); } while (0)
#define PG8_CAT(x0, x1) __builtin_shufflevector(__builtin_bit_cast(i32x4, x0), __builtin_bit_cast(i32x4, x1), 0, 1, 2, 3, 4, 5, 6, 7)
#define PG8_WAIT_V(n) asm volatile("s_waitcnt vmcnt(" #n ")" ::: "memory")
#define PG8_WAIT_L(n) asm volatile("s_waitcnt lgkmcnt(" #n ")" ::: "memory")
#define PG8_BAR __builtin_amdgcn_s_barrier()
#define PG8_SCHED __builtin_amdgcn_sched_barrier(0)
    Unit cur, nxt; int ui = 0;
    if (!S.next(0, cur)) return;
    f32x4 acc[2][2][4][2];
#pragma unroll
    for (int a = 0; a < 2; ++a)
#pragma unroll
        for (int b = 0; b < 2; ++b)
#pragma unroll
            for (int m = 0; m < 4; ++m)
#pragma unroll
                for (int n = 0; n < 2; ++n) acc[a][b][m][n] = (f32x4){0.f, 0.f, 0.f, 0.f};
    bf16x8 At[4][2], B0[2][2], B1[2][2];
    unsigned gA[2][2];
    unsigned cA, cB = (unsigned)cur.e * (unsigned)(g.b_estride * 2) + (unsigned)cur.pn * tstepB;
    if constexpr (GATHER) { cA = 0u;
#pragma unroll
        for (int h = 0; h < 2; ++h)
#pragma unroll
            for (int i = 0; i < 2; ++i) gA[h][i] = (unsigned)g.rowidx[cur.pm * BM + h * HALF + Rr[i]] * (unsigned)(g.lda * 2) + (unsigned)Cc[i] * 2u;
    } else { cA = (unsigned)cur.pm * tstepA;
#pragma unroll
        for (int h = 0; h < 2; ++h)
#pragma unroll
            for (int i = 0; i < 2; ++i) gA[h][i] = voffA[h][i]; }
    PG8_STAGE(PG8_SB(0, 0), rB, cB, voffB); PG8_STAGE(PG8_SB(0, 1), rB, cB + hstepB, voffB); PG8_STAGE(PG8_SA(0, 0), rA, cA, gA[0]); PG8_STAGE(PG8_SA(0, 1), rA, cA, gA[1]);
    if (wr == 1) PG8_BAR;
    PG8_WAIT_V(2); PG8_BAR;
    PG8_STAGE(PG8_SB(1, 0), rB, cB + kstep, voffB); PG8_STAGE(PG8_SA(1, 0), rA, cA + kstep, gA[0]); PG8_STAGE(PG8_SB(1, 1), rB, cB + hstepB + kstep, voffB);
    PG8_WAIT_V(6); PG8_BAR;
    for (;;) {
        const bool has_next = S.next(ui + 1, nxt);
        unsigned nA; const unsigned nB = has_next ? (unsigned)nxt.e * (unsigned)(g.b_estride * 2) + (unsigned)nxt.pn * tstepB : cB;
        if constexpr (GATHER) nA = cA; else nA = has_next ? (unsigned)nxt.pm * tstepA : cA;
#pragma nounroll
        for (int t = 0; t < nt; t += 2) {
            const bool last = (t == nt - 2);
            const unsigned a1 = cA + (unsigned)(t + 1) * kstep;
            const unsigned a2 = last ? nA : cA + (unsigned)(t + 2) * kstep, b2 = last ? nB : cB + (unsigned)(t + 2) * kstep;
            const unsigned a3 = a2 + kstep, b3 = b2 + kstep;
            if constexpr (GATHER) { if (t == 0 && has_next && wid < 4)
                __builtin_amdgcn_global_load_lds((const unsigned*)(g.rowidx + nxt.pm * BM + wid * 64 + lane), (LAS unsigned*)(idxl + ((ui + 1) & 1) * 1024 + wid * 256), 4, 0, 0); }
            PG8_LDB(B0, 0, 0); PG8_LDB(B1, 0, 1); PG8_SCHED; PG8_LDA(At, 0, 0); PG8_STAGE(PG8_SA(1, 1), rA, a1, gA[1]);
            if constexpr (GATHER) { if (last && has_next) { int t3 = threadIdx.x; asm volatile("" : "+v"(t3));
#pragma unroll
                for (int i = 0; i < 2; ++i) { int R3, C3; stage_rc(t3 * 16 + i * 8192, R3, C3);
#pragma unroll
                    for (int h = 0; h < 2; ++h) gA[h][i] = *(const LAS unsigned*)(idxl + ((ui + 1) & 1) * 1024 + (h * HALF + R3) * 4) * (unsigned)(g.lda * 2) + (unsigned)C3 * 2u; } } }
            PG8_WAIT_V(8); PG8_WAIT_L(0); PG8_BAR; PG8_MMA(0, 0, At, B0); PG8_MMA(0, 1, At, B1); PG8_BAR; PG8_SCHED;
            PG8_LDA(At, 0, 1); PG8_STAGE(PG8_SB(0, 0), rB, b2, voffB); PG8_STAGE(PG8_SB(0, 1), rB, b2 + hstepB, voffB); PG8_STAGE(PG8_SA(0, 0), rA, a2, gA[0]);
            PG8_WAIT_V(8); PG8_WAIT_L(0); PG8_BAR; PG8_MMA(1, 0, At, B0); PG8_MMA(1, 1, At, B1); PG8_BAR; PG8_SCHED;
            PG8_LDB(B0, 1, 0); PG8_LDB(B1, 1, 1); PG8_SCHED; PG8_LDA(At, 1, 0); PG8_STAGE(PG8_SA(0, 1), rA, a2, gA[1]);
            PG8_WAIT_V(8); PG8_WAIT_L(0); PG8_BAR; PG8_MMA(0, 0, At, B0); PG8_MMA(0, 1, At, B1); PG8_BAR; PG8_SCHED;
            PG8_LDA(At, 1, 1); PG8_STAGE(PG8_SB(1, 0), rB, b3, voffB); PG8_STAGE(PG8_SB(1, 1), rB, b3 + hstepB, voffB); PG8_STAGE(PG8_SA(1, 0), rA, a3, gA[0]);
            PG8_WAIT_V(8); PG8_WAIT_L(0); PG8_BAR; PG8_MMA(1, 0, At, B0); PG8_MMA(1, 1, At, B1); PG8_BAR; PG8_SCHED;
        }
#ifndef PG8_NOALIGN
        if (wr == 0) PG8_BAR;
#endif
        { int t2 = threadIdx.x; asm volatile("" : "+v"(t2)); E(acc, cur, wr, wc, t2 & 15, (t2 >> 4) & 3); }
        if (!has_next) break;
#pragma unroll
        for (int a = 0; a < 2; ++a)
#pragma unroll
            for (int b = 0; b < 2; ++b)
#pragma unroll
                for (int m = 0; m < 4; ++m)
#pragma unroll
                    for (int n = 0; n < 2; ++n) acc[a][b][m][n] = (f32x4){0.f, 0.f, 0.f, 0.f};
        cur = nxt; cA = nA; cB = nB; ++ui;
#ifndef PG8_NOALIGN
        if (wr == 1) PG8_BAR;
#endif
    }
    PG8_WAIT_V(0);
#ifdef PG8_NOALIGN
    if (wr == 0) PG8_BAR;
#endif
    PG8_BAR;
#undef PG8_SA
#undef PG8_SB
#undef PG8_STAGE
#undef PG8_LDA
#undef PG8_LDB
#undef PG8_MMA
#undef PG8_CAT
#undef PG8_WAIT_V
#undef PG8_WAIT_L
#undef PG8_BAR
#undef PG8_SCHED
}
}
namespace epi {
using pg8::Unit; using pg8::HALF; using pg8::BM;
__device__ __forceinline__ u32x4 pack8(f32x4 a, f32x4 b) { u32x4 w; w.x = cvt_pk_bf16(a[0], a[1]); w.y = cvt_pk_bf16(a[2], a[3]); w.z = cvt_pk_bf16(b[0], b[1]); w.w = cvt_pk_bf16(b[2], b[3]); return w; }
__device__ __forceinline__ u32x2 pack4(f32x4 a) { u32x2 w; w.x = cvt_pk_bf16(a[0], a[1]); w.y = cvt_pk_bf16(a[2], a[3]); return w; }
__device__ __forceinline__ void rope4(f32x4& a, f32x4& b, const f32x4 t0, const f32x4 t1) {
    const f32x4 c = {t0[0], t0[2], t1[0], t1[2]}, s = {t0[1], t0[3], t1[1], t1[3]};
    const f32x4 na = a * c - b * s, nb = b * c + a * s; a = na; b = nb;
}
__device__ __forceinline__ void ssq_add(float* ssq, int row, float ss, int fq) { ss += __shfl_xor(ss, 16); ss += __shfl_xor(ss, 32); if (fq == 0) atomicAdd(ssq + row, ss); }
__device__ __forceinline__ float sq8(f32x4 a, f32x4 b) { return (a[0] * a[0] + a[1] * a[1]) + (a[2] * a[2] + a[3] * a[3]) + (b[0] * b[0] + b[1] * b[1]) + (b[2] * b[2] + b[3] * b[3]); }

struct EpiProj {
    static constexpr bool PERM = true;
    bf16_t* P; const f32x4* tabm; const f32x4* tabd; float* ssq_q; float* ssq_kv;
    __device__ __forceinline__ void operator()(const f32x4 (&acc)[2][2][4][2], const Unit& u, int wr, int wc, int fr, int fq) const {
        const int row0 = u.pm * BM + wr * 64 + fr, pn = u.pn;
#pragma unroll
        for (int ai = 0; ai < 2; ++ai)
#pragma unroll
            for (int m = 0; m < 4; ++m) { const int row = row0 + ai * HALF + m * 16; bf16_t* rp = P + (size_t)row * PJ;
                if (pn == 0) { float ss = 0.f;
#pragma unroll
                    for (int bj = 0; bj < 2; ++bj) { const f32x4 v0 = acc[ai][bj][m][0], v1 = acc[ai][bj][m][1]; ss += sq8(v0, v1); *(u32x4*)(rp + bj * HALF + wc * 32 + 8 * fq) = pack8(v0, v1); }
                    ssq_add(ssq_q, row, ss, fq);
                } else if (pn == 1) {
                    { const f32x4 v0 = acc[ai][0][m][0], v1 = acc[ai][0][m][1]; *(u32x4*)(rp + 256 + wc * 32 + 8 * fq) = pack8(v0, v1); ssq_add(ssq_kv, row, sq8(v0, v1), fq); }
                    if (wc == 0) { f32x4 a = acc[ai][1][m][0], b = acc[ai][1][m][1]; const f32x4 t0 = tabm[(size_t)row * 8 + 2 * fq], t1 = tabm[(size_t)row * 8 + 2 * fq + 1]; rope4(a, b, t0, t1);
                        *(u32x2*)(rp + PC_KR + 4 * fq) = pack4(a); *(u32x2*)(rp + PC_KR + 16 + 4 * fq) = pack4(b); }
                } else if (pn < 6) { const int g = 4 * (wc & 1) + fq; const f32x4 t0 = tabd[(size_t)row * 16 + 2 * g], t1 = tabd[(size_t)row * 16 + 2 * g + 1]; const float sc = pn < 4 ? C2D : 1.f;
#pragma unroll
                    for (int bj = 0; bj < 2; ++bj) { f32x4 a = acc[ai][bj][m][0] * sc, b = acc[ai][bj][m][1] * sc; rope4(a, b, t0, t1);
                        bf16_t* bp = rp + pn * 256 + bj * HALF + (wc >> 1) * 64 + 4 * g; *(u32x2*)bp = pack4(a); *(u32x2*)(bp + 32) = pack4(b); }
                } else {
#pragma unroll
                    for (int bj = 0; bj < 2; ++bj) *(u32x4*)(rp + pn * 256 + bj * HALF + wc * 32 + 8 * fq) = pack8(acc[ai][bj][m][0], acc[ai][bj][m][1]);
                }
            }
    }
};
struct EpiQ {
    static constexpr bool PERM = true;
    bf16_t* Q; const f32x4* tabm; const float* ssq_q;
    __device__ __forceinline__ void operator()(const f32x4 (&acc)[2][2][4][2], const Unit& u, int wr, int wc, int fr, int fq) const {
        const int row0 = u.pm * BM + wr * 64 + fr;
        if (u.pn < 2) {
#pragma unroll
            for (int ai = 0; ai < 2; ++ai)
#pragma unroll
                for (int m = 0; m < 4; ++m) { const int row = row0 + ai * HALF + m * 16; const float rs = rsqrtf(ssq_q[row] * (1.f / 256.f) + 1e-6f) * C2M; bf16_t* rp = Q + (size_t)row * 768 + u.pn * BM + wc * 32 + 8 * fq;
#pragma unroll
                    for (int bj = 0; bj < 2; ++bj) *(u32x4*)(rp + bj * HALF) = pack8(acc[ai][bj][m][0] * rs, acc[ai][bj][m][1] * rs); }
        } else {
#pragma unroll
            for (int ai = 0; ai < 2; ++ai)
#pragma unroll
                for (int m = 0; m < 4; ++m) { const int row = row0 + ai * HALF + m * 16; const float rs = rsqrtf(ssq_q[row] * (1.f / 256.f) + 1e-6f) * C2M; bf16_t* rp = Q + (size_t)row * 768 + 512 + wc * 32 + 4 * fq;
                    const f32x4 t0 = tabm[(size_t)row * 8 + 2 * fq], t1 = tabm[(size_t)row * 8 + 2 * fq + 1];
#pragma unroll
                    for (int bj = 0; bj < 2; ++bj) { f32x4 a = acc[ai][bj][m][0] * rs, b = acc[ai][bj][m][1] * rs; rope4(a, b, t0, t1); *(u32x2*)(rp + bj * 128) = pack4(a); *(u32x2*)(rp + bj * 128 + 16) = pack4(b); }
                    asm volatile("" ::: "memory"); }
        }
    }
};
struct EpiKV {
    static constexpr bool PERM = true;
    bf16_t* KV; const float* ssq_kv;
    __device__ __forceinline__ void operator()(const f32x4 (&acc)[2][2][4][2], const Unit& u, int wr, int wc, int fr, int fq) const {
        const int row0 = u.pm * BM + wr * 64 + fr;
#pragma unroll
        for (int ai = 0; ai < 2; ++ai)
#pragma unroll
            for (int m = 0; m < 4; ++m) { const int row = row0 + ai * HALF + m * 16; const float rs = rsqrtf(ssq_kv[row] * (1.f / 128.f) + 1e-6f); bf16_t* rp = KV + (size_t)row * 1024 + u.pn * BM + wc * 32 + 8 * fq;
#pragma unroll
                for (int bj = 0; bj < 2; ++bj) *(u32x4*)(rp + bj * HALF) = pack8(acc[ai][bj][m][0] * rs, acc[ai][bj][m][1] * rs); }
    }
};
struct EpiY {
    static constexpr bool PERM = true;
    bf16_t* Y;
    __device__ __forceinline__ void operator()(const f32x4 (&acc)[2][2][4][2], const Unit& u, int wr, int wc, int fr, int fq) const {
        const __amdgpu_buffer_rsrc_t rY = __builtin_amdgcn_make_buffer_rsrc((void*)Y, 0, T * 1024 * 2, 0x00020000);
        const int row0 = u.pm * BM + wr * 64 + fr, col = u.pn * BM + wc * 32 + 8 * fq;
#pragma unroll
        for (int ai = 0; ai < 2; ++ai)
#pragma unroll
            for (int m = 0; m < 4; ++m) { const int row = row0 + ai * HALF + m * 16;
#pragma unroll
                for (int bj = 0; bj < 2; ++bj) __builtin_amdgcn_raw_buffer_store_b128(pack8(acc[ai][bj][m][0], acc[ai][bj][m][1]), rY, (row * 1024 + col + bj * HALF) * 2, 0, 0); }
    }
};
struct EpiAct {
    static constexpr bool PERM = true;
    unsigned char* ACT; const float* bgu;
    __device__ __forceinline__ void operator()(const f32x4 (&acc)[2][2][4][2], const Unit& u, int wr, int wc, int fr, int fq) const {
        const __amdgpu_buffer_rsrc_t rA = __builtin_amdgcn_make_buffer_rsrc((void*)ACT, 0, 0x7ffffff0, 0x00020000), rB = __builtin_amdgcn_make_buffer_rsrc((void*)bgu, 0, NE * 2048 * 4, 0x00020000);
        const int row0 = u.pm * BM + wr * 64 + fr, j0 = u.pn * 128 + wc * 32 + 8 * fq;
        f32x4 bg[2], bu[2];
#pragma unroll
        for (int n = 0; n < 2; ++n) { bg[n] = __builtin_bit_cast(f32x4, __builtin_amdgcn_raw_buffer_load_b128(rB, (u.e * 2048 + j0 + 4 * n) * 4, 0, 0)); bu[n] = __builtin_bit_cast(f32x4, __builtin_amdgcn_raw_buffer_load_b128(rB, (u.e * 2048 + 1024 + j0 + 4 * n) * 4, 0, 0)); }
#pragma unroll
        for (int ai = 0; ai < 2; ++ai)
#pragma unroll
            for (int m = 0; m < 4; ++m) { const int row = row0 + ai * HALF + m * 16; u32x2 o;
#pragma unroll
                for (int n = 0; n < 2; ++n) { const f32x4 gv = acc[ai][0][m][n] * W8_INV + bg[n], uv = acc[ai][1][m][n] * W8_INV + bu[n]; float a4[4];
#pragma unroll
                    for (int i = 0; i < 4; ++i) { const float gg = fminf(gv[i], 7.f), uu = fminf(fmaxf(uv[i], -7.f), 7.f); a4[i] = gg * __builtin_amdgcn_rcpf(1.f + __builtin_amdgcn_exp2f(-1.702f * LOG2E * gg)) * (uu + 1.f); }
                    o[n] = pack4_fp8(a4[0], a4[1], a4[2], a4[3]); }
                __builtin_amdgcn_raw_buffer_store_b64(o, rA, row * 1024 + j0, 0, 0); }
    }
};
struct EpiDown {
    static constexpr bool PERM = true, PERM16 = true;
    unsigned char* YR; const float* bd; const float* roww;
    __device__ __forceinline__ void operator()(const f32x4 (&acc)[2][2][4][2], const Unit& u, int wr, int wc, int fr, int fq) const {
        const __amdgpu_buffer_rsrc_t rY = __builtin_amdgcn_make_buffer_rsrc((void*)YR, 0, 0x7ffffff0, 0x00020000), rB = __builtin_amdgcn_make_buffer_rsrc((void*)bd, 0, NE * 1024 * 4, 0x00020000),
                                     rW = __builtin_amdgcn_make_buffer_rsrc((void*)roww, 0, NROWS * 4, 0x00020000);
        const int row0 = u.pm * BM + wr * 64 + fr, col = u.pn * BM + wc * 64 + 16 * fq, boff = (u.e * 1024 + col) * 4;
#pragma unroll
        for (int ai = 0; ai < 2; ++ai) {
            f32x4 bv[2][2];
#pragma unroll
            for (int bj = 0; bj < 2; ++bj)
#pragma unroll
                for (int n = 0; n < 2; ++n) bv[bj][n] = __builtin_bit_cast(f32x4, __builtin_amdgcn_raw_buffer_load_b128(rB, boff + (8 * bj + 4 * n) * 4, 0, 0));
#pragma unroll
            for (int m = 0; m < 4; ++m) { const int row = row0 + ai * HALF + m * 16; const float ww = YR_SCALE * __builtin_bit_cast(float, __builtin_amdgcn_raw_buffer_load_b32(rW, row * 4, 0, 0)), w8 = ww * W8_INV; u32x4 o;
#pragma unroll
                for (int bj = 0; bj < 2; ++bj)
#pragma unroll
                    for (int n = 0; n < 2; ++n) { const f32x4 v = acc[ai][bj][m][n] * w8 + bv[bj][n] * ww; o[2 * bj + n] = pack4_fp8s(v[0], v[1], v[2], v[3]); }
                __builtin_amdgcn_raw_buffer_store_b128(o, rY, row * 1024 + col, 0, 0); }
            asm volatile("" ::: "memory"); }
    }
};
}
constexpr size_t MiB = 1u << 20;
constexpr size_t WS_CTL = 0, CTL_ZERO_BYTES = 64 * 1024;
constexpr size_t WS_MOD = 1 * MiB;
constexpr size_t WS_SSQ = 1 * MiB + 512 * 1024;
constexpr size_t WS_TABM = 2 * MiB, WS_TABD = 6 * MiB;
constexpr size_t WS_SE = 14 * MiB, WS_SG = 14 * MiB + 512 * 1024, WS_SRANK = 18 * MiB + 512 * 1024;
constexpr size_t WS_POS = 15 * MiB;
constexpr size_t WS_ROWTOK = 16 * MiB, WS_ROWW = 17 * MiB;
constexpr size_t WS_CNT = 18 * MiB;
constexpr size_t WS_TD0 = 19 * MiB;
constexpr size_t WS_WIN = 20 * MiB, WS_WQB = 24 * MiB, WS_WKVB = 25 * MiB, WS_WO = 26 * MiB;
constexpr size_t WS_WGU = 28 * MiB, WS_WD = 156 * MiB;
constexpr size_t WS_H = 220 * MiB;
constexpr size_t WS_PROJ = 284 * MiB;
constexpr size_t WS_QM = 412 * MiB, WS_KVM = 460 * MiB, WS_ATT = 524 * MiB, WS_Y = 588 * MiB;
constexpr size_t WS_X1 = 524 * MiB;
constexpr size_t WS_ACT = 284 * MiB;
constexpr size_t WS_YR = 588 * MiB;
constexpr size_t WS_END = 860 * MiB;
static_assert(WS_ACT + (size_t)NROWS * 1024 * 2 <= WS_YR && WS_YR + (size_t)NROWS * 1024 * 2 <= WS_END, "ws map");
constexpr int CW_BAR = 4096;

constexpr int RING_OFF = 0, RING_BYTES = 131072;
constexpr int LDSCTL_OFF = RING_BYTES, MISC_OFF = LDSCTL_OFF + 320;
constexpr int XTRA_OFF = MISC_OFF + 128;
constexpr int X_TILEE = XTRA_OFF;
constexpr int X_SE = X_TILEE + 2304, X_SG = X_SE + 2048, X_SRANK = X_SG + 2048, X_WCNT = X_SRANK + 2048, X_MISC2 = X_WCNT + 1024;
constexpr int X_IDX = X_MISC2 + 1024;
constexpr int X_CONST = 147456;
constexpr int LDS_BYTES = 163840;
static_assert(X_IDX + 2048 <= X_CONST && X_CONST + 12288 <= LDS_BYTES, "LDS map");
constexpr int NWAVES = 8;

#define XB_TMO      128
#define XB_XCNT(j)  (256  + 64 * (j))
#define XB_XSUB(j)  (1280 + 64 * (j))
#define XB_XGEN(j)  (2304 + 64 * (j))
#define XB_TOP      3328
#define XB_TOPGEN   3392
#define XCD_BAR_WORDS 3456
#define XB_SPIN_CAP (1u << 18)
__device__ __forceinline__ unsigned xb_ld(unsigned* p)              { return __hip_atomic_load(p, __ATOMIC_RELAXED, __HIP_MEMORY_SCOPE_AGENT); }
__device__ __forceinline__ unsigned xb_add(unsigned* p, unsigned v) { return __hip_atomic_fetch_add(p, v, __ATOMIC_RELAXED, __HIP_MEMORY_SCOPE_AGENT); }
__device__ __forceinline__ unsigned xb_xcc_id() { return (unsigned)__builtin_amdgcn_s_getreg((3 << 11) | 20) & 0xFu; }
#define XB_SPIN(cond, bar) do { unsigned _sp = 0; while (cond) { __builtin_amdgcn_s_sleep(1); \
    if ((++_sp & 255u) == 0u) { if (xb_ld(&(bar)[XB_TMO])) break; if (_sp > XB_SPIN_CAP) { atomicAdd(&(bar)[XB_TMO], 1u); break; } } } } while (0)
struct XcdBarrier { unsigned* bar; unsigned x; volatile LAS unsigned* st; };
__device__ __forceinline__ XcdBarrier xcd_barrier_post(unsigned* bar, volatile LAS unsigned* st) {
    XcdBarrier b; b.bar = bar; b.x = xb_xcc_id(); b.st = st;
    if (threadIdx.x == 0) (void)xb_add(&bar[XB_XCNT(b.x)], 1u);
    return b;
}
__device__ __forceinline__ void xcd_barrier_complete(unsigned* bar, unsigned x, unsigned& nloc, unsigned& nx) {
    const unsigned G = gridDim.x * gridDim.y * gridDim.z;
    unsigned sum, cnt, mine, sp = 0u;
    for (;;) {
        sum = 0u; cnt = 0u; mine = 0u;
#pragma unroll
        for (unsigned j = 0; j < 16; ++j) { const unsigned c = xb_ld(&bar[XB_XCNT(j)]); sum += c; cnt += (c > 0u) ? 1u : 0u; mine = (j == x) ? c : mine; }
        if (sum == G) break;
        __builtin_amdgcn_s_sleep(1);
        if ((++sp & 255u) == 0u) { if (xb_ld(&bar[XB_TMO])) break; if (sp > XB_SPIN_CAP) { atomicAdd(&bar[XB_TMO], 1u); break; } }
    }
    nloc = mine > 0u ? mine : 1u; nx = cnt > 0u ? cnt : 1u;
}
__device__ __forceinline__ void xcd_barrier(const XcdBarrier& b) {
    asm volatile("s_waitcnt vmcnt(0)" ::: "memory");
    __syncthreads();
    if (threadIdx.x == 0) {
        unsigned* bar = b.bar;
        __builtin_amdgcn_s_waitcnt(0);
        unsigned nloc = b.st[0], nx = b.st[1];
        if (nloc == 0u) { xcd_barrier_complete(bar, b.x, nloc, nx); b.st[0] = nloc; b.st[1] = nx; }
        const unsigned old = xb_add(&bar[XB_XSUB(b.x)], 1u);
        const unsigned gen = old / nloc;
        if (old + 1u == (gen + 1u) * nloc) {
            __builtin_amdgcn_fence(__ATOMIC_RELEASE, "agent");
            asm volatile("s_waitcnt vmcnt(0)" ::: "memory");
            const unsigned og = xb_add(&bar[XB_TOP], 1u);
            const unsigned tg = og / nx;
            if (og + 1u == (tg + 1u) * nx) xb_add(&bar[XB_TOPGEN], 1u);
            else XB_SPIN(xb_ld(&bar[XB_TOPGEN]) == tg, bar);
            __builtin_amdgcn_fence(__ATOMIC_ACQUIRE, "agent");
            xb_add(&bar[XB_XGEN(b.x)], 1u);
            asm volatile("s_waitcnt vmcnt(0)" ::: "memory");
        } else {
            XB_SPIN(xb_ld(&bar[XB_XGEN(b.x)]) == gen, bar);
            __builtin_amdgcn_fence(__ATOMIC_ACQUIRE, "agent");
            asm volatile("s_waitcnt vmcnt(0)" ::: "memory");
        }
    }
    __syncthreads();
}

struct Args { const float* in[26]; float* out; unsigned char* ws; int ph_lo, ph_hi, li, pad; };
struct Frame {
    LAS unsigned char* lds; volatile LAS unsigned* MISC; unsigned* ctl;
    int G, bid;
    const Args* a;
};
#define PHASE_IDS() int tid_ = threadIdx.x; asm volatile("" : "+v"(tid_)); const int tid = tid_, lane = tid & 63, wave = __builtin_amdgcn_readfirstlane(tid >> 6); (void)lane; (void)wave
#define IN_X 0
#define IN_C 1
#define IN_POS 2
#define IN_WADA 3
#define IN_BADA 4
#define IN_GMIXPRE 5
#define IN_GMIXPOST 6
#define IN_WIN 7
#define IN_GQA 8
#define IN_WQB 9
#define IN_GKVA 10
#define IN_WKVB 11
#define IN_LQ1 12
#define IN_LK1 13
#define IN_LQ2 14
#define IN_LK2 15
#define IN_GSUBLN 16
#define IN_WO 17
#define IN_GFFNPRE 18
#define IN_GFFNPOST 19
#define IN_WROUTER 20
#define IN_BROUTER 21
#define IN_WGU 22
#define IN_BGU 23
#define IN_WDN 24
#define IN_BDN 25

template <class Map>
__device__ __forceinline__ void transpose_item(const float* W, int K, int N, bf16_t* WT, const float* gain, Map dst, LAS float* scr, int item, int lane) {
    const int nblk = N / 32, kb = item / nblk, nb = item % nblk, k0 = 64 * kb, n0 = 32 * nb;
    { float v[32];
#pragma unroll
      for (int i = 0; i < 32; ++i) v[i] = W[(size_t)(k0 + 2 * i + (lane >> 5)) * N + n0 + (lane & 31)];
#pragma unroll
      for (int i = 0; i < 32; ++i) scr[(2 * i + (lane >> 5)) * 33 + (lane & 31)] = v[i]; }
    LDS_WAIT(); asm volatile("" ::: "memory");
    const int c = lane & 7;
    float gk[8];
#pragma unroll
    for (int i = 0; i < 8; ++i) gk[i] = gain ? gain[k0 + 8 * c + i] : 1.f;
#pragma unroll
    for (int j = 0; j < 4; ++j) { const int n = (lane >> 3) + 8 * j; const LAS float* s = scr + (8 * c) * 33 + n;
        u32x4 o; o.x = cvt_pk_bf16(s[0 * 33] * gk[0], s[1 * 33] * gk[1]); o.y = cvt_pk_bf16(s[2 * 33] * gk[2], s[3 * 33] * gk[3]); o.z = cvt_pk_bf16(s[4 * 33] * gk[4], s[5 * 33] * gk[5]); o.w = cvt_pk_bf16(s[6 * 33] * gk[6], s[7 * 33] * gk[7]);
        *(GAS u32x4*)(WT + (size_t)dst(n0 + n) * K + k0 + 8 * c) = o; }
    LDS_WAIT(); asm volatile("" ::: "memory");
}
template <class Map>
__device__ __forceinline__ void transpose8_stream(const float* W, int N, unsigned char* WT, Map dst, LAS float* scr, int first, int stride, int lane) {
    const int nblk = N / 32, per_e = 8 * nblk, total = NE * per_e;
    if (first >= total) return;
    float v[32];
    auto src = [&](int it, int hb) -> const float* { const int e = it / per_e, r = it - e * per_e, kb = r / nblk, nb = r - kb * nblk; return W + ((size_t)e * 1024 + 128 * kb + 64 * hb + (lane >> 5)) * N + 32 * nb + (lane & 31); };
    { const float* p = src(first, 0);
#pragma unroll
      for (int i = 0; i < 32; ++i) v[i] = __builtin_nontemporal_load(p + (size_t)(2 * i) * N); }
    for (int it = first; it < total; it += stride) {
#pragma unroll
        for (int hb = 0; hb < 2; ++hb) {
            float w[32];
#pragma unroll
            for (int i = 0; i < 32; ++i) w[i] = v[i];
            const int nit = hb == 0 ? it : it + stride;
            if (nit < total) { const float* p = src(nit, hb ^ 1);
#pragma unroll
                for (int i = 0; i < 32; ++i) v[i] = __builtin_nontemporal_load(p + (size_t)(2 * i) * N); }
#pragma unroll
            for (int i = 0; i < 32; ++i) { const int kk = 64 * hb + 2 * i + (lane >> 5); scr[kk * 32 + ((lane & 31) ^ (kk & 31) ^ (((kk >> 5) & 3) << 2))] = w[i]; }
        }
        LDS_WAIT(); asm volatile("" ::: "memory");
        const int e = it / per_e, r = it - e * per_e, kb = r / nblk, nb = r - kb * nblk, c = lane & 7;
#pragma unroll
        for (int j = 0; j < 4; ++j) { const int n = (lane >> 3) + 8 * j; float t[16];
#pragma unroll
            for (int i = 0; i < 16; ++i) { const int kk = 16 * c + i; t[i] = scr[kk * 32 + (n ^ (kk & 31) ^ (((kk >> 5) & 3) << 2))] * W8_SCALE; }
            u32x4 o; o.x = pack4_fp8(t[0], t[1], t[2], t[3]); o.y = pack4_fp8(t[4], t[5], t[6], t[7]); o.z = pack4_fp8(t[8], t[9], t[10], t[11]); o.w = pack4_fp8(t[12], t[13], t[14], t[15]);
            __builtin_nontemporal_store(o, (GAS u32x4*)(WT + ((size_t)e * N + dst(32 * nb + n)) * 1024 + 128 * kb + 16 * c)); }
        LDS_WAIT(); asm volatile("" ::: "memory");
    }
}
__device__ __forceinline__ int il4(int i, int x2) { return 8 * (i >> 2) + 4 * x2 + (i & 3); }
struct MapWin { __device__ int operator()(int n) const {
    if (n < 384) return n;
    if (n < 416) { const int r = n - 384; return PC_KR + il4(r & 15, r >> 4); }
    if (n < 1440) { const int r = n - 416, hj = r >> 6, d = r & 63; return PC_QD + hj * 64 + il4(d & 31, d >> 5); }
    return PC_VD + (n - 1440); } };
struct MapWqb { __device__ int operator()(int n) const { const int h = n / 96, d = n - h * 96; if (d < 64) return h * 64 + d; const int r = d - 64; return 512 + h * 32 + il4(r & 15, r >> 4); } };
struct MapId { __device__ int operator()(int n) const { return n; } };
struct MapWgu { __device__ int operator()(int n) const { const int which = n >> 10, j = n & 1023; return (j >> 7) * 256 + which * 128 + (j & 127); } };

__device__ __forceinline__ void p0_prologue(Frame& F) {
    PHASE_IDS();
    float* mod = (float*)(F.a->ws + WS_MOD);
    if (F.bid < 192) {
        LAS float* cact = (LAS float*)(F.lds);
        LAS float* red = (LAS float*)(F.lds + 65536);
        const float* c = F.a->in[IN_C];
        { float cv[32];
#pragma unroll
          for (int i = 0; i < 32; ++i) cv[i] = c[tid + 512 * i];
#pragma unroll
          for (int i = 0; i < 32; ++i) cact[tid + 512 * i] = cv[i] / (1.f + __expf(-cv[i])); }
        __syncthreads();
        const int n0 = 32 * F.bid, col = tid & 31, kg = tid >> 5;
        float acc[16];
#pragma unroll
        for (int b = 0; b < 16; ++b) acc[b] = 0.f;
        const float* wp = F.a->in[IN_WADA] + (size_t)(kg * 64) * 6144 + n0 + col;
#pragma unroll
        for (int q = 0; q < 2; ++q) { float w[32];
#pragma unroll
            for (int kk = 0; kk < 32; ++kk) w[kk] = wp[(size_t)(32 * q + kk) * 6144];
#pragma unroll
            for (int kk = 0; kk < 32; ++kk)
#pragma unroll
                for (int b = 0; b < 16; ++b) acc[b] += cact[b * 1024 + kg * 64 + 32 * q + kk] * w[kk]; }
#pragma unroll
        for (int b = 0; b < 16; ++b) red[(kg * 16 + b) * 32 + col] = acc[b];
        __syncthreads();
        { const int b = tid >> 5; float s = 0.f;
#pragma unroll
          for (int k2 = 0; k2 < 16; ++k2) s += red[(k2 * 16 + b) * 32 + col];
          mod[b * 6144 + n0 + col] = s + F.a->in[IN_BADA][n0 + col]; }
        __syncthreads();
    }
    { float* ssq = (float*)(F.a->ws + WS_SSQ); for (int i = F.bid * 512 + tid; i < 3 * T; i += F.G * 512) ssq[i] = 0.f;
      u32x4* wz = (u32x4*)((bf16_t*)(F.a->ws + WS_WIN) + (size_t)416 * 1024); for (int i = F.bid * 512 + tid; i < 96 * 1024 / 8; i += F.G * 512) wz[i] = (u32x4){0u, 0u, 0u, 0u}; }
    { const int* pos = (const int*)F.a->in[IN_POS]; float2* tabm = (float2*)(F.a->ws + WS_TABM); float2* tabd = (float2*)(F.a->ws + WS_TABD);
      for (int gid = F.bid * 512 + tid; gid < T * 48; gid += F.G * 512) { const int t = gid / 48, i = gid - t * 48; const float p = (float)pos[t];
          if (i < 16) { const float inv = powf(10000.f, -(float)(2 * i) / 32.f); const double a = (double)(p * inv); tabm[t * 16 + i] = make_float2((float)cos(a), (float)sin(a)); }
          else { const int j = i - 16; const float inv = powf(10000.f, -(float)(2 * j) / 64.f); const double a = (double)(p * inv); tabd[t * 32 + j] = make_float2((float)cos(a), (float)sin(a)); } } }
    LAS float* scr = (LAS float*)(F.lds + RING_OFF + wave * 16384);
    const int gw = F.bid * NWAVES + wave, NGW = F.G * NWAVES;
    constexpr int I_WIN = 16 * 61, I_WQB = 4 * 24, I_WKVB = 2 * 32, I_WO = 16 * 32;
    constexpr int NITEMS = I_WIN + I_WQB + I_WKVB + I_WO;
    for (int it = gw; it < NITEMS; it += NGW) {
        int r = it;
        if (r < I_WIN) { transpose_item(F.a->in[IN_WIN], 1024, INC, (bf16_t*)(F.a->ws + WS_WIN), nullptr, MapWin{}, scr, r, lane); continue; } r -= I_WIN;
        if (r < I_WQB) { transpose_item(F.a->in[IN_WQB], 256, 768, (bf16_t*)(F.a->ws + WS_WQB), F.a->in[IN_GQA], MapWqb{}, scr, r, lane); continue; } r -= I_WQB;
        if (r < I_WKVB) { transpose_item(F.a->in[IN_WKVB], 128, 1024, (bf16_t*)(F.a->ws + WS_WKVB), F.a->in[IN_GKVA], MapId{}, scr, r, lane); continue; } r -= I_WKVB;
        transpose_item(F.a->in[IN_WO], 1024, 1024, (bf16_t*)(F.a->ws + WS_WO), nullptr, MapId{}, scr, r, lane);
    }
    transpose8_stream(F.a->in[IN_WGU], 2048, (unsigned char*)(F.a->ws + WS_WGU), MapWgu{}, scr, gw, NGW, lane);
    transpose8_stream(F.a->in[IN_WDN], 1024, (unsigned char*)(F.a->ws + WS_WD), MapId{}, scr, gw, NGW, lane);
}
__device__ __forceinline__ void p0b_norm(Frame& F) {
    PHASE_IDS();
    const float* mod = (const float*)(F.a->ws + WS_MOD); bf16_t* H = (bf16_t*)(F.a->ws + WS_H);
    const int tok0 = F.bid * 128 + wave * 16, b = (F.bid * 128) / S;
    f32x4 g[4], sh[4];
#pragma unroll
    for (int j = 0; j < 4; ++j) { const int c = 4 * lane + 256 * j; g[j] = *(const f32x4*)(F.a->in[IN_GMIXPRE] + c) * (*(const f32x4*)(mod + b * 6144 + 1024 + c) + 1.f); sh[j] = *(const f32x4*)(mod + b * 6144 + c); }
    for (int i = 0; i < 16; i += 4) {
        f32x4 v[4][4];
#pragma unroll
        for (int r = 0; r < 4; ++r)
#pragma unroll
            for (int j = 0; j < 4; ++j) v[r][j] = __builtin_nontemporal_load((const GAS f32x4*)(F.a->in[IN_X] + (size_t)(tok0 + i + r) * D) + lane + 64 * j);
#pragma unroll
        for (int r = 0; r < 4; ++r) { float ss = 0.f;
#pragma unroll
            for (int j = 0; j < 4; ++j) ss += (v[r][j].x * v[r][j].x + v[r][j].y * v[r][j].y) + (v[r][j].z * v[r][j].z + v[r][j].w * v[r][j].w);
            const float rs = rsqrtf(wave_sum(ss) * (1.f / D) + 1e-6f);
            GAS u32x2* o8 = (GAS u32x2*)(H + (size_t)(tok0 + i + r) * D) + lane;
#pragma unroll
            for (int j = 0; j < 4; ++j) { const f32x4 h = (v[r][j] * rs) * g[j] + sh[j]; u32x2 w; w.x = cvt_pk_bf16(h[0], h[1]); w.y = cvt_pk_bf16(h[2], h[3]); o8[64 * j] = w; } }
    }
}
__device__ __forceinline__ void p5_rows(Frame& F) {
    PHASE_IDS();
    LAS float* wt = (LAS float*)(F.lds + RING_OFF);
    for (int idx = tid; idx < NE * 1024; idx += 512) { const int e = idx >> 10, k = idx & 1023; wt[idx] = F.a->in[IN_WROUTER][k * NE + e]; }
    LAS int* se = (LAS int*)(F.lds + X_SE); LAS float* sg = (LAS float*)(F.lds + X_SG);
    const float* mod = (const float*)(F.a->ws + WS_MOD); const float* ssq_y = (const float*)(F.a->ws + WS_SSQ) + 2 * T;
    const bf16_t* Y = (const bf16_t*)(F.a->ws + WS_Y); unsigned char* H2 = (unsigned char*)(F.a->ws + WS_H); bf16_t* X1 = (bf16_t*)(F.a->ws + WS_X1);
    const int tok0 = F.bid * 128 + wave * 16, b = (F.bid * 128) / S;
    LAS float* cst = (LAS float*)(F.lds + X_CONST);
    for (int c = tid; c < 1024; c += 512) { cst[c] = F.a->in[IN_GMIXPOST][c] * mod[b * 6144 + 2048 + c]; cst[1024 + c] = F.a->in[IN_GFFNPRE][c] * (mod[b * 6144 + 4096 + c] + 1.f); cst[2048 + c] = mod[b * 6144 + 3072 + c]; }
    f32x4 xn[2][4]; u32x2 yn[2][4];
#define P5_PRE(r_) do { _Pragma("unroll") for (int q_ = 0; q_ < 2; ++q_) { _Pragma("unroll") for (int j = 0; j < 4; ++j) { xn[q_][j] = __builtin_nontemporal_load((const GAS f32x4*)(F.a->in[IN_X] + (size_t)((r_) + q_) * D + 4 * lane + 256 * j)); yn[q_][j] = __builtin_nontemporal_load((const GAS u32x2*)(Y + (size_t)((r_) + q_) * D + 4 * lane + 256 * j)); } } } while (0)
    P5_PRE(tok0);
    __syncthreads();
#pragma nounroll
    for (int i = 0; i < 16; i += 2) {
        const int row = tok0 + i;
        f32x2 hp[4][4];
        {   f32x4 xv[2][4]; u32x2 yv[2][4]; float rsy[2];
#pragma unroll
            for (int q = 0; q < 2; ++q) { float sy = 0.f;
#pragma unroll
                for (int j = 0; j < 4; ++j) { xv[q][j] = xn[q][j]; yv[q][j] = yn[q][j]; const float a0 = bflo(yv[q][j].x), a1 = bfhi(yv[q][j].x), a2 = bflo(yv[q][j].y), a3 = bfhi(yv[q][j].y); sy += (a0 * a0 + a1 * a1) + (a2 * a2 + a3 * a3); }
                rsy[q] = rsqrtf(wave_sum(sy) * (1.f / D) + 1e-6f); }
            if (i + 2 < 16) P5_PRE(row + 2);
            f32x4 gpost[4], gpre[4], shf[4];
#pragma unroll
            for (int j = 0; j < 4; ++j) { gpost[j] = *(const LAS f32x4*)(cst + 4 * lane + 256 * j); gpre[j] = *(const LAS f32x4*)(cst + 1024 + 4 * lane + 256 * j); shf[j] = *(const LAS f32x4*)(cst + 2048 + 4 * lane + 256 * j); }
#pragma unroll
            for (int q = 0; q < 2; ++q) { f32x4 x1[4]; float ss = 0.f;
#pragma unroll
                for (int j = 0; j < 4; ++j) { const f32x4 yy = {bflo(yv[q][j].x), bfhi(yv[q][j].x), bflo(yv[q][j].y), bfhi(yv[q][j].y)}; x1[j] = xv[q][j] + (yy * rsy[q]) * gpost[j];
                    ss += (x1[j][0] * x1[j][0] + x1[j][1] * x1[j][1]) + (x1[j][2] * x1[j][2] + x1[j][3] * x1[j][3]);
                    { u32x2 w; w.x = cvt_pk_bf16(x1[j][0], x1[j][1]); w.y = cvt_pk_bf16(x1[j][2], x1[j][3]); __builtin_nontemporal_store(w, (GAS u32x2*)(X1 + (size_t)(row + q) * D + 4 * lane + 256 * j)); } }
                const float r1 = rsqrtf(wave_sum(ss) * (1.f / D) + 1e-6f);
#pragma unroll
                for (int j = 0; j < 4; ++j) { const f32x4 h = (x1[j] * r1) * gpre[j] + shf[j]; *(GAS unsigned*)(H2 + (size_t)(row + q) * D + 4 * lane + 256 * j) = pack4_fp8s(h[0], h[1], h[2], h[3]);
#pragma unroll
                    for (int c = 0; c < 4; ++c) hp[j][c][q] = h[c]; } } }
        f32x2 v[32];
#pragma unroll
        for (int e = 0; e < NE; ++e) { const LAS f32x4* wp = (const LAS f32x4*)(wt + e * 1024 + 4 * lane); f32x2 p = {0.f, 0.f};
#pragma unroll
            for (int j = 0; j < 4; ++j) { const f32x4 w = wp[64 * j]; p = p + hp[j][0] * w[0]; p = p + hp[j][1] * w[1]; p = p + hp[j][2] * w[2]; p = p + hp[j][3] * w[3]; }
            v[e] = p; if ((e & 3) == 3) __builtin_amdgcn_sched_barrier(0); }
        const int my_e = lane >> 1; const float brt = F.a->in[IN_BROUTER][my_e];
#define P5_REDUCE(Q) do { float u_[16]; \
            _Pragma("unroll") for (int j = 0; j < 16; ++j) u_[j] = swap32_sum(v[j][Q], v[16 + j][Q]); \
            _Pragma("unroll") for (int j = 0; j < 8; ++j) u_[j] = swap16_sum(u_[j], u_[8 + j]); \
            _Pragma("unroll") for (int j = 0; j < 4; ++j) { const bool up = (lane & 8) != 0; const float keep = up ? u_[4 + j] : u_[j], send = up ? u_[j] : u_[4 + j]; u_[j] = keep + lane_xor8(send); } \
            _Pragma("unroll") for (int j = 0; j < 2; ++j) { const bool up = (lane & 4) != 0; const float keep = up ? u_[2 + j] : u_[j], send = up ? u_[j] : u_[2 + j]; u_[j] = keep + lane_xor4(send); } \
            { const bool up = (lane & 2) != 0; const float keep = up ? u_[1] : u_[0], send = up ? u_[0] : u_[1]; u_[0] = keep + DPPF(send, 0x4E); } \
            float lg = u_[0] + DPPF(u_[0], 0xB1) + brt; \
            float vals[4]; int idx[4]; \
            _Pragma("unroll") for (int k = 0; k < 4; ++k) { const float mx = wave_max(lg); const unsigned long long bm = __ballot(lg == mx); const int wl = __builtin_ctzll(bm); vals[k] = mx; idx[k] = wl >> 1; if (my_e == idx[k]) lg = -INFINITY; } \
            float ex[4], den = 0.f; \
            _Pragma("unroll") for (int k = 0; k < 4; ++k) { ex[k] = __expf(vals[k] - vals[0]); den += ex[k]; } \
            const float inv = 1.f / den; \
            if (lane < 4) { const int a = (wave * 16 + i + Q) * 4 + lane; se[a] = lane == 0 ? idx[0] : lane == 1 ? idx[1] : lane == 2 ? idx[2] : idx[3]; sg[a] = (lane == 0 ? ex[0] : lane == 1 ? ex[1] : lane == 2 ? ex[2] : ex[3]) * inv; } \
            __builtin_amdgcn_sched_barrier(0); } while (0)
        P5_REDUCE(0);
        P5_REDUCE(1);
#undef P5_REDUCE
    }
#undef P5_PRE
#define P5_LOAD(x)
#undef P5_LOAD
    __syncthreads();
    LAS int* srank = (LAS int*)(F.lds + X_SRANK); LAS int* wcnt = (LAS int*)(F.lds + X_WCNT);
    const int e_my = se[tid]; int rk = 0;
    for (int e = 0; e < NE; ++e) { const unsigned long long bm = __ballot(e_my == e); if (e_my == e) rk = __builtin_popcountll(bm & ((1ull << lane) - 1ull)); if (lane == 0) wcnt[wave * 32 + e] = __builtin_popcountll(bm); }
    __syncthreads();
    int base = 0;
    for (int w = 0; w < wave; ++w) base += wcnt[w * 32 + e_my];
    srank[tid] = base + rk;
    { const int a = F.bid * 512 + tid; ((int*)(F.a->ws + WS_SE))[a] = e_my; ((float*)(F.a->ws + WS_SG))[a] = sg[tid]; ((int*)(F.a->ws + WS_SRANK))[a] = base + rk; }
    if (tid < NE) { int tot = 0; for (int w = 0; w < 8; ++w) tot += wcnt[w * 32 + tid]; ((int*)(F.a->ws + WS_CNT))[F.bid * NE + tid] = tot; }
}
__device__ __forceinline__ void p9_final(Frame& F) {
    PHASE_IDS();
    const float* mod = (const float*)(F.a->ws + WS_MOD); const unsigned char* YR = (const unsigned char*)(F.a->ws + WS_YR); const int* pos = (const int*)(F.a->ws + WS_POS);
    const int tok0 = F.bid * 128 + wave * 16, b = (F.bid * 128) / S;
    f32x4 gf[4];
#pragma unroll
    for (int j = 0; j < 4; ++j) { const int c = 4 * lane + 256 * j; gf[j] = *(const f32x4*)(F.a->in[IN_GFFNPOST] + c) * *(const f32x4*)(mod + b * 6144 + 5120 + c); }
    unsigned yn[4][4]; u32x2 xn[4]; const bf16_t* X1 = (const bf16_t*)(F.a->ws + WS_X1);
#define P9_LOAD(row) do { _Pragma("unroll") for (int s_ = 0; s_ < 4; ++s_) { const int pr = __builtin_amdgcn_readfirstlane(pos[(row) * 4 + s_]); _Pragma("unroll") for (int j = 0; j < 4; ++j) yn[s_][j] = __builtin_nontemporal_load((const GAS unsigned*)(YR + (size_t)pr * D + 4 * lane + 256 * j)); } \
        _Pragma("unroll") for (int j = 0; j < 4; ++j) xn[j] = __builtin_nontemporal_load((const GAS u32x2*)(X1 + (size_t)(row) * D + 4 * lane + 256 * j)); } while (0)
    P9_LOAD(tok0);
    for (int i = 0; i < 16; ++i) {
        const int row = tok0 + i;
        f32x4 y[4], x1[4]; float ss = 0.f;
#pragma unroll
        for (int j = 0; j < 4; ++j) { y[j] = (f32x4){0.f, 0.f, 0.f, 0.f};
#pragma unroll
            for (int s_ = 0; s_ < 4; ++s_) { const unsigned w = yn[s_][j]; const f32x2 lo = __builtin_amdgcn_cvt_pk_f32_fp8((int)w, false), hi2 = __builtin_amdgcn_cvt_pk_f32_fp8((int)w, true); y[j] += (f32x4){lo[0], lo[1], hi2[0], hi2[1]}; }
            y[j] = y[j] * YR_INV; x1[j] = (f32x4){bflo(xn[j].x), bfhi(xn[j].x), bflo(xn[j].y), bfhi(xn[j].y)}; ss += (y[j][0] * y[j][0] + y[j][1] * y[j][1]) + (y[j][2] * y[j][2] + y[j][3] * y[j][3]); }
        if (i + 1 < 16) P9_LOAD(row + 1);
        const float r = rsqrtf(wave_sum(ss) * (1.f / D) + 1e-6f);
#pragma unroll
        for (int j = 0; j < 4; ++j) __builtin_nontemporal_store(x1[j] + (y[j] * r) * gf[j], (GAS f32x4*)(F.a->out + (size_t)row * D + 4 * lane + 256 * j));
    }
#undef P9_LOAD
}
namespace att {
#define SBAR() __builtin_amdgcn_sched_barrier(0)
typedef short s16x4 __attribute__((ext_vector_type(4)));
typedef short v4i16_t __attribute__((ext_vector_type(4)));
typedef __attribute__((address_space(3))) const char* lds_cptr;
__device__ __forceinline__ int crow(int r, int hi) { return (r & 3) + 8 * (r >> 2) + 4 * hi; }
__device__ __forceinline__ void glds16(const void* gsrc, unsigned lds_dst) { unsigned keep;
    asm volatile("s_mov_b32 %0, m0\n\ts_mov_b32 m0, %2\n\ts_nop 0\n\tglobal_load_lds_dwordx4 %1, off\n\ts_mov_b32 m0, %0" : "=&s"(keep) : "v"(gsrc), "s"(lds_dst) : "memory"); }
__device__ __forceinline__ s16x4 vtr(lds_cptr p) { return __builtin_bit_cast(s16x4, __builtin_amdgcn_ds_read_tr16_b64_v4i16((__attribute__((address_space(3))) v4i16_t*)p)); }
typedef float f32x2_t __attribute__((ext_vector_type(2))); typedef __bf16 bf16x2_t __attribute__((ext_vector_type(2)));
__device__ __forceinline__ unsigned cvtpk_s(float lo, float hi) { f32x2_t v = {lo, hi}; bf16x2_t b = __builtin_convertvector(v, bf16x2_t); return __builtin_bit_cast(unsigned, b); }
#define WAIT_BAR0() asm volatile("s_waitcnt vmcnt(0) lgkmcnt(0)\n\ts_barrier" ::: "memory")

struct Src {
    const bf16_t* q0; const bf16_t* q1; int qp;
    const bf16_t* k0; const bf16_t* k1; int kp0, kp1;
    const bf16_t* v; int vp;
};
template <int DQK, int DV> struct Geo {
    static constexpr int NKC = DQK / 8, NVB = DV / 32, KSLOT = NKC * 1024, VSLOT = NVB * 4096, NPIECE = NKC + 4 * NVB;
    static constexpr int NSLOT = 3, LDS_K = 0, LDS_V = NSLOT * KSLOT, LDS_WS = LDS_V + NSLOT * VSLOT, LDS_OST = 0  , LDS_TOTAL = LDS_WS + 8 * 256;
    static_assert(8 * 32 * DV * 2 <= LDS_WS && LDS_TOTAL <= 131072, "attention LDS map");
};
constexpr float THR = 8.f;
#ifndef ATT_VPM
#define ATT_VPM 8
#endif

template <int DQK, int DV, int MODE>
__device__ __forceinline__ void attn_unit(LAS char* shm, const Src sc, int qb, bf16_t* obase, float* td, float lam, const float* gsub) {
    typedef Geo<DQK, DV> G;
    int tid_ = threadIdx.x; asm volatile("" : "+v"(tid_));
    const int tid = tid_, lane = tid & 63, r32 = lane & 31, hi = lane >> 5; const int wid = __builtin_amdgcn_readfirstlane(tid >> 6);
    const int q0 = qb * 256, NT = 4 * (qb + 1);
    const unsigned lds0 = (unsigned)(uintptr_t)shm;
    LAS float* wsf = (LAS float*)(shm + G::LDS_WS) + wid * 64;
    const char* ksrc[2]; const char* vsrc[2]; long kstep[2], vstep;
#pragma unroll
    for (int i = 0; i < 2; ++i) { const int p = wid + 8 * i; ksrc[i] = nullptr; kstep[i] = 0; vsrc[i] = nullptr;
        if (p < G::NKC) { const bf16_t* base = p < 8 ? sc.k0 + 8 * p : sc.k1 + 8 * (p - 8); const int pitch = p < 8 ? sc.kp0 : sc.kp1; ksrc[i] = (const char*)(base + (long)lane * pitch); kstep[i] = 128L * pitch; }
        if (p < 4 * G::NVB) { const int db = p >> 2, rg = p & 3; vsrc[i] = (const char*)(sc.v + (long)(16 * rg + (lane >> 2)) * sc.vp + 32 * db + 8 * (lane & 3)); } }
    vstep = 128L * sc.vp;
#define DMA_K(slot) do { _Pragma("unroll") for (int i_ = 0; i_ < 2; ++i_) if (wid + 8 * i_ < G::NKC) { glds16(ksrc[i_], (unsigned)__builtin_amdgcn_readfirstlane(lds0 + G::LDS_K + (wid + 8 * i_) * 1024 + (slot) * G::KSLOT)); ksrc[i_] += kstep[i_]; } } while (0)
#define DMA_V(slot) do { _Pragma("unroll") for (int i_ = 0; i_ < 2; ++i_) if (wid + 8 * i_ < 4 * G::NVB) { glds16(vsrc[i_], (unsigned)__builtin_amdgcn_readfirstlane(lds0 + G::LDS_V + (wid + 8 * i_) * 1024 + (slot) * G::VSLOT)); vsrc[i_] += vstep; } } while (0)
    DMA_K(0); DMA_V(0); DMA_K(1); DMA_V(1); DMA_K(2);
    bf16x8 qr[DQK / 16];
    { const long qrow = (long)(q0 + wid * 32 + r32) * sc.qp;
#pragma unroll
      for (int d0 = 0; d0 < DQK / 16; ++d0) qr[d0] = d0 < 4 ? *reinterpret_cast<const bf16x8*>(sc.q0 + qrow + d0 * 16 + hi * 8) : *reinterpret_cast<const bf16x8*>(sc.q1 + qrow + (d0 - 4) * 16 + hi * 8); }
    float m_run = 0.f, l_reg = 0.f; bool first = true;
    f32x16 negm = f32x16{};
    f32x16 o[G::NVB];
#pragma unroll
    for (int d = 0; d < G::NVB; ++d) o[d] = f32x16{};
    const int qrel = wid * 32 + r32;
    const lds_cptr shm3 = (lds_cptr)shm;
    const lds_cptr kp0 = shm3 + G::LDS_K + hi * 1024 + r32 * 16;
    const lds_cptr vp0 = shm3 + G::LDS_V + ((lane >> 4) & 1) * 32 + (lane & 3) * 8 + (4 * hi + ((lane & 15) >> 2)) * 64;
#define QKT(P0, P1, slot) do { const lds_cptr kp_ = kp0 + (slot) * G::KSLOT; _Pragma("unroll") for (int d0 = 0; d0 < DQK / 16; ++d0) { \
        const bf16x8 b0_ = *(const __attribute__((address_space(3))) bf16x8*)(kp_ + d0 * 2048), b1_ = *(const __attribute__((address_space(3))) bf16x8*)(kp_ + d0 * 2048 + 512); \
        if (d0 == 0) { P0 = __builtin_amdgcn_mfma_f32_32x32x16_bf16(b0_, qr[0], negm, 0, 0, 0); P1 = __builtin_amdgcn_mfma_f32_32x32x16_bf16(b1_, qr[0], negm, 0, 0, 0); } \
        else { P0 = __builtin_amdgcn_mfma_f32_32x32x16_bf16(b0_, qr[d0], P0, 0, 0, 0); P1 = __builtin_amdgcn_mfma_f32_32x32x16_bf16(b1_, qr[d0], P1, 0, 0, 0); } } } while (0)
#define ACTIVE(t_) (!((t_) - (NT - 4) >= 0 && 64 * ((t_) - (NT - 4)) > 32 * wid + 31))
    int s_cur = 0, s_nx1 = 1, s_nx2 = 2;
    const bool three = (wid + 8 < G::NKC ? 2 : 1) + (wid + 8 < 4 * G::NVB ? 2 : 1) == 3;
    f32x16 sc0 = f32x16{}, sc1 = f32x16{}, sn0 = f32x16{}, sn1 = f32x16{};
    asm volatile("s_waitcnt vmcnt(0) lgkmcnt(0)\n\ts_barrier" ::: "memory");
    QKT(sc0, sc1, 0);
    for (int t = 0; t < NT; ++t) {
        if (t + 3 < NT) { if (three) asm volatile("s_waitcnt vmcnt(3) lgkmcnt(0)\n\ts_barrier" ::: "memory"); else asm volatile("s_waitcnt vmcnt(2) lgkmcnt(0)\n\ts_barrier" ::: "memory"); }
        else WAIT_BAR0();
        if (t + 3 < NT) DMA_K(s_cur);
        if (t + 2 < NT) DMA_V(s_nx2);
        const int jb = t - (NT - 4);
        const bool act = ACTIVE(t), nxt = (t + 1 < NT) && ACTIVE(t + 1);
        if (!act) { const int tmp = s_cur; s_cur = s_nx1; s_nx1 = s_nx2; s_nx2 = tmp; continue; }
        if (jb >= 0) { const int kb = 64 * jb + 4 * hi;
#pragma unroll
            for (int r = 0; r < 16; ++r) { const int kv = kb + (r & 3) + 8 * (r >> 2); if (kv > qrel) sc0[r] = -INFINITY; if (kv + 32 > qrel) sc1[r] = -INFINITY; } }
        float rm = fmaxf(sc0[0], sc1[0]);
#pragma unroll
        for (int r = 1; r < 16; ++r) rm = fmaxf(rm, fmaxf(sc0[r], sc1[r]));
        rm = swap32_max(rm, rm);
        if (first || __any(rm > THR)) {
            const float dl = first ? rm : fmaxf(rm, 0.f), f = first ? 1.f : __builtin_amdgcn_exp2f(-dl); m_run += dl; l_reg *= f; first = false;
#pragma unroll
            for (int r = 0; r < 16; ++r) { sc0[r] -= dl; sc1[r] -= dl; negm[r] = -m_run; }
            if (hi == 0) wsf[r32] = f;
            asm volatile("s_waitcnt lgkmcnt(0)" ::: "memory");
#pragma unroll
            for (int g = 0; g < 4; ++g) { const f32x4 fv = *(const LAS f32x4*)(wsf + 8 * g + 4 * hi);
#pragma unroll
                for (int d = 0; d < G::NVB; ++d) { o[d][4 * g] *= fv[0]; o[d][4 * g + 1] *= fv[1]; o[d][4 * g + 2] *= fv[2]; o[d][4 * g + 3] *= fv[3]; } }
        }
        u32x4 pw[4];
        if (nxt) {
            constexpr int ND0 = DQK / 16, NG = 2 * ND0;
            const lds_cptr kpn = kp0 + s_nx1 * G::KSLOT;
            float sacc = 0.f;
            bf16x8 kb0 = *(const __attribute__((address_space(3))) bf16x8*)(kpn), kb1 = *(const __attribute__((address_space(3))) bf16x8*)(kpn + 512), nb0 = kb0, nb1 = kb1;
#define ATT_GAP(g_) do { _Pragma("unroll") for (int e_ = ((g_) * 32) / NG; e_ < (((g_) + 1) * 32) / NG; ++e_) { \
                if (e_ < 16) { sc0[e_] = __builtin_amdgcn_exp2f(sc0[e_]); sacc += sc0[e_]; } else { sc1[e_ - 16] = __builtin_amdgcn_exp2f(sc1[e_ - 16]); sacc += sc1[e_ - 16]; } } \
                asm volatile("" : "+v"(sacc), "+v"(sc0), "+v"(sc1)); SBAR(); } while (0)
#pragma unroll
            for (int d0 = 0; d0 < ND0; ++d0) {
                if (d0 + 1 < ND0) { nb0 = *(const __attribute__((address_space(3))) bf16x8*)(kpn + (d0 + 1) * 2048); nb1 = *(const __attribute__((address_space(3))) bf16x8*)(kpn + (d0 + 1) * 2048 + 512); }
                sn0 = d0 == 0 ? __builtin_amdgcn_mfma_f32_32x32x16_bf16(kb0, qr[0], negm, 0, 0, 0) : __builtin_amdgcn_mfma_f32_32x32x16_bf16(kb0, qr[d0], sn0, 0, 0, 0);
                ATT_GAP(2 * d0);
                sn1 = d0 == 0 ? __builtin_amdgcn_mfma_f32_32x32x16_bf16(kb1, qr[0], negm, 0, 0, 0) : __builtin_amdgcn_mfma_f32_32x32x16_bf16(kb1, qr[d0], sn1, 0, 0, 0);
                ATT_GAP(2 * d0 + 1);
                kb0 = nb0; kb1 = nb1;
            }
#undef ATT_GAP
            l_reg += sacc;
#pragma unroll
            for (int k = 0; k < 4; ++k) { pw[0][k] = cvtpk_s(sc0[2 * k], sc0[2 * k + 1]); pw[1][k] = cvtpk_s(sc0[8 + 2 * k], sc0[8 + 2 * k + 1]); pw[2][k] = cvtpk_s(sc1[2 * k], sc1[2 * k + 1]); pw[3][k] = cvtpk_s(sc1[8 + 2 * k], sc1[8 + 2 * k + 1]); }
        } else {
            float sacc = 0.f;
#pragma unroll
            for (int r = 0; r < 16; ++r) { sc0[r] = __builtin_amdgcn_exp2f(sc0[r]); sc1[r] = __builtin_amdgcn_exp2f(sc1[r]); sacc += sc0[r] + sc1[r]; }
            l_reg += sacc;
#pragma unroll
            for (int k = 0; k < 4; ++k) { pw[0][k] = cvtpk_s(sc0[2 * k], sc0[2 * k + 1]); pw[1][k] = cvtpk_s(sc0[8 + 2 * k], sc0[8 + 2 * k + 1]); pw[2][k] = cvtpk_s(sc1[2 * k], sc1[2 * k + 1]); pw[3][k] = cvtpk_s(sc1[8 + 2 * k], sc1[8 + 2 * k + 1]); }
        }
        const lds_cptr vpp = vp0 + s_cur * G::VSLOT;
#pragma unroll
        for (int d = 0; d < G::NVB; ++d) {
#pragma unroll
            for (int ks = 0; ks < 4; ++ks) { const s16x4 lo = vtr(vpp + d * 4096 + ks * 1024), hh = vtr(vpp + d * 4096 + ks * 1024 + 512);
                const bf16x8 vf = {lo[0], lo[1], lo[2], lo[3], hh[0], hh[1], hh[2], hh[3]};
                o[d] = __builtin_amdgcn_mfma_f32_32x32x16_bf16(__builtin_bit_cast(bf16x8, pw[ks]), vf, o[d], 0, 0, 0); } }
        sc0 = sn0; sc1 = sn1;
        { const int tmp = s_cur; s_cur = s_nx1; s_nx1 = s_nx2; s_nx2 = tmp; }
    }
#undef QKT
#undef ACTIVE
#undef DMA_K
#undef DMA_V
    l_reg = swap32_sum(l_reg, l_reg);
    if (hi == 0) wsf[32 + r32] = l_reg;
    asm volatile("s_waitcnt lgkmcnt(0)" ::: "memory");
    float rli[16];
#pragma unroll
    for (int r = 0; r < 16; ++r) rli[r] = __builtin_amdgcn_rcpf(wsf[32 + crow(r, hi)]);
    const long orow0 = (long)(q0 + wid * 32);
    if (MODE == 1) {
#pragma unroll
        for (int r = 0; r < 16; ++r)
#pragma unroll
            for (int d = 0; d < G::NVB; ++d) td[(orow0 + crow(r, hi)) * 512 + d * 32 + r32] = o[d][r] * rli[r];
    } else {
        if (MODE == 2) {
            float ssr[16];
#pragma unroll
            for (int r = 0; r < 16; ++r) { float ss = 0.f;
#pragma unroll
                for (int d = 0; d < G::NVB; ++d) { const float v = td[(orow0 + crow(r, hi)) * 512 + d * 32 + r32] - lam * (o[d][r] * rli[r]); o[d][r] = v; ss += v * v; }
                ss += DPPF(ss, 0xB1); ss += DPPF(ss, 0x4E); ss += DPPF(ss, 0x141); ss += DPPF(ss, 0x140); ss = swap16_sum(ss, ss);
                ssr[r] = rsqrtf(ss * (1.f / DV) + 1e-5f) * (1.f - LAMBDA_INIT); }
#pragma unroll
            for (int d = 0; d < G::NVB; ++d) { const float gv = gsub[d * 32 + r32];
#pragma unroll
                for (int r = 0; r < 16; ++r) o[d][r] *= ssr[r] * gv; }
#pragma unroll
            for (int r = 0; r < 16; ++r) rli[r] = 1.f;
        }
        asm volatile("s_waitcnt lgkmcnt(0)\n\ts_barrier" ::: "memory");
        LAS bf16_t* stg = (LAS bf16_t*)(shm + G::LDS_OST) + wid * 32 * DV;
#pragma unroll
        for (int r = 0; r < 16; ++r) { const int orow = crow(r, hi);
#pragma unroll
            for (int d = 0; d < G::NVB; ++d) stg[orow * DV + d * 32 + r32] = (bf16_t)(cvtpk_s(o[d][r] * rli[r], 0.f) & 0xffffu); }
        asm volatile("s_waitcnt lgkmcnt(0)" ::: "memory");
        constexpr int CPR = DV / 8;
#pragma unroll
        for (int i = 0; i < 32 * CPR / 64; ++i) { const int idx = i * 64 + lane, row = idx / CPR, ch = idx % CPR; const u32x4 v = *(const LAS u32x4*)(stg + row * DV + ch * 8);
            *(u32x4*)(obase + (orow0 + row) * 1024 + ch * 8) = v; }
    }
    __builtin_amdgcn_s_setprio(0);
    asm volatile("s_waitcnt vmcnt(0) lgkmcnt(0)\n\ts_barrier" ::: "memory");
}
#undef SBAR
#undef WAIT_BAR0
}

__device__ __forceinline__ void attn_phase_all(Frame& F) {
    LAS char* shm = (LAS char*)(F.lds + RING_OFF);
    const int vcu = (F.bid & 7) * (F.G >> 3) + (F.bid >> 3);
    const bf16_t* QM = (const bf16_t*)(F.a->ws + WS_QM); const bf16_t* KVM = (const bf16_t*)(F.a->ws + WS_KVM); const bf16_t* PR = (const bf16_t*)(F.a->ws + WS_PROJ); bf16_t* ATT = (bf16_t*)(F.a->ws + WS_ATT);
    { const int p = vcu >> 1, b = p >> 3, h = p & 7, half = vcu & 1; const long r0 = (long)b * S;
      att::Src sc{QM + r0 * 768 + h * 64, QM + r0 * 768 + 512 + h * 32, 768, KVM + r0 * 1024 + h * 128, PR + r0 * PJ + PC_KR, 1024, PJ, KVM + r0 * 1024 + h * 128 + 64, 1024};
      for (int i = 0; i < 4; ++i) { const int qb = half == 0 ? (i == 0 ? 7 : i == 1 ? 5 : i == 2 ? 2 : 0) : (i == 0 ? 6 : i == 1 ? 4 : i == 2 ? 3 : 1);
#ifdef LEAK_UNIT
          if (i == LEAK_UNIT && threadIdx.x == 0) F.MISC[16] = (unsigned)__builtin_amdgcn_s_memrealtime();
#endif
          att::attn_unit<96, 64, 0>(shm, sc, qb, ATT + r0 * 1024 + h * 64, nullptr, 0.f, nullptr);
#ifdef LEAK_UNIT
          if (i == LEAK_UNIT && threadIdx.x == 0) F.MISC[17] = (unsigned)__builtin_amdgcn_s_memrealtime();
#endif
      } }
    { const int p = vcu >> 2, b = p >> 2, h = p & 3, s4 = vcu & 3; const long r0 = (long)b * S;
      float lam; { const float* l1 = F.a->in[IN_LQ1]; const float* k1 = F.a->in[IN_LK1]; const float* l2 = F.a->in[IN_LQ2]; const float* k2 = F.a->in[IN_LK2]; float s1 = 0.f, s2 = 0.f;
          for (int i = 0; i < 64; ++i) { s1 += l1[i] * k1[i]; s2 += l2[i] * k2[i]; } lam = __expf(s1) - __expf(s2) + LAMBDA_INIT; }
      float* td = (float*)(F.a->ws + WS_Y) + r0 * 512 + h * 128;
      for (int i = 0; i < 2; ++i) { const int qb = i == 0 ? 7 - s4 : s4;
          att::Src s0{PR + r0 * PJ + PC_QD + (2 * h) * 64, nullptr, PJ, PR + r0 * PJ + PC_KD + (2 * h) * 64, nullptr, PJ, PJ, PR + r0 * PJ + PC_VD + h * 128, PJ};
          att::Src s1{PR + r0 * PJ + PC_QD + (2 * h + 1) * 64, nullptr, PJ, PR + r0 * PJ + PC_KD + (2 * h + 1) * 64, nullptr, PJ, PJ, PR + r0 * PJ + PC_VD + h * 128, PJ};
          att::attn_unit<64, 128, 1>(shm, s0, qb, nullptr, td, 0.f, nullptr);
          att::attn_unit<64, 128, 2>(shm, s1, qb, ATT + r0 * 1024 + 512 + h * 128, td, lam, F.a->in[IN_GSUBLN]); } }
}
__device__ __forceinline__ void offsets_from_counts(Frame& F) {
    PHASE_IDS();
    int* cnt = (int*)(F.a->ws + WS_CNT);
    LAS int* part = (LAS int*)(F.lds + RING_OFF);
    LAS int* tile_e = (LAS int*)(F.lds + X_TILEE); LAS int* m2 = (LAS int*)(F.lds + X_MISC2);
    { const int e = tid & 31, p = tid >> 5; int tot = 0, pre = 0;
      for (int w = p * 16; w < p * 16 + 16; ++w) { const int c = __hip_atomic_load(cnt + w * NE + e, RLX_AGENT); tot += c; if (w < F.bid) pre += c; }
      part[(p * 32 + e) * 2] = tot; part[(p * 32 + e) * 2 + 1] = pre; }
    __syncthreads();
    if (tid < NE) { int tot = 0, pre = 0; for (int p = 0; p < 16; ++p) { tot += part[(p * 32 + tid) * 2]; pre += part[(p * 32 + tid) * 2 + 1]; } m2[96 + tid] = tot; m2[64 + tid] = pre; }
    __syncthreads();
    if (tid < NE) { int st = 0; for (int e = 0; e < tid; ++e) st += (m2[96 + e] + 255) & ~255; m2[32 + tid] = st; const int pad = (m2[96 + tid] + 255) & ~255;
        for (int r = st; r < st + pad; r += 256) tile_e[r >> 8] = tid; if (tid == NE - 1) m2[0] = (st + pad) >> 8; }
    __syncthreads();
}
__device__ __forceinline__ void p6_scatter(Frame& F) {
    offsets_from_counts(F);
    PHASE_IDS();
    LAS int* m2 = (LAS int*)(F.lds + X_MISC2);
    int* rowtok = (int*)(F.a->ws + WS_ROWTOK); float* roww = (float*)(F.a->ws + WS_ROWW); int* pos = (int*)(F.a->ws + WS_POS);
    { const int a = F.bid * 512 + tid; const int e = ((const int*)(F.a->ws + WS_SE))[a]; const float gt = ((const float*)(F.a->ws + WS_SG))[a]; const int rk = ((const int*)(F.a->ws + WS_SRANK))[a];
      const int dst = m2[32 + e] + m2[64 + e] + rk, tok = F.bid * 128 + (tid >> 2);
      rowtok[dst] = tok; roww[dst] = gt; pos[tok * 4 + (tid & 3)] = dst; }
    if (F.bid < NE && tid < 256) { const int e = F.bid, tot = m2[96 + e], st = m2[32 + e], pad = (tot + 255) & ~255; const int r = st + tot + tid; if (r < st + pad) { rowtok[r] = 0; roww[r] = 0.f; } }
}

#ifdef DEV_NAIVE_ATTN
template <int MODE>
__global__ void __launch_bounds__(256) k_attn_ref(const bf16_t* QM, const bf16_t* KVM, const bf16_t* PROJ, bf16_t* ATT, float* TD, const float* lq1, const float* lk1, const float* lq2, const float* lk2, const float* gsub) {
    constexpr int DQK = MODE == 0 ? 96 : 64, DV = MODE == 0 ? 64 : 128, NH = MODE == 0 ? 8 : 4;
    __shared__ float Ks[32][DQK]; __shared__ float Vs[32][DV];
    const int bh = blockIdx.y, b = bh / NH, h = bh % NH, q = blockIdx.x * 256 + threadIdx.x, tid = threadIdx.x, t = b * S + q;
    float lam = 0.f;
    if (MODE == 1) { float s1 = 0.f, s2 = 0.f; for (int i = 0; i < 64; ++i) { s1 += lq1[i] * lk1[i]; s2 += lq2[i] * lk2[i]; } lam = expf(s1) - expf(s2) + LAMBDA_INIT; }
    float res[DV];
    for (int j = 0; j < (MODE == 0 ? 1 : 2); ++j) {
        float qv[DQK]; float o[DV];
#pragma unroll
        for (int d = 0; d < DQK; ++d) qv[d] = MODE == 0 ? bf2f(QM[(size_t)t * 768 + (d < 64 ? h * 64 + d : 512 + h * 32 + d - 64)]) : bf2f(PROJ[(size_t)t * PJ + PC_QD + (2 * h + j) * 64 + d]);
#pragma unroll
        for (int d = 0; d < DV; ++d) o[d] = 0.f;
        float m = -1e30f, l = 0.f;
        const int kend = blockIdx.x * 256 + 256;
        for (int k0 = 0; k0 < kend; k0 += 32) {
            __syncthreads();
            for (int i = tid; i < 32 * DQK; i += 256) { const int kk = i / DQK, d = i % DQK; const size_t tk = (size_t)b * S + k0 + kk;
                Ks[kk][d] = MODE == 0 ? (d < 64 ? bf2f(KVM[tk * 1024 + h * 128 + d]) : bf2f(PROJ[tk * PJ + PC_KR + d - 64])) : bf2f(PROJ[tk * PJ + PC_KD + (2 * h + j) * 64 + d]); }
            for (int i = tid; i < 32 * DV; i += 256) { const int kk = i / DV, d = i % DV; const size_t tk = (size_t)b * S + k0 + kk;
                Vs[kk][d] = MODE == 0 ? bf2f(KVM[tk * 1024 + h * 128 + 64 + d]) : bf2f(PROJ[tk * PJ + PC_VD + h * 128 + d]); }
            __syncthreads();
            for (int kk = 0; kk < 32; ++kk) {
                if (k0 + kk > q) break;
                float s = 0.f;
#pragma unroll
                for (int d = 0; d < DQK; ++d) s += qv[d] * Ks[kk][d];
                const float mn = fmaxf(m, s), al = exp2f(m - mn), p = exp2f(s - mn);
                l = l * al + p; m = mn;
#pragma unroll
                for (int d = 0; d < DV; ++d) o[d] = o[d] * al + p * Vs[kk][d];
            }
        }
        const float inv = 1.f / l;
        if (MODE == 0) {
#pragma unroll
            for (int d = 0; d < DV; ++d) ATT[(size_t)t * D + h * 64 + d] = (bf16_t)(cvt_pk_bf16(o[d] * inv, 0.f) & 0xffffu);
        } else if (j == 0) {
#pragma unroll
            for (int d = 0; d < DV; ++d) TD[((size_t)t * 4 + h) * 128 + d] = o[d] * inv;
        } else { float ss = 0.f;
#pragma unroll
            for (int d = 0; d < DV; ++d) { res[d] = TD[((size_t)t * 4 + h) * 128 + d] - lam * (o[d] * inv); ss += res[d] * res[d]; }
            const float r = rsqrtf(ss * (1.f / 128.f) + 1e-5f) * (1.f - LAMBDA_INIT);
#pragma unroll
            for (int d = 0; d < DV; ++d) ATT[(size_t)t * D + 512 + h * 128 + d] = (bf16_t)(cvt_pk_bf16(res[d] * r * gsub[d], 0.f) & 0xffffu);
        }
    }
}
#endif

constexpr int N_PHASES = 11;
__global__ void __launch_bounds__(NWAVES * 64, 2) mk_fwd(Args args) {
    extern __shared__ __attribute__((aligned(16))) unsigned char lds[];
    Frame F;
    F.lds = (LAS unsigned char*)lds; F.MISC = (volatile LAS unsigned*)(F.lds + MISC_OFF);
    F.G = gridDim.x; F.bid = blockIdx.x;
    F.a = &args; F.ctl = (unsigned*)(args.ws + WS_CTL);
    for (int u = threadIdx.x; u < (X_TILEE - LDSCTL_OFF) / 4; u += NWAVES * 64) ((LAS unsigned*)(F.lds + LDSCTL_OFF))[u] = 0u;
    __syncthreads();
    const int lo = args.ph_lo, hi = args.ph_hi;
#ifdef LEAK_LO
    if (LEAK_LO == 0 && threadIdx.x == 0) F.MISC[16] = (unsigned)__builtin_amdgcn_s_memrealtime();
#endif
    XcdBarrier bar; bar.bar = F.ctl + CW_BAR; bar.x = 0; bar.st = nullptr;
    if (hi - lo > 1) bar = xcd_barrier_post(F.ctl + CW_BAR + args.li * XCD_BAR_WORDS, F.MISC + 8);
#ifndef PH_MASK
#define PH_MASK 0x7ff
#endif
#define IN(k) (((PH_MASK >> (k)) & 1) && lo <= (k) && (k) < hi)
#ifdef LEAK_LO
#define SEAM(k) do { if (IN(k) && IN((k) + 1)) xcd_barrier(bar); if (((k) + 1 == LEAK_LO || (k) + 1 == LEAK_HI) && threadIdx.x == 0) F.MISC[(k) + 1 == LEAK_LO ? 16 : 17] = (unsigned)__builtin_amdgcn_s_memrealtime(); } while (0)
#else
#define SEAM(k) do { if (IN(k) && IN((k) + 1)) xcd_barrier(bar); } while (0)
#endif
    LAS unsigned char* ring = F.lds + RING_OFF;
    if (IN(0)) { p0_prologue(F); } SEAM(0);
    if (IN(1)) { p0b_norm(F); } SEAM(1);
    if (IN(2)) {
        pg8::Gemm g{(const bf16_t*)(F.a->ws + WS_H), (const bf16_t*)(F.a->ws + WS_WIN), nullptr, 0, D, D, D, 0}; pg8::StaticOrder So; So.init(T, PJ, F.G, F.bid);
        epi::EpiProj E{(bf16_t*)(F.a->ws + WS_PROJ), (const f32x4*)(F.a->ws + WS_TABM), (const f32x4*)(F.a->ws + WS_TABD), (float*)(F.a->ws + WS_SSQ), (float*)(F.a->ws + WS_SSQ) + T};
        pg8::gemm_phase<epi::EpiProj, pg8::StaticOrder, false>(ring, g, So, E);
    } SEAM(2);
    if (IN(3)) {
#ifndef NO_Q
        { pg8::Gemm g{(const bf16_t*)(F.a->ws + WS_PROJ) + PC_CQ, (const bf16_t*)(F.a->ws + WS_WQB), nullptr, 0, PJ, 256, 256, 0}; pg8::StaticOrder So; So.init(T, 768, F.G, F.bid);
          epi::EpiQ E{(bf16_t*)(F.a->ws + WS_QM), (const f32x4*)(F.a->ws + WS_TABM), (const float*)(F.a->ws + WS_SSQ)};
          pg8::gemm_phase<epi::EpiQ, pg8::StaticOrder, false>(ring, g, So, E); }
#endif
#ifndef NO_KV
        { pg8::Gemm g{(const bf16_t*)(F.a->ws + WS_PROJ) + PC_CKV, (const bf16_t*)(F.a->ws + WS_WKVB), nullptr, 0, PJ, 128, 128, 0}; pg8::StaticOrder So; So.init(T, 1024, F.G, F.bid);
          epi::EpiKV E{(bf16_t*)(F.a->ws + WS_KVM), (const float*)(F.a->ws + WS_SSQ) + T};
          pg8::gemm_phase<epi::EpiKV, pg8::StaticOrder, false>(ring, g, So, E); }
#endif
    } SEAM(3);
    if (IN(4)) {
#ifndef DEV_NAIVE_ATTN
        attn_phase_all(F);
#endif
    } SEAM(4);
    if (IN(5)) {
        pg8::Gemm g{(const bf16_t*)(F.a->ws + WS_ATT), (const bf16_t*)(F.a->ws + WS_WO), nullptr, 0, D, D, D, 0}; pg8::StaticOrder So; So.init(T, D, F.G, F.bid);
        epi::EpiY E{(bf16_t*)(F.a->ws + WS_Y)};
        pg8::gemm_phase<epi::EpiY, pg8::StaticOrder, false>(ring, g, So, E);
    } SEAM(5);
    if (IN(6)) { p5_rows(F); } SEAM(6);
    if (IN(7)) { p6_scatter(F); } SEAM(7);
    if (IN(8)) {
        if (!IN(7)) offsets_from_counts(F);
        pg8::GroupedOrder So{(const LAS int*)(F.lds + X_TILEE), __builtin_amdgcn_readfirstlane(((LAS int*)(F.lds + X_MISC2))[0]), 8, F.G, F.bid};
        pg8::Gemm g{(const bf16_t*)(F.a->ws + WS_H), (const bf16_t*)(F.a->ws + WS_WGU), (const int*)(F.a->ws + WS_ROWTOK), (size_t)2048 * 512, 512, 512, 512, 0};
        epi::EpiAct E{(unsigned char*)(F.a->ws + WS_ACT), F.a->in[IN_BGU]};
        pg8::gemm_phase<epi::EpiAct, pg8::GroupedOrder, true, true>(ring, g, So, E, F.lds + X_IDX);
    } SEAM(8);
    if (IN(9)) {
        if (!IN(7)) offsets_from_counts(F);
        pg8::GroupedOrder So{(const LAS int*)(F.lds + X_TILEE), __builtin_amdgcn_readfirstlane(((LAS int*)(F.lds + X_MISC2))[0]), 4, F.G, F.bid};
        pg8::Gemm g{(const bf16_t*)(F.a->ws + WS_ACT), (const bf16_t*)(F.a->ws + WS_WD), nullptr, (size_t)1024 * 512, 512, 512, 512, 0};
        epi::EpiDown E{(unsigned char*)(F.a->ws + WS_YR), F.a->in[IN_BDN], (const float*)(F.a->ws + WS_ROWW)};
        pg8::gemm_phase<epi::EpiDown, pg8::GroupedOrder, false, true>(ring, g, So, E);
    } SEAM(9);
    if (IN(10)) { p9_final(F); }
#ifdef LEAK_LO
    if (blockIdx.x == 0 && threadIdx.x == 0) { if (LEAK_HI == 11) F.MISC[17] = (unsigned)__builtin_amdgcn_s_memrealtime(); asm volatile("s_waitcnt vmcnt(0) lgkmcnt(0)" ::: "memory"); args.out[0] += (float)(F.MISC[17] - F.MISC[16]) * LEAK_SCALE; }
#endif
#undef IN
#undef SEAM
}

extern "C" void kernel_launch(void* const* d_in, const int* in_sizes, int n_in, void* d_out, int out_size, void* d_ws, size_t ws_size, hipStream_t stream) {
    static int grid = 0;
    if (grid == 0) {
        if (n_in != 26 || in_sizes[0] != T * D || out_size != T * D || ws_size < WS_END) { fprintf(stderr, "kernel_launch: unexpected shapes (n_in %d, ws %zu); nothing launched\n", n_in, ws_size); grid = -1; return; }
        int dev = 0, cus = 0;
        if (hipGetDevice(&dev) != hipSuccess || hipDeviceGetAttribute(&cus, hipDeviceAttributeMultiprocessorCount, dev) != hipSuccess) { grid = -1; return; }
        if (hipFuncSetAttribute((const void*)mk_fwd, hipFuncAttributeMaxDynamicSharedMemorySize, LDS_BYTES) != hipSuccess) { fprintf(stderr, "kernel_launch: hipFuncSetAttribute failed\n"); grid = -1; return; }
        grid = cus;
        if (grid != 256) fprintf(stderr, "kernel_launch: %d CUs; this kernel is built for 256\n", grid);
    }
    if (grid < 0) return;
    (void)hipMemsetAsync((char*)d_ws + WS_CTL, 0, CTL_ZERO_BYTES, stream);
    Args a{};
    for (int i = 0; i < 26; ++i) a.in[i] = (const float*)d_in[i];
    a.out = (float*)d_out; a.ws = (unsigned char*)d_ws;
#ifndef MK_CUTS
#define MK_CUTS {0, N_PHASES}
#endif
    const int cuts[] = MK_CUTS; const int ncut = (int)(sizeof(cuts) / sizeof(int)) - 1;
    for (int li = 0; li < ncut; ++li) {
        a.ph_lo = cuts[li]; a.ph_hi = cuts[li + 1]; a.li = li;
        hipLaunchKernelGGL(mk_fwd, dim3(grid), dim3(NWAVES * 64), LDS_BYTES, stream, a);
#ifdef DEV_NAIVE_ATTN
        if (cuts[li + 1] == 5) {
            unsigned char* ws = (unsigned char*)d_ws;
            k_attn_ref<0><<<dim3(S / 256, NB * 8), 256, 0, stream>>>((const bf16_t*)(ws + WS_QM), (const bf16_t*)(ws + WS_KVM), (const bf16_t*)(ws + WS_PROJ), (bf16_t*)(ws + WS_ATT), nullptr, nullptr, nullptr, nullptr, nullptr, nullptr);
            k_attn_ref<1><<<dim3(S / 256, NB * 4), 256, 0, stream>>>((const bf16_t*)(ws + WS_QM), (const bf16_t*)(ws + WS_KVM), (const bf16_t*)(ws + WS_PROJ), (bf16_t*)(ws + WS_ATT), (float*)(ws + WS_Y),
                (const float*)d_in[IN_LQ1], (const float*)d_in[IN_LK1], (const float*)d_in[IN_LQ2], (const float*)d_in[IN_LK2], (const float*)d_in[IN_GSUBLN]);
        }
#endif
    }
}
```

```cpp
#include <hip/hip_runtime.h>
#include <cstdio>
#include <cstdint>

#define GAS __attribute__((address_space(1)))
#define LAS __attribute__((address_space(3)))
typedef unsigned short bf16_t;
typedef short bf16x8 __attribute__((ext_vector_type(8)));
typedef float f32x4 __attribute__((ext_vector_type(4)));
typedef float f32x2 __attribute__((ext_vector_type(2)));
typedef float f32x16 __attribute__((ext_vector_type(16)));
typedef unsigned u32x4 __attribute__((ext_vector_type(4)));
typedef unsigned u32x2 __attribute__((ext_vector_type(2)));
typedef int i32x4 __attribute__((ext_vector_type(4)));
typedef GAS unsigned gu32;
#define RLX_AGENT __ATOMIC_RELAXED, __HIP_MEMORY_SCOPE_AGENT
#define LDS_WAIT() asm volatile("s_waitcnt lgkmcnt(0)" ::: "memory")
#define VM_WAIT() asm volatile("s_waitcnt vmcnt(0)" ::: "memory")

constexpr int D = 1024, NB = 16, S = 2048, T = NB * S;
constexpr int INC = 1952;
constexpr int PJ = 2048;
constexpr int PC_CQ = 0, PC_CKV = 256, PC_KR = 384, PC_QD = 512, PC_KD = 1024, PC_VD = 1536;
constexpr int NE = 32, TOPK = 4, NA = T * TOPK, NROWS = (NA / 256 + NE) * 256, NTILE_MAX = NROWS / 256;
constexpr float LAMBDA_INIT = 0.2f, LOG2E = 1.4426950408889634f;
constexpr float C2M = 0.10206207261596577f * LOG2E;
constexpr float C2D = 0.125f * LOG2E;
#ifndef FP8_SCALE_OPND
#define FP8_SCALE_OPND 0x7f7f7f7f
#endif
constexpr float YR_SCALE = 16.f, YR_INV = 1.f / 16.f;
constexpr float W8_SCALE = 64.f, W8_INV = 1.f / 64.f;

__device__ __forceinline__ unsigned cvt_pk_bf16(float lo, float hi) { unsigned r; asm volatile("v_cvt_pk_bf16_f32 %0, %1, %2" : "=v"(r) : "v"(lo), "v"(hi)); return r; }
__device__ __forceinline__ float sat8(float v) { return __builtin_amdgcn_fmed3f(v, -448.f, 448.f); }
__device__ __forceinline__ unsigned pack4_fp8s(float a, float b, float c, float d);
__device__ __forceinline__ unsigned pack4_fp8(float a, float b, float c, float d) { int w = 0; w = __builtin_amdgcn_cvt_pk_fp8_f32(a, b, w, false); w = __builtin_amdgcn_cvt_pk_fp8_f32(c, d, w, true); return (unsigned)w; }
__device__ __forceinline__ unsigned pack4_fp8s(float a, float b, float c, float d) { return pack4_fp8(sat8(a), sat8(b), sat8(c), sat8(d)); }
__device__ __forceinline__ float bf2f(unsigned short h) { return __uint_as_float((unsigned)h << 16); }
__device__ __forceinline__ float bflo(unsigned w) { return __uint_as_float(w << 16); }
__device__ __forceinline__ float bfhi(unsigned w) { return __uint_as_float(w & 0xffff0000u); }
#define DPPF(v, ctrl) __builtin_bit_cast(float, __builtin_amdgcn_update_dpp(0, __builtin_bit_cast(int, (float)(v)), (ctrl), 0xf, 0xf, true))
__device__ __forceinline__ void swap16(float a, float b, float& x, float& y) { auto r = __builtin_amdgcn_permlane16_swap(__builtin_bit_cast(unsigned, a), __builtin_bit_cast(unsigned, b), false, false); unsigned r0 = r[0], r1 = r[1]; asm volatile("" : "+v"(r0), "+v"(r1)); x = __builtin_bit_cast(float, r0); y = __builtin_bit_cast(float, r1); }
__device__ __forceinline__ void swap32(float a, float b, float& x, float& y) { auto r = __builtin_amdgcn_permlane32_swap(__builtin_bit_cast(unsigned, a), __builtin_bit_cast(unsigned, b), false, false); unsigned r0 = r[0], r1 = r[1]; asm volatile("" : "+v"(r0), "+v"(r1)); x = __builtin_bit_cast(float, r0); y = __builtin_bit_cast(float, r1); }
__device__ __forceinline__ float swap16_sum(float a, float b) { float x, y; swap16(a, b, x, y); return x + y; }
__device__ __forceinline__ float swap32_sum(float a, float b) { float x, y; swap32(a, b, x, y); return x + y; }
__device__ __forceinline__ float swap32_max(float a, float b) { float x, y; swap32(a, b, x, y); return fmaxf(x, y); }
__device__ __forceinline__ float wave_sum(float v) {
    v += DPPF(v, 0xB1); v += DPPF(v, 0x4E); v += DPPF(v, 0x141); v += DPPF(v, 0x140);
    v = swap16_sum(v, v); return swap32_sum(v, v);
}
__device__ __forceinline__ float wave_max(float v) {
    v = fmaxf(v, DPPF(v, 0xB1)); v = fmaxf(v, DPPF(v, 0x4E)); v = fmaxf(v, DPPF(v, 0x141)); v = fmaxf(v, DPPF(v, 0x140));
    { float x, y; swap16(v, v, x, y); v = fmaxf(x, y); }
    return swap32_max(v, v);
}
__device__ __forceinline__ float lane_xor8(float v) { return DPPF(DPPF(v, 0x141), 0x140); }
__device__ __forceinline__ float lane_xor4(float v) { return DPPF(DPPF(v, 0x1B), 0x141); }

namespace pg8 {
constexpr int BM = 256, BK = 64, HALF = 128, HTB = HALF * BK * 2, STAGE_BYTES = 8 * HTB, NXCD = 8, WGM = 8;
__host__ __device__ __forceinline__ int lds_byte(int r, int c) { const int st = (r >> 4) * 2 + (c >> 5), rr = r & 15, cc = c & 31, ob = rr * 64 + cc * 2; return st * 1024 + (ob ^ (((ob >> 9) & 1) << 5)); }
__host__ __device__ __forceinline__ void stage_rc(int b, int& R, int& C) { const int st = b / 1024, sb = b % 1024, swz = sb ^ (((sb >> 9) & 1) << 5); R = (st >> 1) * 16 + swz / 64; C = (st & 1) * 32 + (swz % 64) / 2; }
__host__ __device__ __forceinline__ int perm32(int rho) { const int n = rho >> 4, i = rho & 15; return 8 * (i >> 2) + 4 * n + (i & 3); }

__host__ __device__ __forceinline__ int perm16(int R) { return 64 * (R >> 5) + 16 * ((R & 15) >> 2) + 4 * ((R >> 4) & 1) + (R & 3); }
template <class E, class = void> struct has_perm16 { static constexpr bool value = false; };
template <class E> struct has_perm16<E, decltype((void)E::PERM16)> { static constexpr bool value = E::PERM16; };
struct Unit { int pm, pn, e; };
struct Gemm { const bf16_t* A; const bf16_t* Bt; const int* rowidx; size_t b_estride; int lda, ldb, K, pad; };

struct StaticOrder {
    int nM, nN, nwg, G, c;
    __host__ __device__ void init(int M, int N, int G_, int c_) { nM = M / BM; nN = N / BM; nwg = nM * nN; G = G_; c = c_; }
    __host__ __device__ bool next(int i, Unit& u) const {
        const long L = (long)i * G + c; if (L >= nwg) return false;
        int wgid = (int)L; { const int q = nwg / NXCD, r = nwg % NXCD, xcd = wgid % NXCD, off = wgid / NXCD; wgid = (xcd < r ? xcd * (q + 1) : r * (q + 1) + (xcd - r) * q) + off; }
        const int nig = WGM * nN, gid = wgid / nig, fm = gid * WGM, gsz = (nM - fm) < WGM ? (nM - fm) : WGM;
        u.pm = fm + ((wgid % nig) % gsz); u.pn = (wgid % nig) / gsz; u.e = 0; return true;
    }
};
struct GroupedOrder {
    const LAS int* tile_e; int ntiles, ncol, G, c;
    __device__ bool next(int i, Unit& u) const {
        const int L = i * G + c, xcd = L & 7, j = L >> 3, block = j >> 5, within = j & 31, rpc = 32 / ncol;
        const int r = within / ncol, pn = within % ncol, rt = (block * 8 + xcd) * rpc + r;
        if (rt >= ntiles) return false;
        u.pm = rt; u.pn = pn; u.e = __builtin_amdgcn_readfirstlane(tile_e[rt]); return true;
    }
};

template <class Epi, class Sched, bool GATHER = false, bool FP8 = false>
__device__ __forceinline__ void gemm_phase(LAS unsigned char* lds, const Gemm g, const Sched& S, const Epi& E, LAS unsigned char* idxl = nullptr) {
    int tid_ = threadIdx.x; asm volatile("" : "+v"(tid_));
    const int tid = tid_, wid = __builtin_amdgcn_readfirstlane(tid >> 6), lane = tid & 63, wr = wid >> 2, wc = wid & 3, fr = lane & 15, fq = lane >> 4;
    const int K = g.K, nt = K / BK;
    int Rr[2], Cc[2];
    unsigned voffA[2][2], voffB[2];
#pragma unroll
    for (int i = 0; i < 2; ++i) { stage_rc(tid * 16 + i * 8192, Rr[i], Cc[i]); const int Rb = has_perm16<Epi>::value ? perm16(Rr[i]) : Epi::PERM ? ((Rr[i] & ~31) + perm32(Rr[i] & 31)) : Rr[i];
        voffA[0][i] = (unsigned)(Rr[i] * g.lda + Cc[i]) * 2u; voffA[1][i] = (unsigned)((Rr[i] + HALF) * g.lda + Cc[i]) * 2u; voffB[i] = (unsigned)(Rb * g.ldb + Cc[i]) * 2u; }
    const unsigned kstep = BK * 2, hstepB = (unsigned)((has_perm16<Epi>::value ? 8 : HALF) * g.ldb * 2), tstepA = (unsigned)(BM * g.lda * 2), tstepB = (unsigned)(BM * g.ldb * 2);
    const __amdgpu_buffer_rsrc_t rA = __builtin_amdgcn_make_buffer_rsrc((void*)g.A, 0, 0x7ffffff0, 0x00020000), rB = __builtin_amdgcn_make_buffer_rsrc((void*)g.Bt, 0, 0x7ffffff0, 0x00020000);
    const unsigned ldsw = (unsigned)wid * 1024u;
    const int aoff = lds_byte(wr * 64 + fr, fq * 8), boff = lds_byte(wc * 32 + fr, fq * 8);
#define PG8_SA(b, h) (((b) * 2 + (h)) * HTB)
#define PG8_SB(b, h) ((4 + (b) * 2 + (h)) * HTB)
#define PG8_STAGE(bufoff, rs, soff, voff) do { _Pragma("unroll") for (int _i = 0; _i < 2; ++_i) \
        __builtin_amdgcn_raw_ptr_buffer_load_lds(rs, (LAS void*)(lds + (bufoff) + ldsw + _i * 8192), 16, (int)(voff)[_i], (int)(soff), 0, 0); } while (0)
#define PG8_LDA(dst, b, h) do { _Pragma("unroll") for (int m = 0; m < 4; ++m) _Pragma("unroll") for (int k = 0; k < 2; ++k) dst[m][k] = *(const LAS bf16x8*)(lds + PG8_SA(b, h) + aoff + m * 2048 + k * 1024); } while (0)
#define PG8_LDB(dst, b, h) do { _Pragma("unroll") for (int n = 0; n < 2; ++n) _Pragma("unroll") for (int k = 0; k < 2; ++k) dst[n][k] = *(const LAS bf16x8*)(lds + PG8_SB(b, h) + boff + n * 2048 + k * 1024); } while (0)
#define PG8_MMA(ai, bj, At, Bt) do { __builtin_amdgcn_s_setprio(1); _Pragma("unroll") for (int m = 0; m < 4; ++m) _Pragma("unroll") for (int n = 0; n < 2; ++n) { \
        if constexpr (FP8) acc[ai][bj][m][n] = __builtin_amdgcn_mfma_scale_f32_16x16x128_f8f6f4(PG8_CAT(Bt[n][0], Bt[n][1]), PG8_CAT(At[m][0], At[m][1]), acc[ai][bj][m][n], 0, 0, 0, FP8_SCALE_OPND, 0, FP8_SCALE_OPND); \
        else { _Pragma("unroll") for (int k = 0; k < 2; ++k) acc[ai][bj][m][n] = __builtin_amdgcn_mfma_f32_16x16x32_bf16(Bt[n][k], At[m][k], acc[ai][bj][m][n], 0, 0, 0); } } __builtin_amdgcn_s_setprio(0); } while (0)
#define PG8_CAT(x0, x1) __builtin_shufflevector(__builtin_bit_cast(i32x4, x0), __builtin_bit_cast(i32x4, x1), 0, 1, 2, 3, 4, 5, 6, 7)
#define PG8_WAIT_V(n) asm volatile("s_waitcnt vmcnt(" #n ")" ::: "memory")
#define PG8_WAIT_L(n) asm volatile("s_waitcnt lgkmcnt(" #n ")" ::: "memory")
#define PG8_BAR __builtin_amdgcn_s_barrier()
#define PG8_SCHED __builtin_amdgcn_sched_barrier(0)
    Unit cur, nxt; int ui = 0;
    if (!S.next(0, cur)) return;
    f32x4 acc[2][2][4][2];
#pragma unroll
    for (int a = 0; a < 2; ++a)
#pragma unroll
        for (int b = 0; b < 2; ++b)
#pragma unroll
            for (int m = 0; m < 4; ++m)
#pragma unroll
                for (int n = 0; n < 2; ++n) acc[a][b][m][n] = (f32x4){0.f, 0.f, 0.f, 0.f};
    bf16x8 At[4][2], B0[2][2], B1[2][2];
    unsigned gA[2][2];
    unsigned cA, cB = (unsigned)cur.e * (unsigned)(g.b_estride * 2) + (unsigned)cur.pn * tstepB;
    if constexpr (GATHER) { cA = 0u;
#pragma unroll
        for (int h = 0; h < 2; ++h)
#pragma unroll
            for (int i = 0; i < 2; ++i) gA[h][i] = (unsigned)g.rowidx[cur.pm * BM + h * HALF + Rr[i]] * (unsigned)(g.lda * 2) + (unsigned)Cc[i] * 2u;
    } else { cA = (unsigned)cur.pm * tstepA;
#pragma unroll
        for (int h = 0; h < 2; ++h)
#pragma unroll
            for (int i = 0; i < 2; ++i) gA[h][i] = voffA[h][i]; }
    PG8_STAGE(PG8_SB(0, 0), rB, cB, voffB); PG8_STAGE(PG8_SB(0, 1), rB, cB + hstepB, voffB); PG8_STAGE(PG8_SA(0, 0), rA, cA, gA[0]); PG8_STAGE(PG8_SA(0, 1), rA, cA, gA[1]);
    if (wr == 1) PG8_BAR;
    PG8_WAIT_V(2); PG8_BAR;
    PG8_STAGE(PG8_SB(1, 0), rB, cB + kstep, voffB); PG8_STAGE(PG8_SA(1, 0), rA, cA + kstep, gA[0]); PG8_STAGE(PG8_SB(1, 1), rB, cB + hstepB + kstep, voffB);
    PG8_WAIT_V(6); PG8_BAR;
    for (;;) {
        const bool has_next = S.next(ui + 1, nxt);
        unsigned nA; const unsigned nB = has_next ? (unsigned)nxt.e * (unsigned)(g.b_estride * 2) + (unsigned)nxt.pn * tstepB : cB;
        if constexpr (GATHER) nA = cA; else nA = has_next ? (unsigned)nxt.pm * tstepA : cA;
#pragma nounroll
        for (int t = 0; t < nt; t += 2) {
            const bool last = (t == nt - 2);
            const unsigned a1 = cA + (unsigned)(t + 1) * kstep;
            const unsigned a2 = last ? nA : cA + (unsigned)(t + 2) * kstep, b2 = last ? nB : cB + (unsigned)(t + 2) * kstep;
            const unsigned a3 = a2 + kstep, b3 = b2 + kstep;
            if constexpr (GATHER) { if (t == 0 && has_next && wid < 4)
                __builtin_amdgcn_global_load_lds((const unsigned*)(g.rowidx + nxt.pm * BM + wid * 64 + lane), (LAS unsigned*)(idxl + ((ui + 1) & 1) * 1024 + wid * 256), 4, 0, 0); }
            PG8_LDB(B0, 0, 0); PG8_LDB(B1, 0, 1); PG8_SCHED; PG8_LDA(At, 0, 0); PG8_STAGE(PG8_SA(1, 1), rA, a1, gA[1]);
            if constexpr (GATHER) { if (last && has_next) { int t3 = threadIdx.x; asm volatile("" : "+v"(t3));
#pragma unroll
                for (int i = 0; i < 2; ++i) { int R3, C3; stage_rc(t3 * 16 + i * 8192, R3, C3);
#pragma unroll
                    for (int h = 0; h < 2; ++h) gA[h][i] = *(const LAS unsigned*)(idxl + ((ui + 1) & 1) * 1024 + (h * HALF + R3) * 4) * (unsigned)(g.lda * 2) + (unsigned)C3 * 2u; } } }
            PG8_WAIT_V(8); PG8_WAIT_L(0); PG8_BAR; PG8_MMA(0, 0, At, B0); PG8_MMA(0, 1, At, B1); PG8_BAR; PG8_SCHED;
            PG8_LDA(At, 0, 1); PG8_STAGE(PG8_SB(0, 0), rB, b2, voffB); PG8_STAGE(PG8_SB(0, 1), rB, b2 + hstepB, voffB); PG8_STAGE(PG8_SA(0, 0), rA, a2, gA[0]);
            PG8_WAIT_V(8); PG8_WAIT_L(0); PG8_BAR; PG8_MMA(1, 0, At, B0); PG8_MMA(1, 1, At, B1); PG8_BAR; PG8_SCHED;
            PG8_LDB(B0, 1, 0); PG8_LDB(B1, 1, 1); PG8_SCHED; PG8_LDA(At, 1, 0); PG8_STAGE(PG8_SA(0, 1), rA, a2, gA[1]);
            PG8_WAIT_V(8); PG8_WAIT_L(0); PG8_BAR; PG8_MMA(0, 0, At, B0); PG8_MMA(0, 1, At, B1); PG8_BAR; PG8_SCHED;
            PG8_LDA(At, 1, 1); PG8_STAGE(PG8_SB(1, 0), rB, b3, voffB); PG8_STAGE(PG8_SB(1, 1), rB, b3 + hstepB, voffB); PG8_STAGE(PG8_SA(1, 0), rA, a3, gA[0]);
            PG8_WAIT_V(8); PG8_WAIT_L(0); PG8_BAR; PG8_MMA(1, 0, At, B0); PG8_MMA(1, 1, At, B1); PG8_BAR; PG8_SCHED;
        }
#ifndef PG8_NOALIGN
        if (wr == 0) PG8_BAR;
#endif
        { int t2 = threadIdx.x; asm volatile("" : "+v"(t2)); E(acc, cur, wr, wc, t2 & 15, (t2 >> 4) & 3); }
        if (!has_next) break;
#pragma unroll
        for (int a = 0; a < 2; ++a)
#pragma unroll
            for (int b = 0; b < 2; ++b)
#pragma unroll
                for (int m = 0; m < 4; ++m)
#pragma unroll
                    for (int n = 0; n < 2; ++n) acc[a][b][m][n] = (f32x4){0.f, 0.f, 0.f, 0.f};
        cur = nxt; cA = nA; cB = nB; ++ui;
#ifndef PG8_NOALIGN
        if (wr == 1) PG8_BAR;
#endif
    }
    PG8_WAIT_V(0);
#ifdef PG8_NOALIGN
    if (wr == 0) PG8_BAR;
#endif
    PG8_BAR;
#undef PG8_SA
#undef PG8_SB
#undef PG8_STAGE
#undef PG8_LDA
#undef PG8_LDB
#undef PG8_MMA
#undef PG8_CAT
#undef PG8_WAIT_V
#undef PG8_WAIT_L
#undef PG8_BAR
#undef PG8_SCHED
}
}
namespace epi {
using pg8::Unit; using pg8::HALF; using pg8::BM;
__device__ __forceinline__ u32x4 pack8(f32x4 a, f32x4 b) { u32x4 w; w.x = cvt_pk_bf16(a[0], a[1]); w.y = cvt_pk_bf16(a[2], a[3]); w.z = cvt_pk_bf16(b[0], b[1]); w.w = cvt_pk_bf16(b[2], b[3]); return w; }
__device__ __forceinline__ u32x2 pack4(f32x4 a) { u32x2 w; w.x = cvt_pk_bf16(a[0], a[1]); w.y = cvt_pk_bf16(a[2], a[3]); return w; }
__device__ __forceinline__ void rope4(f32x4& a, f32x4& b, const f32x4 t0, const f32x4 t1) {
    const f32x4 c = {t0[0], t0[2], t1[0], t1[2]}, s = {t0[1], t0[3], t1[1], t1[3]};
    const f32x4 na = a * c - b * s, nb = b * c + a * s; a = na; b = nb;
}
__device__ __forceinline__ void ssq_add(float* ssq, int row, float ss, int fq) { ss += __shfl_xor(ss, 16); ss += __shfl_xor(ss, 32); if (fq == 0) atomicAdd(ssq + row, ss); }
__device__ __forceinline__ float sq8(f32x4 a, f32x4 b) { return (a[0] * a[0] + a[1] * a[1]) + (a[2] * a[2] + a[3] * a[3]) + (b[0] * b[0] + b[1] * b[1]) + (b[2] * b[2] + b[3] * b[3]); }

struct EpiProj {
    static constexpr bool PERM = true;
    bf16_t* P; const f32x4* tabm; const f32x4* tabd; float* ssq_q; float* ssq_kv;
    __device__ __forceinline__ void operator()(const f32x4 (&acc)[2][2][4][2], const Unit& u, int wr, int wc, int fr, int fq) const {
        const int row0 = u.pm * BM + wr * 64 + fr, pn = u.pn;
#pragma unroll
        for (int ai = 0; ai < 2; ++ai)
#pragma unroll
            for (int m = 0; m < 4; ++m) { const int row = row0 + ai * HALF + m * 16; bf16_t* rp = P + (size_t)row * PJ;
                if (pn == 0) { float ss = 0.f;
#pragma unroll
                    for (int bj = 0; bj < 2; ++bj) { const f32x4 v0 = acc[ai][bj][m][0], v1 = acc[ai][bj][m][1]; ss += sq8(v0, v1); *(u32x4*)(rp + bj * HALF + wc * 32 + 8 * fq) = pack8(v0, v1); }
                    ssq_add(ssq_q, row, ss, fq);
                } else if (pn == 1) {
                    { const f32x4 v0 = acc[ai][0][m][0], v1 = acc[ai][0][m][1]; *(u32x4*)(rp + 256 + wc * 32 + 8 * fq) = pack8(v0, v1); ssq_add(ssq_kv, row, sq8(v0, v1), fq); }
                    if (wc == 0) { f32x4 a = acc[ai][1][m][0], b = acc[ai][1][m][1]; const f32x4 t0 = tabm[(size_t)row * 8 + 2 * fq], t1 = tabm[(size_t)row * 8 + 2 * fq + 1]; rope4(a, b, t0, t1);
                        *(u32x2*)(rp + PC_KR + 4 * fq) = pack4(a); *(u32x2*)(rp + PC_KR + 16 + 4 * fq) = pack4(b); }
                } else if (pn < 6) { const int g = 4 * (wc & 1) + fq; const f32x4 t0 = tabd[(size_t)row * 16 + 2 * g], t1 = tabd[(size_t)row * 16 + 2 * g + 1]; const float sc = pn < 4 ? C2D : 1.f;
#pragma unroll
                    for (int bj = 0; bj < 2; ++bj) { f32x4 a = acc[ai][bj][m][0] * sc, b = acc[ai][bj][m][1] * sc; rope4(a, b, t0, t1);
                        bf16_t* bp = rp + pn * 256 + bj * HALF + (wc >> 1) * 64 + 4 * g; *(u32x2*)bp = pack4(a); *(u32x2*)(bp + 32) = pack4(b); }
                } else {
#pragma unroll
                    for (int bj = 0; bj < 2; ++bj) *(u32x4*)(rp + pn * 256 + bj * HALF + wc * 32 + 8 * fq) = pack8(acc[ai][bj][m][0], acc[ai][bj][m][1]);
                }
            }
    }
};
struct EpiQ {
    static constexpr bool PERM = true;
    bf16_t* Q; const f32x4* tabm; const float* ssq_q;
    __device__ __forceinline__ void operator()(const f32x4 (&acc)[2][2][4][2], const Unit& u, int wr, int wc, int fr, int fq) const {
        const int row0 = u.pm * BM + wr * 64 + fr;
        if (u.pn < 2) {
#pragma unroll
            for (int ai = 0; ai < 2; ++ai)
#pragma unroll
                for (int m = 0; m < 4; ++m) { const int row = row0 + ai * HALF + m * 16; const float rs = rsqrtf(ssq_q[row] * (1.f / 256.f) + 1e-6f) * C2M; bf16_t* rp = Q + (size_t)row * 768 + u.pn * BM + wc * 32 + 8 * fq;
#pragma unroll
                    for (int bj = 0; bj < 2; ++bj) *(u32x4*)(rp + bj * HALF) = pack8(acc[ai][bj][m][0] * rs, acc[ai][bj][m][1] * rs); }
        } else {
#pragma unroll
            for (int ai = 0; ai < 2; ++ai)
#pragma unroll
                for (int m = 0; m < 4; ++m) { const int row = row0 + ai * HALF + m * 16; const float rs = rsqrtf(ssq_q[row] * (1.f / 256.f) + 1e-6f) * C2M; bf16_t* rp = Q + (size_t)row * 768 + 512 + wc * 32 + 4 * fq;
                    const f32x4 t0 = tabm[(size_t)row * 8 + 2 * fq], t1 = tabm[(size_t)row * 8 + 2 * fq + 1];
#pragma unroll
                    for (int bj = 0; bj < 2; ++bj) { f32x4 a = acc[ai][bj][m][0] * rs, b = acc[ai][bj][m][1] * rs; rope4(a, b, t0, t1); *(u32x2*)(rp + bj * 128) = pack4(a); *(u32x2*)(rp + bj * 128 + 16) = pack4(b); }
                    asm volatile("" ::: "memory"); }
        }
    }
};
struct EpiKV {
    static constexpr bool PERM = true;
    bf16_t* KV; const float* ssq_kv;
    __device__ __forceinline__ void operator()(const f32x4 (&acc)[2][2][4][2], const Unit& u, int wr, int wc, int fr, int fq) const {
        const int row0 = u.pm * BM + wr * 64 + fr;
#pragma unroll
        for (int ai = 0; ai < 2; ++ai)
#pragma unroll
            for (int m = 0; m < 4; ++m) { const int row = row0 + ai * HALF + m * 16; const float rs = rsqrtf(ssq_kv[row] * (1.f / 128.f) + 1e-6f); bf16_t* rp = KV + (size_t)row * 1024 + u.pn * BM + wc * 32 + 8 * fq;
#pragma unroll
                for (int bj = 0; bj < 2; ++bj) *(u32x4*)(rp + bj * HALF) = pack8(acc[ai][bj][m][0] * rs, acc[ai][bj][m][1] * rs); }
    }
};
struct EpiY {
    static constexpr bool PERM = true;
    bf16_t* Y;
    __device__ __forceinline__ void operator()(const f32x4 (&acc)[2][2][4][2], const Unit& u, int wr, int wc, int fr, int fq) const {
        const __amdgpu_buffer_rsrc_t rY = __builtin_amdgcn_make_buffer_rsrc((void*)Y, 0, T * 1024 * 2, 0x00020000);
        const int row0 = u.pm * BM + wr * 64 + fr, col = u.pn * BM + wc * 32 + 8 * fq;
#pragma unroll
        for (int ai = 0; ai < 2; ++ai)
#pragma unroll
            for (int m = 0; m < 4; ++m) { const int row = row0 + ai * HALF + m * 16;
#pragma unroll
                for (int bj = 0; bj < 2; ++bj) __builtin_amdgcn_raw_buffer_store_b128(pack8(acc[ai][bj][m][0], acc[ai][bj][m][1]), rY, (row * 1024 + col + bj * HALF) * 2, 0, 0); }
    }
};
struct EpiAct {
    static constexpr bool PERM = true;
    unsigned char* ACT; const float* bgu;
    __device__ __forceinline__ void operator()(const f32x4 (&acc)[2][2][4][2], const Unit& u, int wr, int wc, int fr, int fq) const {
        const __amdgpu_buffer_rsrc_t rA = __builtin_amdgcn_make_buffer_rsrc((void*)ACT, 0, 0x7ffffff0, 0x00020000), rB = __builtin_amdgcn_make_buffer_rsrc((void*)bgu, 0, NE * 2048 * 4, 0x00020000);
        const int row0 = u.pm * BM + wr * 64 + fr, j0 = u.pn * 128 + wc * 32 + 8 * fq;
        f32x4 bg[2], bu[2];
#pragma unroll
        for (int n = 0; n < 2; ++n) { bg[n] = __builtin_bit_cast(f32x4, __builtin_amdgcn_raw_buffer_load_b128(rB, (u.e * 2048 + j0 + 4 * n) * 4, 0, 0)); bu[n] = __builtin_bit_cast(f32x4, __builtin_amdgcn_raw_buffer_load_b128(rB, (u.e * 2048 + 1024 + j0 + 4 * n) * 4, 0, 0)); }
#pragma unroll
        for (int ai = 0; ai < 2; ++ai)
#pragma unroll
            for (int m = 0; m < 4; ++m) { const int row = row0 + ai * HALF + m * 16; u32x2 o;
#pragma unroll
                for (int n = 0; n < 2; ++n) { const f32x4 gv = acc[ai][0][m][n] * W8_INV + bg[n], uv = acc[ai][1][m][n] * W8_INV + bu[n]; float a4[4];
#pragma unroll
                    for (int i = 0; i < 4; ++i) { const float gg = fminf(gv[i], 7.f), uu = fminf(fmaxf(uv[i], -7.f), 7.f); a4[i] = gg * __builtin_amdgcn_rcpf(1.f + __builtin_amdgcn_exp2f(-1.702f * LOG2E * gg)) * (uu + 1.f); }
                    o[n] = pack4_fp8(a4[0], a4[1], a4[2], a4[3]); }
                __builtin_amdgcn_raw_buffer_store_b64(o, rA, row * 1024 + j0, 0, 0); }
    }
};
struct EpiDown {
    static constexpr bool PERM = true, PERM16 = true;
    unsigned char* YR; const float* bd; const float* roww;
    __device__ __forceinline__ void operator()(const f32x4 (&acc)[2][2][4][2], const Unit& u, int wr, int wc, int fr, int fq) const {
        const __amdgpu_buffer_rsrc_t rY = __builtin_amdgcn_make_buffer_rsrc((void*)YR, 0, 0x7ffffff0, 0x00020000), rB = __builtin_amdgcn_make_buffer_rsrc((void*)bd, 0, NE * 1024 * 4, 0x00020000),
                                     rW = __builtin_amdgcn_make_buffer_rsrc((void*)roww, 0, NROWS * 4, 0x00020000);
        const int row0 = u.pm * BM + wr * 64 + fr, col = u.pn * BM + wc * 64 + 16 * fq, boff = (u.e * 1024 + col) * 4;
#pragma unroll
        for (int ai = 0; ai < 2; ++ai) {
            f32x4 bv[2][2];
#pragma unroll
            for (int bj = 0; bj < 2; ++bj)
#pragma unroll
                for (int n = 0; n < 2; ++n) bv[bj][n] = __builtin_bit_cast(f32x4, __builtin_amdgcn_raw_buffer_load_b128(rB, boff + (8 * bj + 4 * n) * 4, 0, 0));
#pragma unroll
            for (int m = 0; m < 4; ++m) { const int row = row0 + ai * HALF + m * 16; const float ww = YR_SCALE * __builtin_bit_cast(float, __builtin_amdgcn_raw_buffer_load_b32(rW, row * 4, 0, 0)), w8 = ww * W8_INV; u32x4 o;
#pragma unroll
                for (int bj = 0; bj < 2; ++bj)
#pragma unroll
                    for (int n = 0; n < 2; ++n) { const f32x4 v = acc[ai][bj][m][n] * w8 + bv[bj][n] * ww; o[2 * bj + n] = pack4_fp8s(v[0], v[1], v[2], v[3]); }
                __builtin_amdgcn_raw_buffer_store_b128(o, rY, row * 1024 + col, 0, 0); }
            asm volatile("" ::: "memory"); }
    }
};
}
constexpr size_t MiB = 1u << 20;
constexpr size_t WS_CTL = 0, CTL_ZERO_BYTES = 64 * 1024;
constexpr size_t WS_MOD = 1 * MiB;
constexpr size_t WS_SSQ = 1 * MiB + 512 * 1024;
constexpr size_t WS_TABM = 2 * MiB, WS_TABD = 6 * MiB;
constexpr size_t WS_SE = 14 * MiB, WS_SG = 14 * MiB + 512 * 1024, WS_SRANK = 18 * MiB + 512 * 1024;
constexpr size_t WS_POS = 15 * MiB;
constexpr size_t WS_ROWTOK = 16 * MiB, WS_ROWW = 17 * MiB;
constexpr size_t WS_CNT = 18 * MiB;
constexpr size_t WS_TD0 = 19 * MiB;
constexpr size_t WS_WIN = 20 * MiB, WS_WQB = 24 * MiB, WS_WKVB = 25 * MiB, WS_WO = 26 * MiB;
constexpr size_t WS_WGU = 28 * MiB, WS_WD = 156 * MiB;
constexpr size_t WS_H = 220 * MiB;
constexpr size_t WS_PROJ = 284 * MiB;
constexpr size_t WS_QM = 412 * MiB, WS_KVM = 460 * MiB, WS_ATT = 524 * MiB, WS_Y = 588 * MiB;
constexpr size_t WS_X1 = 524 * MiB;
constexpr size_t WS_ACT = 284 * MiB;
constexpr size_t WS_YR = 588 * MiB;
constexpr size_t WS_END = 860 * MiB;
static_assert(WS_ACT + (size_t)NROWS * 1024 * 2 <= WS_YR && WS_YR + (size_t)NROWS * 1024 * 2 <= WS_END, "ws map");
constexpr int CW_BAR = 4096;

constexpr int RING_OFF = 0, RING_BYTES = 131072;
constexpr int LDSCTL_OFF = RING_BYTES, MISC_OFF = LDSCTL_OFF + 320;
constexpr int XTRA_OFF = MISC_OFF + 128;
constexpr int X_TILEE = XTRA_OFF;
constexpr int X_SE = X_TILEE + 2304, X_SG = X_SE + 2048, X_SRANK = X_SG + 2048, X_WCNT = X_SRANK + 2048, X_MISC2 = X_WCNT + 1024;
constexpr int X_IDX = X_MISC2 + 1024;
constexpr int X_CONST = 147456;
constexpr int LDS_BYTES = 163840;
static_assert(X_IDX + 2048 <= X_CONST && X_CONST + 12288 <= LDS_BYTES, "LDS map");
constexpr int NWAVES = 8;

#define XB_TMO      128
#define XB_XCNT(j)  (256  + 64 * (j))
#define XB_XSUB(j)  (1280 + 64 * (j))
#define XB_XGEN(j)  (2304 + 64 * (j))
#define XB_TOP      3328
#define XB_TOPGEN   3392
#define XCD_BAR_WORDS 3456
#define XB_SPIN_CAP (1u << 18)
__device__ __forceinline__ unsigned xb_ld(unsigned* p)              { return __hip_atomic_load(p, __ATOMIC_RELAXED, __HIP_MEMORY_SCOPE_AGENT); }
__device__ __forceinline__ unsigned xb_add(unsigned* p, unsigned v) { return __hip_atomic_fetch_add(p, v, __ATOMIC_RELAXED, __HIP_MEMORY_SCOPE_AGENT); }
__device__ __forceinline__ unsigned xb_xcc_id() { return (unsigned)__builtin_amdgcn_s_getreg((3 << 11) | 20) & 0xFu; }
#define XB_SPIN(cond, bar) do { unsigned _sp = 0; while (cond) { __builtin_amdgcn_s_sleep(1); \
    if ((++_sp & 255u) == 0u) { if (xb_ld(&(bar)[XB_TMO])) break; if (_sp > XB_SPIN_CAP) { atomicAdd(&(bar)[XB_TMO], 1u); break; } } } } while (0)
struct XcdBarrier { unsigned* bar; unsigned x; volatile LAS unsigned* st; };
__device__ __forceinline__ XcdBarrier xcd_barrier_post(unsigned* bar, volatile LAS unsigned* st) {
    XcdBarrier b; b.bar = bar; b.x = xb_xcc_id(); b.st = st;
    if (threadIdx.x == 0) (void)xb_add(&bar[XB_XCNT(b.x)], 1u);
    return b;
}
__device__ __forceinline__ void xcd_barrier_complete(unsigned* bar, unsigned x, unsigned& nloc, unsigned& nx) {
    const unsigned G = gridDim.x * gridDim.y * gridDim.z;
    unsigned sum, cnt, mine, sp = 0u;
    for (;;) {
        sum = 0u; cnt = 0u; mine = 0u;
#pragma unroll
        for (unsigned j = 0; j < 16; ++j) { const unsigned c = xb_ld(&bar[XB_XCNT(j)]); sum += c; cnt += (c > 0u) ? 1u : 0u; mine = (j == x) ? c : mine; }
        if (sum == G) break;
        __builtin_amdgcn_s_sleep(1);
        if ((++sp & 255u) == 0u) { if (xb_ld(&bar[XB_TMO])) break; if (sp > XB_SPIN_CAP) { atomicAdd(&bar[XB_TMO], 1u); break; } }
    }
    nloc = mine > 0u ? mine : 1u; nx = cnt > 0u ? cnt : 1u;
}
__device__ __forceinline__ void xcd_barrier(const XcdBarrier& b) {
    asm volatile("s_waitcnt vmcnt(0)" ::: "memory");
    __syncthreads();
    if (threadIdx.x == 0) {
        unsigned* bar = b.bar;
        __builtin_amdgcn_s_waitcnt(0);
        unsigned nloc = b.st[0], nx = b.st[1];
        if (nloc == 0u) { xcd_barrier_complete(bar, b.x, nloc, nx); b.st[0] = nloc; b.st[1] = nx; }
        const unsigned old = xb_add(&bar[XB_XSUB(b.x)], 1u);
        const unsigned gen = old / nloc;
        if (old + 1u == (gen + 1u) * nloc) {
            __builtin_amdgcn_fence(__ATOMIC_RELEASE, "agent");
            asm volatile("s_waitcnt vmcnt(0)" ::: "memory");
            const unsigned og = xb_add(&bar[XB_TOP], 1u);
            const unsigned tg = og / nx;
            if (og + 1u == (tg + 1u) * nx) xb_add(&bar[XB_TOPGEN], 1u);
            else XB_SPIN(xb_ld(&bar[XB_TOPGEN]) == tg, bar);
            __builtin_amdgcn_fence(__ATOMIC_ACQUIRE, "agent");
            xb_add(&bar[XB_XGEN(b.x)], 1u);
            asm volatile("s_waitcnt vmcnt(0)" ::: "memory");
        } else {
            XB_SPIN(xb_ld(&bar[XB_XGEN(b.x)]) == gen, bar);
            __builtin_amdgcn_fence(__ATOMIC_ACQUIRE, "agent");
            asm volatile("s_waitcnt vmcnt(0)" ::: "memory");
        }
    }
    __syncthreads();
}

struct Args { const float* in[26]; float* out; unsigned char* ws; int ph_lo, ph_hi, li, pad; };
struct Frame {
    LAS unsigned char* lds; volatile LAS unsigned* MISC; unsigned* ctl;
    int G, bid;
    const Args* a;
};
#define PHASE_IDS() int tid_ = threadIdx.x; asm volatile("" : "+v"(tid_)); const int tid = tid_, lane = tid & 63, wave = __builtin_amdgcn_readfirstlane(tid >> 6); (void)lane; (void)wave
#define IN_X 0
#define IN_C 1
#define IN_POS 2
#define IN_WADA 3
#define IN_BADA 4
#define IN_GMIXPRE 5
#define IN_GMIXPOST 6
#define IN_WIN 7
#define IN_GQA 8
#define IN_WQB 9
#define IN_GKVA 10
#define IN_WKVB 11
#define IN_LQ1 12
#define IN_LK1 13
#define IN_LQ2 14
#define IN_LK2 15
#define IN_GSUBLN 16
#define IN_WO 17
#define IN_GFFNPRE 18
#define IN_GFFNPOST 19
#define IN_WROUTER 20
#define IN_BROUTER 21
#define IN_WGU 22
#define IN_BGU 23
#define IN_WDN 24
#define IN_BDN 25

template <class Map>
__device__ __forceinline__ void transpose_item(const float* W, int K, int N, bf16_t* WT, const float* gain, Map dst, LAS float* scr, int item, int lane) {
    const int nblk = N / 32, kb = item / nblk, nb = item % nblk, k0 = 64 * kb, n0 = 32 * nb;
    { float v[32];
#pragma unroll
      for (int i = 0; i < 32; ++i) v[i] = W[(size_t)(k0 + 2 * i + (lane >> 5)) * N + n0 + (lane & 31)];
#pragma unroll
      for (int i = 0; i < 32; ++i) scr[(2 * i + (lane >> 5)) * 33 + (lane & 31)] = v[i]; }
    LDS_WAIT(); asm volatile("" ::: "memory");
    const int c = lane & 7;
    float gk[8];
#pragma unroll
    for (int i = 0; i < 8; ++i) gk[i] = gain ? gain[k0 + 8 * c + i] : 1.f;
#pragma unroll
    for (int j = 0; j < 4; ++j) { const int n = (lane >> 3) + 8 * j; const LAS float* s = scr + (8 * c) * 33 + n;
        u32x4 o; o.x = cvt_pk_bf16(s[0 * 33] * gk[0], s[1 * 33] * gk[1]); o.y = cvt_pk_bf16(s[2 * 33] * gk[2], s[3 * 33] * gk[3]); o.z = cvt_pk_bf16(s[4 * 33] * gk[4], s[5 * 33] * gk[5]); o.w = cvt_pk_bf16(s[6 * 33] * gk[6], s[7 * 33] * gk[7]);
        *(GAS u32x4*)(WT + (size_t)dst(n0 + n) * K + k0 + 8 * c) = o; }
    LDS_WAIT(); asm volatile("" ::: "memory");
}
template <class Map>
__device__ __forceinline__ void transpose8_stream(const float* W, int N, unsigned char* WT, Map dst, LAS float* scr, int first, int stride, int lane) {
    const int nblk = N / 32, per_e = 8 * nblk, total = NE * per_e;
    if (first >= total) return;
    float v[32];
    auto src = [&](int it, int hb) -> const float* { const int e = it / per_e, r = it - e * per_e, kb = r / nblk, nb = r - kb * nblk; return W + ((size_t)e * 1024 + 128 * kb + 64 * hb + (lane >> 5)) * N + 32 * nb + (lane & 31); };
    { const float* p = src(first, 0);
#pragma unroll
      for (int i = 0; i < 32; ++i) v[i] = __builtin_nontemporal_load(p + (size_t)(2 * i) * N); }
    for (int it = first; it < total; it += stride) {
#pragma unroll
        for (int hb = 0; hb < 2; ++hb) {
            float w[32];
#pragma unroll
            for (int i = 0; i < 32; ++i) w[i] = v[i];
            const int nit = hb == 0 ? it : it + stride;
            if (nit < total) { const float* p = src(nit, hb ^ 1);
#pragma unroll
                for (int i = 0; i < 32; ++i) v[i] = __builtin_nontemporal_load(p + (size_t)(2 * i) * N); }
#pragma unroll
            for (int i = 0; i < 32; ++i) { const int kk = 64 * hb + 2 * i + (lane >> 5); scr[kk * 32 + ((lane & 31) ^ (kk & 31) ^ (((kk >> 5) & 3) << 2))] = w[i]; }
        }
        LDS_WAIT(); asm volatile("" ::: "memory");
        const int e = it / per_e, r = it - e * per_e, kb = r / nblk, nb = r - kb * nblk, c = lane & 7;
#pragma unroll
        for (int j = 0; j < 4; ++j) { const int n = (lane >> 3) + 8 * j; float t[16];
#pragma unroll
            for (int i = 0; i < 16; ++i) { const int kk = 16 * c + i; t[i] = scr[kk * 32 + (n ^ (kk & 31) ^ (((kk >> 5) & 3) << 2))] * W8_SCALE; }
            u32x4 o; o.x = pack4_fp8(t[0], t[1], t[2], t[3]); o.y = pack4_fp8(t[4], t[5], t[6], t[7]); o.z = pack4_fp8(t[8], t[9], t[10], t[11]); o.w = pack4_fp8(t[12], t[13], t[14], t[15]);
            __builtin_nontemporal_store(o, (GAS u32x4*)(WT + ((size_t)e * N + dst(32 * nb + n)) * 1024 + 128 * kb + 16 * c)); }
        LDS_WAIT(); asm volatile("" ::: "memory");
    }
}
__device__ __forceinline__ int il4(int i, int x2) { return 8 * (i >> 2) + 4 * x2 + (i & 3); }
struct MapWin { __device__ int operator()(int n) const {
    if (n < 384) return n;
    if (n < 416) { const int r = n - 384; return PC_KR + il4(r & 15, r >> 4); }
    if (n < 1440) { const int r = n - 416, hj = r >> 6, d = r & 63; return PC_QD + hj * 64 + il4(d & 31, d >> 5); }
    return PC_VD + (n - 1440); } };
struct MapWqb { __device__ int operator()(int n) const { const int h = n / 96, d = n - h * 96; if (d < 64) return h * 64 + d; const int r = d - 64; return 512 + h * 32 + il4(r & 15, r >> 4); } };
struct MapId { __device__ int operator()(int n) const { return n; } };
struct MapWgu { __device__ int operator()(int n) const { const int which = n >> 10, j = n & 1023; return (j >> 7) * 256 + which * 128 + (j & 127); } };

__device__ __forceinline__ void p0_prologue(Frame& F) {
    PHASE_IDS();
    float* mod = (float*)(F.a->ws + WS_MOD);
    if (F.bid < 192) {
        LAS float* cact = (LAS float*)(F.lds);
        LAS float* red = (LAS float*)(F.lds + 65536);
        const float* c = F.a->in[IN_C];
        { float cv[32];
#pragma unroll
          for (int i = 0; i < 32; ++i) cv[i] = c[tid + 512 * i];
#pragma unroll
          for (int i = 0; i < 32; ++i) cact[tid + 512 * i] = cv[i] / (1.f + __expf(-cv[i])); }
        __syncthreads();
        const int n0 = 32 * F.bid, col = tid & 31, kg = tid >> 5;
        float acc[16];
#pragma unroll
        for (int b = 0; b < 16; ++b) acc[b] = 0.f;
        const float* wp = F.a->in[IN_WADA] + (size_t)(kg * 64) * 6144 + n0 + col;
#pragma unroll
        for (int q = 0; q < 2; ++q) { float w[32];
#pragma unroll
            for (int kk = 0; kk < 32; ++kk) w[kk] = wp[(size_t)(32 * q + kk) * 6144];
#pragma unroll
            for (int kk = 0; kk < 32; ++kk)
#pragma unroll
                for (int b = 0; b < 16; ++b) acc[b] += cact[b * 1024 + kg * 64 + 32 * q + kk] * w[kk]; }
#pragma unroll
        for (int b = 0; b < 16; ++b) red[(kg * 16 + b) * 32 + col] = acc[b];
        __syncthreads();
        { const int b = tid >> 5; float s = 0.f;
#pragma unroll
          for (int k2 = 0; k2 < 16; ++k2) s += red[(k2 * 16 + b) * 32 + col];
          mod[b * 6144 + n0 + col] = s + F.a->in[IN_BADA][n0 + col]; }
        __syncthreads();
    }
    { float* ssq = (float*)(F.a->ws + WS_SSQ); for (int i = F.bid * 512 + tid; i < 3 * T; i += F.G * 512) ssq[i] = 0.f;
      u32x4* wz = (u32x4*)((bf16_t*)(F.a->ws + WS_WIN) + (size_t)416 * 1024); for (int i = F.bid * 512 + tid; i < 96 * 1024 / 8; i += F.G * 512) wz[i] = (u32x4){0u, 0u, 0u, 0u}; }
    { const int* pos = (const int*)F.a->in[IN_POS]; float2* tabm = (float2*)(F.a->ws + WS_TABM); float2* tabd = (float2*)(F.a->ws + WS_TABD);
      for (int gid = F.bid * 512 + tid; gid < T * 48; gid += F.G * 512) { const int t = gid / 48, i = gid - t * 48; const float p = (float)pos[t];
          if (i < 16) { const float inv = powf(10000.f, -(float)(2 * i) / 32.f); const double a = (double)(p * inv); tabm[t * 16 + i] = make_float2((float)cos(a), (float)sin(a)); }
          else { const int j = i - 16; const float inv = powf(10000.f, -(float)(2 * j) / 64.f); const double a = (double)(p * inv); tabd[t * 32 + j] = make_float2((float)cos(a), (float)sin(a)); } } }
    LAS float* scr = (LAS float*)(F.lds + RING_OFF + wave * 16384);
    const int gw = F.bid * NWAVES + wave, NGW = F.G * NWAVES;
    constexpr int I_WIN = 16 * 61, I_WQB = 4 * 24, I_WKVB = 2 * 32, I_WO = 16 * 32;
    constexpr int NITEMS = I_WIN + I_WQB + I_WKVB + I_WO;
    for (int it = gw; it < NITEMS; it += NGW) {
        int r = it;
        if (r < I_WIN) { transpose_item(F.a->in[IN_WIN], 1024, INC, (bf16_t*)(F.a->ws + WS_WIN), nullptr, MapWin{}, scr, r, lane); continue; } r -= I_WIN;
        if (r < I_WQB) { transpose_item(F.a->in[IN_WQB], 256, 768, (bf16_t*)(F.a->ws + WS_WQB), F.a->in[IN_GQA], MapWqb{}, scr, r, lane); continue; } r -= I_WQB;
        if (r < I_WKVB) { transpose_item(F.a->in[IN_WKVB], 128, 1024, (bf16_t*)(F.a->ws + WS_WKVB), F.a->in[IN_GKVA], MapId{}, scr, r, lane); continue; } r -= I_WKVB;
        transpose_item(F.a->in[IN_WO], 1024, 1024, (bf16_t*)(F.a->ws + WS_WO), nullptr, MapId{}, scr, r, lane);
    }
    transpose8_stream(F.a->in[IN_WGU], 2048, (unsigned char*)(F.a->ws + WS_WGU), MapWgu{}, scr, gw, NGW, lane);
    transpose8_stream(F.a->in[IN_WDN], 1024, (unsigned char*)(F.a->ws + WS_WD), MapId{}, scr, gw, NGW, lane);
}
__device__ __forceinline__ void p0b_norm(Frame& F) {
    PHASE_IDS();
    const float* mod = (const float*)(F.a->ws + WS_MOD); bf16_t* H = (bf16_t*)(F.a->ws + WS_H);
    const int tok0 = F.bid * 128 + wave * 16, b = (F.bid * 128) / S;
    f32x4 g[4], sh[4];
#pragma unroll
    for (int j = 0; j < 4; ++j) { const int c = 4 * lane + 256 * j; g[j] = *(const f32x4*)(F.a->in[IN_GMIXPRE] + c) * (*(const f32x4*)(mod + b * 6144 + 1024 + c) + 1.f); sh[j] = *(const f32x4*)(mod + b * 6144 + c); }
    for (int i = 0; i < 16; i += 4) {
        f32x4 v[4][4];
#pragma unroll
        for (int r = 0; r < 4; ++r)
#pragma unroll
            for (int j = 0; j < 4; ++j) v[r][j] = __builtin_nontemporal_load((const GAS f32x4*)(F.a->in[IN_X] + (size_t)(tok0 + i + r) * D) + lane + 64 * j);
#pragma unroll
        for (int r = 0; r < 4; ++r) { float ss = 0.f;
#pragma unroll
            for (int j = 0; j < 4; ++j) ss += (v[r][j].x * v[r][j].x + v[r][j].y * v[r][j].y) + (v[r][j].z * v[r][j].z + v[r][j].w * v[r][j].w);
            const float rs = rsqrtf(wave_sum(ss) * (1.f / D) + 1e-6f);
            GAS u32x2* o8 = (GAS u32x2*)(H + (size_t)(tok0 + i + r) * D) + lane;
#pragma unroll
            for (int j = 0; j < 4; ++j) { const f32x4 h = (v[r][j] * rs) * g[j] + sh[j]; u32x2 w; w.x = cvt_pk_bf16(h[0], h[1]); w.y = cvt_pk_bf16(h[2], h[3]); o8[64 * j] = w; } }
    }
}
__device__ __forceinline__ void p5_rows(Frame& F) {
    PHASE_IDS();
    LAS float* wt = (LAS float*)(F.lds + RING_OFF);
    for (int idx = tid; idx < NE * 1024; idx += 512) { const int e = idx >> 10, k = idx & 1023; wt[idx] = F.a->in[IN_WROUTER][k * NE + e]; }
    LAS int* se = (LAS int*)(F.lds + X_SE); LAS float* sg = (LAS float*)(F.lds + X_SG);
    const float* mod = (const float*)(F.a->ws + WS_MOD); const float* ssq_y = (const float*)(F.a->ws + WS_SSQ) + 2 * T;
    const bf16_t* Y = (const bf16_t*)(F.a->ws + WS_Y); unsigned char* H2 = (unsigned char*)(F.a->ws + WS_H); bf16_t* X1 = (bf16_t*)(F.a->ws + WS_X1);
    const int tok0 = F.bid * 128 + wave * 16, b = (F.bid * 128) / S;
    LAS float* cst = (LAS float*)(F.lds + X_CONST);
    for (int c = tid; c < 1024; c += 512) { cst[c] = F.a->in[IN_GMIXPOST][c] * mod[b * 6144 + 2048 + c]; cst[1024 + c] = F.a->in[IN_GFFNPRE][c] * (mod[b * 6144 + 4096 + c] + 1.f); cst[2048 + c] = mod[b * 6144 + 3072 + c]; }
    f32x4 xn[2][4]; u32x2 yn[2][4];
#define P5_PRE(r_) do { _Pragma("unroll") for (int q_ = 0; q_ < 2; ++q_) { _Pragma("unroll") for (int j = 0; j < 4; ++j) { xn[q_][j] = __builtin_nontemporal_load((const GAS f32x4*)(F.a->in[IN_X] + (size_t)((r_) + q_) * D + 4 * lane + 256 * j)); yn[q_][j] = __builtin_nontemporal_load((const GAS u32x2*)(Y + (size_t)((r_) + q_) * D + 4 * lane + 256 * j)); } } } while (0)
    P5_PRE(tok0);
    __syncthreads();
#pragma nounroll
    for (int i = 0; i < 16; i += 2) {
        const int row = tok0 + i;
        f32x2 hp[4][4];
        {   f32x4 xv[2][4]; u32x2 yv[2][4]; float rsy[2];
#pragma unroll
            for (int q = 0; q < 2; ++q) { float sy = 0.f;
#pragma unroll
                for (int j = 0; j < 4; ++j) { xv[q][j] = xn[q][j]; yv[q][j] = yn[q][j]; const float a0 = bflo(yv[q][j].x), a1 = bfhi(yv[q][j].x), a2 = bflo(yv[q][j].y), a3 = bfhi(yv[q][j].y); sy += (a0 * a0 + a1 * a1) + (a2 * a2 + a3 * a3); }
                rsy[q] = rsqrtf(wave_sum(sy) * (1.f / D) + 1e-6f); }
            if (i + 2 < 16) P5_PRE(row + 2);
            f32x4 gpost[4], gpre[4], shf[4];
#pragma unroll
            for (int j = 0; j < 4; ++j) { gpost[j] = *(const LAS f32x4*)(cst + 4 * lane + 256 * j); gpre[j] = *(const LAS f32x4*)(cst + 1024 + 4 * lane + 256 * j); shf[j] = *(const LAS f32x4*)(cst + 2048 + 4 * lane + 256 * j); }
#pragma unroll
            for (int q = 0; q < 2; ++q) { f32x4 x1[4]; float ss = 0.f;
#pragma unroll
                for (int j = 0; j < 4; ++j) { const f32x4 yy = {bflo(yv[q][j].x), bfhi(yv[q][j].x), bflo(yv[q][j].y), bfhi(yv[q][j].y)}; x1[j] = xv[q][j] + (yy * rsy[q]) * gpost[j];
                    ss += (x1[j][0] * x1[j][0] + x1[j][1] * x1[j][1]) + (x1[j][2] * x1[j][2] + x1[j][3] * x1[j][3]);
                    { u32x2 w; w.x = cvt_pk_bf16(x1[j][0], x1[j][1]); w.y = cvt_pk_bf16(x1[j][2], x1[j][3]); __builtin_nontemporal_store(w, (GAS u32x2*)(X1 + (size_t)(row + q) * D + 4 * lane + 256 * j)); } }
                const float r1 = rsqrtf(wave_sum(ss) * (1.f / D) + 1e-6f);
#pragma unroll
                for (int j = 0; j < 4; ++j) { const f32x4 h = (x1[j] * r1) * gpre[j] + shf[j]; *(GAS unsigned*)(H2 + (size_t)(row + q) * D + 4 * lane + 256 * j) = pack4_fp8s(h[0], h[1], h[2], h[3]);
#pragma unroll
                    for (int c = 0; c < 4; ++c) hp[j][c][q] = h[c]; } } }
        f32x2 v[32];
#pragma unroll
        for (int e = 0; e < NE; ++e) { const LAS f32x4* wp = (const LAS f32x4*)(wt + e * 1024 + 4 * lane); f32x2 p = {0.f, 0.f};
#pragma unroll
            for (int j = 0; j < 4; ++j) { const f32x4 w = wp[64 * j]; p = p + hp[j][0] * w[0]; p = p + hp[j][1] * w[1]; p = p + hp[j][2] * w[2]; p = p + hp[j][3] * w[3]; }
            v[e] = p; if ((e & 3) == 3) __builtin_amdgcn_sched_barrier(0); }
        const int my_e = lane >> 1; const float brt = F.a->in[IN_BROUTER][my_e];
#define P5_REDUCE(Q) do { float u_[16]; \
            _Pragma("unroll") for (int j = 0; j < 16; ++j) u_[j] = swap32_sum(v[j][Q], v[16 + j][Q]); \
            _Pragma("unroll") for (int j = 0; j < 8; ++j) u_[j] = swap16_sum(u_[j], u_[8 + j]); \
            _Pragma("unroll") for (int j = 0; j < 4; ++j) { const bool up = (lane & 8) != 0; const float keep = up ? u_[4 + j] : u_[j], send = up ? u_[j] : u_[4 + j]; u_[j] = keep + lane_xor8(send); } \
            _Pragma("unroll") for (int j = 0; j < 2; ++j) { const bool up = (lane & 4) != 0; const float keep = up ? u_[2 + j] : u_[j], send = up ? u_[j] : u_[2 + j]; u_[j] = keep + lane_xor4(send); } \
            { const bool up = (lane & 2) != 0; const float keep = up ? u_[1] : u_[0], send = up ? u_[0] : u_[1]; u_[0] = keep + DPPF(send, 0x4E); } \
            float lg = u_[0] + DPPF(u_[0], 0xB1) + brt; \
            float vals[4]; int idx[4]; \
            _Pragma("unroll") for (int k = 0; k < 4; ++k) { const float mx = wave_max(lg); const unsigned long long bm = __ballot(lg == mx); const int wl = __builtin_ctzll(bm); vals[k] = mx; idx[k] = wl >> 1; if (my_e == idx[k]) lg = -INFINITY; } \
            float ex[4], den = 0.f; \
            _Pragma("unroll") for (int k = 0; k < 4; ++k) { ex[k] = __expf(vals[k] - vals[0]); den += ex[k]; } \
            const float inv = 1.f / den; \
            if (lane < 4) { const int a = (wave * 16 + i + Q) * 4 + lane; se[a] = lane == 0 ? idx[0] : lane == 1 ? idx[1] : lane == 2 ? idx[2] : idx[3]; sg[a] = (lane == 0 ? ex[0] : lane == 1 ? ex[1] : lane == 2 ? ex[2] : ex[3]) * inv; } \
            __builtin_amdgcn_sched_barrier(0); } while (0)
        P5_REDUCE(0);
        P5_REDUCE(1);
#undef P5_REDUCE
    }
#undef P5_PRE
#define P5_LOAD(x)
#undef P5_LOAD
    __syncthreads();
    LAS int* srank = (LAS int*)(F.lds + X_SRANK); LAS int* wcnt = (LAS int*)(F.lds + X_WCNT);
    const int e_my = se[tid]; int rk = 0;
    for (int e = 0; e < NE; ++e) { const unsigned long long bm = __ballot(e_my == e); if (e_my == e) rk = __builtin_popcountll(bm & ((1ull << lane) - 1ull)); if (lane == 0) wcnt[wave * 32 + e] = __builtin_popcountll(bm); }
    __syncthreads();
    int base = 0;
    for (int w = 0; w < wave; ++w) base += wcnt[w * 32 + e_my];
    srank[tid] = base + rk;
    { const int a = F.bid * 512 + tid; ((int*)(F.a->ws + WS_SE))[a] = e_my; ((float*)(F.a->ws + WS_SG))[a] = sg[tid]; ((int*)(F.a->ws + WS_SRANK))[a] = base + rk; }
    if (tid < NE) { int tot = 0; for (int w = 0; w < 8; ++w) tot += wcnt[w * 32 + tid]; ((int*)(F.a->ws + WS_CNT))[F.bid * NE + tid] = tot; }
}
__device__ __forceinline__ void p9_final(Frame& F) {
    PHASE_IDS();
    const float* mod = (const float*)(F.a->ws + WS_MOD); const unsigned char* YR = (const unsigned char*)(F.a->ws + WS_YR); const int* pos = (const int*)(F.a->ws + WS_POS);
    const int tok0 = F.bid * 128 + wave * 16, b = (F.bid * 128) / S;
    f32x4 gf[4];
#pragma unroll
    for (int j = 0; j < 4; ++j) { const int c = 4 * lane + 256 * j; gf[j] = *(const f32x4*)(F.a->in[IN_GFFNPOST] + c) * *(const f32x4*)(mod + b * 6144 + 5120 + c); }
    unsigned yn[4][4]; u32x2 xn[4]; const bf16_t* X1 = (const bf16_t*)(F.a->ws + WS_X1);
#define P9_LOAD(row) do { _Pragma("unroll") for (int s_ = 0; s_ < 4; ++s_) { const int pr = __builtin_amdgcn_readfirstlane(pos[(row) * 4 + s_]); _Pragma("unroll") for (int j = 0; j < 4; ++j) yn[s_][j] = __builtin_nontemporal_load((const GAS unsigned*)(YR + (size_t)pr * D + 4 * lane + 256 * j)); } \
        _Pragma("unroll") for (int j = 0; j < 4; ++j) xn[j] = __builtin_nontemporal_load((const GAS u32x2*)(X1 + (size_t)(row) * D + 4 * lane + 256 * j)); } while (0)
    P9_LOAD(tok0);
    for (int i = 0; i < 16; ++i) {
        const int row = tok0 + i;
        f32x4 y[4], x1[4]; float ss = 0.f;
#pragma unroll
        for (int j = 0; j < 4; ++j) { y[j] = (f32x4){0.f, 0.f, 0.f, 0.f};
#pragma unroll
            for (int s_ = 0; s_ < 4; ++s_) { const unsigned w = yn[s_][j]; const f32x2 lo = __builtin_amdgcn_cvt_pk_f32_fp8((int)w, false), hi2 = __builtin_amdgcn_cvt_pk_f32_fp8((int)w, true); y[j] += (f32x4){lo[0], lo[1], hi2[0], hi2[1]}; }
            y[j] = y[j] * YR_INV; x1[j] = (f32x4){bflo(xn[j].x), bfhi(xn[j].x), bflo(xn[j].y), bfhi(xn[j].y)}; ss += (y[j][0] * y[j][0] + y[j][1] * y[j][1]) + (y[j][2] * y[j][2] + y[j][3] * y[j][3]); }
        if (i + 1 < 16) P9_LOAD(row + 1);
        const float r = rsqrtf(wave_sum(ss) * (1.f / D) + 1e-6f);
#pragma unroll
        for (int j = 0; j < 4; ++j) __builtin_nontemporal_store(x1[j] + (y[j] * r) * gf[j], (GAS f32x4*)(F.a->out + (size_t)row * D + 4 * lane + 256 * j));
    }
#undef P9_LOAD
}
namespace att {
#define SBAR() __builtin_amdgcn_sched_barrier(0)
typedef short s16x4 __attribute__((ext_vector_type(4)));
typedef short v4i16_t __attribute__((ext_vector_type(4)));
typedef __attribute__((address_space(3))) const char* lds_cptr;
__device__ __forceinline__ int crow(int r, int hi) { return (r & 3) + 8 * (r >> 2) + 4 * hi; }
__device__ __forceinline__ void glds16(const void* gsrc, unsigned lds_dst) { unsigned keep;
    asm volatile("s_mov_b32 %0, m0\n\ts_mov_b32 m0, %2\n\ts_nop 0\n\tglobal_load_lds_dwordx4 %1, off\n\ts_mov_b32 m0, %0" : "=&s"(keep) : "v"(gsrc), "s"(lds_dst) : "memory"); }
__device__ __forceinline__ s16x4 vtr(lds_cptr p) { return __builtin_bit_cast(s16x4, __builtin_amdgcn_ds_read_tr16_b64_v4i16((__attribute__((address_space(3))) v4i16_t*)p)); }
typedef float f32x2_t __attribute__((ext_vector_type(2))); typedef __bf16 bf16x2_t __attribute__((ext_vector_type(2)));
__device__ __forceinline__ unsigned cvtpk_s(float lo, float hi) { f32x2_t v = {lo, hi}; bf16x2_t b = __builtin_convertvector(v, bf16x2_t); return __builtin_bit_cast(unsigned, b); }
#define WAIT_BAR0() asm volatile("s_waitcnt vmcnt(0) lgkmcnt(0)\n\ts_barrier" ::: "memory")

struct Src {
    const bf16_t* q0; const bf16_t* q1; int qp;
    const bf16_t* k0; const bf16_t* k1; int kp0, kp1;
    const bf16_t* v; int vp;
};
template <int DQK, int DV> struct Geo {
    static constexpr int NKC = DQK / 8, NVB = DV / 32, KSLOT = NKC * 1024, VSLOT = NVB * 4096, NPIECE = NKC + 4 * NVB;
    static constexpr int NSLOT = 3, LDS_K = 0, LDS_V = NSLOT * KSLOT, LDS_WS = LDS_V + NSLOT * VSLOT, LDS_OST = 0  , LDS_TOTAL = LDS_WS + 8 * 256;
    static_assert(8 * 32 * DV * 2 <= LDS_WS && LDS_TOTAL <= 131072, "attention LDS map");
};
constexpr float THR = 8.f;
#ifndef ATT_VPM
#define ATT_VPM 8
#endif

template <int DQK, int DV, int MODE>
__device__ __forceinline__ void attn_unit(LAS char* shm, const Src sc, int qb, bf16_t* obase, float* td, float lam, const float* gsub) {
    typedef Geo<DQK, DV> G;
    int tid_ = threadIdx.x; asm volatile("" : "+v"(tid_));
    const int tid = tid_, lane = tid & 63, r32 = lane & 31, hi = lane >> 5; const int wid = __builtin_amdgcn_readfirstlane(tid >> 6);
    const int q0 = qb * 256, NT = 4 * (qb + 1);
    const unsigned lds0 = (unsigned)(uintptr_t)shm;
    LAS float* wsf = (LAS float*)(shm + G::LDS_WS) + wid * 64;
    const char* ksrc[2]; const char* vsrc[2]; long kstep[2], vstep;
#pragma unroll
    for (int i = 0; i < 2; ++i) { const int p = wid + 8 * i; ksrc[i] = nullptr; kstep[i] = 0; vsrc[i] = nullptr;
        if (p < G::NKC) { const bf16_t* base = p < 8 ? sc.k0 + 8 * p : sc.k1 + 8 * (p - 8); const int pitch = p < 8 ? sc.kp0 : sc.kp1; ksrc[i] = (const char*)(base + (long)lane * pitch); kstep[i] = 128L * pitch; }
        if (p < 4 * G::NVB) { const int db = p >> 2, rg = p & 3; vsrc[i] = (const char*)(sc.v + (long)(16 * rg + (lane >> 2)) * sc.vp + 32 * db + 8 * (lane & 3)); } }
    vstep = 128L * sc.vp;
#define DMA_K(slot) do { _Pragma("unroll") for (int i_ = 0; i_ < 2; ++i_) if (wid + 8 * i_ < G::NKC) { glds16(ksrc[i_], (unsigned)__builtin_amdgcn_readfirstlane(lds0 + G::LDS_K + (wid + 8 * i_) * 1024 + (slot) * G::KSLOT)); ksrc[i_] += kstep[i_]; } } while (0)
#define DMA_V(slot) do { _Pragma("unroll") for (int i_ = 0; i_ < 2; ++i_) if (wid + 8 * i_ < 4 * G::NVB) { glds16(vsrc[i_], (unsigned)__builtin_amdgcn_readfirstlane(lds0 + G::LDS_V + (wid + 8 * i_) * 1024 + (slot) * G::VSLOT)); vsrc[i_] += vstep; } } while (0)
    DMA_K(0); DMA_V(0); DMA_K(1); DMA_V(1); DMA_K(2);
    bf16x8 qr[DQK / 16];
    { const long qrow = (long)(q0 + wid * 32 + r32) * sc.qp;
#pragma unroll
      for (int d0 = 0; d0 < DQK / 16; ++d0) qr[d0] = d0 < 4 ? *reinterpret_cast<const bf16x8*>(sc.q0 + qrow + d0 * 16 + hi * 8) : *reinterpret_cast<const bf16x8*>(sc.q1 + qrow + (d0 - 4) * 16 + hi * 8); }
    float m_run = 0.f, l_reg = 0.f; bool first = true;
    f32x16 negm = f32x16{};
    f32x16 o[G::NVB];
#pragma unroll
    for (int d = 0; d < G::NVB; ++d) o[d] = f32x16{};
    const int qrel = wid * 32 + r32;
    const lds_cptr shm3 = (lds_cptr)shm;
    const lds_cptr kp0 = shm3 + G::LDS_K + hi * 1024 + r32 * 16;
    const lds_cptr vp0 = shm3 + G::LDS_V + ((lane >> 4) & 1) * 32 + (lane & 3) * 8 + (4 * hi + ((lane & 15) >> 2)) * 64;
#define QKT(P0, P1, slot) do { const lds_cptr kp_ = kp0 + (slot) * G::KSLOT; _Pragma("unroll") for (int d0 = 0; d0 < DQK / 16; ++d0) { \
        const bf16x8 b0_ = *(const __attribute__((address_space(3))) bf16x8*)(kp_ + d0 * 2048), b1_ = *(const __attribute__((address_space(3))) bf16x8*)(kp_ + d0 * 2048 + 512); \
        if (d0 == 0) { P0 = __builtin_amdgcn_mfma_f32_32x32x16_bf16(b0_, qr[0], negm, 0, 0, 0); P1 = __builtin_amdgcn_mfma_f32_32x32x16_bf16(b1_, qr[0], negm, 0, 0, 0); } \
        else { P0 = __builtin_amdgcn_mfma_f32_32x32x16_bf16(b0_, qr[d0], P0, 0, 0, 0); P1 = __builtin_amdgcn_mfma_f32_32x32x16_bf16(b1_, qr[d0], P1, 0, 0, 0); } } } while (0)
#define ACTIVE(t_) (!((t_) - (NT - 4) >= 0 && 64 * ((t_) - (NT - 4)) > 32 * wid + 31))
    int s_cur = 0, s_nx1 = 1, s_nx2 = 2;
    const bool three = (wid + 8 < G::NKC ? 2 : 1) + (wid + 8 < 4 * G::NVB ? 2 : 1) == 3;
    f32x16 sc0 = f32x16{}, sc1 = f32x16{}, sn0 = f32x16{}, sn1 = f32x16{};
    asm volatile("s_waitcnt vmcnt(0) lgkmcnt(0)\n\ts_barrier" ::: "memory");
    QKT(sc0, sc1, 0);
    constexpr bool EARLYMAX = (DV == 64);
    float rm_carry = 0.f;
    if constexpr (EARLYMAX) {   if (NT == 4) { const int kb = 4 * hi;
#pragma unroll
            for (int r = 0; r < 16; ++r) { const int kv = kb + (r & 3) + 8 * (r >> 2); if (kv > qrel) sc0[r] = -INFINITY; if (kv + 32 > qrel) sc1[r] = -INFINITY; } }
        float rm = fmaxf(sc0[0], sc1[0]);
#pragma unroll
        for (int r = 1; r < 16; ++r) rm = fmaxf(rm, fmaxf(sc0[r], sc1[r]));
        rm_carry = swap32_max(rm, rm); }
    for (int t = 0; t < NT; ++t) {
        if (t + 3 < NT) { if (three) asm volatile("s_waitcnt vmcnt(3) lgkmcnt(0)\n\ts_barrier" ::: "memory"); else asm volatile("s_waitcnt vmcnt(2) lgkmcnt(0)\n\ts_barrier" ::: "memory"); }
        else WAIT_BAR0();
        if (t + 3 < NT) DMA_K(s_cur);
        if (t + 2 < NT) DMA_V(s_nx2);
        const int jb = t - (NT - 4);
        const bool act = ACTIVE(t), nxt = (t + 1 < NT) && ACTIVE(t + 1);
        if (!act) { const int tmp = s_cur; s_cur = s_nx1; s_nx1 = s_nx2; s_nx2 = tmp; continue; }
        float rm;
        if constexpr (EARLYMAX) rm = rm_carry;
        else {
            if (jb >= 0) { const int kb = 64 * jb + 4 * hi;
#pragma unroll
                for (int r = 0; r < 16; ++r) { const int kv = kb + (r & 3) + 8 * (r >> 2); if (kv > qrel) sc0[r] = -INFINITY; if (kv + 32 > qrel) sc1[r] = -INFINITY; } }
            rm = fmaxf(sc0[0], sc1[0]);
#pragma unroll
            for (int r = 1; r < 16; ++r) rm = fmaxf(rm, fmaxf(sc0[r], sc1[r]));
            rm = swap32_max(rm, rm); }
        if (first || __any(rm > THR)) {
            const float dl = first ? rm : fmaxf(rm, 0.f), f = first ? 1.f : __builtin_amdgcn_exp2f(-dl); m_run += dl; l_reg *= f; first = false;
#pragma unroll
            for (int r = 0; r < 16; ++r) { sc0[r] -= dl; sc1[r] -= dl; negm[r] = -m_run; }
            if (hi == 0) wsf[r32] = f;
            asm volatile("s_waitcnt lgkmcnt(0)" ::: "memory");
#pragma unroll
            for (int g = 0; g < 4; ++g) { const f32x4 fv = *(const LAS f32x4*)(wsf + 8 * g + 4 * hi);
#pragma unroll
                for (int d = 0; d < G::NVB; ++d) { o[d][4 * g] *= fv[0]; o[d][4 * g + 1] *= fv[1]; o[d][4 * g + 2] *= fv[2]; o[d][4 * g + 3] *= fv[3]; } }
        }
        u32x4 pw[4];
        if (nxt) {
            constexpr int ND0 = DQK / 16, NG = 2 * ND0;
            const lds_cptr kpn = kp0 + s_nx1 * G::KSLOT;
            float sacc = 0.f;
            bf16x8 kb0 = *(const __attribute__((address_space(3))) bf16x8*)(kpn), kb1 = *(const __attribute__((address_space(3))) bf16x8*)(kpn + 512), nb0 = kb0, nb1 = kb1;
#define ATT_GAP(g_) do { _Pragma("unroll") for (int e_ = ((g_) * 32) / NG; e_ < (((g_) + 1) * 32) / NG; ++e_) { \
                if (e_ < 16) { sc0[e_] = __builtin_amdgcn_exp2f(sc0[e_]); sacc += sc0[e_]; } else { sc1[e_ - 16] = __builtin_amdgcn_exp2f(sc1[e_ - 16]); sacc += sc1[e_ - 16]; } } \
                asm volatile("" : "+v"(sacc), "+v"(sc0), "+v"(sc1)); SBAR(); } while (0)
#pragma unroll
            for (int d0 = 0; d0 < ND0; ++d0) {
                if (d0 + 1 < ND0) { nb0 = *(const __attribute__((address_space(3))) bf16x8*)(kpn + (d0 + 1) * 2048); nb1 = *(const __attribute__((address_space(3))) bf16x8*)(kpn + (d0 + 1) * 2048 + 512); }
                sn0 = d0 == 0 ? __builtin_amdgcn_mfma_f32_32x32x16_bf16(kb0, qr[0], negm, 0, 0, 0) : __builtin_amdgcn_mfma_f32_32x32x16_bf16(kb0, qr[d0], sn0, 0, 0, 0);
                ATT_GAP(2 * d0);
                sn1 = d0 == 0 ? __builtin_amdgcn_mfma_f32_32x32x16_bf16(kb1, qr[0], negm, 0, 0, 0) : __builtin_amdgcn_mfma_f32_32x32x16_bf16(kb1, qr[d0], sn1, 0, 0, 0);
                ATT_GAP(2 * d0 + 1);
                kb0 = nb0; kb1 = nb1;
            }
#undef ATT_GAP
            l_reg += sacc;
#pragma unroll
            for (int k = 0; k < 4; ++k) { pw[0][k] = cvtpk_s(sc0[2 * k], sc0[2 * k + 1]); pw[1][k] = cvtpk_s(sc0[8 + 2 * k], sc0[8 + 2 * k + 1]); pw[2][k] = cvtpk_s(sc1[2 * k], sc1[2 * k + 1]); pw[3][k] = cvtpk_s(sc1[8 + 2 * k], sc1[8 + 2 * k + 1]); }
        } else {
            float sacc = 0.f;
#pragma unroll
            for (int r = 0; r < 16; ++r) { sc0[r] = __builtin_amdgcn_exp2f(sc0[r]); sc1[r] = __builtin_amdgcn_exp2f(sc1[r]); sacc += sc0[r] + sc1[r]; }
            l_reg += sacc;
#pragma unroll
            for (int k = 0; k < 4; ++k) { pw[0][k] = cvtpk_s(sc0[2 * k], sc0[2 * k + 1]); pw[1][k] = cvtpk_s(sc0[8 + 2 * k], sc0[8 + 2 * k + 1]); pw[2][k] = cvtpk_s(sc1[2 * k], sc1[2 * k + 1]); pw[3][k] = cvtpk_s(sc1[8 + 2 * k], sc1[8 + 2 * k + 1]); }
        }
        const lds_cptr vpp = vp0 + s_cur * G::VSLOT;
        if (EARLYMAX && nxt && jb + 1 >= 0) { const int kb = 64 * (jb + 1) + 4 * hi;
#pragma unroll
            for (int r = 0; r < 16; ++r) { const int kv = kb + (r & 3) + 8 * (r >> 2); if (kv > qrel) sn0[r] = -INFINITY; if (kv + 32 > qrel) sn1[r] = -INFINITY; } }
        float rma = -INFINITY, rmb = -INFINITY;
#pragma unroll
        for (int d = 0; d < G::NVB; ++d) {
#pragma unroll
            for (int ks = 0; ks < 4; ++ks) { const s16x4 lo = vtr(vpp + d * 4096 + ks * 1024), hh = vtr(vpp + d * 4096 + ks * 1024 + 512);
                const bf16x8 vf = {lo[0], lo[1], lo[2], lo[3], hh[0], hh[1], hh[2], hh[3]};
                o[d] = __builtin_amdgcn_mfma_f32_32x32x16_bf16(__builtin_bit_cast(bf16x8, pw[ks]), vf, o[d], 0, 0, 0);
                constexpr int PER = 16 / (4 * G::NVB) > 0 ? 16 / (4 * G::NVB) : 1;
                const int gi = d * 4 + ks;
                if (EARLYMAX && gi * PER < 16) {
#pragma unroll
                    for (int e_ = gi * PER; e_ < gi * PER + PER; ++e_) { rma = fmaxf(rma, sn0[e_]); rmb = fmaxf(rmb, sn1[e_]); }
                    } } }
        if constexpr (EARLYMAX) rm_carry = swap32_max(fmaxf(rma, rmb), fmaxf(rma, rmb));
        sc0 = sn0; sc1 = sn1;
        { const int tmp = s_cur; s_cur = s_nx1; s_nx1 = s_nx2; s_nx2 = tmp; }
    }
#undef QKT
#undef ACTIVE
#undef DMA_K
#undef DMA_V
    l_reg = swap32_sum(l_reg, l_reg);
    if (hi == 0) wsf[32 + r32] = l_reg;
    asm volatile("s_waitcnt lgkmcnt(0)" ::: "memory");
    float rli[16];
#pragma unroll
    for (int r = 0; r < 16; ++r) rli[r] = __builtin_amdgcn_rcpf(wsf[32 + crow(r, hi)]);
    const long orow0 = (long)(q0 + wid * 32);
    if (MODE == 1) {
#pragma unroll
        for (int r = 0; r < 16; ++r)
#pragma unroll
            for (int d = 0; d < G::NVB; ++d) td[(orow0 + crow(r, hi)) * 512 + d * 32 + r32] = o[d][r] * rli[r];
    } else {
        if (MODE == 2) {
            float ssr[16];
#pragma unroll
            for (int r = 0; r < 16; ++r) { float ss = 0.f;
#pragma unroll
                for (int d = 0; d < G::NVB; ++d) { const float v = td[(orow0 + crow(r, hi)) * 512 + d * 32 + r32] - lam * (o[d][r] * rli[r]); o[d][r] = v; ss += v * v; }
                ss += DPPF(ss, 0xB1); ss += DPPF(ss, 0x4E); ss += DPPF(ss, 0x141); ss += DPPF(ss, 0x140); ss = swap16_sum(ss, ss);
                ssr[r] = rsqrtf(ss * (1.f / DV) + 1e-5f) * (1.f - LAMBDA_INIT); }
#pragma unroll
            for (int d = 0; d < G::NVB; ++d) { const float gv = gsub[d * 32 + r32];
#pragma unroll
                for (int r = 0; r < 16; ++r) o[d][r] *= ssr[r] * gv; }
#pragma unroll
            for (int r = 0; r < 16; ++r) rli[r] = 1.f;
        }
        asm volatile("s_waitcnt lgkmcnt(0)\n\ts_barrier" ::: "memory");
        LAS bf16_t* stg = (LAS bf16_t*)(shm + G::LDS_OST) + wid * 32 * DV;
#pragma unroll
        for (int r = 0; r < 16; ++r) { const int orow = crow(r, hi);
#pragma unroll
            for (int d = 0; d < G::NVB; ++d) stg[orow * DV + d * 32 + r32] = (bf16_t)(cvtpk_s(o[d][r] * rli[r], 0.f) & 0xffffu); }
        asm volatile("s_waitcnt lgkmcnt(0)" ::: "memory");
        constexpr int CPR = DV / 8;
#pragma unroll
        for (int i = 0; i < 32 * CPR / 64; ++i) { const int idx = i * 64 + lane, row = idx / CPR, ch = idx % CPR; const u32x4 v = *(const LAS u32x4*)(stg + row * DV + ch * 8);
            *(u32x4*)(obase + (orow0 + row) * 1024 + ch * 8) = v; }
    }
    __builtin_amdgcn_s_setprio(0);
    asm volatile("s_waitcnt vmcnt(0) lgkmcnt(0)\n\ts_barrier" ::: "memory");
}
#undef SBAR
#undef WAIT_BAR0
}

__device__ __forceinline__ void attn_phase_all(Frame& F) {
    LAS char* shm = (LAS char*)(F.lds + RING_OFF);
    const int vcu = (F.bid & 7) * (F.G >> 3) + (F.bid >> 3);
    const bf16_t* QM = (const bf16_t*)(F.a->ws + WS_QM); const bf16_t* KVM = (const bf16_t*)(F.a->ws + WS_KVM); const bf16_t* PR = (const bf16_t*)(F.a->ws + WS_PROJ); bf16_t* ATT = (bf16_t*)(F.a->ws + WS_ATT);
    { const int p = vcu >> 1, b = p >> 3, h = p & 7, half = vcu & 1; const long r0 = (long)b * S;
      att::Src sc{QM + r0 * 768 + h * 64, QM + r0 * 768 + 512 + h * 32, 768, KVM + r0 * 1024 + h * 128, PR + r0 * PJ + PC_KR, 1024, PJ, KVM + r0 * 1024 + h * 128 + 64, 1024};
      for (int i = 0; i < 4; ++i) { const int qb = half == 0 ? (i == 0 ? 7 : i == 1 ? 5 : i == 2 ? 2 : 0) : (i == 0 ? 6 : i == 1 ? 4 : i == 2 ? 3 : 1);
#ifdef LEAK_UNIT
          if (i == LEAK_UNIT && threadIdx.x == 0) F.MISC[16] = (unsigned)__builtin_amdgcn_s_memrealtime();
#endif
          att::attn_unit<96, 64, 0>(shm, sc, qb, ATT + r0 * 1024 + h * 64, nullptr, 0.f, nullptr);
#ifdef LEAK_UNIT
          if (i == LEAK_UNIT && threadIdx.x == 0) F.MISC[17] = (unsigned)__builtin_amdgcn_s_memrealtime();
#endif
      } }
    { const int p = vcu >> 2, b = p >> 2, h = p & 3, s4 = vcu & 3; const long r0 = (long)b * S;
      float lam; { const float* l1 = F.a->in[IN_LQ1]; const float* k1 = F.a->in[IN_LK1]; const float* l2 = F.a->in[IN_LQ2]; const float* k2 = F.a->in[IN_LK2]; float s1 = 0.f, s2 = 0.f;
          for (int i = 0; i < 64; ++i) { s1 += l1[i] * k1[i]; s2 += l2[i] * k2[i]; } lam = __expf(s1) - __expf(s2) + LAMBDA_INIT; }
      float* td = (float*)(F.a->ws + WS_Y) + r0 * 512 + h * 128;
      for (int i = 0; i < 2; ++i) { const int qb = i == 0 ? 7 - s4 : s4;
          att::Src s0{PR + r0 * PJ + PC_QD + (2 * h) * 64, nullptr, PJ, PR + r0 * PJ + PC_KD + (2 * h) * 64, nullptr, PJ, PJ, PR + r0 * PJ + PC_VD + h * 128, PJ};
          att::Src s1{PR + r0 * PJ + PC_QD + (2 * h + 1) * 64, nullptr, PJ, PR + r0 * PJ + PC_KD + (2 * h + 1) * 64, nullptr, PJ, PJ, PR + r0 * PJ + PC_VD + h * 128, PJ};
          att::attn_unit<64, 128, 1>(shm, s0, qb, nullptr, td, 0.f, nullptr);
          att::attn_unit<64, 128, 2>(shm, s1, qb, ATT + r0 * 1024 + 512 + h * 128, td, lam, F.a->in[IN_GSUBLN]); } }
}
__device__ __forceinline__ void offsets_from_counts(Frame& F) {
    PHASE_IDS();
    int* cnt = (int*)(F.a->ws + WS_CNT);
    LAS int* part = (LAS int*)(F.lds + RING_OFF);
    LAS int* tile_e = (LAS int*)(F.lds + X_TILEE); LAS int* m2 = (LAS int*)(F.lds + X_MISC2);
    { const int e = tid & 31, p = tid >> 5; int tot = 0, pre = 0;
      for (int w = p * 16; w < p * 16 + 16; ++w) { const int c = __hip_atomic_load(cnt + w * NE + e, RLX_AGENT); tot += c; if (w < F.bid) pre += c; }
      part[(p * 32 + e) * 2] = tot; part[(p * 32 + e) * 2 + 1] = pre; }
    __syncthreads();
    if (tid < NE) { int tot = 0, pre = 0; for (int p = 0; p < 16; ++p) { tot += part[(p * 32 + tid) * 2]; pre += part[(p * 32 + tid) * 2 + 1]; } m2[96 + tid] = tot; m2[64 + tid] = pre; }
    __syncthreads();
    if (tid < NE) { int st = 0; for (int e = 0; e < tid; ++e) st += (m2[96 + e] + 255) & ~255; m2[32 + tid] = st; const int pad = (m2[96 + tid] + 255) & ~255;
        for (int r = st; r < st + pad; r += 256) tile_e[r >> 8] = tid; if (tid == NE - 1) m2[0] = (st + pad) >> 8; }
    __syncthreads();
}
__device__ __forceinline__ void p6_scatter(Frame& F) {
    offsets_from_counts(F);
    PHASE_IDS();
    LAS int* m2 = (LAS int*)(F.lds + X_MISC2);
    int* rowtok = (int*)(F.a->ws + WS_ROWTOK); float* roww = (float*)(F.a->ws + WS_ROWW); int* pos = (int*)(F.a->ws + WS_POS);
    { const int a = F.bid * 512 + tid; const int e = ((const int*)(F.a->ws + WS_SE))[a]; const float gt = ((const float*)(F.a->ws + WS_SG))[a]; const int rk = ((const int*)(F.a->ws + WS_SRANK))[a];
      const int dst = m2[32 + e] + m2[64 + e] + rk, tok = F.bid * 128 + (tid >> 2);
      rowtok[dst] = tok; roww[dst] = gt; pos[tok * 4 + (tid & 3)] = dst; }
    if (F.bid < NE && tid < 256) { const int e = F.bid, tot = m2[96 + e], st = m2[32 + e], pad = (tot + 255) & ~255; const int r = st + tot + tid; if (r < st + pad) { rowtok[r] = 0; roww[r] = 0.f; } }
}

#ifdef DEV_NAIVE_ATTN
template <int MODE>
__global__ void __launch_bounds__(256) k_attn_ref(const bf16_t* QM, const bf16_t* KVM, const bf16_t* PROJ, bf16_t* ATT, float* TD, const float* lq1, const float* lk1, const float* lq2, const float* lk2, const float* gsub) {
    constexpr int DQK = MODE == 0 ? 96 : 64, DV = MODE == 0 ? 64 : 128, NH = MODE == 0 ? 8 : 4;
    __shared__ float Ks[32][DQK]; __shared__ float Vs[32][DV];
    const int bh = blockIdx.y, b = bh / NH, h = bh % NH, q = blockIdx.x * 256 + threadIdx.x, tid = threadIdx.x, t = b * S + q;
    float lam = 0.f;
    if (MODE == 1) { float s1 = 0.f, s2 = 0.f; for (int i = 0; i < 64; ++i) { s1 += lq1[i] * lk1[i]; s2 += lq2[i] * lk2[i]; } lam = expf(s1) - expf(s2) + LAMBDA_INIT; }
    float res[DV];
    for (int j = 0; j < (MODE == 0 ? 1 : 2); ++j) {
        float qv[DQK]; float o[DV];
#pragma unroll
        for (int d = 0; d < DQK; ++d) qv[d] = MODE == 0 ? bf2f(QM[(size_t)t * 768 + (d < 64 ? h * 64 + d : 512 + h * 32 + d - 64)]) : bf2f(PROJ[(size_t)t * PJ + PC_QD + (2 * h + j) * 64 + d]);
#pragma unroll
        for (int d = 0; d < DV; ++d) o[d] = 0.f;
        float m = -1e30f, l = 0.f;
        const int kend = blockIdx.x * 256 + 256;
        for (int k0 = 0; k0 < kend; k0 += 32) {
            __syncthreads();
            for (int i = tid; i < 32 * DQK; i += 256) { const int kk = i / DQK, d = i % DQK; const size_t tk = (size_t)b * S + k0 + kk;
                Ks[kk][d] = MODE == 0 ? (d < 64 ? bf2f(KVM[tk * 1024 + h * 128 + d]) : bf2f(PROJ[tk * PJ + PC_KR + d - 64])) : bf2f(PROJ[tk * PJ + PC_KD + (2 * h + j) * 64 + d]); }
            for (int i = tid; i < 32 * DV; i += 256) { const int kk = i / DV, d = i % DV; const size_t tk = (size_t)b * S + k0 + kk;
                Vs[kk][d] = MODE == 0 ? bf2f(KVM[tk * 1024 + h * 128 + 64 + d]) : bf2f(PROJ[tk * PJ + PC_VD + h * 128 + d]); }
            __syncthreads();
            for (int kk = 0; kk < 32; ++kk) {
                if (k0 + kk > q) break;
                float s = 0.f;
#pragma unroll
                for (int d = 0; d < DQK; ++d) s += qv[d] * Ks[kk][d];
                const float mn = fmaxf(m, s), al = exp2f(m - mn), p = exp2f(s - mn);
                l = l * al + p; m = mn;
#pragma unroll
                for (int d = 0; d < DV; ++d) o[d] = o[d] * al + p * Vs[kk][d];
            }
        }
        const float inv = 1.f / l;
        if (MODE == 0) {
#pragma unroll
            for (int d = 0; d < DV; ++d) ATT[(size_t)t * D + h * 64 + d] = (bf16_t)(cvt_pk_bf16(o[d] * inv, 0.f) & 0xffffu);
        } else if (j == 0) {
#pragma unroll
            for (int d = 0; d < DV; ++d) TD[((size_t)t * 4 + h) * 128 + d] = o[d] * inv;
        } else { float ss = 0.f;
#pragma unroll
            for (int d = 0; d < DV; ++d) { res[d] = TD[((size_t)t * 4 + h) * 128 + d] - lam * (o[d] * inv); ss += res[d] * res[d]; }
            const float r = rsqrtf(ss * (1.f / 128.f) + 1e-5f) * (1.f - LAMBDA_INIT);
#pragma unroll
            for (int d = 0; d < DV; ++d) ATT[(size_t)t * D + 512 + h * 128 + d] = (bf16_t)(cvt_pk_bf16(res[d] * r * gsub[d], 0.f) & 0xffffu);
        }
    }
}
#endif

constexpr int N_PHASES = 11;
__global__ void __launch_bounds__(NWAVES * 64, 2) mk_fwd(Args args) {
    extern __shared__ __attribute__((aligned(16))) unsigned char lds[];
    Frame F;
    F.lds = (LAS unsigned char*)lds; F.MISC = (volatile LAS unsigned*)(F.lds + MISC_OFF);
    F.G = gridDim.x; F.bid = blockIdx.x;
    F.a = &args; F.ctl = (unsigned*)(args.ws + WS_CTL);
    for (int u = threadIdx.x; u < (X_TILEE - LDSCTL_OFF) / 4; u += NWAVES * 64) ((LAS unsigned*)(F.lds + LDSCTL_OFF))[u] = 0u;
    __syncthreads();
    const int lo = args.ph_lo, hi = args.ph_hi;
#ifdef LEAK_LO
    if (LEAK_LO == 0 && threadIdx.x == 0) F.MISC[16] = (unsigned)__builtin_amdgcn_s_memrealtime();
#endif
    XcdBarrier bar; bar.bar = F.ctl + CW_BAR; bar.x = 0; bar.st = nullptr;
    if (hi - lo > 1) bar = xcd_barrier_post(F.ctl + CW_BAR + args.li * XCD_BAR_WORDS, F.MISC + 8);
#ifndef PH_MASK
#define PH_MASK 0x7ff
#endif
#define IN(k) (((PH_MASK >> (k)) & 1) && lo <= (k) && (k) < hi)
#ifdef LEAK_LO
#define SEAM(k) do { if (IN(k) && IN((k) + 1)) xcd_barrier(bar); if (((k) + 1 == LEAK_LO || (k) + 1 == LEAK_HI) && threadIdx.x == 0) F.MISC[(k) + 1 == LEAK_LO ? 16 : 17] = (unsigned)__builtin_amdgcn_s_memrealtime(); } while (0)
#else
#define SEAM(k) do { if (IN(k) && IN((k) + 1)) xcd_barrier(bar); } while (0)
#endif
    LAS unsigned char* ring = F.lds + RING_OFF;
    if (IN(0)) { p0_prologue(F); } SEAM(0);
    if (IN(1)) { p0b_norm(F); } SEAM(1);
    if (IN(2)) {
        pg8::Gemm g{(const bf16_t*)(F.a->ws + WS_H), (const bf16_t*)(F.a->ws + WS_WIN), nullptr, 0, D, D, D, 0}; pg8::StaticOrder So; So.init(T, PJ, F.G, F.bid);
        epi::EpiProj E{(bf16_t*)(F.a->ws + WS_PROJ), (const f32x4*)(F.a->ws + WS_TABM), (const f32x4*)(F.a->ws + WS_TABD), (float*)(F.a->ws + WS_SSQ), (float*)(F.a->ws + WS_SSQ) + T};
        pg8::gemm_phase<epi::EpiProj, pg8::StaticOrder, false>(ring, g, So, E);
    } SEAM(2);
    if (IN(3)) {
#ifndef NO_Q
        { pg8::Gemm g{(const bf16_t*)(F.a->ws + WS_PROJ) + PC_CQ, (const bf16_t*)(F.a->ws + WS_WQB), nullptr, 0, PJ, 256, 256, 0}; pg8::StaticOrder So; So.init(T, 768, F.G, F.bid);
          epi::EpiQ E{(bf16_t*)(F.a->ws + WS_QM), (const f32x4*)(F.a->ws + WS_TABM), (const float*)(F.a->ws + WS_SSQ)};
          pg8::gemm_phase<epi::EpiQ, pg8::StaticOrder, false>(ring, g, So, E); }
#endif
#ifndef NO_KV
        { pg8::Gemm g{(const bf16_t*)(F.a->ws + WS_PROJ) + PC_CKV, (const bf16_t*)(F.a->ws + WS_WKVB), nullptr, 0, PJ, 128, 128, 0}; pg8::StaticOrder So; So.init(T, 1024, F.G, F.bid);
          epi::EpiKV E{(bf16_t*)(F.a->ws + WS_KVM), (const float*)(F.a->ws + WS_SSQ) + T};
          pg8::gemm_phase<epi::EpiKV, pg8::StaticOrder, false>(ring, g, So, E); }
#endif
    } SEAM(3);
    if (IN(4)) {
#ifndef DEV_NAIVE_ATTN
        attn_phase_all(F);
#endif
    } SEAM(4);
    if (IN(5)) {
        pg8::Gemm g{(const bf16_t*)(F.a->ws + WS_ATT), (const bf16_t*)(F.a->ws + WS_WO), nullptr, 0, D, D, D, 0}; pg8::StaticOrder So; So.init(T, D, F.G, F.bid);
        epi::EpiY E{(bf16_t*)(F.a->ws + WS_Y)};
        pg8::gemm_phase<epi::EpiY, pg8::StaticOrder, false>(ring, g, So, E);
    } SEAM(5);
    if (IN(6)) { p5_rows(F); } SEAM(6);
    if (IN(7)) { p6_scatter(F); } SEAM(7);
    if (IN(8)) {
        if (!IN(7)) offsets_from_counts(F);
        pg8::GroupedOrder So{(const LAS int*)(F.lds + X_TILEE), __builtin_amdgcn_readfirstlane(((LAS int*)(F.lds + X_MISC2))[0]), 8, F.G, F.bid};
        pg8::Gemm g{(const bf16_t*)(F.a->ws + WS_H), (const bf16_t*)(F.a->ws + WS_WGU), (const int*)(F.a->ws + WS_ROWTOK), (size_t)2048 * 512, 512, 512, 512, 0};
        epi::EpiAct E{(unsigned char*)(F.a->ws + WS_ACT), F.a->in[IN_BGU]};
        pg8::gemm_phase<epi::EpiAct, pg8::GroupedOrder, true, true>(ring, g, So, E, F.lds + X_IDX);
    } SEAM(8);
    if (IN(9)) {
        if (!IN(7)) offsets_from_counts(F);
        pg8::GroupedOrder So{(const LAS int*)(F.lds + X_TILEE), __builtin_amdgcn_readfirstlane(((LAS int*)(F.lds + X_MISC2))[0]), 4, F.G, F.bid};
        pg8::Gemm g{(const bf16_t*)(F.a->ws + WS_ACT), (const bf16_t*)(F.a->ws + WS_WD), nullptr, (size_t)1024 * 512, 512, 512, 512, 0};
        epi::EpiDown E{(unsigned char*)(F.a->ws + WS_YR), F.a->in[IN_BDN], (const float*)(F.a->ws + WS_ROWW)};
        pg8::gemm_phase<epi::EpiDown, pg8::GroupedOrder, false, true>(ring, g, So, E);
    } SEAM(9);
    if (IN(10)) { p9_final(F); }
#ifdef LEAK_LO
    if (blockIdx.x == 0 && threadIdx.x == 0) { if (LEAK_HI == 11) F.MISC[17] = (unsigned)__builtin_amdgcn_s_memrealtime(); asm volatile("s_waitcnt vmcnt(0) lgkmcnt(0)" ::: "memory"); args.out[0] += (float)(F.MISC[17] - F.MISC[16]) * LEAK_SCALE; }
#endif
#undef IN
#undef SEAM
}

extern "C" void kernel_launch(void* const* d_in, const int* in_sizes, int n_in, void* d_out, int out_size, void* d_ws, size_t ws_size, hipStream_t stream) {
    static int grid = 0;
    if (grid == 0) {
        if (n_in != 26 || in_sizes[0] != T * D || out_size != T * D || ws_size < WS_END) { fprintf(stderr, "kernel_launch: unexpected shapes (n_in %d, ws %zu); nothing launched\n", n_in, ws_size); grid = -1; return; }
        int dev = 0, cus = 0;
        if (hipGetDevice(&dev) != hipSuccess || hipDeviceGetAttribute(&cus, hipDeviceAttributeMultiprocessorCount, dev) != hipSuccess) { grid = -1; return; }
        if (hipFuncSetAttribute((const void*)mk_fwd, hipFuncAttributeMaxDynamicSharedMemorySize, LDS_BYTES) != hipSuccess) { fprintf(stderr, "kernel_launch: hipFuncSetAttribute failed\n"); grid = -1; return; }
        grid = cus;
        if (grid != 256) fprintf(stderr, "kernel_launch: %d CUs; this kernel is built for 256\n", grid);
    }
    if (grid < 0) return;
    (void)hipMemsetAsync((char*)d_ws + WS_CTL, 0, CTL_ZERO_BYTES, stream);
    Args a{};
    for (int i = 0; i < 26; ++i) a.in[i] = (const float*)d_in[i];
    a.out = (float*)d_out; a.ws = (unsigned char*)d_ws;
#ifndef MK_CUTS
#define MK_CUTS {0, N_PHASES}
#endif
    const int cuts[] = MK_CUTS; const int ncut = (int)(sizeof(cuts) / sizeof(int)) - 1;
    for (int li = 0; li < ncut; ++li) {
        a.ph_lo = cuts[li]; a.ph_hi = cuts[li + 1]; a.li = li;
        hipLaunchKernelGGL(mk_fwd, dim3(grid), dim3(NWAVES * 64), LDS_BYTES, stream, a);
#ifdef DEV_NAIVE_ATTN
        if (cuts[li + 1] == 5) {
            unsigned char* ws = (unsigned char*)d_ws;
            k_attn_ref<0><<<dim3(S / 256, NB * 8), 256, 0, stream>>>((const bf16_t*)(ws + WS_QM), (const bf16_t*)(ws + WS_KVM), (const bf16_t*)(ws + WS_PROJ), (bf16_t*)(ws + WS_ATT), nullptr, nullptr, nullptr, nullptr, nullptr, nullptr);
            k_attn_ref<1><<<dim3(S / 256, NB * 4), 256, 0, stream>>>((const bf16_t*)(ws + WS_QM), (const bf16_t*)(ws + WS_KVM), (const bf16_t*)(ws + WS_PROJ), (bf16_t*)(ws + WS_ATT), (float*)(ws + WS_Y),
                (const float*)d_in[IN_LQ1], (const float*)d_in[IN_LK1], (const float*)d_in[IN_LQ2], (const float*)d_in[IN_LK2], (const float*)d_in[IN_GSUBLN]);
        }
#endif
    }
}
```

```cpp
#include <hip/hip_runtime.h>
#include <cstdio>
#include <cstdint>

#define GAS __attribute__((address_space(1)))
#define LAS __attribute__((address_space(3)))
typedef unsigned short bf16_t;
typedef short bf16x8 __attribute__((ext_vector_type(8)));
typedef float f32x4 __attribute__((ext_vector_type(4)));
typedef float f32x2 __attribute__((ext_vector_type(2)));
typedef float f32x16 __attribute__((ext_vector_type(16)));
typedef unsigned u32x4 __attribute__((ext_vector_type(4)));
typedef unsigned u32x2 __attribute__((ext_vector_type(2)));
typedef int i32x4 __attribute__((ext_vector_type(4)));
typedef GAS unsigned gu32;
#define RLX_AGENT __ATOMIC_RELAXED, __HIP_MEMORY_SCOPE_AGENT
#define LDS_WAIT() asm volatile("s_waitcnt lgkmcnt(0)" ::: "memory")
#define VM_WAIT() asm volatile("s_waitcnt vmcnt(0)" ::: "memory")

constexpr int D = 1024, NB = 16, S = 2048, T = NB * S;
constexpr int INC = 1952;
constexpr int PJ = 2048;
constexpr int PC_CQ = 0, PC_CKV = 256, PC_KR = 384, PC_QD = 512, PC_KD = 1024, PC_VD = 1536;
constexpr int NE = 32, TOPK = 4, NA = T * TOPK, NROWS = (NA / 256 + NE) * 256, NTILE_MAX = NROWS / 256;
constexpr float LAMBDA_INIT = 0.2f, LOG2E = 1.4426950408889634f;
constexpr float C2M = 0.10206207261596577f * LOG2E;
constexpr float C2D = 0.125f * LOG2E;
#ifndef FP8_SCALE_OPND
#define FP8_SCALE_OPND 0x7f7f7f7f
#endif
constexpr float YR_SCALE = 16.f, YR_INV = 1.f / 16.f;
constexpr float H_SCALE = 16.f;
constexpr float ATT_SCALE = 16.f;
constexpr float W8_SCALE = 64.f, W8_INV = 1.f / 64.f;

__device__ __forceinline__ unsigned cvt_pk_bf16(float lo, float hi) { unsigned r; asm volatile("v_cvt_pk_bf16_f32 %0, %1, %2" : "=v"(r) : "v"(lo), "v"(hi)); return r; }
__device__ __forceinline__ float sat8(float v) { return __builtin_amdgcn_fmed3f(v, -448.f, 448.f); }
__device__ __forceinline__ unsigned pack4_fp8s(float a, float b, float c, float d);
__device__ __forceinline__ unsigned pack4_fp8(float a, float b, float c, float d) { int w = 0; w = __builtin_amdgcn_cvt_pk_fp8_f32(a, b, w, false); w = __builtin_amdgcn_cvt_pk_fp8_f32(c, d, w, true); return (unsigned)w; }
__device__ __forceinline__ unsigned pack4_fp8s(float a, float b, float c, float d) { return pack4_fp8(sat8(a), sat8(b), sat8(c), sat8(d)); }
__device__ __forceinline__ float bf2f(unsigned short h) { return __uint_as_float((unsigned)h << 16); }
__device__ __forceinline__ float bflo(unsigned w) { return __uint_as_float(w << 16); }
__device__ __forceinline__ float bfhi(unsigned w) { return __uint_as_float(w & 0xffff0000u); }
#define DPPF(v, ctrl) __builtin_bit_cast(float, __builtin_amdgcn_update_dpp(0, __builtin_bit_cast(int, (float)(v)), (ctrl), 0xf, 0xf, true))
__device__ __forceinline__ void swap16(float a, float b, float& x, float& y) { auto r = __builtin_amdgcn_permlane16_swap(__builtin_bit_cast(unsigned, a), __builtin_bit_cast(unsigned, b), false, false); unsigned r0 = r[0], r1 = r[1]; asm volatile("" : "+v"(r0), "+v"(r1)); x = __builtin_bit_cast(float, r0); y = __builtin_bit_cast(float, r1); }
__device__ __forceinline__ void swap32(float a, float b, float& x, float& y) { auto r = __builtin_amdgcn_permlane32_swap(__builtin_bit_cast(unsigned, a), __builtin_bit_cast(unsigned, b), false, false); unsigned r0 = r[0], r1 = r[1]; asm volatile("" : "+v"(r0), "+v"(r1)); x = __builtin_bit_cast(float, r0); y = __builtin_bit_cast(float, r1); }
__device__ __forceinline__ float swap16_sum(float a, float b) { float x, y; swap16(a, b, x, y); return x + y; }
__device__ __forceinline__ float swap32_sum(float a, float b) { float x, y; swap32(a, b, x, y); return x + y; }
__device__ __forceinline__ float swap32_max(float a, float b) { float x, y; swap32(a, b, x, y); return fmaxf(x, y); }
__device__ __forceinline__ float wave_sum(float v) {
    v += DPPF(v, 0xB1); v += DPPF(v, 0x4E); v += DPPF(v, 0x141); v += DPPF(v, 0x140);
    v = swap16_sum(v, v); return swap32_sum(v, v);
}
__device__ __forceinline__ float wave_max(float v) {
    v = fmaxf(v, DPPF(v, 0xB1)); v = fmaxf(v, DPPF(v, 0x4E)); v = fmaxf(v, DPPF(v, 0x141)); v = fmaxf(v, DPPF(v, 0x140));
    { float x, y; swap16(v, v, x, y); v = fmaxf(x, y); }
    return swap32_max(v, v);
}
__device__ __forceinline__ float lane_xor8(float v) { return DPPF(DPPF(v, 0x141), 0x140); }
__device__ __forceinline__ float lane_xor4(float v) { return DPPF(DPPF(v, 0x1B), 0x141); }

__device__ __forceinline__ int mk_lane() { int r; asm volatile("v_mbcnt_lo_u32_b32 %0, -1, 0\n\tv_mbcnt_hi_u32_b32 %0, -1, %0" : "=v"(r)); return r; }
namespace pg8 {
constexpr int BM = 256, BK = 64, HALF = 128, HTB = HALF * BK * 2, STAGE_BYTES = 8 * HTB, NXCD = 8, WGM = 8;
__host__ __device__ __forceinline__ int lds_byte(int r, int c) { const int st = (r >> 4) * 2 + (c >> 5), rr = r & 15, cc = c & 31, ob = rr * 64 + cc * 2; return st * 1024 + (ob ^ (((ob >> 9) & 1) << 5)); }
__host__ __device__ __forceinline__ void stage_rc(int b, int& R, int& C) { const int st = b / 1024, sb = b % 1024, swz = sb ^ (((sb >> 9) & 1) << 5); R = (st >> 1) * 16 + swz / 64; C = (st & 1) * 32 + (swz % 64) / 2; }
__host__ __device__ __forceinline__ int perm32(int rho) { const int n = rho >> 4, i = rho & 15; return 8 * (i >> 2) + 4 * n + (i & 3); }

__host__ __device__ __forceinline__ int perm16(int R) { return 64 * (R >> 5) + 16 * ((R & 15) >> 2) + 4 * ((R >> 4) & 1) + (R & 3); }
template <class E, class = void> struct has_perm16 { static constexpr bool value = false; };
template <class E> struct has_perm16<E, decltype((void)E::PERM16)> { static constexpr bool value = E::PERM16; };
template <class E, class = void> struct mx_scale_w { static constexpr int value = FP8_SCALE_OPND; };
template <class E> struct mx_scale_w<E, decltype((void)E::MXW)> { static constexpr int value = E::MXW; };
template <class E, class = void> struct mx_scale_a { static constexpr int value = FP8_SCALE_OPND; };
template <class E> struct mx_scale_a<E, decltype((void)E::MXA)> { static constexpr int value = E::MXA; };
template <class E, class = void> struct has_pub { static constexpr bool value = false; };
template <class E> struct has_pub<E, decltype((void)E::PUB)> { static constexpr bool value = E::PUB; };
template <class E, class = void> struct has_dep { static constexpr bool value = false; };
template <class E> struct has_dep<E, decltype((void)E::DEP)> { static constexpr bool value = E::DEP; };
#define PG8_DEP_SPIN(p_, need_) do { unsigned sp_ = 0u; while (__hip_atomic_load((p_), __ATOMIC_RELAXED, __HIP_MEMORY_SCOPE_AGENT) < (need_)) { if (++sp_ > (1u << 22)) break; } } while (0)
template <class E, class = void> struct has_pref { static constexpr bool value = false; };
template <class E> struct has_pref<E, decltype((void)E::PREF)> { static constexpr bool value = E::PREF; };
struct Unit { int pm, pn, e; };
struct Gemm { const bf16_t* A; const bf16_t* Bt; const int* rowidx; size_t b_estride; int lda, ldb, K, pad; };

struct StaticOrder {
    int nM, nN, nwg, G, c;
    __host__ __device__ void init(int M, int N, int G_, int c_) { nM = M / BM; nN = N / BM; nwg = nM * nN; G = G_; c = c_; }
    __host__ __device__ bool next(int i, Unit& u) const {
        const long L = (long)i * G + c; if (L >= nwg) return false;
        int wgid = (int)L; { const int q = nwg / NXCD, r = nwg % NXCD, xcd = wgid % NXCD, off = wgid / NXCD; wgid = (xcd < r ? xcd * (q + 1) : r * (q + 1) + (xcd - r) * q) + off; }
        const int nig = WGM * nN, gid = wgid / nig, fm = gid * WGM, gsz = (nM - fm) < WGM ? (nM - fm) : WGM;
        u.pm = fm + ((wgid % nig) % gsz); u.pn = (wgid % nig) / gsz; u.e = 0; return true;
    }
};
struct GroupedOrder {
    const LAS int* tile_e; int ntiles, ncol, G, c, mir;
    __device__ bool next(int i, Unit& u) const {
        const int L = i * G + c, xcd = (L & 7) ^ mir, j = L >> 3, block = j >> 5, within = j & 31, rpc = 32 / ncol;
        const int r = within / ncol, pn = within % ncol, rt = (block * 8 + xcd) * rpc + r;
        if (rt >= ntiles) return false;
        u.pm = rt; u.pn = pn; u.e = __builtin_amdgcn_readfirstlane(tile_e[rt]); return true;
    }
    __device__ int count() const { int n = 0; Unit u; while (next(n, u)) ++n; return n; }
    __device__ void stagger(unsigned ticks) const { GroupedOrder s0 = *this; s0.c = 0; if (count() < s0.count()) { const unsigned t0 = (unsigned)__builtin_amdgcn_s_memrealtime(); while ((unsigned)__builtin_amdgcn_s_memrealtime() - t0 < ticks) __builtin_amdgcn_s_sleep(16); } }
};

template <class Epi, class Sched, bool GATHER = false, bool FP8 = false>
__device__ __forceinline__ void gemm_phase(LAS unsigned char* lds, const Gemm g, const Sched& S, const Epi& E, int wv, LAS unsigned char* idxl = nullptr, LAS unsigned char* epl = nullptr) {
    int tid_ = wv * 64 + mk_lane(); asm volatile("" : "+v"(tid_));
    const int tid = tid_, wid = __builtin_amdgcn_readfirstlane(tid >> 6), lane = tid & 63, wr = wid >> 2, wc = wid & 3, fr = lane & 15, fq = lane >> 4;
    const int K = g.K, nt = K / BK;
    int Rr[2], Cc[2];
    unsigned voffA[2][2], voffB[2];
#pragma unroll
    for (int i = 0; i < 2; ++i) { stage_rc(tid * 16 + i * 8192, Rr[i], Cc[i]); const int Rb = has_perm16<Epi>::value ? perm16(Rr[i]) : Epi::PERM ? ((Rr[i] & ~31) + perm32(Rr[i] & 31)) : Rr[i];
        voffA[0][i] = (unsigned)(Rr[i] * g.lda + Cc[i]) * 2u; voffA[1][i] = (unsigned)((Rr[i] + HALF) * g.lda + Cc[i]) * 2u; voffB[i] = (unsigned)(Rb * g.ldb + Cc[i]) * 2u; }
    const unsigned kstep = BK * 2, hstepB = (unsigned)((has_perm16<Epi>::value ? 8 : HALF) * g.ldb * 2), tstepA = (unsigned)(BM * g.lda * 2), tstepB = (unsigned)(BM * g.ldb * 2);
    const __amdgpu_buffer_rsrc_t rA = __builtin_amdgcn_make_buffer_rsrc((void*)g.A, 0, 0x7ffffff0, 0x00020000), rB = __builtin_amdgcn_make_buffer_rsrc((void*)g.Bt, 0, 0x7ffffff0, 0x00020000);
    const unsigned ldsw = (unsigned)wid * 1024u;
    const int aoff = lds_byte(wr * 64 + fr, fq * 8), boff = lds_byte(wc * 32 + fr, fq * 8);
#define PG8_SA(b, h) (((b) * 2 + (h)) * HTB)
#define PG8_SB(b, h) ((4 + (b) * 2 + (h)) * HTB)
#define PG8_STAGE(bufoff, rs, soff, voff) do { _Pragma("unroll") for (int _i = 0; _i < 2; ++_i) \
        __builtin_amdgcn_raw_ptr_buffer_load_lds(rs, (LAS void*)(lds + (bufoff) + ldsw + _i * 8192), 16, (int)(voff)[_i], (int)(soff), 0, 0); } while (0)
#define PG8_LDA(dst, b, h) do { _Pragma("unroll") for (int m = 0; m < 4; ++m) _Pragma("unroll") for (int k = 0; k < 2; ++k) dst[m][k] = *(const LAS bf16x8*)(lds + PG8_SA(b, h) + aoff + m * 2048 + k * 1024); } while (0)
#define PG8_LDB(dst, b, h) do { _Pragma("unroll") for (int n = 0; n < 2; ++n) _Pragma("unroll") for (int k = 0; k < 2; ++k) dst[n][k] = *(const LAS bf16x8*)(lds + PG8_SB(b, h) + boff + n * 2048 + k * 1024); } while (0)
#define PG8_MMA(ai, bj, At, Bt) do { __builtin_amdgcn_s_setprio(1); _Pragma("unroll") for (int m = 0; m < 4; ++m) _Pragma("unroll") for (int n = 0; n < 2; ++n) { \
        if constexpr (FP8) acc[ai][bj][m][n] = __builtin_amdgcn_mfma_scale_f32_16x16x128_f8f6f4(PG8_CAT(Bt[n][0], Bt[n][1]), PG8_CAT(At[m][0], At[m][1]), acc[ai][bj][m][n], 0, 0, 0, mx_scale_w<Epi>::value, 0, mx_scale_a<Epi>::value); \
        else { _Pragma("unroll") for (int k = 0; k < 2; ++k) acc[ai][bj][m][n] = __builtin_amdgcn_mfma_f32_16x16x32_bf16(Bt[n][k], At[m][k], acc[ai][bj][m][n], 0, 0, 0); } } __builtin_amdgcn_s_setprio(0); } while (0)
#define PG8_CAT(x0, x1) __builtin_shufflevector(__builtin_bit_cast(i32x4, x0), __builtin_bit_cast(i32x4, x1), 0, 1, 2, 3, 4, 5, 6, 7)
#define PG8_WAIT_V(n) asm volatile("s_waitcnt vmcnt(" #n ")" ::: "memory")
#define PG8_WAIT_L(n) asm volatile("s_waitcnt lgkmcnt(" #n ")" ::: "memory")
#define PG8_BAR __builtin_amdgcn_s_barrier()
#define PG8_SCHED __builtin_amdgcn_sched_barrier(0)
    Unit cur, nxt; int ui = 0;
    if (!S.next(0, cur)) return;
    f32x4 acc[2][2][4][2];
#pragma unroll
    for (int a = 0; a < 2; ++a)
#pragma unroll
        for (int b = 0; b < 2; ++b)
#pragma unroll
            for (int m = 0; m < 4; ++m)
#pragma unroll
                for (int n = 0; n < 2; ++n) acc[a][b][m][n] = (f32x4){0.f, 0.f, 0.f, 0.f};
    bf16x8 At[4][2], B0[2][2], B1[2][2];
    unsigned gA[2][2];
    unsigned cA, cB = (unsigned)cur.e * (unsigned)(g.b_estride * 2) + (unsigned)cur.pn * tstepB;
    if constexpr (GATHER) { cA = 0u;
#pragma unroll
        for (int h = 0; h < 2; ++h)
#pragma unroll
            for (int i = 0; i < 2; ++i) gA[h][i] = (unsigned)g.rowidx[cur.pm * BM + h * HALF + Rr[i]] * (unsigned)(g.lda * 2) + (unsigned)Cc[i] * 2u;
    } else { cA = (unsigned)cur.pm * tstepA;
#pragma unroll
        for (int h = 0; h < 2; ++h)
#pragma unroll
            for (int i = 0; i < 2; ++i) gA[h][i] = voffA[h][i]; }
    int pend = -1, pend2 = -1; unsigned pv = 0u, pv2 = 0u;
    PG8_STAGE(PG8_SB(0, 0), rB, cB, voffB); PG8_STAGE(PG8_SB(0, 1), rB, cB + hstepB, voffB);
    if constexpr (has_dep<Epi>::value) { if (wid == 0 && mk_lane() == 0) PG8_DEP_SPIN(E.dep + cur.pm, E.need); PG8_BAR; }
    PG8_STAGE(PG8_SA(0, 0), rA, cA, gA[0]); PG8_STAGE(PG8_SA(0, 1), rA, cA, gA[1]);
    if (wr == 1) PG8_BAR;
    PG8_WAIT_V(2); PG8_BAR;
    PG8_STAGE(PG8_SB(1, 0), rB, cB + kstep, voffB); PG8_STAGE(PG8_SA(1, 0), rA, cA + kstep, gA[0]); PG8_STAGE(PG8_SB(1, 1), rB, cB + hstepB + kstep, voffB);
    PG8_WAIT_V(6); PG8_BAR;
    for (;;) {
        const bool has_next = S.next(ui + 1, nxt);
        unsigned nA; const unsigned nB = has_next ? (unsigned)nxt.e * (unsigned)(g.b_estride * 2) + (unsigned)nxt.pn * tstepB : cB;
        if constexpr (GATHER) nA = cA; else nA = has_next ? (unsigned)nxt.pm * tstepA : cA;
#pragma nounroll
        for (int t = 0; t < nt; t += 2) {
            const bool last = (t == nt - 2);
            const unsigned a1 = cA + (unsigned)(t + 1) * kstep;
            const unsigned a2 = last ? nA : cA + (unsigned)(t + 2) * kstep, b2 = last ? nB : cB + (unsigned)(t + 2) * kstep;
            const unsigned a3 = a2 + kstep, b3 = b2 + kstep;
            if constexpr (has_pub<Epi>::value) {
                if (nt >= 4) { if (t == 2 && pend >= 0) { if (wid == 0 && mk_lane() == 0) (void)__hip_atomic_fetch_add(E.done + pend, 1u, __ATOMIC_RELAXED, __HIP_MEMORY_SCOPE_AGENT); pend = -1; } }
                else { if (pend2 >= 0 && wid == 0 && mk_lane() == 0) (void)__hip_atomic_fetch_add(E.done + pend2, 1u, __ATOMIC_RELAXED, __HIP_MEMORY_SCOPE_AGENT); pend2 = pend; pend = -1; } }
            if constexpr (has_dep<Epi>::value) { if (has_next && wid == 0) {
                if (t == nt - 4) pv = __hip_atomic_load(E.dep + nxt.pm, __ATOMIC_RELAXED, __HIP_MEMORY_SCOPE_AGENT);
                if (nt == 2) { pv = pv2; Unit n2; pv2 = S.next(ui + 2, n2) ? __hip_atomic_load(E.dep + n2.pm, __ATOMIC_RELAXED, __HIP_MEMORY_SCOPE_AGENT) : 0u; }
                if (last && mk_lane() == 0 && pv < E.need) PG8_DEP_SPIN(E.dep + nxt.pm, E.need); } }
            if constexpr (has_pref<Epi>::value) { if (t == 0) E.prefetch(cur, epl + (ui & 1) * 2048, wid, lane); }
            if constexpr (GATHER) { if (t == 0 && has_next && wid < 4)
                __builtin_amdgcn_global_load_lds((const unsigned*)(g.rowidx + nxt.pm * BM + wid * 64 + lane), (LAS unsigned*)(idxl + ((ui + 1) & 1) * 1024 + wid * 256), 4, 0, 0); }
            PG8_LDB(B0, 0, 0); PG8_LDB(B1, 0, 1); PG8_SCHED; PG8_LDA(At, 0, 0); PG8_STAGE(PG8_SA(1, 1), rA, a1, gA[1]);
            if constexpr (GATHER) { if (last && has_next) { int t3 = wv * 64 + mk_lane(); asm volatile("" : "+v"(t3));
#pragma unroll
                for (int i = 0; i < 2; ++i) { int R3, C3; stage_rc(t3 * 16 + i * 8192, R3, C3);
#pragma unroll
                    for (int h = 0; h < 2; ++h) gA[h][i] = *(const LAS unsigned*)(idxl + ((ui + 1) & 1) * 1024 + (h * HALF + R3) * 4) * (unsigned)(g.lda * 2) + (unsigned)C3 * 2u; } } }
            PG8_WAIT_V(8); PG8_WAIT_L(0); PG8_BAR; PG8_MMA(0, 0, At, B0); PG8_MMA(0, 1, At, B1); PG8_BAR; PG8_SCHED;
            PG8_LDA(At, 0, 1); PG8_STAGE(PG8_SB(0, 0), rB, b2, voffB); PG8_STAGE(PG8_SB(0, 1), rB, b2 + hstepB, voffB); PG8_STAGE(PG8_SA(0, 0), rA, a2, gA[0]);
            PG8_WAIT_V(8); PG8_WAIT_L(0); PG8_BAR; PG8_MMA(1, 0, At, B0); PG8_MMA(1, 1, At, B1); PG8_BAR; PG8_SCHED;
            PG8_LDB(B0, 1, 0); PG8_LDB(B1, 1, 1); PG8_SCHED; PG8_LDA(At, 1, 0); PG8_STAGE(PG8_SA(0, 1), rA, a2, gA[1]);
            PG8_WAIT_V(8); PG8_WAIT_L(0); PG8_BAR; PG8_MMA(0, 0, At, B0); PG8_MMA(0, 1, At, B1); PG8_BAR; PG8_SCHED;
            PG8_LDA(At, 1, 1); PG8_STAGE(PG8_SB(1, 0), rB, b3, voffB); PG8_STAGE(PG8_SB(1, 1), rB, b3 + hstepB, voffB); PG8_STAGE(PG8_SA(1, 0), rA, a3, gA[0]);
            PG8_WAIT_V(8); PG8_WAIT_L(0); PG8_BAR; PG8_MMA(1, 0, At, B0); PG8_MMA(1, 1, At, B1); PG8_BAR; PG8_SCHED;
        }
#ifndef PG8_NOALIGN
        if (wr == 0) PG8_BAR;
#endif
        { int t2 = mk_lane(); asm volatile("" : "+v"(t2));
          if constexpr (has_pref<Epi>::value) E(acc, cur, wr, wc, t2 & 15, (t2 >> 4) & 3, epl + (ui & 1) * 2048); else E(acc, cur, wr, wc, t2 & 15, (t2 >> 4) & 3); }
        if constexpr (has_pub<Epi>::value) pend = cur.pm;
        if (!has_next) break;
#pragma unroll
        for (int a = 0; a < 2; ++a)
#pragma unroll
            for (int b = 0; b < 2; ++b)
#pragma unroll
                for (int m = 0; m < 4; ++m)
#pragma unroll
                    for (int n = 0; n < 2; ++n) acc[a][b][m][n] = (f32x4){0.f, 0.f, 0.f, 0.f};
        cur = nxt; cA = nA; cB = nB; ++ui;
#ifndef PG8_NOALIGN
        if (wr == 1) PG8_BAR;
#endif
    }
    PG8_WAIT_V(0);
#ifdef PG8_NOALIGN
    if (wr == 0) PG8_BAR;
#endif
    PG8_BAR;
    if constexpr (has_pub<Epi>::value) { if (wid == 0 && mk_lane() == 0) { if (pend2 >= 0) (void)__hip_atomic_fetch_add(E.done + pend2, 1u, __ATOMIC_RELAXED, __HIP_MEMORY_SCOPE_AGENT);
        if (pend >= 0) (void)__hip_atomic_fetch_add(E.done + pend, 1u, __ATOMIC_RELAXED, __HIP_MEMORY_SCOPE_AGENT); } }
#undef PG8_SA
#undef PG8_SB
#undef PG8_STAGE
#undef PG8_LDA
#undef PG8_LDB
#undef PG8_MMA
#undef PG8_CAT
#undef PG8_WAIT_V
#undef PG8_WAIT_L
#undef PG8_BAR
#undef PG8_SCHED
}
}
namespace epi {
using pg8::Unit; using pg8::HALF; using pg8::BM;
__device__ __forceinline__ u32x4 pack8(f32x4 a, f32x4 b) { u32x4 w; w.x = cvt_pk_bf16(a[0], a[1]); w.y = cvt_pk_bf16(a[2], a[3]); w.z = cvt_pk_bf16(b[0], b[1]); w.w = cvt_pk_bf16(b[2], b[3]); return w; }
__device__ __forceinline__ u32x2 pack4(f32x4 a) { u32x2 w; w.x = cvt_pk_bf16(a[0], a[1]); w.y = cvt_pk_bf16(a[2], a[3]); return w; }
__device__ __forceinline__ void rope4(f32x4& a, f32x4& b, const f32x4 t0, const f32x4 t1) {
    const f32x4 c = {t0[0], t0[2], t1[0], t1[2]}, s = {t0[1], t0[3], t1[1], t1[3]};
    const f32x4 na = a * c - b * s, nb = b * c + a * s; a = na; b = nb;
}
__device__ __forceinline__ void ssq_add(float* ssq, int row, float ss, int fq) { ss += __shfl_xor(ss, 16); ss += __shfl_xor(ss, 32); if (fq == 0) atomicAdd(ssq + row, ss); }
__device__ __forceinline__ float sq8(f32x4 a, f32x4 b) { return (a[0] * a[0] + a[1] * a[1]) + (a[2] * a[2] + a[3] * a[3]) + (b[0] * b[0] + b[1] * b[1]) + (b[2] * b[2] + b[3] * b[3]); }

struct EpiProj {
    static constexpr bool PERM = true, PUB = true;
    static constexpr int MXW = 0x7a7a7a7a, MXA = 0x7a7a7a7a;
    bf16_t* P; const f32x4* tabm; const f32x4* tabd; float* ssq_q; float* ssq_kv; unsigned* done;
    __device__ __forceinline__ void operator()(const f32x4 (&acc)[2][2][4][2], const Unit& u, int wr, int wc, int fr, int fq) const {
        const int row0 = u.pm * BM + wr * 64 + fr, pn = u.pn;
        const __amdgpu_buffer_rsrc_t rP = __builtin_amdgcn_make_buffer_rsrc((void*)P, 0, T * PJ * 2, 0x00020000);
        if (pn == 0) {
#pragma unroll
            for (int ai = 0; ai < 2; ++ai)
#pragma unroll
                for (int m = 0; m < 4; ++m) { const int row = row0 + ai * HALF + m * 16; float ss = 0.f;
#pragma unroll
                    for (int bj = 0; bj < 2; ++bj) { const f32x4 v0 = acc[ai][bj][m][0], v1 = acc[ai][bj][m][1]; ss += sq8(v0, v1); __builtin_amdgcn_raw_buffer_store_b128(pack8(v0, v1), rP, (row * PJ + bj * HALF + wc * 32 + 8 * fq) * 2, 0, 16); }
                    ssq_add(ssq_q, row, ss, fq); }
        } else if (pn == 1) {
            f32x4 t0[2][4], t1[2][4];
            if (wc == 0) {
#pragma unroll
                for (int ai = 0; ai < 2; ++ai)
#pragma unroll
                    for (int m = 0; m < 4; ++m) { const int row = row0 + ai * HALF + m * 16; t0[ai][m] = tabm[(size_t)row * 8 + 2 * fq]; t1[ai][m] = tabm[(size_t)row * 8 + 2 * fq + 1]; }
            }
#pragma unroll
            for (int ai = 0; ai < 2; ++ai)
#pragma unroll
                for (int m = 0; m < 4; ++m) { const int row = row0 + ai * HALF + m * 16;
                    { const f32x4 v0 = acc[ai][0][m][0], v1 = acc[ai][0][m][1]; __builtin_amdgcn_raw_buffer_store_b128(pack8(v0, v1), rP, (row * PJ + 256 + wc * 32 + 8 * fq) * 2, 0, 16); ssq_add(ssq_kv, row, sq8(v0, v1), fq); }
                    if (wc == 0) { f32x4 a = acc[ai][1][m][0], b = acc[ai][1][m][1]; rope4(a, b, t0[ai][m], t1[ai][m]);
                        __builtin_amdgcn_raw_buffer_store_b128(pack8(a, b), rP, (row * PJ + PC_KR + 8 * fq) * 2, 0, 16); } }
        } else if (pn < 6) {
            const int g = 4 * (wc & 1) + fq; const float sc = pn < 4 ? C2D : 1.f;
#pragma unroll
            for (int ai = 0; ai < 2; ++ai) {
                f32x4 t0[4], t1[4];
#pragma unroll
                for (int m = 0; m < 4; ++m) { const int row = row0 + ai * HALF + m * 16; t0[m] = tabd[(size_t)row * 16 + 2 * g]; t1[m] = tabd[(size_t)row * 16 + 2 * g + 1]; }
#pragma unroll
                for (int m = 0; m < 4; ++m) { const int row = row0 + ai * HALF + m * 16;
#pragma unroll
                    for (int bj = 0; bj < 2; ++bj) { f32x4 a = acc[ai][bj][m][0] * sc, b = acc[ai][bj][m][1] * sc; rope4(a, b, t0[m], t1[m]);
                        __builtin_amdgcn_raw_buffer_store_b128(pack8(a, b), rP, (row * PJ + pn * 256 + bj * HALF + (wc >> 1) * 64 + 8 * g) * 2, 0, 16); } }
                asm volatile("" ::: "memory"); }
        } else {
#pragma unroll
            for (int ai = 0; ai < 2; ++ai)
#pragma unroll
                for (int m = 0; m < 4; ++m) { const int row = row0 + ai * HALF + m * 16;
#pragma unroll
                    for (int bj = 0; bj < 2; ++bj) __builtin_amdgcn_raw_buffer_store_b128(pack8(acc[ai][bj][m][0], acc[ai][bj][m][1]), rP, (row * PJ + pn * 256 + bj * HALF + wc * 32 + 8 * fq) * 2, 0, 16); }
        }
    }
};
struct EpiQ {
    static constexpr bool PERM = true;
    static constexpr bool PREF = true, DEP = true, PUB = true;
    bf16_t* Q; const f32x4* tabm; const float* ssq_q; unsigned* dep; unsigned need; unsigned* done;
    __device__ __forceinline__ void prefetch(const Unit& u, LAS unsigned char* dst, int wid, int lane) const {
        if (wid == 0) __builtin_amdgcn_global_load_lds((const unsigned*)(ssq_q + u.pm * BM + lane * 4), (LAS unsigned*)dst, 16, 0, 0);
    }
    __device__ __forceinline__ void operator()(const f32x4 (&acc)[2][2][4][2], const Unit& u, int wr, int wc, int fr, int fq, LAS unsigned char* epl) const {
        const int row0 = u.pm * BM + wr * 64 + fr;
        const __amdgpu_buffer_rsrc_t rQ = __builtin_amdgcn_make_buffer_rsrc((void*)Q, 0, T * 768 * 2, 0x00020000);
        if (u.pn < 2) {
            float rs[2][4];
#pragma unroll
            for (int ai = 0; ai < 2; ++ai)
#pragma unroll
                for (int m = 0; m < 4; ++m) rs[ai][m] = *(const LAS float*)(epl + (wr * 64 + fr + ai * HALF + m * 16) * 4);
#pragma unroll
            for (int ai = 0; ai < 2; ++ai)
#pragma unroll
                for (int m = 0; m < 4; ++m) { const int row = row0 + ai * HALF + m * 16; const float r = rsqrtf(rs[ai][m] * (1.f / 256.f) + 1e-6f) * C2M; const int ro = (row * 768 + u.pn * BM + wc * 32 + 8 * fq) * 2;
#pragma unroll
                    for (int bj = 0; bj < 2; ++bj) __builtin_amdgcn_raw_buffer_store_b128(pack8(acc[ai][bj][m][0] * r, acc[ai][bj][m][1] * r), rQ, ro + bj * HALF * 2, 0, 16); }
        } else {
#pragma unroll
            for (int ai = 0; ai < 2; ++ai) {
                f32x4 t0[4], t1[4]; float rs[4];
#pragma unroll
                for (int m = 0; m < 4; ++m) { const int row = row0 + ai * HALF + m * 16; rs[m] = *(const LAS float*)(epl + (wr * 64 + fr + ai * HALF + m * 16) * 4); t0[m] = tabm[(size_t)row * 8 + 2 * fq]; t1[m] = tabm[(size_t)row * 8 + 2 * fq + 1]; }
#pragma unroll
                for (int m = 0; m < 4; ++m) { const int row = row0 + ai * HALF + m * 16; const float r = rsqrtf(rs[m] * (1.f / 256.f) + 1e-6f) * C2M; const int ro = (row * 768 + 512 + wc * 32 + 8 * fq) * 2;
#pragma unroll
                    for (int bj = 0; bj < 2; ++bj) { f32x4 a = acc[ai][bj][m][0] * r, b = acc[ai][bj][m][1] * r; rope4(a, b, t0[m], t1[m]); __builtin_amdgcn_raw_buffer_store_b128(pack8(a, b), rQ, ro + bj * 256, 0, 16); } }
                asm volatile("" ::: "memory"); }
        }
    }
};
struct EpiKV {
    static constexpr bool PERM = true;
    static constexpr bool PREF = true, DEP = true, PUB = true;
    bf16_t* KV; const float* ssq_kv; unsigned* dep; unsigned need; unsigned* done;
    __device__ __forceinline__ void prefetch(const Unit& u, LAS unsigned char* dst, int wid, int lane) const {
        if (wid == 0) __builtin_amdgcn_global_load_lds((const unsigned*)(ssq_kv + u.pm * BM + lane * 4), (LAS unsigned*)dst, 16, 0, 0);
    }
    __device__ __forceinline__ void operator()(const f32x4 (&acc)[2][2][4][2], const Unit& u, int wr, int wc, int fr, int fq, LAS unsigned char* epl) const {
        const int row0 = u.pm * BM + wr * 64 + fr;
        const __amdgpu_buffer_rsrc_t rK = __builtin_amdgcn_make_buffer_rsrc((void*)KV, 0, T * 1024 * 2, 0x00020000);
        float rs[2][4];
#pragma unroll
        for (int ai = 0; ai < 2; ++ai)
#pragma unroll
            for (int m = 0; m < 4; ++m) rs[ai][m] = *(const LAS float*)(epl + (wr * 64 + fr + ai * HALF + m * 16) * 4);
#pragma unroll
        for (int ai = 0; ai < 2; ++ai)
#pragma unroll
            for (int m = 0; m < 4; ++m) { const int row = row0 + ai * HALF + m * 16; const float r = rsqrtf(rs[ai][m] * (1.f / 128.f) + 1e-6f); const int ro = (row * 1024 + u.pn * BM + wc * 32 + 8 * fq) * 2;
#pragma unroll
                for (int bj = 0; bj < 2; ++bj) __builtin_amdgcn_raw_buffer_store_b128(pack8(acc[ai][bj][m][0] * r, acc[ai][bj][m][1] * r), rK, ro + bj * HALF * 2, 0, 16); }
    }
};
struct EpiY {
    static constexpr bool PERM = true, PUB = true, DEP = true;
    bf16_t* Y; unsigned* done; unsigned* dep; unsigned need;
    __device__ __forceinline__ void operator()(const f32x4 (&acc)[2][2][4][2], const Unit& u, int wr, int wc, int fr, int fq) const {
        const __amdgpu_buffer_rsrc_t rY = __builtin_amdgcn_make_buffer_rsrc((void*)Y, 0, T * 1024 * 2, 0x00020000);
        const int row0 = u.pm * BM + wr * 64 + fr, col = u.pn * BM + wc * 32 + 8 * fq;
#pragma unroll
        for (int ai = 0; ai < 2; ++ai)
#pragma unroll
            for (int m = 0; m < 4; ++m) { const int row = row0 + ai * HALF + m * 16;
#pragma unroll
                for (int bj = 0; bj < 2; ++bj) __builtin_amdgcn_raw_buffer_store_b128(pack8(acc[ai][bj][m][0], acc[ai][bj][m][1]), rY, (row * 1024 + col + bj * HALF) * 2, 0, 16); }
    }
};
struct EpiAct {
    static constexpr bool PERM = true;
    static constexpr bool PREF = true, PUB = true;
    unsigned char* ACT; const float* bgu; unsigned* done;
    __device__ __forceinline__ void prefetch(const Unit& u, LAS unsigned char* dst, int wid, int lane) const {
        if (wid == 0) __builtin_amdgcn_global_load_lds((const unsigned*)(bgu + u.e * 2048 + (lane >> 5) * 1024 + u.pn * 128 + (lane & 31) * 4), (LAS unsigned*)dst, 16, 0, 0);
    }
    __device__ __forceinline__ void operator()(const f32x4 (&acc)[2][2][4][2], const Unit& u, int wr, int wc, int fr, int fq, LAS unsigned char* epl) const {
        const __amdgpu_buffer_rsrc_t rA = __builtin_amdgcn_make_buffer_rsrc((void*)ACT, 0, 0x7ffffff0, 0x00020000);
        const int row0 = u.pm * BM + wr * 64 + fr, j0 = u.pn * 128 + wc * 32 + 8 * fq;
        f32x4 bg[2], bu[2];
#pragma unroll
        for (int n = 0; n < 2; ++n) { bg[n] = *(const LAS f32x4*)(epl + (wc * 32 + 8 * fq + 4 * n) * 4); bu[n] = *(const LAS f32x4*)(epl + 512 + (wc * 32 + 8 * fq + 4 * n) * 4) + 1.f; }
#pragma unroll
        for (int ai = 0; ai < 2; ++ai)
#pragma unroll
            for (int m = 0; m < 4; ++m) { const int row = row0 + ai * HALF + m * 16; u32x2 o;
#pragma unroll
                for (int n = 0; n < 2; ++n) { f32x2 rs[2];
#pragma unroll
                    for (int h = 0; h < 2; ++h) {
                        const f32x2 ag = {acc[ai][0][m][n][2 * h], acc[ai][0][m][n][2 * h + 1]}, au = {acc[ai][1][m][n][2 * h], acc[ai][1][m][n][2 * h + 1]};
                        const f32x2 bgp = {bg[n][2 * h], bg[n][2 * h + 1]}, bup = {bu[n][2 * h], bu[n][2 * h + 1]};
                        const f32x2 gv = ag * W8_INV + bgp, uv1 = au * W8_INV + bup;
                        const f32x2 gg = {fminf(gv[0], 7.f), fminf(gv[1], 7.f)}, uu1 = {__builtin_amdgcn_fmed3f(uv1[0], -6.f, 8.f), __builtin_amdgcn_fmed3f(uv1[1], -6.f, 8.f)};
                        const f32x2 tt = gg * (-1.702f * LOG2E);
                        const f32x2 den = (f32x2){__builtin_amdgcn_exp2f(tt[0]), __builtin_amdgcn_exp2f(tt[1])} + 1.f;
                        const f32x2 rc = {__builtin_amdgcn_rcpf(den[0]), __builtin_amdgcn_rcpf(den[1])};
                        rs[h] = (gg * rc) * uu1; }
                    o[n] = pack4_fp8(rs[0][0], rs[0][1], rs[1][0], rs[1][1]); }
                __builtin_amdgcn_raw_buffer_store_b64(o, rA, row * 1024 + j0, 0, 16); }
    }
};
struct EpiDown {
    static constexpr bool PERM = true, PERM16 = true;
    static constexpr bool PREF = true, DEP = true;
    unsigned char* YR; const float* bd; const float* roww; unsigned need; unsigned* dep;
    __device__ __forceinline__ void prefetch(const Unit& u, LAS unsigned char* dst, int wid, int lane) const {
        if (wid == 0) __builtin_amdgcn_global_load_lds((const unsigned*)(bd + u.e * 1024 + u.pn * BM + lane * 4), (LAS unsigned*)dst, 16, 0, 0);
        if (wid == 1) __builtin_amdgcn_global_load_lds((const unsigned*)(roww + u.pm * BM + lane * 4), (LAS unsigned*)(dst + 1024), 16, 0, 0);
    }
    __device__ __forceinline__ void operator()(const f32x4 (&acc)[2][2][4][2], const Unit& u, int wr, int wc, int fr, int fq, LAS unsigned char* epl) const {
        const __amdgpu_buffer_rsrc_t rY = __builtin_amdgcn_make_buffer_rsrc((void*)YR, 0, 0x7ffffff0, 0x00020000);
        const int row0 = u.pm * BM + wr * 64 + fr, col = u.pn * BM + wc * 64 + 16 * fq;
        float ww[2][4]; f32x4 bv[2][2];
#pragma unroll
        for (int ai = 0; ai < 2; ++ai)
#pragma unroll
            for (int m = 0; m < 4; ++m) ww[ai][m] = *(const LAS float*)(epl + 1024 + (wr * 64 + fr + ai * HALF + m * 16) * 4);
#pragma unroll
        for (int bj = 0; bj < 2; ++bj)
#pragma unroll
            for (int n = 0; n < 2; ++n) bv[bj][n] = *(const LAS f32x4*)(epl + (wc * 64 + 16 * fq + 8 * bj + 4 * n) * 4);
#pragma unroll
        for (int ai = 0; ai < 2; ++ai)
#pragma unroll
            for (int m = 0; m < 4; ++m) { const int row = row0 + ai * HALF + m * 16; const float w1 = YR_SCALE * ww[ai][m], w8 = w1 * W8_INV; u32x4 o;
#pragma unroll
                for (int bj = 0; bj < 2; ++bj)
#pragma unroll
                    for (int n = 0; n < 2; ++n) { const f32x4 v = acc[ai][bj][m][n] * w8 + bv[bj][n] * w1; o[2 * bj + n] = pack4_fp8s(v[0], v[1], v[2], v[3]); }
                __builtin_amdgcn_raw_buffer_store_b128(o, rY, row * 1024 + col, 0, 0); }
    }
};
}
constexpr size_t MiB = 1u << 20;
constexpr size_t WS_CTL = 0, CTL_ZERO_BYTES = 64 * 1024;
constexpr size_t WS_MOD = 1 * MiB;
constexpr size_t WS_SSQ = 1 * MiB + 512 * 1024;
constexpr size_t WS_TABM = 2 * MiB, WS_TABD = 6 * MiB;
constexpr size_t WS_SE = 14 * MiB, WS_SG = 14 * MiB + 512 * 1024, WS_SRANK = 18 * MiB + 512 * 1024;
constexpr size_t WS_POS = 15 * MiB;
constexpr size_t WS_ROWTOK = 16 * MiB, WS_ROWW = 17 * MiB;
constexpr size_t WS_CNT = 18 * MiB;
constexpr size_t WS_TD0 = 19 * MiB;
constexpr size_t WS_WIN = 20 * MiB, WS_WQB = 24 * MiB, WS_WKVB = 25 * MiB, WS_WO = 26 * MiB;
constexpr size_t WS_WGU = 28 * MiB, WS_WD = 156 * MiB;
constexpr size_t WS_H = 220 * MiB;
constexpr size_t WS_PROJ = 284 * MiB;
constexpr size_t WS_QM = 412 * MiB, WS_KVM = 460 * MiB, WS_ATT = 524 * MiB, WS_Y = 588 * MiB;
constexpr size_t WS_X1 = 524 * MiB;
constexpr size_t WS_ACT = 284 * MiB;
constexpr size_t WS_TD = 652 * MiB;
constexpr size_t WS_YR = 588 * MiB;
constexpr size_t WS_END = 860 * MiB;
static_assert(WS_ACT + (size_t)NROWS * 1024 * 2 <= WS_YR && WS_YR + (size_t)NROWS * 1024 * 2 <= WS_END, "ws map");
constexpr int CW_DONE = 1024;
constexpr int CW_DONE4 = 1600;
constexpr int CW_P5FLAG = 1728;
constexpr int CW_DONEA = 3200;
constexpr int CW_DONE1 = 3400;
constexpr int CW_DONE2Q = 3528, CW_DONE2K = 3656;
constexpr int CW_MODFLAG = 2048;
constexpr int CW_DEAL = 8192;
constexpr int CW_BAR = 4096;

constexpr int RING_OFF = 0, RING_BYTES = 131072;
constexpr int LDSCTL_OFF = RING_BYTES, MISC_OFF = LDSCTL_OFF + 320;
constexpr int XTRA_OFF = MISC_OFF + 128;
constexpr int X_TILEE = XTRA_OFF;
constexpr int X_SE = X_TILEE + 2304, X_SG = X_SE + 2048, X_SRANK = X_SG + 2048, X_WCNT = X_SRANK + 2048, X_MISC2 = X_WCNT + 1024;
constexpr int X_IDX = X_MISC2 + 1024;
constexpr int X_CONST = 147456;
constexpr int X_EPL = 159744;
constexpr int LDS_BYTES = 163840;
static_assert(X_IDX + 2048 <= X_CONST && X_CONST + 12288 <= X_EPL && X_EPL + 4096 <= LDS_BYTES, "LDS map");
constexpr int NWAVES = 8;

#define XB_TMO      128
#define XB_XCNT(j)  (256  + 64 * (j))
#define XB_XSUB(j)  (1280 + 64 * (j))
#define XB_XGEN(j)  (2304 + 64 * (j))
#define XB_TOP      3328
#define XB_TOPGEN   3392
#define XCD_BAR_WORDS 3456
#define XB_SPIN_CAP (1u << 18)
__device__ __forceinline__ unsigned xb_ld(unsigned* p)              { return __hip_atomic_load(p, __ATOMIC_RELAXED, __HIP_MEMORY_SCOPE_AGENT); }
__device__ __forceinline__ unsigned xb_add(unsigned* p, unsigned v) { return __hip_atomic_fetch_add(p, v, __ATOMIC_RELAXED, __HIP_MEMORY_SCOPE_AGENT); }
__device__ __forceinline__ unsigned xb_xcc_id() { return (unsigned)__builtin_amdgcn_s_getreg((3 << 11) | 20) & 0xFu; }
#define XB_SPIN(cond, bar) do { unsigned _sp = 0; while (cond) { __builtin_amdgcn_s_sleep(1); \
    if ((++_sp & 255u) == 0u) { if (xb_ld(&(bar)[XB_TMO])) break; if (_sp > XB_SPIN_CAP) { atomicAdd(&(bar)[XB_TMO], 1u); break; } } } } while (0)
struct XcdBarrier { unsigned* bar; unsigned x; volatile LAS unsigned* st; int wv; };
__device__ __forceinline__ XcdBarrier xcd_barrier_post(unsigned* bar, volatile LAS unsigned* st, int wv) {
    XcdBarrier b; b.bar = bar; b.x = xb_xcc_id(); b.st = st; b.wv = wv;
    if (wv == 0 && mk_lane() == 0) (void)xb_add(&bar[XB_XCNT(b.x)], 1u);
    return b;
}
__device__ __forceinline__ void xcd_barrier_complete(unsigned* bar, unsigned x, unsigned& nloc, unsigned& nx) {
    const unsigned G = gridDim.x * gridDim.y * gridDim.z;
    unsigned sum, cnt, mine, sp = 0u;
    for (;;) {
        sum = 0u; cnt = 0u; mine = 0u;
#pragma unroll
        for (unsigned j = 0; j < 16; ++j) { const unsigned c = xb_ld(&bar[XB_XCNT(j)]); sum += c; cnt += (c > 0u) ? 1u : 0u; mine = (j == x) ? c : mine; }
        if (sum == G) break;
        __builtin_amdgcn_s_sleep(1);
        if ((++sp & 255u) == 0u) { if (xb_ld(&bar[XB_TMO])) break; if (sp > XB_SPIN_CAP) { atomicAdd(&bar[XB_TMO], 1u); break; } }
    }
    nloc = mine > 0u ? mine : 1u; nx = cnt > 0u ? cnt : 1u;
}
__device__ __forceinline__ void xcd_barrier(const XcdBarrier& b) {
    asm volatile("s_waitcnt vmcnt(0)" ::: "memory");
    __syncthreads();
    if (b.wv == 0 && mk_lane() == 0) {
        unsigned* bar = b.bar;
        __builtin_amdgcn_s_waitcnt(0);
        unsigned nloc = b.st[0], nx = b.st[1];
        if (nloc == 0u) { xcd_barrier_complete(bar, b.x, nloc, nx); b.st[0] = nloc; b.st[1] = nx; }
        const unsigned old = xb_add(&bar[XB_XSUB(b.x)], 1u);
        const unsigned gen = old / nloc;
        if (old + 1u == (gen + 1u) * nloc) {
            __builtin_amdgcn_fence(__ATOMIC_RELEASE, "agent");
            asm volatile("s_waitcnt vmcnt(0)" ::: "memory");
            const unsigned og = xb_add(&bar[XB_TOP], 1u);
            const unsigned tg = og / nx;
            if (og + 1u == (tg + 1u) * nx) xb_add(&bar[XB_TOPGEN], 1u);
            else XB_SPIN(xb_ld(&bar[XB_TOPGEN]) == tg, bar);
            __builtin_amdgcn_fence(__ATOMIC_ACQUIRE, "agent");
            xb_add(&bar[XB_XGEN(b.x)], 1u);
            asm volatile("s_waitcnt vmcnt(0)" ::: "memory");
        } else {
            XB_SPIN(xb_ld(&bar[XB_XGEN(b.x)]) == gen, bar);
            __builtin_amdgcn_fence(__ATOMIC_ACQUIRE, "agent");
            asm volatile("s_waitcnt vmcnt(0)" ::: "memory");
        }
    }
    __syncthreads();
}

struct Args { const float* in[26]; float* out; unsigned char* ws; int ph_lo, ph_hi, li, pad; };
struct Frame {
    LAS unsigned char* lds; volatile LAS unsigned* MISC; unsigned* ctl;
    int G, bid, wv;
    const Args* a;
};
#define PHASE_IDS() int tid_ = F.wv * 64 + mk_lane(); asm volatile("" : "+v"(tid_)); const int tid = tid_, lane = tid & 63, wave = __builtin_amdgcn_readfirstlane(tid >> 6); (void)lane; (void)wave
#define IN_X 0
#define IN_C 1
#define IN_POS 2
#define IN_WADA 3
#define IN_BADA 4
#define IN_GMIXPRE 5
#define IN_GMIXPOST 6
#define IN_WIN 7
#define IN_GQA 8
#define IN_WQB 9
#define IN_GKVA 10
#define IN_WKVB 11
#define IN_LQ1 12
#define IN_LK1 13
#define IN_LQ2 14
#define IN_LK2 15
#define IN_GSUBLN 16
#define IN_WO 17
#define IN_GFFNPRE 18
#define IN_GFFNPOST 19
#define IN_WROUTER 20
#define IN_BROUTER 21
#define IN_WGU 22
#define IN_BGU 23
#define IN_WDN 24
#define IN_BDN 25

template <class Map>
__device__ __forceinline__ void transpose_item(const float* W, int K, int N, bf16_t* WT, const float* gain, Map dst, LAS float* scr, int item, int lane) {
    const int nblk = N / 32, kb = item / nblk, nb = item % nblk, k0 = 64 * kb, n0 = 32 * nb;
    { float v[32];
#pragma unroll
      for (int i = 0; i < 32; ++i) v[i] = W[(size_t)(k0 + 2 * i + (lane >> 5)) * N + n0 + (lane & 31)];
#pragma unroll
      for (int i = 0; i < 32; ++i) scr[(2 * i + (lane >> 5)) * 33 + (lane & 31)] = v[i]; }
    LDS_WAIT(); asm volatile("" ::: "memory");
    const int c = lane & 7;
    float gk[8];
#pragma unroll
    for (int i = 0; i < 8; ++i) gk[i] = gain ? gain[k0 + 8 * c + i] : 1.f;
#pragma unroll
    for (int j = 0; j < 4; ++j) { const int n = (lane >> 3) + 8 * j; const LAS float* s = scr + (8 * c) * 33 + n;
        u32x4 o; o.x = cvt_pk_bf16(s[0 * 33] * gk[0], s[1 * 33] * gk[1]); o.y = cvt_pk_bf16(s[2 * 33] * gk[2], s[3 * 33] * gk[3]); o.z = cvt_pk_bf16(s[4 * 33] * gk[4], s[5 * 33] * gk[5]); o.w = cvt_pk_bf16(s[6 * 33] * gk[6], s[7 * 33] * gk[7]);
        *(GAS u32x4*)(WT + (size_t)dst(n0 + n) * K + k0 + 8 * c) = o; }
    LDS_WAIT(); asm volatile("" ::: "memory");
}
template <class Map>
__device__ __forceinline__ void transpose8_stream(const float* W, int N, unsigned char* WT, Map dst, LAS float* scr, int first, int stride, int lane) {
    const int nblk = N / 32, per_e = 8 * nblk, total = NE * per_e;
    if (first >= total) return;
    float v[32];
    auto src = [&](int it, int hb) -> const float* { const int e = it / per_e, r = it - e * per_e, kb = r / nblk, nb = r - kb * nblk; return W + ((size_t)e * 1024 + 128 * kb + 64 * hb + (lane >> 5)) * N + 32 * nb + (lane & 31); };
    { const float* p = src(first, 0);
#pragma unroll
      for (int i = 0; i < 32; ++i) v[i] = __builtin_nontemporal_load(p + (size_t)(2 * i) * N); }
    for (int it = first; it < total; it += stride) {
#pragma unroll
        for (int hb = 0; hb < 2; ++hb) {
            float w[32];
#pragma unroll
            for (int i = 0; i < 32; ++i) w[i] = v[i];
            const int nit = hb == 0 ? it : it + stride;
            if (nit < total) { const float* p = src(nit, hb ^ 1);
#pragma unroll
                for (int i = 0; i < 32; ++i) v[i] = __builtin_nontemporal_load(p + (size_t)(2 * i) * N); }
#pragma unroll
            for (int i = 0; i < 32; ++i) { const int kk = 64 * hb + 2 * i + (lane >> 5); scr[kk * 32 + ((lane & 31) ^ (kk & 31) ^ (((kk >> 5) & 3) << 2))] = w[i]; }
        }
        LDS_WAIT(); asm volatile("" ::: "memory");
        const int e = it / per_e, r = it - e * per_e, kb = r / nblk, nb = r - kb * nblk, c = lane & 7;
#pragma unroll
        for (int j = 0; j < 4; ++j) { const int n = (lane >> 3) + 8 * j; float t[16];
#pragma unroll
            for (int i = 0; i < 16; ++i) { const int kk = 16 * c + i; t[i] = scr[kk * 32 + (n ^ (kk & 31) ^ (((kk >> 5) & 3) << 2))] * W8_SCALE; }
            u32x4 o; o.x = pack4_fp8(t[0], t[1], t[2], t[3]); o.y = pack4_fp8(t[4], t[5], t[6], t[7]); o.z = pack4_fp8(t[8], t[9], t[10], t[11]); o.w = pack4_fp8(t[12], t[13], t[14], t[15]);
            __builtin_nontemporal_store(o, (GAS u32x4*)(WT + ((size_t)e * N + dst(32 * nb + n)) * 1024 + 128 * kb + 16 * c)); }
        LDS_WAIT(); asm volatile("" ::: "memory");
    }
}
__device__ __forceinline__ int il4(int i, int x2) { return 8 * (i >> 2) + 4 * x2 + (i & 3); }
struct MapWin { __device__ int operator()(int n) const {
    if (n < 384) return n;
    if (n < 416) { const int r = n - 384; return PC_KR + il4(r & 15, r >> 4); }
    if (n < 1440) { const int r = n - 416, hj = r >> 6, d = r & 63; return PC_QD + hj * 64 + il4(d & 31, d >> 5); }
    return PC_VD + (n - 1440); } };
struct MapWqb { __device__ int operator()(int n) const { const int h = n / 96, d = n - h * 96; if (d < 64) return h * 64 + d; const int r = d - 64; return 512 + h * 32 + il4(r & 15, r >> 4); } };
struct MapId { __device__ int operator()(int n) const { return n; } };
struct MapWgu { __device__ int operator()(int n) const { const int which = n >> 10, j = n & 1023; return (j >> 7) * 256 + which * 128 + (j & 127); } };

__device__ __forceinline__ unsigned deal_fetch(unsigned* head, const float*& p) {
    unsigned r; unsigned long long sv; const unsigned one = 1u, zero = 0u;
    asm volatile("s_mov_b64 %1, exec\n\ts_mov_b64 exec, 1\n\tglobal_atomic_add %0, %3, %4, %5 sc0\n\ts_mov_b64 exec, %1" : "=&v"(r), "=&s"(sv), "+v"(p) : "v"(zero), "v"(one), "s"(head));
    return r;
}
__device__ __forceinline__ void transpose8_dyn(const float* Wgu, const float* Wdn, const float* Wo, const float* Win, unsigned char* WTgu, unsigned char* WTdn, unsigned char* WTo, unsigned char* WTin, unsigned* head, int hd, LAS float* scr, int first, int nwaves, int lane) {
    constexpr int TOT_GU = NE * 8 * 64, TOT_DN = TOT_GU + NE * 8 * 32, TOT_WO = TOT_DN, TOT = TOT_WO + 8 * 64;
    const int NSTAT = 2 * nwaves, NPOOL = (TOT - NSTAT) / 16;
    float v[32];
    auto src = [&](int it, int hb, int& N) -> const float* { const bool gu = it < TOT_GU, wo = it >= TOT_DN, wi = it >= TOT_WO; const int r0 = gu ? it : wi ? it - TOT_WO : wo ? it - TOT_DN : it - TOT_GU, sh = (gu || wi) ? 6 : 5; N = gu ? 2048 : wi ? INC : 1024;
        const int e = r0 >> (sh + 3), kb = (r0 >> sh) & 7, nb0 = r0 & ((1 << sh) - 1), nb = (wi && nb0 > 60) ? 60 : nb0;
        return (gu ? Wgu : wi ? Win : wo ? Wo : Wdn) + ((size_t)e * 1024 + 128 * kb + 64 * hb + (lane >> 5)) * N + 32 * nb + (lane & 31); };
    { int N; const float* p = src(first, 0, N);
#pragma unroll
      for (int i = 0; i < 32; ++i) v[i] = __builtin_nontemporal_load(p + (size_t)(2 * i) * N); }
    int it = first, nit = first + nwaves, nnit = TOT;
    while (true) {
        unsigned nxt = 0u;
#pragma unroll
        for (int hb = 0; hb < 2; ++hb) {
            float w[32];
#pragma unroll
            for (int i = 0; i < 32; ++i) w[i] = v[i];
            if (hb == 0) { int N; const float* p = src(it, 1, N); nxt = deal_fetch(head, p); const GAS float* q = (const GAS float*)p;
#pragma unroll
                for (int i = 0; i < 32; ++i) v[i] = __builtin_nontemporal_load(q + (size_t)(2 * i) * N); }
            else if (nit < TOT) { int N; const float* p = src(nit, 0, N);
#pragma unroll
                for (int i = 0; i < 32; ++i) v[i] = __builtin_nontemporal_load(p + (size_t)(2 * i) * N); }
#pragma unroll
            for (int i = 0; i < 32; ++i) { const int kk = 64 * hb + 2 * i + (lane >> 5); scr[kk * 32 + ((lane & 31) ^ (kk & 31) ^ (((kk >> 5) & 3) << 2))] = w[i]; }
            if (hb == 1) { asm volatile("" : "+v"(nxt) : "v"(w[31]));
                const int k = __builtin_amdgcn_readfirstlane((int)nxt); nnit = k < NPOOL ? NSTAT + 16 * k + hd : TOT; }
        }
        LDS_WAIT(); asm volatile("" ::: "memory");
        const bool gu = it < TOT_GU, wo = it >= TOT_DN, wi = it >= TOT_WO; const int r0 = gu ? it : wi ? it - TOT_WO : wo ? it - TOT_DN : it - TOT_GU, sh = (gu || wi) ? 6 : 5, N = gu ? 2048 : 1024;
        const int e = r0 >> (sh + 3), kb = (r0 >> sh) & 7, nb = r0 & ((1 << sh) - 1), c = lane & 7;
        unsigned char* WT = gu ? WTgu : wi ? WTin : wo ? WTo : WTdn;
        if (!(wi && nb > 60))
#pragma unroll
        for (int j = 0; j < 4; ++j) { const int n = (lane >> 3) + 8 * j; float t[16];
#pragma unroll
            for (int i = 0; i < 16; ++i) { const int kk = 16 * c + i; t[i] = scr[kk * 32 + (n ^ (kk & 31) ^ (((kk >> 5) & 3) << 2))] * W8_SCALE; }
            u32x4 o; o.x = pack4_fp8(t[0], t[1], t[2], t[3]); o.y = pack4_fp8(t[4], t[5], t[6], t[7]); o.z = pack4_fp8(t[8], t[9], t[10], t[11]); o.w = pack4_fp8(t[12], t[13], t[14], t[15]);
            const int nn = 32 * nb + n, row = gu ? MapWgu{}(nn) : wi ? MapWin{}(nn) : nn;
            __builtin_nontemporal_store(o, (GAS u32x4*)(WT + ((size_t)e * N + row) * 1024 + 128 * kb + 16 * c)); }
        LDS_WAIT(); asm volatile("" ::: "memory");
        if (nit >= TOT) break;
        it = nit; nit = nnit;
    }
}
__device__ __forceinline__ void p0_prologue(Frame& F) {
    PHASE_IDS();
    float* mod = (float*)(F.a->ws + WS_MOD);
    if (F.bid < 192) {
        LAS float* cact = (LAS float*)(F.lds);
        LAS float* red = (LAS float*)(F.lds + 65536);
        const float* c = F.a->in[IN_C];
        const int n0 = 32 * F.bid, col = tid & 31, kg = tid >> 5;
        const float* wp = F.a->in[IN_WADA] + (size_t)(kg * 64) * 6144 + n0 + col;
        float w[64];
#pragma unroll
        for (int kk = 0; kk < 64; ++kk) w[kk] = wp[(size_t)kk * 6144];
        { float cv[32];
#pragma unroll
          for (int i = 0; i < 32; ++i) cv[i] = c[tid + 512 * i];
#pragma unroll
          for (int i = 0; i < 32; ++i) cact[tid + 512 * i] = cv[i] / (1.f + __expf(-cv[i])); }
        __syncthreads();
        float acc[16];
#pragma unroll
        for (int b = 0; b < 16; ++b) acc[b] = 0.f;
#pragma unroll
        for (int kk = 0; kk < 64; ++kk)
#pragma unroll
            for (int b = 0; b < 16; ++b) acc[b] += cact[b * 1024 + kg * 64 + kk] * w[kk];
#pragma unroll
        for (int b = 0; b < 16; ++b) red[(kg * 16 + b) * 32 + col] = acc[b];
        __syncthreads();
        { const int b = tid >> 5; float s = 0.f;
#pragma unroll
          for (int k2 = 0; k2 < 16; ++k2) s += red[(k2 * 16 + b) * 32 + col];
          __hip_atomic_store(mod + b * 6144 + n0 + col, s + F.a->in[IN_BADA][n0 + col], __ATOMIC_RELAXED, __HIP_MEMORY_SCOPE_AGENT); }
        asm volatile("s_waitcnt vmcnt(0)" ::: "memory");
        __syncthreads();
        if (tid == 0) (void)__hip_atomic_fetch_add(F.ctl + CW_MODFLAG, 1u, __ATOMIC_RELAXED, __HIP_MEMORY_SCOPE_AGENT);
    }
    LAS float* scr = (LAS float*)(F.lds + RING_OFF + wave * 16384);
    if (wave >= 6) {
        const int t2 = tid - 384, NT2 = F.G * 128;
        { float* ssq = (float*)(F.a->ws + WS_SSQ); for (int i = F.bid * 128 + t2; i < 3 * T; i += NT2) ssq[i] = 0.f;
          u32x4* wz = (u32x4*)((unsigned char*)(F.a->ws + WS_WIN) + (size_t)416 * 1024); for (int i = F.bid * 128 + t2; i < 96 * 1024 / 16; i += NT2) wz[i] = (u32x4){0u, 0u, 0u, 0u}; }
        { const int* pos = (const int*)F.a->in[IN_POS]; float2* tabm = (float2*)(F.a->ws + WS_TABM); float2* tabd = (float2*)(F.a->ws + WS_TABD);
          const float invl = lane < 16 ? powf(10000.f, -(float)(2 * lane) / 32.f) : powf(10000.f, -(float)(2 * ((lane - 16) & 31)) / 64.f);
          for (int gid = F.bid * 128 + t2; gid < T * 48; gid += NT2) { const int t = gid / 48, i = gid - t * 48; const float p = (float)pos[t];
              const float inv = __shfl(invl, i); float sn, cs; sincosf(p * inv, &sn, &cs);
              if (i < 16) tabm[t * 16 + i] = make_float2(cs, sn); else tabd[t * 32 + (i - 16)] = make_float2(cs, sn); } }
        constexpr int I_WQB = 4 * 24, I_WKVB = 2 * 32, I_WO = 16 * 32;
        constexpr int NITEMS = I_WQB + I_WKVB + I_WO;
        for (int it = F.bid * 2 + (wave - 6); it < NITEMS; it += F.G * 2) {
            int r = it;
            if (r < I_WQB) { transpose_item(F.a->in[IN_WQB], 256, 768, (bf16_t*)(F.a->ws + WS_WQB), F.a->in[IN_GQA], MapWqb{}, scr, r, lane); continue; } r -= I_WQB;
            if (r < I_WKVB) { transpose_item(F.a->in[IN_WKVB], 128, 1024, (bf16_t*)(F.a->ws + WS_WKVB), F.a->in[IN_GKVA], MapId{}, scr, r, lane); continue; } r -= I_WKVB;
            transpose_item(F.a->in[IN_WO], 1024, 1024, (bf16_t*)(F.a->ws + WS_WO), nullptr, MapId{}, scr, r, lane);
        }
    }
    { const int gw = F.bid * NWAVES + wave, NGW = F.G * NWAVES, hd = ((wave + F.bid) & 7) + 8 * ((F.bid >> 3) & 1);
      transpose8_dyn(F.a->in[IN_WGU], F.a->in[IN_WDN], F.a->in[IN_WO], F.a->in[IN_WIN], (unsigned char*)(F.a->ws + WS_WGU), (unsigned char*)(F.a->ws + WS_WD), (unsigned char*)(F.a->ws + WS_WO), (unsigned char*)(F.a->ws + WS_WIN), F.ctl + CW_DEAL + 512 * hd, hd, scr, gw, NGW, lane); }
}
__device__ __forceinline__ void p0b_norm(Frame& F) {
    PHASE_IDS();
    const float* mod = (const float*)(F.a->ws + WS_MOD); bf16_t* H = (bf16_t*)(F.a->ws + WS_H);
    if (tid == 0) { const unsigned need = F.G < 192 ? (unsigned)F.G : 192u; while (xb_ld(F.ctl + CW_MODFLAG) < need) __builtin_amdgcn_s_sleep(2);
        __builtin_amdgcn_fence(__ATOMIC_ACQUIRE, "agent"); asm volatile("s_waitcnt vmcnt(0)" ::: "memory"); }
    __syncthreads();
    const int gw = F.bid * NWAVES + wave, NGW = F.G * NWAVES, hd = ((wave + F.bid) & 7) + 8 * ((F.bid >> 3) & 1);
    constexpr int NCH = T / 4;
    unsigned* head = F.ctl + CW_DEAL + 512 * hd + 64;
    const int NSTAT = 2 * NGW, NPOOL = (NCH - NSTAT) / 16;
    int c = gw, nc = gw + NGW, cur_b = -1;
    f32x4 g[4], sh[4];
    while (c < NCH) {
        const int bb = c >> 9;
        if (bb != cur_b) { cur_b = bb;
#pragma unroll
            for (int j = 0; j < 4; ++j) { const int cc = 4 * lane + 256 * j; g[j] = *(const f32x4*)(F.a->in[IN_GMIXPRE] + cc) * (*(const f32x4*)(mod + bb * 6144 + 1024 + cc) + 1.f); sh[j] = *(const f32x4*)(mod + bb * 6144 + cc); } }
        const float* p = F.a->in[IN_X] + (size_t)(4 * c) * D;
        unsigned nxt = deal_fetch(head, p);
        const GAS f32x4* q = (const GAS f32x4*)p;
        f32x4 v[4][4];
#pragma unroll
        for (int r = 0; r < 4; ++r)
#pragma unroll
            for (int j = 0; j < 4; ++j) v[r][j] = __builtin_nontemporal_load(q + r * (D / 4) + lane + 64 * j);
        float rs3 = 0.f;
#pragma unroll
        for (int r = 0; r < 4; ++r) { float ss = 0.f;
#pragma unroll
            for (int j = 0; j < 4; ++j) ss += (v[r][j].x * v[r][j].x + v[r][j].y * v[r][j].y) + (v[r][j].z * v[r][j].z + v[r][j].w * v[r][j].w);
            const float rs = rsqrtf(wave_sum(ss) * (1.f / D) + 1e-6f); rs3 = rs;
            GAS unsigned* o8 = (GAS unsigned*)((unsigned char*)H + (size_t)(4 * c + r) * D) + lane;
#pragma unroll
            for (int j = 0; j < 4; ++j) { const f32x4 h = ((v[r][j] * rs) * g[j] + sh[j]) * H_SCALE; o8[64 * j] = pack4_fp8s(h[0], h[1], h[2], h[3]); } }
        asm volatile("" : "+v"(nxt) : "v"(rs3));
        const int k = __builtin_amdgcn_readfirstlane((int)nxt);
        c = nc; nc = k < NPOOL ? NSTAT + 16 * k + hd : NCH;
    }
}
__device__ __forceinline__ void p5_stage_router(Frame& F) {
    PHASE_IDS();
    LAS float* wt = (LAS float*)(F.lds + RING_OFF);
    float v[64];
#pragma unroll
    for (int i = 0; i < 64; ++i) v[i] = F.a->in[IN_WROUTER][tid + 512 * i];
#pragma unroll
    for (int i = 0; i < 64; ++i) { const int idx = tid + 512 * i, k = idx >> 5, e = idx & 31; wt[e * 1024 + (k ^ ((e & 7) << 2))] = v[i]; }
    { const float* mod = (const float*)(F.a->ws + WS_MOD); LAS float* cst = (LAS float*)(F.lds + X_CONST); const int b = (F.bid * 128) / S;
      for (int c = tid; c < 1024; c += 512) { cst[c] = F.a->in[IN_GMIXPOST][c] * mod[b * 6144 + 2048 + c]; cst[1024 + c] = F.a->in[IN_GFFNPRE][c] * (mod[b * 6144 + 4096 + c] + 1.f); cst[2048 + c] = mod[b * 6144 + 3072 + c]; } }
}
__device__ __forceinline__ void p5_rows(Frame& F) {
    PHASE_IDS();
    LAS float* wt = (LAS float*)(F.lds + RING_OFF);
    LAS int* se = (LAS int*)(F.lds + X_SE); LAS float* sg = (LAS float*)(F.lds + X_SG);
    const float* mod = (const float*)(F.a->ws + WS_MOD); const float* ssq_y = (const float*)(F.a->ws + WS_SSQ) + 2 * T;
    const bf16_t* Y = (const bf16_t*)(F.a->ws + WS_Y); unsigned char* H2 = (unsigned char*)(F.a->ws + WS_H); bf16_t* X1 = (bf16_t*)(F.a->ws + WS_X1);
    const int tok0 = F.bid * 128 + wave * 16, b = (F.bid * 128) / S;
    LAS float* cst = (LAS float*)(F.lds + X_CONST);
    f32x4 xn[2][4]; u32x2 yn[2][4];
#define P5_PRE(r_) do { _Pragma("unroll") for (int q_ = 0; q_ < 2; ++q_) { _Pragma("unroll") for (int j = 0; j < 4; ++j) { xn[q_][j] = __builtin_nontemporal_load((const GAS f32x4*)(F.a->in[IN_X] + (size_t)((r_) + q_) * D + 4 * lane + 256 * j)); yn[q_][j] = __builtin_nontemporal_load((const GAS u32x2*)(Y + (size_t)((r_) + q_) * D + 4 * lane + 256 * j)); } } } while (0)
#pragma unroll
    for (int q_ = 0; q_ < 2; ++q_)
#pragma unroll
        for (int j = 0; j < 4; ++j) xn[q_][j] = __builtin_nontemporal_load((const GAS f32x4*)(F.a->in[IN_X] + (size_t)(tok0 + q_) * D + 4 * lane + 256 * j));
    if (tid == 0) PG8_DEP_SPIN(F.ctl + CW_DONE4 + (F.bid >> 1), 4u);
    __syncthreads();
#pragma unroll
    for (int q_ = 0; q_ < 2; ++q_)
#pragma unroll
        for (int j = 0; j < 4; ++j) yn[q_][j] = __builtin_nontemporal_load((const GAS u32x2*)(Y + (size_t)(tok0 + q_) * D + 4 * lane + 256 * j));
    __syncthreads();
#pragma nounroll
    for (int i = 0; i < 16; i += 2) {
        const int row = tok0 + i;
        f32x2 hp[4][4];
        {   f32x4 xv[2][4]; u32x2 yv[2][4]; float rsy[2];
#pragma unroll
            for (int q = 0; q < 2; ++q) { float sy = 0.f;
#pragma unroll
                for (int j = 0; j < 4; ++j) { xv[q][j] = xn[q][j]; yv[q][j] = yn[q][j]; const float a0 = bflo(yv[q][j].x), a1 = bfhi(yv[q][j].x), a2 = bflo(yv[q][j].y), a3 = bfhi(yv[q][j].y); sy += (a0 * a0 + a1 * a1) + (a2 * a2 + a3 * a3); }
                rsy[q] = rsqrtf(wave_sum(sy) * (1.f / D) + 1e-6f); }
            if (i + 2 < 16) P5_PRE(row + 2);
            f32x4 gpost[4], gpre[4], shf[4];
#pragma unroll
            for (int j = 0; j < 4; ++j) { gpost[j] = *(const LAS f32x4*)(cst + 4 * lane + 256 * j); gpre[j] = *(const LAS f32x4*)(cst + 1024 + 4 * lane + 256 * j); shf[j] = *(const LAS f32x4*)(cst + 2048 + 4 * lane + 256 * j); }
#pragma unroll
            for (int q = 0; q < 2; ++q) { f32x4 x1[4]; float ss = 0.f;
#pragma unroll
                for (int j = 0; j < 4; ++j) { const f32x4 yy = {bflo(yv[q][j].x), bfhi(yv[q][j].x), bflo(yv[q][j].y), bfhi(yv[q][j].y)}; x1[j] = xv[q][j] + (yy * rsy[q]) * gpost[j];
                    ss += (x1[j][0] * x1[j][0] + x1[j][1] * x1[j][1]) + (x1[j][2] * x1[j][2] + x1[j][3] * x1[j][3]);
                    { u32x2 w; w.x = cvt_pk_bf16(x1[j][0], x1[j][1]); w.y = cvt_pk_bf16(x1[j][2], x1[j][3]); __builtin_nontemporal_store(w, (GAS u32x2*)(X1 + (size_t)(row + q) * D + 4 * lane + 256 * j)); } }
                const float r1 = rsqrtf(wave_sum(ss) * (1.f / D) + 1e-6f);
#pragma unroll
                for (int j = 0; j < 4; ++j) { const f32x4 h = (x1[j] * r1) * gpre[j] + shf[j]; *(GAS unsigned*)(H2 + (size_t)(row + q) * D + 4 * lane + 256 * j) = pack4_fp8s(h[0], h[1], h[2], h[3]);
#pragma unroll
                    for (int c = 0; c < 4; ++c) hp[j][c][q] = h[c]; } } }
        f32x2 v[32];
#pragma unroll
        for (int e = 0; e < NE; ++e) { const LAS f32x4* wp = (const LAS f32x4*)(wt + e * 1024) + (lane ^ (e & 7)); f32x2 p = {0.f, 0.f};
#pragma unroll
            for (int j = 0; j < 4; ++j) { const f32x4 w = wp[64 * j]; p = p + hp[j][0] * w[0]; p = p + hp[j][1] * w[1]; p = p + hp[j][2] * w[2]; p = p + hp[j][3] * w[3]; }
            v[e] = p; if ((e & 3) == 3) __builtin_amdgcn_sched_barrier(0); }
        const int my_e = lane >> 1; const float brt = F.a->in[IN_BROUTER][my_e];
#define P5_REDUCE(Q) do { float u_[16]; \
            _Pragma("unroll") for (int j = 0; j < 16; ++j) u_[j] = swap32_sum(v[j][Q], v[16 + j][Q]); \
            _Pragma("unroll") for (int j = 0; j < 8; ++j) u_[j] = swap16_sum(u_[j], u_[8 + j]); \
            _Pragma("unroll") for (int j = 0; j < 4; ++j) { const bool up = (lane & 8) != 0; const float keep = up ? u_[4 + j] : u_[j], send = up ? u_[j] : u_[4 + j]; u_[j] = keep + lane_xor8(send); } \
            _Pragma("unroll") for (int j = 0; j < 2; ++j) { const bool up = (lane & 4) != 0; const float keep = up ? u_[2 + j] : u_[j], send = up ? u_[j] : u_[2 + j]; u_[j] = keep + lane_xor4(send); } \
            { const bool up = (lane & 2) != 0; const float keep = up ? u_[1] : u_[0], send = up ? u_[0] : u_[1]; u_[0] = keep + DPPF(send, 0x4E); } \
            float lg = u_[0] + DPPF(u_[0], 0xB1) + brt; \
            float vals[4]; int idx[4]; \
            _Pragma("unroll") for (int k = 0; k < 4; ++k) { const float mx = wave_max(lg); const unsigned long long bm = __ballot(lg == mx); const int wl = __builtin_ctzll(bm); vals[k] = mx; idx[k] = wl >> 1; if (my_e == idx[k]) lg = -INFINITY; } \
            float ex[4], den = 0.f; \
            _Pragma("unroll") for (int k = 0; k < 4; ++k) { ex[k] = __expf(vals[k] - vals[0]); den += ex[k]; } \
            const float inv = 1.f / den; \
            if (lane < 4) { const int a = (wave * 16 + i + Q) * 4 + lane; se[a] = lane == 0 ? idx[0] : lane == 1 ? idx[1] : lane == 2 ? idx[2] : idx[3]; sg[a] = (lane == 0 ? ex[0] : lane == 1 ? ex[1] : lane == 2 ? ex[2] : ex[3]) * inv; } \
            __builtin_amdgcn_sched_barrier(0); } while (0)
        P5_REDUCE(0);
        P5_REDUCE(1);
#undef P5_REDUCE
    }
#undef P5_PRE
#define P5_LOAD(x)
#undef P5_LOAD
    __syncthreads();
    LAS int* srank = (LAS int*)(F.lds + X_SRANK); LAS int* wcnt = (LAS int*)(F.lds + X_WCNT);
    const int e_my = se[tid]; int rk = 0;
    for (int e = 0; e < NE; ++e) { const unsigned long long bm = __ballot(e_my == e); if (e_my == e) rk = __builtin_popcountll(bm & ((1ull << lane) - 1ull)); if (lane == 0) wcnt[wave * 32 + e] = __builtin_popcountll(bm); }
    __syncthreads();
    int base = 0;
    for (int w = 0; w < wave; ++w) base += wcnt[w * 32 + e_my];
    srank[tid] = base + rk;
    { const int a = F.bid * 512 + tid; ((int*)(F.a->ws + WS_SE))[a] = e_my; ((float*)(F.a->ws + WS_SG))[a] = sg[tid]; ((int*)(F.a->ws + WS_SRANK))[a] = base + rk; }
    if (tid < NE) { int tot = 0; for (int w = 0; w < 8; ++w) tot += wcnt[w * 32 + tid]; __hip_atomic_store((int*)(F.a->ws + WS_CNT) + F.bid * NE + tid, tot, __ATOMIC_RELAXED, __HIP_MEMORY_SCOPE_AGENT); }
    asm volatile("s_waitcnt vmcnt(0)" ::: "memory");
    __syncthreads();
    if (tid == 0) __hip_atomic_store(F.ctl + CW_P5FLAG + F.bid, 1u, __ATOMIC_RELAXED, __HIP_MEMORY_SCOPE_AGENT);
}
__device__ __forceinline__ void p9_final(Frame& F) {
    PHASE_IDS();
    const float* mod = (const float*)(F.a->ws + WS_MOD); const unsigned char* YR = (const unsigned char*)(F.a->ws + WS_YR); const int* pos = (const int*)(F.a->ws + WS_POS);
    const int gw = F.bid * NWAVES + wave, NGW = F.G * NWAVES, hd = ((wave + F.bid) & 7) + 8 * ((F.bid >> 3) & 1);
    constexpr int NCH = T / 4;
    unsigned* head = F.ctl + CW_DEAL + 512 * hd + 128;
    const int NSTAT = 2 * NGW, NPOOL = (NCH - NSTAT) / 16;
    int c = gw, nc = gw + NGW, cur_b = -1;
    f32x4 gf[4];
    unsigned yn[4][4]; u32x2 xn[4]; const bf16_t* X1 = (const bf16_t*)(F.a->ws + WS_X1);
#define P9_LOADY(row) do { _Pragma("unroll") for (int s_ = 0; s_ < 4; ++s_) { const int pr = __builtin_amdgcn_readfirstlane(pos[(row) * 4 + s_]); _Pragma("unroll") for (int j = 0; j < 4; ++j) yn[s_][j] = __builtin_nontemporal_load((const GAS unsigned*)(YR + (size_t)pr * D + 4 * lane + 256 * j)); } } while (0)
#define P9_LOADX(xp) do { _Pragma("unroll") for (int j = 0; j < 4; ++j) xn[j] = __builtin_nontemporal_load((const GAS u32x2*)((const GAS bf16_t*)(xp) + 4 * lane + 256 * j)); } while (0)
    if (c < NCH) { P9_LOADY(4 * c); P9_LOADX(X1 + (size_t)(4 * c) * D); }
    while (c < NCH) {
        const int bb = c >> 9;
        if (bb != cur_b) { cur_b = bb;
#pragma unroll
            for (int j = 0; j < 4; ++j) { const int cc = 4 * lane + 256 * j; gf[j] = *(const f32x4*)(F.a->in[IN_GFFNPOST] + cc) * *(const f32x4*)(mod + bb * 6144 + 5120 + cc); } }
        unsigned nxt = 0u; float dep = 0.f;
#pragma unroll
        for (int i = 0; i < 4; ++i) {
            const int row = 4 * c + i;
            f32x4 y[4], x1[4]; float ss = 0.f;
#pragma unroll
            for (int j = 0; j < 4; ++j) { y[j] = (f32x4){0.f, 0.f, 0.f, 0.f};
#pragma unroll
                for (int s_ = 0; s_ < 4; ++s_) { const unsigned w = yn[s_][j]; const f32x2 lo = __builtin_amdgcn_cvt_pk_f32_fp8((int)w, false), hi2 = __builtin_amdgcn_cvt_pk_f32_fp8((int)w, true); y[j] += (f32x4){lo[0], lo[1], hi2[0], hi2[1]}; }
                y[j] = y[j] * YR_INV; x1[j] = (f32x4){bflo(xn[j].x), bfhi(xn[j].x), bflo(xn[j].y), bfhi(xn[j].y)}; ss += (y[j][0] * y[j][0] + y[j][1] * y[j][1]) + (y[j][2] * y[j][2] + y[j][3] * y[j][3]); }
            const int nr = i < 3 ? row + 1 : 4 * nc;
            if (i < 3 || nc < NCH) {
                if (i == 0) { const float* p = (const float*)(X1 + (size_t)nr * D); nxt = deal_fetch(head, p); P9_LOADY(nr); P9_LOADX(p); }
                else { P9_LOADY(nr); P9_LOADX(X1 + (size_t)nr * D); } }
            const float r = rsqrtf(wave_sum(ss) * (1.f / D) + 1e-6f); dep = r;
#pragma unroll
            for (int j = 0; j < 4; ++j) __builtin_nontemporal_store(x1[j] + (y[j] * r) * gf[j], (GAS f32x4*)(F.a->out + (size_t)row * D + 4 * lane + 256 * j));
        }
        asm volatile("" : "+v"(nxt) : "v"(dep));
        const int k = __builtin_amdgcn_readfirstlane((int)nxt);
        c = nc; nc = k < NPOOL ? NSTAT + 16 * k + hd : NCH;
    }
#undef P9_LOADY
#undef P9_LOADX
#define P9_LOAD(x)
#undef P9_LOAD
}
namespace att {
#define SBAR() __builtin_amdgcn_sched_barrier(0)
typedef short s16x4 __attribute__((ext_vector_type(4)));
typedef short v4i16_t __attribute__((ext_vector_type(4)));
typedef __attribute__((address_space(3))) const char* lds_cptr;
__device__ __forceinline__ int crow(int r, int hi) { return (r & 3) + 8 * (r >> 2) + 4 * hi; }
__device__ __forceinline__ void glds16(const void* gsrc, unsigned lds_dst) { unsigned keep;
    asm volatile("s_mov_b32 %0, m0\n\ts_mov_b32 m0, %2\n\ts_nop 0\n\tglobal_load_lds_dwordx4 %1, off\n\ts_mov_b32 m0, %0" : "=&s"(keep) : "v"(gsrc), "s"(lds_dst) : "memory"); }
__device__ __forceinline__ s16x4 vtr(lds_cptr p) { return __builtin_bit_cast(s16x4, __builtin_amdgcn_ds_read_tr16_b64_v4i16((__attribute__((address_space(3))) v4i16_t*)p)); }
typedef float f32x2_t __attribute__((ext_vector_type(2))); typedef __bf16 bf16x2_t __attribute__((ext_vector_type(2)));
__device__ __forceinline__ unsigned cvtpk_s(float lo, float hi) { f32x2_t v = {lo, hi}; bf16x2_t b = __builtin_convertvector(v, bf16x2_t); return __builtin_bit_cast(unsigned, b); }
#define WAIT_BAR0() asm volatile("s_waitcnt vmcnt(0) lgkmcnt(0)\n\ts_barrier" ::: "memory")

struct Src {
    const bf16_t* q0; const bf16_t* q1; int qp;
    const bf16_t* k0; const bf16_t* k1; int kp0, kp1;
    const bf16_t* v; int vp;
};
template <int DQK, int DV> struct Geo {
    static constexpr int NKC = DQK / 8, NVB = DV / 32, KSLOT = NKC * 1024, VSLOT = NVB * 4096, NPIECE = NKC + 4 * NVB;
    static constexpr int NSLOT = 3, LDS_K = 0, LDS_V = NSLOT * KSLOT, LDS_WS = LDS_V + NSLOT * VSLOT, LDS_OST = 0  , LDS_TOTAL = LDS_WS + 8 * 256;
    static_assert(8 * 32 * DV * 2 <= LDS_WS && LDS_TOTAL <= 131072, "attention LDS map");
};
constexpr float THR = 8.f;
#ifndef ATT_VPM
#define ATT_VPM 8
#endif

template <int DQK, int DV, int MODE>
__device__ __forceinline__ void attn_unit(LAS char* shm, const Src sc, int qb, bf16_t* obase, float* td, float lam, const float* gsub, int wv, unsigned* pubp) {
    typedef Geo<DQK, DV> G;
    int tid_ = wv * 64 + mk_lane(); asm volatile("" : "+v"(tid_));
    const int tid = tid_, lane = tid & 63, r32 = lane & 31, hi = lane >> 5; const int wid = __builtin_amdgcn_readfirstlane(tid >> 6);
    const int q0 = qb * 256, NT = 4 * (qb + 1);
    const unsigned lds0 = (unsigned)(uintptr_t)shm;
    LAS float* wsf = (LAS float*)(shm + G::LDS_WS) + wid * 64;
    const char* ksrc[2]; const char* vsrc[2]; long kstep[2], vstep;
#pragma unroll
    for (int i = 0; i < 2; ++i) { const int p = wid + 8 * i; ksrc[i] = nullptr; kstep[i] = 0; vsrc[i] = nullptr;
        if (p < G::NKC) { const bf16_t* base = p < 8 ? sc.k0 + 8 * p : sc.k1 + 8 * (p - 8); const int pitch = p < 8 ? sc.kp0 : sc.kp1; ksrc[i] = (const char*)(base + (long)lane * pitch); kstep[i] = 128L * pitch; }
        if (p < 4 * G::NVB) { const int db = p >> 2, rg = p & 3; vsrc[i] = (const char*)(sc.v + (long)(16 * rg + (lane >> 2)) * sc.vp + 32 * db + 8 * (lane & 3)); } }
    vstep = 128L * sc.vp;
#define DMA_K(slot) do { _Pragma("unroll") for (int i_ = 0; i_ < 2; ++i_) if (wid + 8 * i_ < G::NKC) { glds16(ksrc[i_], (unsigned)__builtin_amdgcn_readfirstlane(lds0 + G::LDS_K + (wid + 8 * i_) * 1024 + (slot) * G::KSLOT)); ksrc[i_] += kstep[i_]; } } while (0)
#define DMA_V(slot) do { _Pragma("unroll") for (int i_ = 0; i_ < 2; ++i_) if (wid + 8 * i_ < 4 * G::NVB) { glds16(vsrc[i_], (unsigned)__builtin_amdgcn_readfirstlane(lds0 + G::LDS_V + (wid + 8 * i_) * 1024 + (slot) * G::VSLOT)); vsrc[i_] += vstep; } } while (0)
    DMA_K(0); DMA_V(0); DMA_K(1); DMA_V(1); DMA_K(2);
    bf16x8 qr[DQK / 16];
    { const long qrow = (long)(q0 + wid * 32 + r32) * sc.qp;
#pragma unroll
      for (int d0 = 0; d0 < DQK / 16; ++d0) qr[d0] = d0 < 4 ? *reinterpret_cast<const bf16x8*>(sc.q0 + qrow + d0 * 16 + hi * 8) : *reinterpret_cast<const bf16x8*>(sc.q1 + qrow + (d0 - 4) * 16 + hi * 8); }
    float m_run = 0.f, l_reg = 0.f; bool first = true;
    f32x16 negm = f32x16{};
    f32x16 o[G::NVB];
#pragma unroll
    for (int d = 0; d < G::NVB; ++d) o[d] = f32x16{};
    const int qrel = wid * 32 + r32;
    const lds_cptr shm3 = (lds_cptr)shm;
    const lds_cptr kp0 = shm3 + G::LDS_K + hi * 1024 + r32 * 16;
    const lds_cptr vp0 = shm3 + G::LDS_V + ((lane >> 4) & 1) * 32 + (lane & 3) * 8 + (4 * hi + ((lane & 15) >> 2)) * 64;
#define QKT(P0, P1, slot) do { const lds_cptr kp_ = kp0 + (slot) * G::KSLOT; _Pragma("unroll") for (int d0 = 0; d0 < DQK / 16; ++d0) { \
        const bf16x8 b0_ = *(const __attribute__((address_space(3))) bf16x8*)(kp_ + d0 * 2048), b1_ = *(const __attribute__((address_space(3))) bf16x8*)(kp_ + d0 * 2048 + 512); \
        if (d0 == 0) { P0 = __builtin_amdgcn_mfma_f32_32x32x16_bf16(b0_, qr[0], negm, 0, 0, 0); P1 = __builtin_amdgcn_mfma_f32_32x32x16_bf16(b1_, qr[0], negm, 0, 0, 0); } \
        else { P0 = __builtin_amdgcn_mfma_f32_32x32x16_bf16(b0_, qr[d0], P0, 0, 0, 0); P1 = __builtin_amdgcn_mfma_f32_32x32x16_bf16(b1_, qr[d0], P1, 0, 0, 0); } } } while (0)
#define ACTIVE(t_) (!((t_) - (NT - 4) >= 0 && 64 * ((t_) - (NT - 4)) > 32 * wid + 31))
    int s_cur = 0, s_nx1 = 1, s_nx2 = 2;
    const bool three = (wid + 8 < G::NKC ? 2 : 1) + (wid + 8 < 4 * G::NVB ? 2 : 1) == 3;
    f32x16 sc0 = f32x16{}, sc1 = f32x16{}, sn0 = f32x16{}, sn1 = f32x16{};
    asm volatile("s_waitcnt vmcnt(0) lgkmcnt(0)\n\ts_barrier" ::: "memory");
    QKT(sc0, sc1, 0);
    constexpr bool EARLYMAX = (DV == 64);
    float rm_carry = 0.f;
    if constexpr (EARLYMAX) {   if (NT == 4) { const int kb = 4 * hi;
#pragma unroll
            for (int r = 0; r < 16; ++r) { const int kv = kb + (r & 3) + 8 * (r >> 2); if (kv > qrel) sc0[r] = -INFINITY; if (kv + 32 > qrel) sc1[r] = -INFINITY; } }
        float rm = fmaxf(sc0[0], sc1[0]);
#pragma unroll
        for (int r = 1; r < 16; ++r) rm = fmaxf(rm, fmaxf(sc0[r], sc1[r]));
        rm_carry = swap32_max(rm, rm); }
    for (int t = 0; t < NT; ++t) {
        if (t + 3 < NT) { if (three) asm volatile("s_waitcnt vmcnt(3) lgkmcnt(0)\n\ts_barrier" ::: "memory"); else asm volatile("s_waitcnt vmcnt(2) lgkmcnt(0)\n\ts_barrier" ::: "memory"); }
        else WAIT_BAR0();
        if (t + 3 < NT) DMA_K(s_cur);
        if (t + 2 < NT) DMA_V(s_nx2);
        const int jb = t - (NT - 4);
        const bool act = ACTIVE(t), nxt = (t + 1 < NT) && ACTIVE(t + 1);
        if (!act) { const int tmp = s_cur; s_cur = s_nx1; s_nx1 = s_nx2; s_nx2 = tmp; continue; }
        float rm;
        if constexpr (EARLYMAX) rm = rm_carry;
        else {
            if (jb >= 0) { const int kb = 64 * jb + 4 * hi;
#pragma unroll
                for (int r = 0; r < 16; ++r) { const int kv = kb + (r & 3) + 8 * (r >> 2); if (kv > qrel) sc0[r] = -INFINITY; if (kv + 32 > qrel) sc1[r] = -INFINITY; } }
            rm = fmaxf(sc0[0], sc1[0]);
#pragma unroll
            for (int r = 1; r < 16; ++r) rm = fmaxf(rm, fmaxf(sc0[r], sc1[r]));
            rm = swap32_max(rm, rm); }
        if (first || __any(rm > THR)) {
            const float dl = first ? rm : fmaxf(rm, 0.f), f = first ? 1.f : __builtin_amdgcn_exp2f(-dl); m_run += dl; l_reg *= f; first = false;
#pragma unroll
            for (int r = 0; r < 16; ++r) { sc0[r] -= dl; sc1[r] -= dl; negm[r] = -m_run; }
            if (hi == 0) wsf[r32] = f;
            asm volatile("s_waitcnt lgkmcnt(0)" ::: "memory");
#pragma unroll
            for (int g = 0; g < 4; ++g) { const f32x4 fv = *(const LAS f32x4*)(wsf + 8 * g + 4 * hi);
#pragma unroll
                for (int d = 0; d < G::NVB; ++d) { o[d][4 * g] *= fv[0]; o[d][4 * g + 1] *= fv[1]; o[d][4 * g + 2] *= fv[2]; o[d][4 * g + 3] *= fv[3]; } }
        }
        u32x4 pw[4];
        if (nxt) {
            constexpr int ND0 = DQK / 16, NG = 2 * ND0;
            const lds_cptr kpn = kp0 + s_nx1 * G::KSLOT;
            float sacc = 0.f;
            bf16x8 kb0 = *(const __attribute__((address_space(3))) bf16x8*)(kpn), kb1 = *(const __attribute__((address_space(3))) bf16x8*)(kpn + 512), nb0 = kb0, nb1 = kb1;
#define ATT_GAP(g_) do { _Pragma("unroll") for (int e_ = ((g_) * 32) / NG; e_ < (((g_) + 1) * 32) / NG; ++e_) { \
                if (e_ < 16) { sc0[e_] = __builtin_amdgcn_exp2f(sc0[e_]); sacc += sc0[e_]; } else { sc1[e_ - 16] = __builtin_amdgcn_exp2f(sc1[e_ - 16]); sacc += sc1[e_ - 16]; } } \
                asm volatile("" : "+v"(sacc), "+v"(sc0), "+v"(sc1)); SBAR(); } while (0)
#pragma unroll
            for (int d0 = 0; d0 < ND0; ++d0) {
                if (d0 + 1 < ND0) { nb0 = *(const __attribute__((address_space(3))) bf16x8*)(kpn + (d0 + 1) * 2048); nb1 = *(const __attribute__((address_space(3))) bf16x8*)(kpn + (d0 + 1) * 2048 + 512); }
                sn0 = d0 == 0 ? __builtin_amdgcn_mfma_f32_32x32x16_bf16(kb0, qr[0], negm, 0, 0, 0) : __builtin_amdgcn_mfma_f32_32x32x16_bf16(kb0, qr[d0], sn0, 0, 0, 0);
                ATT_GAP(2 * d0);
                sn1 = d0 == 0 ? __builtin_amdgcn_mfma_f32_32x32x16_bf16(kb1, qr[0], negm, 0, 0, 0) : __builtin_amdgcn_mfma_f32_32x32x16_bf16(kb1, qr[d0], sn1, 0, 0, 0);
                ATT_GAP(2 * d0 + 1);
                kb0 = nb0; kb1 = nb1;
            }
#undef ATT_GAP
            l_reg += sacc;
#pragma unroll
            for (int k = 0; k < 4; ++k) { pw[0][k] = cvtpk_s(sc0[2 * k], sc0[2 * k + 1]); pw[1][k] = cvtpk_s(sc0[8 + 2 * k], sc0[8 + 2 * k + 1]); pw[2][k] = cvtpk_s(sc1[2 * k], sc1[2 * k + 1]); pw[3][k] = cvtpk_s(sc1[8 + 2 * k], sc1[8 + 2 * k + 1]); }
        } else {
            float sacc = 0.f;
#pragma unroll
            for (int r = 0; r < 16; ++r) { sc0[r] = __builtin_amdgcn_exp2f(sc0[r]); sc1[r] = __builtin_amdgcn_exp2f(sc1[r]); sacc += sc0[r] + sc1[r]; }
            l_reg += sacc;
#pragma unroll
            for (int k = 0; k < 4; ++k) { pw[0][k] = cvtpk_s(sc0[2 * k], sc0[2 * k + 1]); pw[1][k] = cvtpk_s(sc0[8 + 2 * k], sc0[8 + 2 * k + 1]); pw[2][k] = cvtpk_s(sc1[2 * k], sc1[2 * k + 1]); pw[3][k] = cvtpk_s(sc1[8 + 2 * k], sc1[8 + 2 * k + 1]); }
        }
        const lds_cptr vpp = vp0 + s_cur * G::VSLOT;
        if (EARLYMAX && nxt && jb + 1 >= 0) { const int kb = 64 * (jb + 1) + 4 * hi;
#pragma unroll
            for (int r = 0; r < 16; ++r) { const int kv = kb + (r & 3) + 8 * (r >> 2); if (kv > qrel) sn0[r] = -INFINITY; if (kv + 32 > qrel) sn1[r] = -INFINITY; } }
        float rma = -INFINITY, rmb = -INFINITY;
#pragma unroll
        for (int d = 0; d < G::NVB; ++d) {
#pragma unroll
            for (int ks = 0; ks < 4; ++ks) { const s16x4 lo = vtr(vpp + d * 4096 + ks * 1024), hh = vtr(vpp + d * 4096 + ks * 1024 + 512);
                const bf16x8 vf = {lo[0], lo[1], lo[2], lo[3], hh[0], hh[1], hh[2], hh[3]};
                o[d] = __builtin_amdgcn_mfma_f32_32x32x16_bf16(__builtin_bit_cast(bf16x8, pw[ks]), vf, o[d], 0, 0, 0);
                constexpr int PER = 16 / (4 * G::NVB) > 0 ? 16 / (4 * G::NVB) : 1;
                const int gi = d * 4 + ks;
                if (EARLYMAX && gi * PER < 16) {
#pragma unroll
                    for (int e_ = gi * PER; e_ < gi * PER + PER; ++e_) { rma = fmaxf(rma, sn0[e_]); rmb = fmaxf(rmb, sn1[e_]); }
                    } } }
        if constexpr (EARLYMAX) rm_carry = swap32_max(fmaxf(rma, rmb), fmaxf(rma, rmb));
        sc0 = sn0; sc1 = sn1;
        { const int tmp = s_cur; s_cur = s_nx1; s_nx1 = s_nx2; s_nx2 = tmp; }
    }
#undef QKT
#undef ACTIVE
#undef DMA_K
#undef DMA_V
    l_reg = swap32_sum(l_reg, l_reg);
    if (hi == 0) wsf[32 + r32] = l_reg;
    asm volatile("s_waitcnt lgkmcnt(0)" ::: "memory");
    float rli[16];
#pragma unroll
    for (int r = 0; r < 16; ++r) rli[r] = __builtin_amdgcn_rcpf(wsf[32 + crow(r, hi)]);
    const long orow0 = (long)(q0 + wid * 32);
    if (MODE == 1) {
#pragma unroll
        for (int d = 0; d < G::NVB; ++d)
#pragma unroll
            for (int q = 0; q < 4; ++q) ((f32x4*)td)[(wid * 16 + d * 4 + q) * 64 + lane] = (f32x4){o[d][4 * q] * rli[4 * q], o[d][4 * q + 1] * rli[4 * q + 1], o[d][4 * q + 2] * rli[4 * q + 2], o[d][4 * q + 3] * rli[4 * q + 3]};
    } else {
        if (MODE == 2) {
            float ssr[16];
#pragma unroll
            for (int d = 0; d < G::NVB; ++d)
#pragma unroll
                for (int q = 0; q < 4; ++q) { const f32x4 t4 = ((const f32x4*)td)[(wid * 16 + d * 4 + q) * 64 + lane];
#pragma unroll
                    for (int i = 0; i < 4; ++i) o[d][4 * q + i] = t4[i] - lam * (o[d][4 * q + i] * rli[4 * q + i]); }
#pragma unroll
            for (int r = 0; r < 16; ++r) { float ss = 0.f;
#pragma unroll
                for (int d = 0; d < G::NVB; ++d) { const float v = o[d][r]; ss += v * v; }
                ss += DPPF(ss, 0xB1); ss += DPPF(ss, 0x4E); ss += DPPF(ss, 0x141); ss += DPPF(ss, 0x140); ss = swap16_sum(ss, ss);
                ssr[r] = rsqrtf(ss * (1.f / DV) + 1e-5f) * (1.f - LAMBDA_INIT); }
#pragma unroll
            for (int d = 0; d < G::NVB; ++d) { const float gv = gsub[d * 32 + r32];
#pragma unroll
                for (int r = 0; r < 16; ++r) o[d][r] *= ssr[r] * gv; }
#pragma unroll
            for (int r = 0; r < 16; ++r) rli[r] = 1.f;
        }
        asm volatile("s_waitcnt lgkmcnt(0)\n\ts_barrier" ::: "memory");
        LAS bf16_t* stg = (LAS bf16_t*)(shm + G::LDS_OST) + wid * 32 * DV;
#pragma unroll
        for (int r = 0; r < 16; ++r) { const int orow = crow(r, hi);
#pragma unroll
            for (int d = 0; d < G::NVB; ++d) stg[orow * DV + d * 32 + r32] = (bf16_t)(cvtpk_s(o[d][r] * rli[r], 0.f) & 0xffffu); }
        asm volatile("s_waitcnt lgkmcnt(0)" ::: "memory");
        constexpr int CPR = DV / 8;
        const __amdgpu_buffer_rsrc_t rO = __builtin_amdgcn_make_buffer_rsrc((void*)obase, 0, 0x7ffffff0, 0x00020000);
#pragma unroll
        for (int i = 0; i < 32 * CPR / 64; ++i) { const int idx = i * 64 + lane, row = idx / CPR, ch = idx % CPR; const u32x4 v = *(const LAS u32x4*)(stg + row * DV + ch * 8);
            __builtin_amdgcn_raw_buffer_store_b128(v, rO, (int)(((orow0 + row) * 1024 + ch * 8) * 2), 0, 16); }
    }
    __builtin_amdgcn_s_setprio(0);
    asm volatile("s_waitcnt vmcnt(0) lgkmcnt(0)\n\ts_barrier" ::: "memory");
    if (MODE != 1) { if (pubp && wid == 0 && lane == 0) (void)__hip_atomic_fetch_add(pubp, 1u, __ATOMIC_RELAXED, __HIP_MEMORY_SCOPE_AGENT); }
}
#undef SBAR
#undef WAIT_BAR0
}

__device__ __forceinline__ void attn_phase_all(Frame& F) {
    LAS char* shm = (LAS char*)(F.lds + RING_OFF);
    const int vcu = (F.bid & 7) * (F.G >> 3) + (F.bid >> 3);
    float lam; { const float* l1 = F.a->in[IN_LQ1]; const float* k1 = F.a->in[IN_LK1]; const float* l2 = F.a->in[IN_LQ2]; const float* k2 = F.a->in[IN_LK2]; float s1 = 0.f, s2 = 0.f;
        for (int i = 0; i < 64; ++i) { s1 += l1[i] * k1[i]; s2 += l2[i] * k2[i]; } lam = __expf(s1) - __expf(s2) + LAMBDA_INIT; }
    { PHASE_IDS(); (void)wave; const int bm = (vcu >> 1) >> 3, bd = (vcu >> 2) >> 2;
      if (tid < 8) PG8_DEP_SPIN(F.ctl + CW_DONE2K + bm * 8 + tid, 4u);
      else if (tid < 16) PG8_DEP_SPIN(F.ctl + CW_DONE2Q + bm * 8 + (tid - 8), 3u);
      else if (tid < 24) PG8_DEP_SPIN(F.ctl + CW_DONE1 + bd * 8 + (tid - 16), 8u);
      __syncthreads(); }
    const bf16_t* QM = (const bf16_t*)(F.a->ws + WS_QM); const bf16_t* KVM = (const bf16_t*)(F.a->ws + WS_KVM); const bf16_t* PR = (const bf16_t*)(F.a->ws + WS_PROJ); bf16_t* ATT = (bf16_t*)(F.a->ws + WS_ATT);
    { const int p = vcu >> 1, b = p >> 3, h = p & 7, half = vcu & 1; const long r0 = (long)b * S;
      att::Src sc{QM + r0 * 768 + h * 64, QM + r0 * 768 + 512 + h * 32, 768, KVM + r0 * 1024 + h * 128, PR + r0 * PJ + PC_KR, 1024, PJ, KVM + r0 * 1024 + h * 128 + 64, 1024};
      for (int i = 0; i < 4; ++i) { const int qb = half == 0 ? (i == 0 ? 7 : i == 1 ? 5 : i == 2 ? 2 : 0) : (i == 0 ? 6 : i == 1 ? 4 : i == 2 ? 3 : 1);
#ifdef LEAK_UNIT
          if (i == LEAK_UNIT && threadIdx.x == 0) F.MISC[16] = (unsigned)__builtin_amdgcn_s_memrealtime();
#endif
          att::attn_unit<96, 64, 0>(shm, sc, qb, ATT + r0 * 1024 + h * 64, nullptr, 0.f, nullptr, F.wv, F.ctl + CW_DONEA + b * 8 + qb);
#ifdef LEAK_UNIT
          if (i == LEAK_UNIT && threadIdx.x == 0) F.MISC[17] = (unsigned)__builtin_amdgcn_s_memrealtime();
#endif
      } }
    { const int p = vcu >> 2, b = p >> 2, h = p & 3, s4 = vcu & 3; const long r0 = (long)b * S;
      for (int i = 0; i < 2; ++i) { const int qb = i == 0 ? 7 - s4 : s4;
          float* td = (float*)(F.a->ws + WS_TD) + ((size_t)(p * 8 + qb) << 15);
          att::Src s0{PR + r0 * PJ + PC_QD + (2 * h) * 64, nullptr, PJ, PR + r0 * PJ + PC_KD + (2 * h) * 64, nullptr, PJ, PJ, PR + r0 * PJ + PC_VD + h * 128, PJ};
          att::Src s1{PR + r0 * PJ + PC_QD + (2 * h + 1) * 64, nullptr, PJ, PR + r0 * PJ + PC_KD + (2 * h + 1) * 64, nullptr, PJ, PJ, PR + r0 * PJ + PC_VD + h * 128, PJ};
          att::attn_unit<64, 128, 1>(shm, s0, qb, nullptr, td, 0.f, nullptr, F.wv, nullptr);
          att::attn_unit<64, 128, 2>(shm, s1, qb, ATT + r0 * 1024 + 512 + h * 128, td, lam, F.a->in[IN_GSUBLN], F.wv, F.ctl + CW_DONEA + b * 8 + qb); } }
}
__device__ __forceinline__ void offsets_from_counts(Frame& F) {
    PHASE_IDS();
    int* cnt = (int*)(F.a->ws + WS_CNT);
    LAS int* part = (LAS int*)(F.lds + RING_OFF);
    LAS int* tile_e = (LAS int*)(F.lds + X_TILEE); LAS int* m2 = (LAS int*)(F.lds + X_MISC2);
    { const int e = tid & 31, p = tid >> 5; int tot = 0, pre = 0;
      for (int w = p * 16; w < p * 16 + 16; ++w) { const int c = __hip_atomic_load(cnt + w * NE + e, RLX_AGENT); tot += c; if (w < F.bid) pre += c; }
      part[(p * 32 + e) * 2] = tot; part[(p * 32 + e) * 2 + 1] = pre; }
    __syncthreads();
    if (tid < NE) { int tot = 0, pre = 0; for (int p = 0; p < 16; ++p) { tot += part[(p * 32 + tid) * 2]; pre += part[(p * 32 + tid) * 2 + 1]; } m2[96 + tid] = tot; m2[64 + tid] = pre; }
    __syncthreads();
    if (tid < NE) { int st = 0; for (int e = 0; e < tid; ++e) st += (m2[96 + e] + 255) & ~255; m2[32 + tid] = st; const int pad = (m2[96 + tid] + 255) & ~255;
        for (int r = st; r < st + pad; r += 256) tile_e[r >> 8] = tid; if (tid == NE - 1) m2[0] = (st + pad) >> 8; }
    __syncthreads();
}
__device__ __forceinline__ void p6_scatter(Frame& F) {
    { PHASE_IDS(); (void)wave; for (int w = tid; w < F.G; w += NWAVES * 64) PG8_DEP_SPIN(F.ctl + CW_P5FLAG + w, 1u); __syncthreads(); }
    offsets_from_counts(F);
    PHASE_IDS();
    LAS int* m2 = (LAS int*)(F.lds + X_MISC2);
    int* rowtok = (int*)(F.a->ws + WS_ROWTOK); float* roww = (float*)(F.a->ws + WS_ROWW); int* pos = (int*)(F.a->ws + WS_POS);
    { const int e = ((const LAS int*)(F.lds + X_SE))[tid]; const float gt = ((const LAS float*)(F.lds + X_SG))[tid]; const int rk = ((const LAS int*)(F.lds + X_SRANK))[tid];
      const int dst = m2[32 + e] + m2[64 + e] + rk, tok = F.bid * 128 + (tid >> 2);
      rowtok[dst] = tok; roww[dst] = gt; pos[tok * 4 + (tid & 3)] = dst; }
    if (F.bid < NE && tid < 256) { const int e = F.bid, tot = m2[96 + e], st = m2[32 + e], pad = (tot + 255) & ~255; const int r = st + tot + tid; if (r < st + pad) { rowtok[r] = 0; roww[r] = 0.f; } }
}

#ifdef DEV_NAIVE_ATTN
template <int MODE>
__global__ void __launch_bounds__(256) k_attn_ref(const bf16_t* QM, const bf16_t* KVM, const bf16_t* PROJ, bf16_t* ATT, float* TD, const float* lq1, const float* lk1, const float* lq2, const float* lk2, const float* gsub) {
    constexpr int DQK = MODE == 0 ? 96 : 64, DV = MODE == 0 ? 64 : 128, NH = MODE == 0 ? 8 : 4;
    __shared__ float Ks[32][DQK]; __shared__ float Vs[32][DV];
    const int bh = blockIdx.y, b = bh / NH, h = bh % NH, q = blockIdx.x * 256 + threadIdx.x, tid = threadIdx.x, t = b * S + q;
    float lam = 0.f;
    if (MODE == 1) { float s1 = 0.f, s2 = 0.f; for (int i = 0; i < 64; ++i) { s1 += lq1[i] * lk1[i]; s2 += lq2[i] * lk2[i]; } lam = expf(s1) - expf(s2) + LAMBDA_INIT; }
    float res[DV];
    for (int j = 0; j < (MODE == 0 ? 1 : 2); ++j) {
        float qv[DQK]; float o[DV];
#pragma unroll
        for (int d = 0; d < DQK; ++d) qv[d] = MODE == 0 ? bf2f(QM[(size_t)t * 768 + (d < 64 ? h * 64 + d : 512 + h * 32 + d - 64)]) : bf2f(PROJ[(size_t)t * PJ + PC_QD + (2 * h + j) * 64 + d]);
#pragma unroll
        for (int d = 0; d < DV; ++d) o[d] = 0.f;
        float m = -1e30f, l = 0.f;
        const int kend = blockIdx.x * 256 + 256;
        for (int k0 = 0; k0 < kend; k0 += 32) {
            __syncthreads();
            for (int i = tid; i < 32 * DQK; i += 256) { const int kk = i / DQK, d = i % DQK; const size_t tk = (size_t)b * S + k0 + kk;
                Ks[kk][d] = MODE == 0 ? (d < 64 ? bf2f(KVM[tk * 1024 + h * 128 + d]) : bf2f(PROJ[tk * PJ + PC_KR + d - 64])) : bf2f(PROJ[tk * PJ + PC_KD + (2 * h + j) * 64 + d]); }
            for (int i = tid; i < 32 * DV; i += 256) { const int kk = i / DV, d = i % DV; const size_t tk = (size_t)b * S + k0 + kk;
                Vs[kk][d] = MODE == 0 ? bf2f(KVM[tk * 1024 + h * 128 + 64 + d]) : bf2f(PROJ[tk * PJ + PC_VD + h * 128 + d]); }
            __syncthreads();
            for (int kk = 0; kk < 32; ++kk) {
                if (k0 + kk > q) break;
                float s = 0.f;
#pragma unroll
                for (int d = 0; d < DQK; ++d) s += qv[d] * Ks[kk][d];
                const float mn = fmaxf(m, s), al = exp2f(m - mn), p = exp2f(s - mn);
                l = l * al + p; m = mn;
#pragma unroll
                for (int d = 0; d < DV; ++d) o[d] = o[d] * al + p * Vs[kk][d];
            }
        }
        const float inv = 1.f / l;
        if (MODE == 0) {
#pragma unroll
            for (int d = 0; d < DV; ++d) ATT[(size_t)t * D + h * 64 + d] = (bf16_t)(cvt_pk_bf16(o[d] * inv, 0.f) & 0xffffu);
        } else if (j == 0) {
#pragma unroll
            for (int d = 0; d < DV; ++d) TD[((size_t)t * 4 + h) * 128 + d] = o[d] * inv;
        } else { float ss = 0.f;
#pragma unroll
            for (int d = 0; d < DV; ++d) { res[d] = TD[((size_t)t * 4 + h) * 128 + d] - lam * (o[d] * inv); ss += res[d] * res[d]; }
            const float r = rsqrtf(ss * (1.f / 128.f) + 1e-5f) * (1.f - LAMBDA_INIT);
#pragma unroll
            for (int d = 0; d < DV; ++d) ATT[(size_t)t * D + 512 + h * 128 + d] = (bf16_t)(cvt_pk_bf16(res[d] * r * gsub[d], 0.f) & 0xffffu);
        }
    }
}
#endif

constexpr int N_PHASES = 11;
__global__ void __launch_bounds__(NWAVES * 64, 2) mk_fwd(Args args) {
    extern __shared__ __attribute__((aligned(16))) unsigned char lds[];
    Frame F;
    F.lds = (LAS unsigned char*)lds; F.MISC = (volatile LAS unsigned*)(F.lds + MISC_OFF);
    F.G = gridDim.x; F.bid = blockIdx.x; F.wv = __builtin_amdgcn_readfirstlane((int)(threadIdx.x >> 6));
    F.a = &args; F.ctl = (unsigned*)(args.ws + WS_CTL);
    for (int u = threadIdx.x; u < (X_TILEE - LDSCTL_OFF) / 4; u += NWAVES * 64) ((LAS unsigned*)(F.lds + LDSCTL_OFF))[u] = 0u;
    __syncthreads();
    const int lo = args.ph_lo, hi = args.ph_hi;
#ifdef LEAK_LO
    if (LEAK_LO == 0 && threadIdx.x == 0) F.MISC[16] = (unsigned)__builtin_amdgcn_s_memrealtime();
#endif
    XcdBarrier bar; bar.bar = F.ctl + CW_BAR; bar.x = 0; bar.st = nullptr; bar.wv = F.wv;
    if (hi - lo > 1) bar = xcd_barrier_post(F.ctl + CW_BAR + args.li * XCD_BAR_WORDS, F.MISC + 8, F.wv);
#ifndef PH_MASK
#define PH_MASK 0x7ff
#endif
#define IN(k) (((PH_MASK >> (k)) & 1) && lo <= (k) && (k) < hi)
#ifdef LEAK_LO
#define SEAM(k) do { if (IN(k) && IN((k) + 1)) xcd_barrier(bar); if (((k) + 1 == LEAK_LO || (k) + 1 == LEAK_HI) && threadIdx.x == 0) F.MISC[(k) + 1 == LEAK_LO ? 16 : 17] = (unsigned)__builtin_amdgcn_s_memrealtime(); } while (0)
#else
#define SEAM(k) do { if (IN(k) && IN((k) + 1)) xcd_barrier(bar); } while (0)
#endif
    LAS unsigned char* ring = F.lds + RING_OFF;
    if (IN(0)) { p0_prologue(F); }
    if (IN(1)) { p0b_norm(F); } SEAM(1);
    if (IN(2)) {
        pg8::Gemm g{(const bf16_t*)(F.a->ws + WS_H), (const bf16_t*)(F.a->ws + WS_WIN), nullptr, 0, 512, 512, 512, 0}; pg8::StaticOrder So; So.init(T, PJ, F.G, F.bid);
        epi::EpiProj E{(bf16_t*)(F.a->ws + WS_PROJ), (const f32x4*)(F.a->ws + WS_TABM), (const f32x4*)(F.a->ws + WS_TABD), (float*)(F.a->ws + WS_SSQ), (float*)(F.a->ws + WS_SSQ) + T, F.ctl + CW_DONE1};
        pg8::gemm_phase<epi::EpiProj, pg8::StaticOrder, false, true>(ring, g, So, E, F.wv);
    }
    if (IN(3)) {
#ifndef NO_Q
        { pg8::Gemm g{(const bf16_t*)(F.a->ws + WS_PROJ) + PC_CQ, (const bf16_t*)(F.a->ws + WS_WQB), nullptr, 0, PJ, 256, 256, 0}; pg8::StaticOrder So; So.init(T, 768, F.G, F.bid);
          epi::EpiQ E{(bf16_t*)(F.a->ws + WS_QM), (const f32x4*)(F.a->ws + WS_TABM), (const float*)(F.a->ws + WS_SSQ), F.ctl + CW_DONE1, 8u, F.ctl + CW_DONE2Q};
          pg8::gemm_phase<epi::EpiQ, pg8::StaticOrder, false>(ring, g, So, E, F.wv, nullptr, F.lds + X_EPL); }
#endif
#ifndef NO_KV
        { pg8::Gemm g{(const bf16_t*)(F.a->ws + WS_PROJ) + PC_CKV, (const bf16_t*)(F.a->ws + WS_WKVB), nullptr, 0, PJ, 128, 128, 0}; pg8::StaticOrder So; So.init(T, 1024, F.G, F.bid);
          epi::EpiKV E{(bf16_t*)(F.a->ws + WS_KVM), (const float*)(F.a->ws + WS_SSQ) + T, F.ctl + CW_DONE1, 8u, F.ctl + CW_DONE2K};
          pg8::gemm_phase<epi::EpiKV, pg8::StaticOrder, false>(ring, g, So, E, F.wv, nullptr, F.lds + X_EPL); }
#endif
    }
    if (IN(4)) {
#ifndef DEV_NAIVE_ATTN
        attn_phase_all(F);
#endif
    }
    if (IN(5)) {
        pg8::Gemm g{(const bf16_t*)(F.a->ws + WS_ATT), (const bf16_t*)(F.a->ws + WS_WO), nullptr, 0, D, D, D, 0}; pg8::StaticOrder So; So.init(T, D, F.G, F.bid);
        epi::EpiY E{(bf16_t*)(F.a->ws + WS_Y), F.ctl + CW_DONE4, F.ctl + CW_DONEA, 12u};
        pg8::gemm_phase<epi::EpiY, pg8::StaticOrder, false>(ring, g, So, E, F.wv);
        if (IN(6)) p5_stage_router(F);
    }
    if (IN(6)) { if (!IN(5)) { p5_stage_router(F); } p5_rows(F); }
    if (IN(7)) { p6_scatter(F); } SEAM(7);
    if (IN(8)) {
        if (!IN(7)) offsets_from_counts(F);
        pg8::GroupedOrder So{(const LAS int*)(F.lds + X_TILEE), __builtin_amdgcn_readfirstlane(((LAS int*)(F.lds + X_MISC2))[0]), 8, F.G, F.bid, 0};
        pg8::Gemm g{(const bf16_t*)(F.a->ws + WS_H), (const bf16_t*)(F.a->ws + WS_WGU), (const int*)(F.a->ws + WS_ROWTOK), (size_t)2048 * 512, 512, 512, 512, 0};
        epi::EpiAct E{(unsigned char*)(F.a->ws + WS_ACT), F.a->in[IN_BGU], F.ctl + CW_DONE};
        pg8::gemm_phase<epi::EpiAct, pg8::GroupedOrder, true, true>(ring, g, So, E, F.wv, F.lds + X_IDX, F.lds + X_EPL);
    }
    if (IN(9)) {
        if (!IN(7)) offsets_from_counts(F);
        pg8::GroupedOrder So{(const LAS int*)(F.lds + X_TILEE), __builtin_amdgcn_readfirstlane(((LAS int*)(F.lds + X_MISC2))[0]), 4, F.G, F.bid, 7};
        pg8::Gemm g{(const bf16_t*)(F.a->ws + WS_ACT), (const bf16_t*)(F.a->ws + WS_WD), nullptr, (size_t)1024 * 512, 512, 512, 512, 0};
        epi::EpiDown E{(unsigned char*)(F.a->ws + WS_YR), F.a->in[IN_BDN], (const float*)(F.a->ws + WS_ROWW), 8u, F.ctl + CW_DONE};
        pg8::gemm_phase<epi::EpiDown, pg8::GroupedOrder, false, true>(ring, g, So, E, F.wv, nullptr, F.lds + X_EPL);
    } SEAM(9);
    if (IN(10)) { p9_final(F); }
#ifdef LEAK_LO
    if (blockIdx.x == 0 && threadIdx.x == 0) { if (LEAK_HI == 11) F.MISC[17] = (unsigned)__builtin_amdgcn_s_memrealtime(); asm volatile("s_waitcnt vmcnt(0) lgkmcnt(0)" ::: "memory"); args.out[0] += (float)(F.MISC[17] - F.MISC[16]) * LEAK_SCALE; }
#endif
#undef IN
#undef SEAM
}

extern "C" void kernel_launch(void* const* d_in, const int* in_sizes, int n_in, void* d_out, int out_size, void* d_ws, size_t ws_size, hipStream_t stream) {
    static int grid = 0;
    if (grid == 0) {
        if (n_in != 26 || in_sizes[0] != T * D || out_size != T * D || ws_size < WS_END) { fprintf(stderr, "kernel_launch: unexpected shapes (n_in %d, ws %zu); nothing launched\n", n_in, ws_size); grid = -1; return; }
        int dev = 0, cus = 0;
        if (hipGetDevice(&dev) != hipSuccess || hipDeviceGetAttribute(&cus, hipDeviceAttributeMultiprocessorCount, dev) != hipSuccess) { grid = -1; return; }
        if (hipFuncSetAttribute((const void*)mk_fwd, hipFuncAttributeMaxDynamicSharedMemorySize, LDS_BYTES) != hipSuccess) { fprintf(stderr, "kernel_launch: hipFuncSetAttribute failed\n"); grid = -1; return; }
        grid = cus;
        if (grid != 256) fprintf(stderr, "kernel_launch: %d CUs; this kernel is built for 256\n", grid);
    }
    if (grid < 0) return;
    (void)hipMemsetAsync((char*)d_ws + WS_CTL, 0, CTL_ZERO_BYTES, stream);
    Args a{};
    for (int i = 0; i < 26; ++i) a.in[i] = (const float*)d_in[i];
    a.out = (float*)d_out; a.ws = (unsigned char*)d_ws;
#ifndef MK_CUTS
#define MK_CUTS {0, N_PHASES}
#endif
    const int cuts[] = MK_CUTS; const int ncut = (int)(sizeof(cuts) / sizeof(int)) - 1;
    for (int li = 0; li < ncut; ++li) {
        a.ph_lo = cuts[li]; a.ph_hi = cuts[li + 1]; a.li = li;
        hipLaunchKernelGGL(mk_fwd, dim3(grid), dim3(NWAVES * 64), LDS_BYTES, stream, a);
#ifdef DEV_NAIVE_ATTN
        if (cuts[li + 1] == 5) {
            unsigned char* ws = (unsigned char*)d_ws;
            k_attn_ref<0><<<dim3(S / 256, NB * 8), 256, 0, stream>>>((const bf16_t*)(ws + WS_QM), (const bf16_t*)(ws + WS_KVM), (const bf16_t*)(ws + WS_PROJ), (bf16_t*)(ws + WS_ATT), nullptr, nullptr, nullptr, nullptr, nullptr, nullptr);
            k_attn_ref<1><<<dim3(S / 256, NB * 4), 256, 0, stream>>>((const bf16_t*)(ws + WS_QM), (const bf16_t*)(ws + WS_KVM), (const bf16_t*)(ws + WS_PROJ), (bf16_t*)(ws + WS_ATT), (float*)(ws + WS_Y),
                (const float*)d_in[IN_LQ1], (const float*)d_in[IN_LK1], (const float*)d_in[IN_LQ2], (const float*)d_in[IN_LK2], (const float*)d_in[IN_GSUBLN]);
        }
#endif
    }
}
```
